# Optimizing an MI355X kernel written in HIP

```python
import jax, jax.numpy as jnp
from jax import lax
import numpy as np

D_MODEL = 2048
BATCH = 1
SEQ = 8192
DEPTH = 4
DEC_BATCH = 8
DEC_SEQ = 64
PAST_LEN = 1024

CHUNK = 64
Q_BLOCK = 128
N_MIXERS = 3
HEAD_DIM = 128
ATTN_HEADS = 12
ATTN_W = ATTN_HEADS * HEAD_DIM
N_MEM = 256
MEM_HEADS = 4
MEM_W = MEM_HEADS * HEAD_DIM
GLA_HEADS = 4
GLA_DK = 192
GLA_DV = 384
GLA_KW = GLA_HEADS * GLA_DK
GLA_VW = GLA_HEADS * GLA_DV
GLA_RANK = 16
GLA_GATE_TEMP = 16.0
D_FF = 4 * D_MODEL
RMS_EPS = 1e-6
FOX_COLS = (ATTN_W, ATTN_W, ATTN_W, ATTN_HEADS, MEM_W)
SB_COLS = (ATTN_W, ATTN_W, ATTN_W, MEM_W)
GLA_COLS = (GLA_KW, GLA_KW, GLA_VW, GLA_VW, GLA_RANK, MEM_W)
N_FOX = len(range(0, DEPTH, N_MIXERS))
N_SB = len(range(1, DEPTH, N_MIXERS))
N_GLA = len(range(2, DEPTH, N_MIXERS))

kernel_name = 'hybrid_fox_sb_gla_streaming_step'


def rmsnorm(x, g):
    xf = x.astype(jnp.float32)
    y = xf * lax.rsqrt(jnp.mean(jnp.square(xf), axis=-1, keepdims=True) + RMS_EPS)
    return (y * g.astype(jnp.float32)).astype(x.dtype)


def split_cols(z, sizes):
    return jnp.split(z, [int(c) for c in np.cumsum(sizes)[:-1]], axis=-1)


def heads(a, n, d):
    return a.reshape(a.shape[0], a.shape[1], n, d)


def query_blocks(a, nb):
    return jnp.swapaxes(a.reshape(a.shape[0], nb, Q_BLOCK, *a.shape[2:]), 0, 1)


def unblock(a):
    return jnp.swapaxes(a, 0, 1).reshape(a.shape[1], -1, *a.shape[3:])


def fox_attend(q, k, v, fq, fk, q_pos, k_pos):
    s = jnp.einsum('bqhd,bkhd->bhqk', q, k, preferred_element_type=jnp.float32) * (HEAD_DIM ** -0.5)
    bias = jnp.swapaxes(fq, 1, 2)[:, :, :, None] - jnp.swapaxes(fk, 1, 2)[:, :, None, :]
    s = jnp.where(k_pos[None, :] <= q_pos[:, None], s + bias, -jnp.inf)
    p = jax.nn.softmax(s, axis=-1)
    return jnp.einsum('bhqk,bkhd->bqhd', p.astype(v.dtype), v)


def sb_attend(q, k, v, q_pos, k_pos):
    z = jnp.einsum('bqhd,bkhd->bhqk', q, k, preferred_element_type=jnp.float32) * (HEAD_DIM ** -0.5)
    mask = k_pos[None, :] < q_pos[:, None]
    sp = jnp.where(mask, jax.nn.softplus(z), 0.0)
    after = lax.cumsum(sp, axis=3, reverse=True) - sp
    a = jnp.where(mask, jnp.exp(jax.nn.log_sigmoid(z) - after), 0.0)
    return jnp.einsum('bhqk,bkhd->bqhd', a.astype(v.dtype), v)


def fox_mixer(h, w_in, b_f, past):
    B, T, _ = h.shape
    q, k, v, f_logit, q_mem = split_cols(h @ w_in, FOX_COLS)
    q, k, v = (heads(a, ATTN_HEADS, HEAD_DIM) for a in (q, k, v))
    logf = jax.nn.log_sigmoid((f_logit + b_f).astype(jnp.float32))
    if past is None:
        F = jnp.cumsum(logf, axis=1)
        pos = jnp.arange(T)
        nb = T // Q_BLOCK

        def block(args):
            qb, fb, pb = args
            return fox_attend(qb, k, v, fb, F, pb, pos)

        o = unblock(lax.map(block, (query_blocks(q, nb), query_blocks(F, nb), pos.reshape(nb, Q_BLOCK))))
    else:
        pk, pv, plogf = past
        P = pk.shape[1]
        F = jnp.cumsum(jnp.concatenate([plogf.astype(jnp.float32), logf], axis=1), axis=1)
        o = fox_attend(q, jnp.concatenate([pk, k], axis=1), jnp.concatenate([pv, v], axis=1),
                       F[:, P:], F, P + jnp.arange(T), jnp.arange(P + T))
    return o.reshape(B, T, ATTN_W), q_mem, (k, v, logf.astype(h.dtype))


def sb_mixer(h, w_in, past):
    B, T, _ = h.shape
    q, k, v, q_mem = split_cols(h @ w_in, SB_COLS)
    q, k, v = (heads(a, ATTN_HEADS, HEAD_DIM) for a in (q, k, v))
    if past is None:
        pos = jnp.arange(T)
        nb = T // Q_BLOCK

        def block(args):
            qb, pb = args
            return sb_attend(qb, k, v, pb, pos)

        o = unblock(lax.map(block, (query_blocks(q, nb), pos.reshape(nb, Q_BLOCK))))
    else:
        pk, pv = past
        P = pk.shape[1]
        o = sb_attend(q, jnp.concatenate([pk, k], axis=1), jnp.concatenate([pv, v], axis=1),
                      P + jnp.arange(T), jnp.arange(P + T))
    return o.reshape(B, T, ATTN_W), q_mem, (k, v)


def gla_recurrence(q, k, v, log_a, S0):
    B, T, H, dk = q.shape
    C = min(CHUNK, T)
    n = T // C
    causal = jnp.tril(jnp.ones((C, C), dtype=bool))[None, :, :, None, None]

    def chunks(a):
        return jnp.swapaxes(a.astype(jnp.float32).reshape(B, n, C, *a.shape[2:]), 0, 1)

    def step(S, xs):
        qc, kc, vc, gc = xs
        G = jnp.cumsum(gc, axis=1)
        o_inter = jnp.einsum('bthk,bhkv->bthv', qc * jnp.exp(G), S)
        decay = jnp.exp(jnp.where(causal, G[:, :, None] - G[:, None, :], -jnp.inf))
        A = jnp.einsum('bthk,bshk,btshk->bhts', qc, kc, decay)
        o_intra = jnp.einsum('bhts,bshv->bthv', A, vc)
        G_last = G[:, -1]
        S_new = jnp.exp(G_last)[..., None] * S + jnp.einsum(
            'bshk,bshv->bhkv', kc * jnp.exp(G_last[:, None] - G), vc)
        return S_new, o_inter + o_intra

    S, o = lax.scan(step, S0.astype(jnp.float32), (chunks(q), chunks(k), chunks(v), chunks(log_a)))
    return unblock(o), S.astype(S0.dtype)


def gla_mixer(h, w_in, w_gate2, b_gate, b_r, norm_g, S0):
    B, T, _ = h.shape
    q, k, v, r, g_low, q_mem = split_cols(h @ w_in, GLA_COLS)
    log_a = jax.nn.log_sigmoid((g_low @ w_gate2 + b_gate).astype(jnp.float32)) / GLA_GATE_TEMP
    o, S = gla_recurrence(heads(q, GLA_HEADS, GLA_DK) * (GLA_DK ** -0.5), heads(k, GLA_HEADS, GLA_DK),
                          heads(v, GLA_HEADS, GLA_DV), heads(log_a, GLA_HEADS, GLA_DK), S0)
    o = rmsnorm(o.astype(h.dtype), norm_g).reshape(B, T, GLA_VW) * jax.nn.silu(r + b_r)
    return o, q_mem, S


def memory_kv(mem, g, w_kv):
    B, M, _ = mem.shape
    mk, mv = jnp.split(rmsnorm(mem, g) @ w_kv, 2, axis=-1)
    return mk.reshape(B, M, MEM_HEADS, HEAD_DIM), mv.reshape(B, M, MEM_HEADS, HEAD_DIM)


def memory_attend(q_mem, mk, mv):
    B, T, _ = q_mem.shape
    q = heads(q_mem, MEM_HEADS, HEAD_DIM)
    s = jnp.einsum('bqhd,bmhd->bhqm', q, mk, preferred_element_type=jnp.float32) * (HEAD_DIM ** -0.5)
    p = jax.nn.softmax(s, axis=-1)
    return jnp.einsum('bhqm,bmhd->bqhd', p.astype(mv.dtype), mv).reshape(B, T, MEM_W)


def squared_relu_mlp(h, w_up, w_down):
    return jnp.square(jax.nn.relu(h @ w_up)) @ w_down


def setup_inputs(seed: int = 0) -> dict:
    key = jax.random.key(seed)
    ks = jax.random.split(key, 32)
    D = D_MODEL

    def nrm(i, shape, scale):
        return jax.random.normal(ks[i], shape, jnp.float32) * scale

    return {
        'x_prompt': nrm(0, (BATCH, SEQ, D), 1.0),
        'x_sample': nrm(1, (DEC_BATCH, DEC_SEQ, D), 1.0),
        'cache_fox_k': nrm(2, (N_FOX, DEC_BATCH, PAST_LEN, ATTN_HEADS, HEAD_DIM), 1.0),
        'cache_fox_v': nrm(3, (N_FOX, DEC_BATCH, PAST_LEN, ATTN_HEADS, HEAD_DIM), 1.0),
        'cache_fox_logf': jax.nn.log_sigmoid(2.0 + nrm(4, (N_FOX, DEC_BATCH, PAST_LEN, ATTN_HEADS), 1.0)),
        'cache_sb_k': nrm(5, (N_SB, DEC_BATCH, PAST_LEN, ATTN_HEADS, HEAD_DIM), 1.0),
        'cache_sb_v': nrm(6, (N_SB, DEC_BATCH, PAST_LEN, ATTN_HEADS, HEAD_DIM), 1.0),
        'state_gla': nrm(7, (N_GLA, DEC_BATCH, GLA_HEADS, GLA_DK, GLA_DV), 0.5),
        'cache_mem_k': nrm(8, (DEPTH, DEC_BATCH, N_MEM, MEM_HEADS, HEAD_DIM), 1.0),
        'cache_mem_v': nrm(9, (DEPTH, DEC_BATCH, N_MEM, MEM_HEADS, HEAD_DIM), 1.0),
        'mem_prompt': nrm(10, (BATCH, N_MEM, D), 1.0),
        'norm_mix_g': 1.0 + nrm(11, (DEPTH, D), 0.02),
        'norm_mlp_g': 1.0 + nrm(12, (DEPTH, D), 0.02),
        'norm_mem_g': 1.0 + nrm(13, (DEPTH, D), 0.02),
        'norm_final_g': 1.0 + nrm(14, (D,), 0.02),
        'w_mem_kv': nrm(15, (DEPTH, D, 2 * MEM_W), D ** -0.5),
        'w_in_fox': nrm(16, (N_FOX, D, sum(FOX_COLS)), D ** -0.5),
        'b_forget': jax.random.uniform(ks[17], (N_FOX, ATTN_HEADS), jnp.float32, 0.0, 4.0),
        'w_out_fox': nrm(18, (N_FOX, ATTN_W + MEM_W, D), (ATTN_W + MEM_W) ** -0.5),
        'w_in_sb': nrm(19, (N_SB, D, sum(SB_COLS)), D ** -0.5),
        'w_out_sb': nrm(20, (N_SB, ATTN_W + MEM_W, D), (ATTN_W + MEM_W) ** -0.5),
        'w_in_gla': nrm(21, (N_GLA, D, sum(GLA_COLS)), D ** -0.5),
        'w_gate2_gla': nrm(22, (N_GLA, GLA_RANK, GLA_KW), GLA_RANK ** -0.5),
        'b_gate_gla': nrm(23, (N_GLA, GLA_KW), 0.1),
        'b_outgate_gla': nrm(24, (N_GLA, GLA_VW), 0.02),
        'norm_gla_g': 1.0 + nrm(25, (N_GLA, GLA_HEADS, GLA_DV), 0.02),
        'w_out_gla': nrm(26, (N_GLA, GLA_VW + MEM_W, D), (GLA_VW + MEM_W) ** -0.5),
        'w_up': nrm(27, (DEPTH, D, D_FF), D ** -0.5),
        'w_down': nrm(28, (DEPTH, D_FF, D), D_FF ** -0.5),
    }


def reference(x_prompt, x_sample, cache_fox_k, cache_fox_v, cache_fox_logf, cache_sb_k, cache_sb_v,
              state_gla, cache_mem_k, cache_mem_v, mem_prompt, norm_mix_g, norm_mlp_g, norm_mem_g,
              norm_final_g, w_mem_kv, w_in_fox, b_forget, w_out_fox, w_in_sb, w_out_sb, w_in_gla,
              w_gate2_gla, b_gate_gla, b_outgate_gla, norm_gla_g, w_out_gla, w_up, w_down):

    def trunk(x, sample):
        fox_st, sb_st, gla_st, mem_st = [], [], [], []
        for i in range(DEPTH):
            kind, j = i % N_MIXERS, i // N_MIXERS
            h = rmsnorm(x, norm_mix_g[i])
            if sample:
                mk, mv = cache_mem_k[i], cache_mem_v[i]
            else:
                mk, mv = memory_kv(mem_prompt, norm_mem_g[i], w_mem_kv[i])
                mem_st.append((mk, mv))
            if kind == 0:
                past = (cache_fox_k[j], cache_fox_v[j], cache_fox_logf[j]) if sample else None
                o, q_mem, st = fox_mixer(h, w_in_fox[j], b_forget[j], past)
                fox_st.append(st)
                w_out = w_out_fox[j]
            elif kind == 1:
                past = (cache_sb_k[j], cache_sb_v[j]) if sample else None
                o, q_mem, st = sb_mixer(h, w_in_sb[j], past)
                sb_st.append(st)
                w_out = w_out_sb[j]
            else:
                S0 = state_gla[j] if sample else jnp.zeros((x.shape[0], GLA_HEADS, GLA_DK, GLA_DV), x.dtype)
                o, q_mem, st = gla_mixer(h, w_in_gla[j], w_gate2_gla[j], b_gate_gla[j], b_outgate_gla[j],
                                         norm_gla_g[j], S0)
                gla_st.append(st)
                w_out = w_out_gla[j]
            x = x + jnp.concatenate([o, memory_attend(q_mem, mk, mv)], axis=-1) @ w_out
            x = x + squared_relu_mlp(rmsnorm(x, norm_mlp_g[i]), w_up[i], w_down[i])
        return rmsnorm(x, norm_final_g), fox_st, sb_st, gla_st, mem_st

    y_prompt, fox_p, sb_p, gla_p, mem_p = trunk(x_prompt, False)
    y_sample, fox_s, sb_s, gla_s, _ = trunk(x_sample, True)

    def stack(sts, n):
        return jnp.stack([st[n] for st in sts])

    return (y_prompt, y_sample,
            stack(fox_p, 0), stack(fox_p, 1), stack(fox_p, 2),
            stack(sb_p, 0), stack(sb_p, 1), jnp.stack(gla_p),
            stack(mem_p, 0), stack(mem_p, 1),
            stack(fox_s, 0), stack(fox_s, 1), stack(fox_s, 2),
            stack(sb_s, 0), stack(sb_s, 1), jnp.stack(gla_s))
```

```cpp
#include <hip/hip_runtime.h>
#include <hip/hip_bf16.h>
#include <cstdio>
#include <cstdint>

#define MK_PER_PHASE 1
#ifndef MK_PER_PHASE
#define MK_PER_PHASE 0
#endif

constexpr int DM = 2048, TP = 8192, TS = 512, MT = TP + TS, NB = 8, CSEQ = 64, PAST = 1024, SKS = PAST + CSEQ;
constexpr int HD = 128, NH = 12, AW = NH * HD, MEMW = 512, NMEM = 256, MH = 4;
constexpr int GH = 4, GDK = 192, GDV = 384, GKW = GH * GDK, GVW = GH * GDV, GRANK = 16;
constexpr int DFF = 8192, ZLD = 5376, NLAYER = 4;
constexpr int NCHUNK = TP / 64 + NB;
constexpr float RMS_EPS = 1e-6f;

constexpr size_t O_YP = 0;
constexpr size_t O_YS = O_YP + (size_t)TP * DM;
constexpr size_t O_FKP = O_YS + (size_t)TS * DM;
constexpr size_t O_FVP = O_FKP + (size_t)2 * TP * AW;
constexpr size_t O_FLP = O_FVP + (size_t)2 * TP * AW;
constexpr size_t O_SKP = O_FLP + (size_t)2 * TP * NH;
constexpr size_t O_SVP = O_SKP + (size_t)TP * AW;
constexpr size_t O_GSP = O_SVP + (size_t)TP * AW;
constexpr size_t O_MKP = O_GSP + (size_t)GH * GDK * GDV;
constexpr size_t O_MVP = O_MKP + (size_t)NLAYER * NMEM * MEMW;
constexpr size_t O_FKS = O_MVP + (size_t)NLAYER * NMEM * MEMW;
constexpr size_t O_FVS = O_FKS + (size_t)2 * TS * AW;
constexpr size_t O_FLS = O_FVS + (size_t)2 * TS * AW;
constexpr size_t O_SKS = O_FLS + (size_t)2 * TS * NH;
constexpr size_t O_SVS = O_SKS + (size_t)TS * AW;
constexpr size_t O_GSS = O_SVS + (size_t)TS * AW;
constexpr size_t O_END = O_GSS + (size_t)NB * GH * GDK * GDV;

constexpr size_t al256(size_t x) { return (x + 255) & ~(size_t)255; }
constexpr size_t WS_CTL = 0, CTL_BYTES = 2u << 20;
constexpr size_t WS_WIN = CTL_BYTES;
constexpr size_t WS_WOUT = WS_WIN + (size_t)NLAYER * ZLD * DM * 2;
constexpr size_t WS_WUP = WS_WOUT + (size_t)NLAYER * DM * DM * 2;
constexpr size_t WS_WDN = WS_WUP + (size_t)NLAYER * DFF * DM * 2;
constexpr size_t WS_WMKV = WS_WDN + (size_t)NLAYER * DM * DFF * 2;
constexpr size_t WS_X = WS_WMKV + (size_t)NLAYER * 1024 * DM * 2;
constexpr size_t WS_XB = WS_X + (size_t)MT * DM * 4;
constexpr size_t WS_Z = WS_XB + (size_t)MT * DM * 2;
constexpr size_t WS_OC = WS_Z + (size_t)MT * ZLD * 2;
constexpr size_t WS_U = WS_OC + (size_t)MT * DM * 2;
constexpr size_t WS_GU = WS_U + (size_t)MT * DFF * 2;
constexpr size_t WS_GDEC = WS_GU + (size_t)NCHUNK * GH * GDV * GDK * 4;
constexpr size_t WS_KVF = al256(WS_GDEC + (size_t)NCHUNK * GH * GDK * 4);
constexpr size_t KVS_ONE = (size_t)NB * SKS * AW * 2;
constexpr size_t WS_KVS = WS_KVF + 4 * KVS_ONE;
constexpr size_t WS_MEMC = WS_KVS + 2 * KVS_ONE;
constexpr size_t MEMC_ONE = (size_t)NB * NMEM * MEMW * 2;
constexpr size_t WS_MEMH = WS_MEMC + 8 * MEMC_ONE;
constexpr size_t WS_MKVB = WS_MEMH + (size_t)NLAYER * NMEM * DM * 2;
constexpr size_t WS_RSS = WS_MKVB + (size_t)NLAYER * NMEM * 1024 * 2;
constexpr size_t WS_END = WS_RSS + (size_t)2 * MT * 32 * 4;

constexpr int CW_BAR = 4096;

constexpr int LDS_WORK = 136 * 1024;
constexpr int MISC_OFF = LDS_WORK;
constexpr int LDS_BYTES = 147456;

#define GAS __attribute__((address_space(1)))
#define LAS __attribute__((address_space(3)))
typedef unsigned short bf16_t;
typedef unsigned u32x4 __attribute__((ext_vector_type(4)));
typedef unsigned u32x2 __attribute__((ext_vector_type(2)));
typedef float f32x4 __attribute__((ext_vector_type(4)));
typedef float f32x2 __attribute__((ext_vector_type(2)));
typedef float f32x16 __attribute__((ext_vector_type(16)));
typedef short bf16x8 __attribute__((ext_vector_type(8)));
typedef short s16x4 __attribute__((ext_vector_type(4)));
#define LDS_WAIT() asm volatile("s_waitcnt lgkmcnt(0)" ::: "memory")
#define VM_WAIT() asm volatile("s_waitcnt vmcnt(0)" ::: "memory")
#define SBAR() __builtin_amdgcn_sched_barrier(0)
__device__ __forceinline__ unsigned cvtpk(float lo, float hi) { unsigned r; asm volatile("v_cvt_pk_bf16_f32 %0, %1, %2" : "=v"(r) : "v"(lo), "v"(hi)); return r; }
__device__ __forceinline__ float bf2f(unsigned short b) { return __uint_as_float((unsigned)b << 16); }
__device__ __forceinline__ u32x4 pack8u(f32x4 a, f32x4 b) { u32x4 w = {cvtpk(a[0], a[1]), cvtpk(a[2], a[3]), cvtpk(b[0], b[1]), cvtpk(b[2], b[3])}; return w; }
__device__ __forceinline__ bf16x8 pack8(f32x4 a, f32x4 b) { u32x4 w = pack8u(a, b); return *reinterpret_cast<bf16x8*>(&w); }
__device__ __forceinline__ float wave_sum(float v) {
#pragma unroll
    for (int o = 1; o < 64; o <<= 1) v += __shfl_xor(v, o);
    return v;
}
__device__ __forceinline__ float log_sigmoidf(float x) { return fminf(x, 0.f) - log1pf(expf(-fabsf(x))); }
__device__ __forceinline__ int opaque_tid_w(int wave) { int l; asm volatile("v_mbcnt_lo_u32_b32 %0, -1, 0\n\tv_mbcnt_hi_u32_b32 %0, -1, %0" : "=v"(l)); return wave * 64 + l; }
#define opaque_tid() opaque_tid_w(g_wave)
template <class T> __device__ __forceinline__ T* launder_s(T* p) { asm volatile("" : "+s"(p)); return p; }
#define XB_TMO      128
#define XB_XCNT(j)  (256  + 64 * (j))
#define XB_XSUB(j)  (1280 + 64 * (j))
#define XB_XGEN(j)  (2304 + 64 * (j))
#define XB_TOP      3328
#define XB_TOPGEN   3392
#define XCD_BAR_WORDS 3456
#define XB_SPIN_CAP (1u << 18)
__device__ __forceinline__ unsigned xb_ld(unsigned* p)              { return __hip_atomic_load(p, __ATOMIC_RELAXED, __HIP_MEMORY_SCOPE_AGENT); }
__device__ __forceinline__ unsigned xb_add(unsigned* p, unsigned v) { return __hip_atomic_fetch_add(p, v, __ATOMIC_RELAXED, __HIP_MEMORY_SCOPE_AGENT); }
__device__ __forceinline__ unsigned xb_xcc_id() { return (unsigned)__builtin_amdgcn_s_getreg((3 << 11) | 20) & 0xFu; }
#define XB_SPIN(cond, bar) do { unsigned _sp = 0; while (cond) { __builtin_amdgcn_s_sleep(1); \
    if ((++_sp & 255u) == 0u) { if (xb_ld(&(bar)[XB_TMO])) break; if (_sp > XB_SPIN_CAP) { atomicAdd(&(bar)[XB_TMO], 1u); break; } } } } while (0)
struct XcdBarrier { unsigned* bar; unsigned x; volatile LAS unsigned* st; };
__device__ __forceinline__ XcdBarrier xcd_barrier_post(unsigned* bar, volatile LAS unsigned* st) {
    XcdBarrier b; b.bar = bar; b.x = xb_xcc_id(); b.st = st;
    if (threadIdx.x == 0) (void)xb_add(&bar[XB_XCNT(b.x)], 1u);
    return b;
}
__device__ __forceinline__ void xcd_barrier_complete(unsigned* bar, unsigned x, unsigned& nloc, unsigned& nx) {
    const unsigned G = gridDim.x * gridDim.y * gridDim.z;
    unsigned sum, cnt, mine, sp = 0u;
    for (;;) {
        sum = 0u; cnt = 0u; mine = 0u;
#pragma unroll
        for (unsigned j = 0; j < 16; ++j) { const unsigned c = xb_ld(&bar[XB_XCNT(j)]); sum += c; cnt += (c > 0u) ? 1u : 0u; mine = (j == x) ? c : mine; }
        if (sum == G) break;
        __builtin_amdgcn_s_sleep(1);
        if ((++sp & 255u) == 0u) { if (xb_ld(&bar[XB_TMO])) break; if (sp > XB_SPIN_CAP) { atomicAdd(&bar[XB_TMO], 1u); break; } }
    }
    nloc = mine > 0u ? mine : 1u; nx = cnt > 0u ? cnt : 1u;
}
__device__ __forceinline__ void xcd_barrier(const XcdBarrier& b) {
    asm volatile("s_waitcnt vmcnt(0)" ::: "memory");
    __syncthreads();
    if (threadIdx.x == 0) {
        unsigned* bar = b.bar;
        __builtin_amdgcn_s_waitcnt(0);
        unsigned nloc = b.st[0], nx = b.st[1];
        if (nloc == 0u) { xcd_barrier_complete(bar, b.x, nloc, nx); b.st[0] = nloc; b.st[1] = nx; }
        const unsigned old = xb_add(&bar[XB_XSUB(b.x)], 1u);
        const unsigned gen = old / nloc;
        if (old + 1u == (gen + 1u) * nloc) {
            __builtin_amdgcn_fence(__ATOMIC_RELEASE, "agent");
            asm volatile("s_waitcnt vmcnt(0)" ::: "memory");
            const unsigned og = xb_add(&bar[XB_TOP], 1u);
            const unsigned tg = og / nx;
            if (og + 1u == (tg + 1u) * nx) xb_add(&bar[XB_TOPGEN], 1u);
            else XB_SPIN(xb_ld(&bar[XB_TOPGEN]) == tg, bar);
            __builtin_amdgcn_fence(__ATOMIC_ACQUIRE, "agent");
            xb_add(&bar[XB_XGEN(b.x)], 1u);
            asm volatile("s_waitcnt vmcnt(0)" ::: "memory");
        } else {
            XB_SPIN(xb_ld(&bar[XB_XGEN(b.x)]) == gen, bar);
            __builtin_amdgcn_fence(__ATOMIC_ACQUIRE, "agent");
            asm volatile("s_waitcnt vmcnt(0)" ::: "memory");
        }
    }
    __syncthreads();
}

namespace pg8 {
constexpr int BM = 256, BK = 64, HALF = 128, HTB = HALF * BK * 2, STAGE_BYTES = 8 * HTB, NXCD = 8, WGM = 8;
__host__ __device__ __forceinline__ int lds_byte(int r, int c) { const int st = (r >> 4) * 2 + (c >> 5), rr = r & 15, cc = c & 31, ob = rr * 64 + cc * 2; return st * 1024 + (ob ^ (((ob >> 9) & 1) << 5)); }
__host__ __device__ __forceinline__ void stage_rc(int b, int& R, int& C) { const int st = b / 1024, sb = b % 1024, swz = sb ^ (((sb >> 9) & 1) << 5); R = (st >> 1) * 16 + swz / 64; C = (st & 1) * 32 + (swz % 64) / 2; }
__host__ __device__ __forceinline__ int perm32(int rho) { const int n = rho >> 4, i = rho & 15; return 8 * (i >> 2) + 4 * n + (i & 3); }

struct Unit { int pm, pn, g; const char* A; const char* B; };

struct Sched {
    int nM, nN, nwg, G, c, nextra;
    const char* A; const char* B; size_t tA, tB;
    const char* Ae; const char* Be; size_t tAe, tBe;
    __device__ __forceinline__ bool next(int i, Unit& u) const {
        const long L = (long)i * G + c; if (L >= nwg + nextra) return false;
        if (L >= nwg) { const int e = (int)(L - nwg); u.g = 1 + (e >> 2); u.pm = 0; u.pn = e & 3; u.A = Ae + (size_t)(e >> 2) * tAe; u.B = Be + (size_t)e * tBe; return true; }
        int wgid = (int)L; { const int q = nwg / NXCD, r = nwg % NXCD, xcd = wgid % NXCD, off = wgid / NXCD; wgid = (xcd < r ? xcd * (q + 1) : r * (q + 1) + (xcd - r) * q) + off; }
        const int nig = WGM * nN, gid = wgid / nig, fm = gid * WGM, gsz = (nM - fm) < WGM ? (nM - fm) : WGM;
        u.pm = fm + ((wgid % nig) % gsz); u.pn = (wgid % nig) / gsz; u.g = 0; u.A = A + (size_t)u.pm * tA; u.B = B + (size_t)u.pn * tB; return true;
    }
};

__device__ __forceinline__ void row_rstd8(const float* rss, int row0, int fq, float (&rs)[2][4]) {
    f32x4 a[2][4], b[2][4];
#pragma unroll
    for (int ai = 0; ai < 2; ++ai)
#pragma unroll
        for (int m = 0; m < 4; ++m) { const f32x4* p = (const f32x4*)(rss + (size_t)(row0 + ai * HALF + m * 16) * 32 + fq * 8); a[ai][m] = p[0]; b[ai][m] = p[1]; }
#pragma unroll
    for (int ai = 0; ai < 2; ++ai)
#pragma unroll
        for (int m = 0; m < 4; ++m) { const f32x4 v = a[ai][m] + b[ai][m]; float s = (v[0] + v[1]) + (v[2] + v[3]); s += __shfl_xor(s, 16); s += __shfl_xor(s, 32); rs[ai][m] = rsqrtf(s * (1.0f / DM) + RMS_EPS); }
}
struct EpiIn {
    static constexpr bool PERM = true, AFTER_DRAIN = false;
    bf16_t* z; const float* rss; float* out; bf16_t* kvb; bf16_t* mkvb; const float* bfg; int kind, j;
    __device__ __forceinline__ void operator()(const f32x4 (&acc)[2][2][4][2], const Unit& u, int wr, int wc, int fr, int fq) const {
        const int row0 = u.pm * BM + wr * 64 + fr, colt = u.pn * BM, col0 = colt + wc * 32 + 8 * fq;
        if (u.g != 0) {
            const int e = u.g - 1; const bool isv = colt >= MEMW; float* of = out + (isv ? O_MVP : O_MKP) + (size_t)e * NMEM * MEMW; bf16_t* ob = mkvb + (size_t)e * NMEM * 1024;
#pragma unroll
            for (int ai = 0; ai < 2; ++ai)
#pragma unroll
                for (int m = 0; m < 4; ++m) { const int row = row0 + ai * HALF + m * 16;
#pragma unroll
                    for (int bj = 0; bj < 2; ++bj) { const int c = col0 + bj * HALF; const f32x4 v0 = acc[ai][bj][m][0], v1 = acc[ai][bj][m][1];
                        *(u32x4*)(ob + (size_t)row * 1024 + c) = pack8u(v0, v1);
                        float* o = of + (size_t)row * MEMW + (c - (isv ? MEMW : 0)); *(f32x4*)o = v0; *(f32x4*)(o + 4) = v1; } }
            return;
        }
        float rs[2][4]; row_rstd8(rss, row0, fq, rs);
        const bool kt = kind != 2 && colt >= AW && colt < 2 * AW, vt = kind != 2 && colt >= 2 * AW && colt < 3 * AW, smp = u.pm >= TP / BM;
        const int cbase = kt ? AW : 2 * AW;
        const size_t ocache = kind == 0 ? (smp ? (kt ? O_FKS : O_FVS) + (size_t)j * TS * AW : (kt ? O_FKP : O_FVP) + (size_t)j * TP * AW) : (smp ? (kt ? O_SKS : O_SVS) : (kt ? O_SKP : O_SVP));
        float* oc = out + ocache; bf16_t* kvs = kvb + (kt ? 0 : KVS_ONE / 2);
        const bool lft = kind == 0 && colt == 5120 && wc == 0 && fq < 2;
        float* lfo = out + (smp ? O_FLS + (size_t)j * TS * NH : O_FLP + (size_t)j * TP * NH);
#pragma unroll
        for (int ai = 0; ai < 2; ++ai)
#pragma unroll
            for (int m = 0; m < 4; ++m) { const int row = row0 + ai * HALF + m * 16, rr = smp ? row - TP : row; const float sc = rs[ai][m];
#pragma unroll
                for (int bj = 0; bj < 2; ++bj) { const int c = col0 + bj * HALF; const f32x4 v0 = acc[ai][bj][m][0] * sc, v1 = acc[ai][bj][m][1] * sc; const u32x4 w = pack8u(v0, v1);
                    *(u32x4*)(z + (size_t)row * ZLD + c) = w;
                    if (kt || vt) { const int cc = c - cbase; float* o = oc + (size_t)rr * AW + cc; *(f32x4*)o = v0; *(f32x4*)(o + 4) = v1;
                        if (smp) *(u32x4*)(kvs + ((size_t)(rr >> 6) * SKS + PAST + (rr & 63)) * AW + cc) = w; }
                    if (lft && bj == 0) {
                        float* o = lfo + (size_t)rr * NH;
#pragma unroll
                        for (int e = 0; e < 8; ++e) { const int h = 8 * fq + e; if (h < NH) o[h] = log_sigmoidf((e < 4 ? v0[e & 3] : v1[e & 3]) + bfg[h]); } } } }
    }
};
struct EpiRes {
    static constexpr bool PERM = true, AFTER_DRAIN = false;
    float* x; bf16_t* xb; float* rss;
    __device__ __forceinline__ void operator()(const f32x4 (&acc)[2][2][4][2], const Unit& u, int wr, int wc, int fr, int fq) const {
        const int row0 = u.pm * BM + wr * 64 + fr, col0 = u.pn * BM + wc * 32 + 8 * fq;
#pragma unroll
        for (int ai = 0; ai < 2; ++ai)
#pragma unroll
            for (int m = 0; m < 4; ++m) { const int row = row0 + ai * HALF + m * 16; float ss = 0.f;
#pragma unroll
                for (int bj = 0; bj < 2; ++bj) { float* p = x + (size_t)row * DM + col0 + bj * HALF;
                    const f32x4 a = *(const f32x4*)p + acc[ai][bj][m][0], b = *(const f32x4*)(p + 4) + acc[ai][bj][m][1];
                    *(f32x4*)p = a; *(f32x4*)(p + 4) = b; *(u32x4*)(xb + (size_t)row * DM + col0 + bj * HALF) = pack8u(a, b);
                    ss += (a[0] * a[0] + a[1] * a[1]) + (a[2] * a[2] + a[3] * a[3]) + (b[0] * b[0] + b[1] * b[1]) + (b[2] * b[2] + b[3] * b[3]); }
                ss += __shfl_xor(ss, 16); ss += __shfl_xor(ss, 32);
                if (fq == 0) rss[(size_t)row * 32 + u.pn * 4 + wc] = ss;
                if (m & 1) asm volatile("" ::: "memory"); }
    }
};
struct EpiUp {
    static constexpr bool PERM = true, AFTER_DRAIN = false;
    bf16_t* o; const float* rss;
    __device__ __forceinline__ void operator()(const f32x4 (&acc)[2][2][4][2], const Unit& u, int wr, int wc, int fr, int fq) const {
        const int row0 = u.pm * BM + wr * 64 + fr, col0 = u.pn * BM + wc * 32 + 8 * fq;
        float rs[2][4]; row_rstd8(rss, row0, fq, rs);
#pragma unroll
        for (int ai = 0; ai < 2; ++ai)
#pragma unroll
            for (int m = 0; m < 4; ++m) { const int row = row0 + ai * HALF + m * 16; const float sc = rs[ai][m];
#pragma unroll
                for (int bj = 0; bj < 2; ++bj) { f32x4 v0 = acc[ai][bj][m][0] * sc, v1 = acc[ai][bj][m][1] * sc;
#pragma unroll
                    for (int e = 0; e < 4; ++e) { const float a = fmaxf(v0[e], 0.f), b = fmaxf(v1[e], 0.f); v0[e] = a * a; v1[e] = b * b; }
                    *(u32x4*)(o + (size_t)row * DFF + col0 + bj * HALF) = pack8u(v0, v1); } }
    }
};

template <class Epi>
__device__ __forceinline__ void gemm_phase(LAS unsigned char* lds, const int K, const int lda, const int ldb, const Sched& S, const Epi& E, const int tid) {
    const int wid = __builtin_amdgcn_readfirstlane(tid >> 6), lane = tid & 63, wr = wid >> 2, wc = wid & 3, fr = lane & 15, fq = lane >> 4;
    const int nt = K / BK;
    unsigned voffA[2], voffB[2];
#pragma unroll
    for (int i = 0; i < 2; ++i) { int R, C; stage_rc(tid * 16 + i * 8192, R, C); const int Rb = Epi::PERM ? ((R & ~31) + perm32(R & 31)) : R;
        voffA[i] = (unsigned)(R * lda + C) * 2u; voffB[i] = (unsigned)(Rb * ldb + C) * 2u; }
    const size_t kstep = (size_t)(BK * 2);
    const size_t hstepA = (size_t)HALF * lda * 2, hstepB = (size_t)HALF * ldb * 2;
    const unsigned ldsw = (unsigned)wid * 1024u;
    const int aoff = lds_byte(wr * 64 + fr, fq * 8), boff = lds_byte(wc * 32 + fr, fq * 8);
#define PG8_SA(b, h) (((b) * 2 + (h)) * HTB)
#define PG8_SB(b, h) ((4 + (b) * 2 + (h)) * HTB)
#define PG8_STAGE(bufoff, gbase, voff) do { _Pragma("unroll") for (int _i = 0; _i < 2; ++_i) \
        __builtin_amdgcn_global_load_lds((const unsigned*)((const char*)(gbase) + (voff)[_i]), (LAS unsigned*)(lds + (bufoff) + ldsw + _i * 8192), 16, 0, 0); } while (0)
#define PG8_LDA(dst, b, h) do { _Pragma("unroll") for (int m = 0; m < 4; ++m) _Pragma("unroll") for (int k = 0; k < 2; ++k) dst[m][k] = *(const LAS bf16x8*)(lds + PG8_SA(b, h) + aoff + m * 2048 + k * 1024); } while (0)
#define PG8_LDB(dst, b, h) do { _Pragma("unroll") for (int n = 0; n < 2; ++n) _Pragma("unroll") for (int k = 0; k < 2; ++k) dst[n][k] = *(const LAS bf16x8*)(lds + PG8_SB(b, h) + boff + n * 2048 + k * 1024); } while (0)
#define PG8_MMA(ai, bj, At, Bt) do { __builtin_amdgcn_s_setprio(1); _Pragma("unroll") for (int m = 0; m < 4; ++m) _Pragma("unroll") for (int n = 0; n < 2; ++n) _Pragma("unroll") for (int k = 0; k < 2; ++k) \
        acc[ai][bj][m][n] = __builtin_amdgcn_mfma_f32_16x16x32_bf16(Bt[n][k], At[m][k], acc[ai][bj][m][n], 0, 0, 0); __builtin_amdgcn_s_setprio(0); } while (0)
#define PG8_WAIT_V(n) asm volatile("s_waitcnt vmcnt(" #n ")" ::: "memory")
#define PG8_WAIT_L(n) asm volatile("s_waitcnt lgkmcnt(" #n ")" ::: "memory")
#define PG8_BAR __builtin_amdgcn_s_barrier()
#define PG8_SCHED __builtin_amdgcn_sched_barrier(0)
    Unit cur, nxt; int ui = 0;
    if (!S.next(0, cur)) return;
    f32x4 acc[2][2][4][2];
#pragma unroll
    for (int a = 0; a < 2; ++a)
#pragma unroll
        for (int b = 0; b < 2; ++b)
#pragma unroll
            for (int m = 0; m < 4; ++m)
#pragma unroll
                for (int n = 0; n < 2; ++n) acc[a][b][m][n] = (f32x4){0.f, 0.f, 0.f, 0.f};
    bf16x8 At[4][2], B0[2][2], B1[2][2];
    const char* cA = cur.A; const char* cB = cur.B;
    PG8_STAGE(PG8_SB(0, 0), cB, voffB); PG8_STAGE(PG8_SB(0, 1), cB + hstepB, voffB); PG8_STAGE(PG8_SA(0, 0), cA, voffA); PG8_STAGE(PG8_SA(0, 1), cA + hstepA, voffA);
    if (wr == 1) PG8_BAR;
    PG8_WAIT_V(2); PG8_BAR;
    PG8_STAGE(PG8_SB(1, 0), cB + kstep, voffB); PG8_STAGE(PG8_SA(1, 0), cA + kstep, voffA); PG8_STAGE(PG8_SB(1, 1), cB + hstepB + kstep, voffB);
    PG8_WAIT_V(6); PG8_BAR;
    for (;;) {
        const bool has_next = S.next(ui + 1, nxt);
        const char* nA = has_next ? nxt.A : cA; const char* nB = has_next ? nxt.B : cB;
        for (int t = 0; t < nt; t += 2) {
            const bool last = (t == nt - 2);
            const char* a1 = cA + (size_t)(t + 1) * kstep;
            const char* a2 = last ? nA : cA + (size_t)(t + 2) * kstep; const char* b2 = last ? nB : cB + (size_t)(t + 2) * kstep;
            const char* a3 = a2 + kstep; const char* b3 = b2 + kstep;
            PG8_LDB(B0, 0, 0); PG8_LDB(B1, 0, 1); PG8_SCHED; PG8_LDA(At, 0, 0); PG8_STAGE(PG8_SA(1, 1), a1 + hstepA, voffA);
            PG8_WAIT_V(8); PG8_WAIT_L(0); PG8_BAR; PG8_MMA(0, 0, At, B0); PG8_MMA(0, 1, At, B1); PG8_BAR; PG8_SCHED;
            PG8_LDA(At, 0, 1); PG8_STAGE(PG8_SB(0, 0), b2, voffB); PG8_STAGE(PG8_SB(0, 1), b2 + hstepB, voffB); PG8_STAGE(PG8_SA(0, 0), a2, voffA);
            PG8_WAIT_V(8); PG8_WAIT_L(0); PG8_BAR; PG8_MMA(1, 0, At, B0); PG8_MMA(1, 1, At, B1); PG8_BAR; PG8_SCHED;
            PG8_LDB(B0, 1, 0); PG8_LDB(B1, 1, 1); PG8_SCHED; PG8_LDA(At, 1, 0); PG8_STAGE(PG8_SA(0, 1), a2 + hstepA, voffA);
            PG8_WAIT_V(8); PG8_WAIT_L(0); PG8_BAR; PG8_MMA(0, 0, At, B0); PG8_MMA(0, 1, At, B1); PG8_BAR; PG8_SCHED;
            PG8_LDA(At, 1, 1); PG8_STAGE(PG8_SB(1, 0), b3, voffB); PG8_STAGE(PG8_SB(1, 1), b3 + hstepB, voffB); PG8_STAGE(PG8_SA(1, 0), a3, voffA);
            PG8_WAIT_V(8); PG8_WAIT_L(0); PG8_BAR; PG8_MMA(1, 0, At, B0); PG8_MMA(1, 1, At, B1); PG8_BAR; PG8_SCHED;
        }
        if (wr == 0) PG8_BAR;
        E(acc, cur, wr, wc, fr, fq);
        if (!has_next) break;
#pragma unroll
        for (int a = 0; a < 2; ++a)
#pragma unroll
            for (int b = 0; b < 2; ++b)
#pragma unroll
                for (int m = 0; m < 4; ++m)
#pragma unroll
                    for (int n = 0; n < 2; ++n) acc[a][b][m][n] = (f32x4){0.f, 0.f, 0.f, 0.f};
        cur = nxt; cA = nA; cB = nB; ++ui;
        if (wr == 1) PG8_BAR;
    }
    PG8_WAIT_V(0);
    PG8_BAR;
#undef PG8_SA
#undef PG8_SB
#undef PG8_STAGE
#undef PG8_LDA
#undef PG8_LDB
#undef PG8_MMA
#undef PG8_WAIT_V
#undef PG8_WAIT_L
#undef PG8_BAR
#undef PG8_SCHED
}
}

namespace att {
constexpr float SCALE = 0.08838834764831845f;
constexpr float THR = 8.f;
constexpr int NW = 8, QBLK = 32, KVBLK = 64, QB = NW * QBLK, D = 128;
constexpr int SHM_V = KVBLK * D * 2, SHM_K = KVBLK * D * 2;
constexpr int ATT_LDS = 2 * SHM_V + 2 * SHM_K + NW * 64 * 4;
constexpr int BOS_OFF = ATT_LDS;
constexpr int BOS_BYTES = 8192 * 4;
constexpr int SCR_OFF = BOS_OFF + BOS_BYTES;
constexpr int WINF = 1 << 30;
static_assert(SCR_OFF + 256 <= LDS_WORK, "attention LDS map");

#define KSWZ(row, colB) ((row) * 256 + ((colB) ^ (((row) & 7) << 4)))
__device__ __forceinline__ int v_st(int k, int c) { const int kk = (k & ~0xC) | ((k & 4) << 1) | ((k & 8) >> 1); return ((kk >> 3) * 4 + (c >> 5)) * 512 + ((kk & 7) * 32 + (c & 31)) * 2; }
__device__ __forceinline__ int v_rd_base(int lane) { return ((lane & 3) << 3) | (((lane >> 2) & 3) << 6) | (((lane >> 4) & 1) << 5) | (((lane >> 5) & 1) << 8); }
constexpr int v_rd_off(int d0, int ks, int half) { return d0 * 512 + ks * 4096 + half * 2048; }
__device__ __forceinline__ int crow(int r, int hi) { return (r & 3) + 8 * (r >> 2) + 4 * hi; }
__device__ __forceinline__ bf16x8 load8(const bf16_t* p) { return *reinterpret_cast<const bf16x8*>(p); }

__device__ __forceinline__ void mask_tile(f32x16& p0, f32x16& p1, int dq, unsigned W) {
    const float NEG = -__builtin_inff();
#pragma unroll
    for (int r = 0; r < 16; ++r) {
        const int c = (r & 3) + 8 * (r >> 2);
        if ((unsigned)(dq - c) >= W) p0[r] = NEG;
        if ((unsigned)(dq - c - 32) >= W) p1[r] = NEG;
    }
}
__device__ __forceinline__ void partialSM(f32x16& p0, f32x16& p1, float& m_reg, float& mn, float& alpha) {
    float pmax = p0[0]; for (int r = 1; r < 16; ++r) pmax = fmaxf(pmax, p0[r]); for (int r = 0; r < 16; ++r) pmax = fmaxf(pmax, p1[r]);
    { auto rr = __builtin_amdgcn_permlane32_swap(__float_as_uint(pmax), __float_as_uint(pmax), false, false);
      pmax = fmaxf(__uint_as_float(rr[0]), __uint_as_float(rr[1])); }
    constexpr float C2 = 1.4426950408889634f * SCALE;
    if (__builtin_expect(__all((pmax - m_reg) * SCALE <= THR), 1)) { mn = m_reg; alpha = 1.f; }
    else { mn = fmaxf(m_reg, pmax); alpha = __builtin_amdgcn_exp2f((m_reg - mn) * C2); m_reg = mn; }
    const float mnL = -mn * C2;
    for (int r = 0; r < 16; ++r) p0[r] = fmaf(p0[r], C2, mnL); for (int r = 0; r < 16; ++r) p1[r] = fmaf(p1[r], C2, mnL);
    for (int r = 0; r < 16; ++r) p0[r] = __builtin_amdgcn_exp2f(p0[r]);
}
#define PK4(P, B_, OUT) do { unsigned a0 = cvtpk(P[B_+0], P[B_+1]), a1 = cvtpk(P[B_+2], P[B_+3]);                          \
        unsigned b0 = cvtpk(P[B_+4], P[B_+5]), b1 = cvtpk(P[B_+6], P[B_+7]);                                             \
        auto r0 = __builtin_amdgcn_permlane32_swap(a0, b0, false, false); auto r1 = __builtin_amdgcn_permlane32_swap(a1, b1, false, false); \
        u32x4 w = {r0[0], r1[0], r0[1], r1[1]}; OUT = *reinterpret_cast<bf16x8*>(&w); } while (0)
__device__ __forceinline__ void finishSM(f32x16& p0, f32x16& p1, float alpha, float& l_reg, bf16x8& pa0, bf16x8& pa1, bf16x8& pa2, bf16x8& pa3) {
    for (int r = 0; r < 16; ++r) p1[r] = __builtin_amdgcn_exp2f(p1[r]);
    float ps = 0; for (int r = 0; r < 16; ++r) ps += p0[r]; for (int r = 0; r < 16; ++r) ps += p1[r];
    { auto rr = __builtin_amdgcn_permlane32_swap(__float_as_uint(ps), __float_as_uint(ps), false, false);
      ps = __uint_as_float(rr[0]) + __uint_as_float(rr[1]); }
    l_reg = l_reg * alpha + ps;
    PK4(p0, 0, pa0); PK4(p0, 8, pa1); PK4(p1, 0, pa2); PK4(p1, 8, pa3);
}
template <int KB, bool BIAS>
__device__ __forceinline__ void qkt(f32x16& p0, f32x16& p1, const char* K_lds, int r32, int hi, const bf16x8* qr, const float* bk) {
    if constexpr (BIAS) {
#pragma unroll
        for (int i = 0; i < 4; ++i) { const f32x4 a = *(const f32x4*)(bk + 8 * i), b = *(const f32x4*)(bk + 32 + 8 * i);
            p0[4 * i] = a[0]; p0[4 * i + 1] = a[1]; p0[4 * i + 2] = a[2]; p0[4 * i + 3] = a[3];
            p1[4 * i] = b[0]; p1[4 * i + 1] = b[1]; p1[4 * i + 2] = b[2]; p1[4 * i + 3] = b[3]; }
    } else { p0 = f32x16{}; p1 = f32x16{}; }
    const char* kb[4];
#pragma unroll
    for (int dd = 0; dd < 4; ++dd) kb[dd] = K_lds + KB * SHM_K + KSWZ(r32, (dd * 16 + hi * 8) * 2);
#pragma unroll
    for (int d0 = 0; d0 < 8; ++d0) { const char* a = kb[d0 & 3] + (d0 >> 2) * 128;
        bf16x8 b0 = *reinterpret_cast<const bf16x8*>(a);
        bf16x8 b1 = *reinterpret_cast<const bf16x8*>(a + 32 * 256);
        p0 = __builtin_amdgcn_mfma_f32_32x32x16_bf16(b0, qr[d0], p0, 0, 0, 0);
        p1 = __builtin_amdgcn_mfma_f32_32x32x16_bf16(b1, qr[d0], p1, 0, 0, 0); }
}
template <int VB>
__device__ __forceinline__ void pv_tile(f32x16* o, int vb0, bf16x8 pa0, bf16x8 pa1, bf16x8 pa2, bf16x8 pa3) {
#define TRRD(dst, off) asm volatile("ds_read_b64_tr_b16 %0, %1 offset:%2" : "=&v"(dst) : "v"(vb0), "i"(off) : "memory")
#define PV_D0(d0) do { s16x4 l0, l1, l2, l3, h0, h1, h2, h3; constexpr int b_ = VB * SHM_V + v_rd_off(d0, 0, 0); \
        TRRD(l0, b_); TRRD(h0, b_ + 2048); TRRD(l1, b_ + 4096); TRRD(h1, b_ + 6144); TRRD(l2, b_ + 8192); TRRD(h2, b_ + 10240); TRRD(l3, b_ + 12288); TRRD(h3, b_ + 14336); \
        asm volatile("s_waitcnt lgkmcnt(0)" ::: "memory"); SBAR();   \
        o[d0] = __builtin_amdgcn_mfma_f32_32x32x16_bf16(pa0, (bf16x8){l0[0], l0[1], l0[2], l0[3], h0[0], h0[1], h0[2], h0[3]}, o[d0], 0, 0, 0);   \
        o[d0] = __builtin_amdgcn_mfma_f32_32x32x16_bf16(pa1, (bf16x8){l1[0], l1[1], l1[2], l1[3], h1[0], h1[1], h1[2], h1[3]}, o[d0], 0, 0, 0);   \
        o[d0] = __builtin_amdgcn_mfma_f32_32x32x16_bf16(pa2, (bf16x8){l2[0], l2[1], l2[2], l2[3], h2[0], h2[1], h2[2], h2[3]}, o[d0], 0, 0, 0);   \
        o[d0] = __builtin_amdgcn_mfma_f32_32x32x16_bf16(pa3, (bf16x8){l3[0], l3[1], l3[2], l3[3], h3[0], h3[1], h3[2], h3[3]}, o[d0], 0, 0, 0); } while (0)
    PV_D0(0); PV_D0(1); PV_D0(2); PV_D0(3);
#undef PV_D0
#undef TRRD
}

struct Blk { const bf16_t* Q; const bf16_t* K; const bf16_t* V; bf16_t* O; int ldq, ldkv, ldo; int P0, skv, nrows; int bmode; const float* lf0; int n0; const float* lf1; };
struct Seam { bf16x8 qr[8]; bf16x8 st_v0, st_v1, st_k0, st_k1; };
__device__ __forceinline__ int blk_jhi(const Blk& b) { int j = (b.P0 + QB - 1) / KVBLK + 1; const int m = b.skv / KVBLK; return j > m ? m : j; }

__device__ __forceinline__ void prepare_bias(const Blk& b, char* lds, int g_wave) {
    const int tid = opaque_tid();
    float* bos = (float*)(lds + BOS_OFF); float* scr = (float*)(lds + SCR_OFF);
    const int nk = blk_jhi(b) * KVBLK, lane = tid & 63, wid = tid >> 6;
    if (b.bmode == 0) { for (int k = tid; k < nk; k += 512) bos[k] = 0.f; __syncthreads(); return; }
    float v[16]; float tot = 0.f; const int k0 = tid * 16; const bool in = k0 < nk;
#pragma unroll
    for (int i = 0; i < 16; ++i) { const int k = k0 + i; v[i] = in ? (k < b.n0 ? b.lf0[(size_t)k * NH] : b.lf1[(size_t)(k - b.n0) * NH]) : 0.f; tot += v[i]; }
    float inc = tot;
#pragma unroll
    for (int o = 1; o < 64; o <<= 1) { const float y = __shfl_down(inc, o); if (lane + o < 64) inc += y; }
    if (lane == 0) scr[wid] = inc;
    __syncthreads();
    float hiw = 0.f;
#pragma unroll
    for (int w = 0; w < 8; ++w) if (w > wid) hiw += scr[w];
    float run = (inc - tot) + hiw;
    if (in) {
#pragma unroll
        for (int i = 15; i >= 0; --i) { bos[k0 + i] = run * (1.0f / SCALE); run += v[i]; }
    }
    __syncthreads();
}

#define ROWK(p, ld, k0, rr) ((p) + (size_t)((k0) + (rr)) * (ld) + sc)
#define VMW() asm volatile("s_waitcnt vmcnt(0)" ::: "memory")
#define VMWN(n) asm volatile("s_waitcnt vmcnt(%0)" :: "i"(n) : "memory")
#define SLOAD_H(Kp, Vp, ld, k0) do { S.st_v0 = load8(ROWK(Vp, ld, k0, sr)); S.st_v1 = load8(ROWK(Vp, ld, k0, 32 + sr));              \
                         S.st_k0 = load8(ROWK(Kp, ld, k0, sr)); S.st_k1 = load8(ROWK(Kp, ld, k0, 32 + sr)); } while (0)
#define SWRITE_HK(bf) do { *(bf16x8*)(K_lds + (bf) * SHM_K + kws) = S.st_k0; *(bf16x8*)(K_lds + (bf) * SHM_K + kws + 32 * 256) = S.st_k1; } while (0)
#define SWRITE_HV(bf) do { *(bf16x8*)(V_lds + (bf) * SHM_V + vst0) = S.st_v0; *(bf16x8*)(V_lds + (bf) * SHM_V + vst1) = S.st_v1; } while (0)
#define SWRITE_H(bf) do { SWRITE_HV(bf); SWRITE_HK(bf); } while (0)
#define QROWP(b_) ((b_).Q + (size_t)((wid * QBLK + r32) & ((b_).nrows - 1)) * (b_).ldq + hi * 8)
__device__ __forceinline__ void att_prime(const Blk& cur, char* lds, Seam& S, int g_wave) {
    const int tid = opaque_tid();
    const int wid = __builtin_amdgcn_readfirstlane(tid >> 6), lane = tid & 63, r32 = lane & 31, hi = lane >> 5;
    const int sr = tid >> 4, sc = (tid & 15) * 8, kws = KSWZ(sr, sc * 2); char* K_lds = lds + 2 * SHM_V;
    const bf16_t* qp = QROWP(cur);
#pragma unroll
    for (int d0 = 0; d0 < 8; ++d0) S.qr[d0] = load8(qp + d0 * 16);
    SLOAD_H(cur.K, cur.V, cur.ldkv, 0); VMW(); SWRITE_HK(0);
    __syncthreads();
}
__device__ __forceinline__ void att_block(const Blk& cur, const Blk& nxt, char* lds, Seam& S, int g_wave) {
    const int tid = opaque_tid();
    const int wid = __builtin_amdgcn_readfirstlane(tid >> 6), lane = tid & 63, r32 = lane & 31, hi = lane >> 5;
    constexpr int W = WINF;
    const int NT = blk_jhi(cur);
    const int qlo = cur.P0 + wid * QBLK, qm = qlo + r32 - 4 * hi;
    char* V_lds = lds; char* K_lds = lds + 2 * SHM_V;
    float* ws = (float*)(lds + 2 * SHM_V + 2 * SHM_K) + wid * 64; float* li_l = ws, * al_l = ws + 32;
    const float* bos = (const float*)(lds + BOS_OFF) + 4 * hi;
    float m_reg = -1e30f, l_reg = 0; f32x16 o[4] = {};
    const int sr = tid >> 4, sc = (tid & 15) * 8, vst0 = v_st(sr, sc), vst1 = v_st(32 + sr, sc), kws = KSWZ(sr, sc * 2);
    const int vb0 = (int)(uintptr_t)V_lds + v_rd_base(lane);
    const bf16_t* Kh = cur.K; const bf16_t* Vh = cur.V; const int ldkv = cur.ldkv;
#define RESC(a) do { if (__any((a) < 1.f)) { if (hi == 0) al_l[r32] = (a); asm volatile("s_waitcnt lgkmcnt(0)" ::: "memory");              \
                     for (int d_ = 0; d_ < 4; ++d_) for (int r = 0; r < 16; ++r) o[d_][r] *= al_l[crow(r, hi)]; } } while (0)
#define KBASE(t) ((t) * KVBLK)
#define MASKT(P0_, P1_, t) do { const int kb_ = KBASE(t); if (kb_ + KVBLK - 1 > qlo) mask_tile(P0_, P1_, qm - kb_, (unsigned)W); } while (0)
    constexpr int NQL = 8;
#define SEAM_K0() do { VMWN(NQL); SWRITE_HK(0); SBAR(); } while (0)
    f32x16 pA0, pA1, pB0, pB1; float mnA, mnB, alA, alB; bf16x8 pa0, pa1, pa2, pa3;
    SWRITE_HV(0); SBAR();
    if (NT > 1) SLOAD_H(Kh, Vh, ldkv, KBASE(1));
    SBAR(); qkt<0, true>(pA0, pA1, K_lds, r32, hi, S.qr, bos + KBASE(0));
    MASKT(pA0, pA1, 0); partialSM(pA0, pA1, m_reg, mnA, alA);
    if (NT > 1) { VMW(); SWRITE_H(1); }
    __syncthreads();
#define HALF_STEP(PX0, PX1, mnX, alX, PY0, PY1, alY, t, KB, VB, SB) do {                                                      \
        SBAR(); qkt<KB, true>(PX0, PX1, K_lds, r32, hi, S.qr, bos + KBASE(t));                                                \
        finishSM(PY0, PY1, alY, l_reg, pa0, pa1, pa2, pa3); SBAR();                                                           \
        if ((t) + 1 < NT) { SLOAD_H(Kh, Vh, ldkv, KBASE((t) + 1)); SBAR(); }                                                  \
        pv_tile<VB>(o, vb0, pa0, pa1, pa2, pa3); MASKT(PX0, PX1, (t)); partialSM(PX0, PX1, m_reg, mnX, alX);                  \
        __syncthreads();                                                                                                      \
        if ((t) + 1 < NT) { VMW(); SWRITE_H(SB); }                                                                            \
        RESC(alX); __syncthreads(); } while (0)
    for (int t = 1; t + 1 < NT; t += 2) {
        HALF_STEP(pB0, pB1, mnB, alB, pA0, pA1, alA, t, 1, 0, 0);
        HALF_STEP(pA0, pA1, mnA, alA, pB0, pB1, alB, t + 1, 0, 1, 1);
    }
    const bool even = (NT & 1) == 0;
    if (even) { SBAR(); qkt<1, true>(pB0, pB1, K_lds, r32, hi, S.qr, bos + KBASE(NT - 1)); SBAR(); }
    SLOAD_H(nxt.K, nxt.V, nxt.ldkv, 0); SBAR();
    { const bf16_t* qp = QROWP(nxt);
#pragma unroll
      for (int d0 = 0; d0 < 8; ++d0) S.qr[d0] = load8(qp + d0 * 16); }
    SBAR();
    finishSM(pA0, pA1, alA, l_reg, pa0, pa1, pa2, pa3); SBAR();
    pv_tile<0>(o, vb0, pa0, pa1, pa2, pa3);
    if (even) { MASKT(pB0, pB1, NT - 1); partialSM(pB0, pB1, m_reg, mnB, alB); __syncthreads(); RESC(alB);
        finishSM(pB0, pB1, alB, l_reg, pa0, pa1, pa2, pa3); SBAR(); pv_tile<1>(o, vb0, pa0, pa1, pa2, pa3); }
    SBAR(); SEAM_K0();
    if (hi == 0) li_l[r32] = l_reg; asm volatile("s_waitcnt lgkmcnt(0)" ::: "memory");
    float rli[16];
#pragma unroll
    for (int r = 0; r < 16; ++r) rli[r] = __builtin_amdgcn_rcpf(li_l[crow(r, hi)]);
    if (wid * QBLK < cur.nrows) {
        bf16_t* Ow = cur.O + (size_t)(wid * QBLK) * cur.ldo;
#pragma unroll
        for (int r = 0; r < 16; ++r) { const int orow = crow(r, hi);
#pragma unroll
            for (int d0 = 0; d0 < 4; ++d0) { const float v = o[d0][r] * rli[r]; const float vn = __shfl_xor(v, 1);
                if ((r32 & 1) == 0) *(unsigned*)(Ow + (size_t)orow * cur.ldo + d0 * 32 + r32) = cvtpk(v, vn); } }
    }
    __syncthreads();
#undef RESC
#undef MASKT
#undef SEAM_K0
#undef HALF_STEP
}

__device__ __forceinline__ void sb_block(const Blk& b, char* lds, int g_wave) {
    const int tid = opaque_tid();
    const int wid = __builtin_amdgcn_readfirstlane(tid >> 6), lane = tid & 63, r32 = lane & 31, hi = lane >> 5;
    char* V_lds = lds; char* K_lds = lds + 2 * SHM_V; int* flags = (int*)(lds + 2 * SHM_V + 2 * SHM_K);
    const int sr = tid >> 4, sc = (tid & 15) * 8, vst0 = v_st(sr, sc), vst1 = v_st(32 + sr, sc), kws = KSWZ(sr, sc * 2);
    const int vb0 = (int)(uintptr_t)V_lds + v_rd_base(lane);
    bf16x8 qr[8];
    { const bf16_t* qp = QROWP(b);
#pragma unroll
      for (int d0 = 0; d0 < 8; ++d0) qr[d0] = load8(qp + d0 * 16); }
    const int NT = blk_jhi(b), qlo = b.P0 + wid * QBLK, pos = qlo + r32;
    bool wdead = wid * QBLK >= b.nrows;
    float prun = 1.f; f32x16 o[4] = {};
    constexpr float C2 = 1.4426950408889634f * SCALE;
    for (int t = NT - 1; t >= 0; --t) {
        const int kb = t * KVBLK;
        const bf16x8 k0 = load8(ROWK(b.K, b.ldkv, kb, sr)), k1 = load8(ROWK(b.K, b.ldkv, kb, 32 + sr)), v0 = load8(ROWK(b.V, b.ldkv, kb, sr)), v1 = load8(ROWK(b.V, b.ldkv, kb, 32 + sr));
        __syncthreads();
        *(bf16x8*)(K_lds + kws) = k0; *(bf16x8*)(K_lds + kws + 32 * 256) = k1; *(bf16x8*)(V_lds + vst0) = v0; *(bf16x8*)(V_lds + vst1) = v1;
        __syncthreads();
        if (!wdead && kb < qlo + QBLK - 1) {
            f32x16 p0, p1; qkt<0, false>(p0, p1, K_lds, r32, hi, qr, nullptr);
            if (kb + KVBLK - 1 >= qlo) {
                const float NEG = -__builtin_inff();
#pragma unroll
                for (int r = 0; r < 16; ++r) { const int key = kb + crow(r, hi); if (key >= pos) p0[r] = NEG; if (key + 32 >= pos) p1[r] = NEG; }
            }
#pragma unroll
            for (int r = 0; r < 16; ++r) {
                p0[r] = __builtin_amdgcn_rcpf(1.f + __builtin_amdgcn_exp2f(fminf(p0[r] * C2, 60.f))); p1[r] = __builtin_amdgcn_rcpf(1.f + __builtin_amdgcn_exp2f(fminf(p1[r] * C2, 60.f))); }
            float gl[8], gu[8];
#pragma unroll
            for (int g = 0; g < 8; ++g) { const float gp = g < 4 ? (p0[4 * g] * p0[4 * g + 1]) * (p0[4 * g + 2] * p0[4 * g + 3]) : (p1[4 * g - 16] * p1[4 * g - 15]) * (p1[4 * g - 14] * p1[4 * g - 13]);
                auto x = __builtin_amdgcn_permlane32_swap(__float_as_uint(gp), __float_as_uint(gp), false, false); gl[g] = __uint_as_float(x[0]); gu[g] = __uint_as_float(x[1]); }
            float s = 1.f, sown[8];
#pragma unroll
            for (int g = 7; g >= 0; --g) { const float su = s; s *= gu[g]; const float sl = s; s *= gl[g]; sown[g] = hi ? su : sl; }
#define SB_EL(P, q) do { const float rr_ = P[q]; P[q] = (1.f - rr_) * tt; tt *= rr_; } while (0)
#pragma unroll
            for (int g = 0; g < 8; ++g) { float tt = sown[g] * prun;
                if (g < 4) { const int q = 4 * g; SB_EL(p0, q + 3); SB_EL(p0, q + 2); SB_EL(p0, q + 1); SB_EL(p0, q); }
                else { const int q = 4 * g - 16; SB_EL(p1, q + 3); SB_EL(p1, q + 2); SB_EL(p1, q + 1); SB_EL(p1, q); } }
#undef SB_EL
            prun *= s;
            bf16x8 pa0, pa1, pa2, pa3;
            PK4(p0, 0, pa0); PK4(p0, 8, pa1); PK4(p1, 0, pa2); PK4(p1, 8, pa3);
            pv_tile<0>(o, vb0, pa0, pa1, pa2, pa3);
            wdead = __all(prun < 8.67e-19f);
        }
        if (lane == 0) flags[wid] = wdead ? 1 : 0;
        __syncthreads();
        const int alld = flags[0] & flags[1] & flags[2] & flags[3] & flags[4] & flags[5] & flags[6] & flags[7];
        if (alld) break;
    }
    if (wid * QBLK < b.nrows) {
        bf16_t* Ow = b.O + (size_t)(wid * QBLK) * b.ldo;
#pragma unroll
        for (int r = 0; r < 16; ++r) { const int orow = crow(r, hi);
#pragma unroll
            for (int d0 = 0; d0 < 4; ++d0) { const float v = o[d0][r]; const float vn = __shfl_xor(v, 1);
                if ((r32 & 1) == 0) *(unsigned*)(Ow + (size_t)orow * b.ldo + d0 * 32 + r32) = cvtpk(v, vn); } }
    }
    __syncthreads();
}
#undef ROWK
#undef VMW
#undef VMWN
#undef SLOAD_H
#undef SWRITE_HK
#undef SWRITE_HV
#undef SWRITE_H
#undef QROWP
#undef PK4
#undef KSWZ
#undef KBASE
}

namespace gla {
constexpr int ZQ = 0, ZK = GKW, ZV = 2 * GKW, ZR = 2 * GKW + GVW, ZG = 5120;
constexpr int KP = 72, QP = 200;
constexpr int L_G = 0;
constexpr int L_GLOW = 49152;
constexpr int L_TOT = 53248;
constexpr int L_QP = 54272;
constexpr int L_KPB = L_QP + 64 * QP * 2;
constexpr int L_AB = L_KPB + 64 * QP * 2;
constexpr int L_VT = L_AB + 64 * KP * 2;
constexpr int L_RS = L_VT + 128 * KP * 2;
constexpr int L_ST = 0;
constexpr int L1_KD = 54272;
constexpr int L1_VT = L1_KD + 192 * KP * 2;
static_assert(L_RS + 1024 <= LDS_WORK && L1_VT + 384 * KP * 2 <= LDS_WORK, "GLA LDS map");

__device__ __forceinline__ int chunk_row0(int c) { return c < TP / 64 ? c * 64 : TP + (c - TP / 64) * 64; }

__device__ __forceinline__ void decay_scan(const bf16_t* z, const float* wg2, const float* bg, int row0, int h, char* lds, int tid) {
    float* G = (float*)(lds + L_G); float* glow = (float*)(lds + L_GLOW); float* tot = (float*)(lds + L_TOT);
    for (int i = tid; i < 64 * 16; i += 512) glow[i] = bf2f(z[(size_t)(row0 + (i >> 4)) * ZLD + ZG + (i & 15)]);
    __syncthreads();
    if (tid < 384) {
        const int k = tid % 192, half = tid / 192; float w[16];
#pragma unroll
        for (int j = 0; j < 16; ++j) w[j] = wg2[(size_t)j * GKW + h * GDK + k];
        const float b = bg[h * GDK + k]; float g = 0.f;
        for (int s = half * 32; s < half * 32 + 32; ++s) { float a = b;
#pragma unroll
            for (int j = 0; j < 16; ++j) a += glow[s * 16 + j] * w[j];
            g += log_sigmoidf(a) * (1.0f / 16.0f); G[s * GDK + k] = g; }
        if (half == 0) tot[k] = g;
    }
    __syncthreads();
}

__device__ __forceinline__ void g1_unit(int c, int h, const bf16_t* z, const float* wg2, const float* bg, float* UT, float* DEC, char* lds, int g_wave) {
    const int tid = opaque_tid(); const int row0 = chunk_row0(c);
    decay_scan(z, wg2, bg, row0, h, lds, tid);
    const float* G = (const float*)(lds + L_G); const float* tot = (const float*)(lds + L_TOT);
    bf16_t* KD = (bf16_t*)(lds + L1_KD); bf16_t* VT = (bf16_t*)(lds + L1_VT);
    for (int it = tid; it < 192 * 8; it += 512) {
        const int k = it % 192, sb = it / 192; const float t0 = tot[k], glast = G[63 * GDK + k] + t0; float v[8];
#pragma unroll
        for (int i = 0; i < 8; ++i) { const int s = sb * 8 + i; const float g = G[s * GDK + k] + (s >= 32 ? t0 : 0.f);
            v[i] = bf2f(z[(size_t)(row0 + s) * ZLD + ZK + h * GDK + k]) * __expf(glast - g); }
        u32x4 w = {cvtpk(v[0], v[1]), cvtpk(v[2], v[3]), cvtpk(v[4], v[5]), cvtpk(v[6], v[7])};
        *(u32x4*)(KD + k * KP + sb * 8) = w;
        if (sb == 0) DEC[(size_t)(c * GH + h) * GDK + k] = __expf(glast);
    }
    for (int it = tid; it < 64 * 48; it += 512) {
        const int s = it & 63, vb = it >> 6; const u32x4 w = *(const u32x4*)(z + (size_t)(row0 + s) * ZLD + ZV + h * GDV + vb * 8);
#pragma unroll
        for (int i = 0; i < 4; ++i) { VT[(vb * 8 + 2 * i) * KP + s] = (bf16_t)(w[i] & 0xffffu); VT[(vb * 8 + 2 * i + 1) * KP + s] = (bf16_t)(w[i] >> 16); }
    }
    __syncthreads();
    const int wid = tid >> 6, lane = tid & 63, l32 = lane & 31, hi = lane >> 5, mq = wid & 3, nh = wid >> 2;
    f32x16 acc[3][3];
#pragma unroll
    for (int i = 0; i < 3; ++i)
#pragma unroll
        for (int j = 0; j < 3; ++j) acc[i][j] = f32x16{};
#pragma unroll
    for (int ks = 0; ks < 4; ++ks) { bf16x8 a[3], bb[3];
#pragma unroll
        for (int i = 0; i < 3; ++i) { a[i] = *(const bf16x8*)(VT + ((mq * 3 + i) * 32 + l32) * KP + ks * 16 + hi * 8); bb[i] = *(const bf16x8*)(KD + ((nh * 3 + i) * 32 + l32) * KP + ks * 16 + hi * 8); }
#pragma unroll
        for (int i = 0; i < 3; ++i)
#pragma unroll
            for (int j = 0; j < 3; ++j) acc[i][j] = __builtin_amdgcn_mfma_f32_32x32x16_bf16(a[i], bb[j], acc[i][j], 0, 0, 0); }
    float* out = UT + (size_t)(c * GH + h) * GDV * GDK;
#pragma unroll
    for (int i = 0; i < 3; ++i)
#pragma unroll
        for (int j = 0; j < 3; ++j)
#pragma unroll
            for (int r = 0; r < 16; ++r) out[(size_t)((mq * 3 + i) * 32 + att::crow(r, hi)) * GDK + (nh * 3 + j) * 32 + l32] = acc[i][j][r];
    __syncthreads();
}

__device__ __forceinline__ void g2_tile(int tile, float* UT, const float* DEC, const float* s0in, float* outp, float* outs, char* lds, int tid) {
    const int h = tile / 36, vt = (tile % 36) / 3, kt = tile % 3, vi = tid >> 4, kg = tid & 15, v = vt * 32 + vi, k = kt * 64 + kg * 4;
    float* T = (float*)lds;
    const size_t cstride = (size_t)GH * GDV * GDK; float* up = UT + ((size_t)h * GDV + v) * GDK + k; const float* dp = DEC + h * GDK + k;
    float zz = 0.f; asm volatile("" : "+v"(zz)); f32x4 S = {zz, zz, zz, zz};
    for (int c0 = 0; c0 < TP / 64; c0 += 8) { f32x4 u[8], d[8];
#pragma unroll
        for (int i = 0; i < 8; ++i) { u[i] = *(const f32x4*)(up + (size_t)(c0 + i) * cstride); d[i] = *(const f32x4*)(dp + (size_t)(c0 + i) * GH * GDK); }
#pragma unroll
        for (int i = 0; i < 8; ++i) { *(f32x4*)(up + (size_t)(c0 + i) * cstride) = S; S = d[i] * S + u[i]; } }
    const int kr = tid >> 3, v4 = (tid & 7) * 4;
    T[(kg * 4 + 0) * 33 + vi] = S[0]; T[(kg * 4 + 1) * 33 + vi] = S[1]; T[(kg * 4 + 2) * 33 + vi] = S[2]; T[(kg * 4 + 3) * 33 + vi] = S[3];
    __syncthreads();
    { f32x4 o = {T[kr * 33 + v4], T[kr * 33 + v4 + 1], T[kr * 33 + v4 + 2], T[kr * 33 + v4 + 3]}; *(f32x4*)(outp + ((size_t)h * GDK + kt * 64 + kr) * GDV + vt * 32 + v4) = o; }
    __syncthreads();
    for (int b = 0; b < NB; ++b) {
        const int c = TP / 64 + b; const size_t sb = ((size_t)b * GH + h) * GDK * GDV;
        { const f32x4 i4 = *(const f32x4*)(s0in + sb + (size_t)(kt * 64 + kr) * GDV + vt * 32 + v4); T[kr * 33 + v4] = i4[0]; T[kr * 33 + v4 + 1] = i4[1]; T[kr * 33 + v4 + 2] = i4[2]; T[kr * 33 + v4 + 3] = i4[3]; }
        __syncthreads();
        f32x4 s0 = {T[(kg * 4 + 0) * 33 + vi], T[(kg * 4 + 1) * 33 + vi], T[(kg * 4 + 2) * 33 + vi], T[(kg * 4 + 3) * 33 + vi]};
        const f32x4 u = *(const f32x4*)(up + (size_t)c * cstride), d = *(const f32x4*)(dp + (size_t)c * GH * GDK);
        *(f32x4*)(up + (size_t)c * cstride) = s0; const f32x4 sn = d * s0 + u;
        __syncthreads();
        T[(kg * 4 + 0) * 33 + vi] = sn[0]; T[(kg * 4 + 1) * 33 + vi] = sn[1]; T[(kg * 4 + 2) * 33 + vi] = sn[2]; T[(kg * 4 + 3) * 33 + vi] = sn[3];
        __syncthreads();
        { f32x4 o = {T[kr * 33 + v4], T[kr * 33 + v4 + 1], T[kr * 33 + v4 + 2], T[kr * 33 + v4 + 3]}; *(f32x4*)(outs + sb + (size_t)(kt * 64 + kr) * GDV + vt * 32 + v4) = o; }
        __syncthreads();
    }
}

__device__ __forceinline__ void g3_unit(int c, int h, const bf16_t* z, const float* wg2, const float* bg, const float* UT, const float* ng, const float* br, bf16_t* oc, char* lds, int g_wave) {
    const int tid = opaque_tid(); const int row0 = chunk_row0(c);
    decay_scan(z, wg2, bg, row0, h, lds, tid);
    const float* G = (const float*)(lds + L_G); const float* tot = (const float*)(lds + L_TOT);
    bf16_t* Qp = (bf16_t*)(lds + L_QP); bf16_t* Kp = (bf16_t*)(lds + L_KPB); bf16_t* Ab = (bf16_t*)(lds + L_AB); bf16_t* VT = (bf16_t*)(lds + L_VT); bf16_t* ST = (bf16_t*)(lds + L_ST);
    float* RS = (float*)(lds + L_RS);
    const float qs = 0.07216878364870322f;
    for (int it = tid; it < 64 * 24; it += 512) {
        const int s = it / 24, kb = (it % 24) * 8; float g[8];
#pragma unroll
        for (int i = 0; i < 8; ++i) g[i] = G[s * GDK + kb + i] + (s >= 32 ? tot[kb + i] : 0.f);
        const u32x4 qw = *(const u32x4*)(z + (size_t)(row0 + s) * ZLD + ZQ + h * GDK + kb), kw = *(const u32x4*)(z + (size_t)(row0 + s) * ZLD + ZK + h * GDK + kb);
        u32x4 qo, ko;
#pragma unroll
        for (int i = 0; i < 4; ++i) { const float e0 = __expf(g[2 * i]), e1 = __expf(g[2 * i + 1]);
            qo[i] = cvtpk(__uint_as_float(qw[i] << 16) * qs * e0, __uint_as_float(qw[i] & 0xffff0000u) * qs * e1);
            ko[i] = cvtpk(__uint_as_float(kw[i] << 16) * __builtin_amdgcn_rcpf(e0), __uint_as_float(kw[i] & 0xffff0000u) * __builtin_amdgcn_rcpf(e1)); }
        *(u32x4*)(Qp + s * QP + kb) = qo; *(u32x4*)(Kp + s * QP + kb) = ko;
    }
    __syncthreads();
    const int wid = tid >> 6, lane = tid & 63, l32 = lane & 31, hi = lane >> 5;
    if (wid < 4) {
        const int mt = wid & 1, nt = wid >> 1; f32x16 a = f32x16{};
        if (nt <= mt) {
#pragma unroll
            for (int ks = 0; ks < 12; ++ks) { const bf16x8 x = *(const bf16x8*)(Qp + (mt * 32 + l32) * QP + ks * 16 + hi * 8), y = *(const bf16x8*)(Kp + (nt * 32 + l32) * QP + ks * 16 + hi * 8);
                a = __builtin_amdgcn_mfma_f32_32x32x16_bf16(x, y, a, 0, 0, 0); }
        }
#pragma unroll
        for (int r = 0; r < 16; ++r) { const int t = mt * 32 + att::crow(r, hi), s = nt * 32 + l32; const float v = (s <= t) ? a[r] : 0.f; Ab[t * KP + s] = (bf16_t)(cvtpk(v, 0.f) & 0xffffu); }
    }
    __syncthreads();
    const int mt = wid & 1, nt = wid >> 1;
    f32x16 oacc[3];
    const float* Sb = UT + (size_t)(c * GH + h) * GDV * GDK;
#pragma unroll
    for (int vs = 0; vs < 3; ++vs) {
        for (int it = tid; it < 128 * 24; it += 512) { const int v = it / 24, kb = (it % 24) * 8; const float* p = Sb + (size_t)(vs * 128 + v) * GDK + kb;
            *(u32x4*)(ST + v * QP + kb) = pack8u(*(const f32x4*)p, *(const f32x4*)(p + 4)); }
        for (int it = tid; it < 64 * 16; it += 512) { const int s = it & 63, vb = it >> 6; const u32x4 w = *(const u32x4*)(z + (size_t)(row0 + s) * ZLD + ZV + h * GDV + vs * 128 + vb * 8);
#pragma unroll
            for (int i = 0; i < 4; ++i) { VT[(vb * 8 + 2 * i) * KP + s] = (bf16_t)(w[i] & 0xffffu); VT[(vb * 8 + 2 * i + 1) * KP + s] = (bf16_t)(w[i] >> 16); } }
        __syncthreads();
        f32x16 a = f32x16{};
#pragma unroll
        for (int ks = 0; ks < 12; ++ks) { const bf16x8 x = *(const bf16x8*)(Qp + (mt * 32 + l32) * QP + ks * 16 + hi * 8), y = *(const bf16x8*)(ST + (nt * 32 + l32) * QP + ks * 16 + hi * 8);
            a = __builtin_amdgcn_mfma_f32_32x32x16_bf16(x, y, a, 0, 0, 0); }
#pragma unroll
        for (int ks = 0; ks < 4; ++ks) { const bf16x8 x = *(const bf16x8*)(Ab + (mt * 32 + l32) * KP + ks * 16 + hi * 8), y = *(const bf16x8*)(VT + (nt * 32 + l32) * KP + ks * 16 + hi * 8);
            a = __builtin_amdgcn_mfma_f32_32x32x16_bf16(x, y, a, 0, 0, 0); }
        oacc[vs] = a;
        __syncthreads();
    }
#pragma unroll
    for (int r = 0; r < 16; ++r) { float q = oacc[0][r] * oacc[0][r] + oacc[1][r] * oacc[1][r] + oacc[2][r] * oacc[2][r];
        q += __shfl_xor(q, 1); q += __shfl_xor(q, 2); q += __shfl_xor(q, 4); q += __shfl_xor(q, 8); q += __shfl_xor(q, 16);
        if (l32 == 0) RS[(mt * 32 + att::crow(r, hi)) * 4 + nt] = q; }
    __syncthreads();
#pragma unroll
    for (int r = 0; r < 16; ++r) { const int t = mt * 32 + att::crow(r, hi); const f32x4 q4 = *(const f32x4*)(RS + t * 4);
        const float rstd = rsqrtf(((q4[0] + q4[1]) + (q4[2] + q4[3])) * (1.0f / GDV) + RMS_EPS);
#pragma unroll
        for (int vs = 0; vs < 3; ++vs) { const int cv = h * GDV + vs * 128 + nt * 32 + l32;
            const float gate = bf2f(z[(size_t)(row0 + t) * ZLD + ZR + cv]) + br[cv]; const float sg = gate / (1.f + __expf(-gate));
            const float val = oacc[vs][r] * rstd * ng[cv] * sg; const float vn = __shfl_xor(val, 1);
            if ((l32 & 1) == 0) *(unsigned*)(oc + (size_t)(row0 + t) * DM + cv) = cvtpk(val, vn); } }
    __syncthreads();
}
}

__device__ __forceinline__ int in_rowmap(int kind, int c) {
    if (kind == 0) return c < 4608 ? c : (c < 4620 ? 5120 + (c - 4608) : 4608 + (c - 4620));
    if (kind == 2) return c < 4608 ? c : (c < 4624 ? 5120 + (c - 4608) : 4608 + (c - 4624));
    return c;
}
__device__ __forceinline__ void tr_item(const float* W, int K, int N, bf16_t* WT, int kind, const float* gain, float* scr, int item, int lane) {
    const int nblk = (N + 31) >> 5, kb = item / nblk, nb = item - kb * nblk, k0 = 64 * kb, n0 = 32 * nb;
    const int nn = n0 + (lane & 31); const bool ok = nn < N;
#pragma unroll 8
    for (int i = 0; i < 32; ++i) { const int kk = 2 * i + (lane >> 5); float v = ok ? W[(size_t)(k0 + kk) * N + nn] : 0.f; if (gain) v *= gain[k0 + kk]; scr[kk * 33 + (lane & 31)] = v; }
    LDS_WAIT(); asm volatile("" ::: "memory");
    const int c = lane & 7;
#pragma unroll
    for (int j = 0; j < 4; ++j) { const int n = (lane >> 3) + 8 * j; const float* s = scr + (8 * c) * 33 + n;
        if (n0 + n < N) { u32x4 o; o[0] = cvtpk(s[0 * 33], s[1 * 33]); o[1] = cvtpk(s[2 * 33], s[3 * 33]); o[2] = cvtpk(s[4 * 33], s[5 * 33]); o[3] = cvtpk(s[6 * 33], s[7 * 33]);
            *(u32x4*)(WT + (size_t)in_rowmap(kind, n0 + n) * K + k0 + 8 * c) = o; } }
    LDS_WAIT(); asm volatile("" ::: "memory");
}
__device__ __forceinline__ void cvt_row(const float* src, bf16_t* dst, int n, int lane) {
    for (int o = lane * 4; o < n; o += 256) { const f32x4 v = *(const f32x4*)(src + o); u32x2 w = {cvtpk(v[0], v[1]), cvtpk(v[2], v[3])}; *(u32x2*)(dst + o) = w; }
}

#ifndef EN_MASK
#define EN_MASK 0xFFFF
#endif
#define EN(k) ((EN_MASK >> (k)) & 1)
struct Args { const float* in[29]; float* out; unsigned char* ws; int ph_lo, ph_hi; };
constexpr int PH_FINAL = 1 + 7 * NLAYER, PH_END = PH_FINAL + 1;
constexpr int PT_OFF = MISC_OFF + 256;
__device__ __forceinline__ unsigned long long ptab_raw(const char* lds, int k) {
    const unsigned long long v = ((const unsigned long long*)(lds + PT_OFF))[k];
    const unsigned l = __builtin_amdgcn_readfirstlane((unsigned)v), h = __builtin_amdgcn_readfirstlane((unsigned)(v >> 32));
    return ((unsigned long long)h << 32) | l;
}
#define PIN(k) ((const float*)(const GAS float*)ptab_raw(lds, (k)))
#define POUT() ((float*)(GAS float*)ptab_raw(lds, 29))
#define PWS() ((unsigned char*)(GAS unsigned char*)ptab_raw(lds, 30))

__global__ void __launch_bounds__(512, 2) trunk_fwd(Args args) {
    extern __shared__ __attribute__((aligned(16))) unsigned char lds_raw[];
    char* lds = (char*)lds_raw;
    volatile LAS unsigned* MISC = (volatile LAS unsigned*)((LAS unsigned char*)lds_raw + MISC_OFF);
    for (int u = threadIdx.x; u < 64; u += 512) MISC[u] = 0u;
    if (threadIdx.x < 29) ((unsigned long long*)(lds + PT_OFF))[threadIdx.x] = (unsigned long long)args.in[threadIdx.x];
    if (threadIdx.x == 29) ((unsigned long long*)(lds + PT_OFF))[29] = (unsigned long long)args.out;
    if (threadIdx.x == 30) ((unsigned long long*)(lds + PT_OFF))[30] = (unsigned long long)args.ws;
    const int g_wave = __builtin_amdgcn_readfirstlane(threadIdx.x >> 6);
    __syncthreads();
    const int G = gridDim.x, bx = blockIdx.x, vcu = (G % 8 == 0) ? (bx % 8) * (G / 8) + bx / 8 : bx;
#if !MK_PER_PHASE
    const XcdBarrier bar = xcd_barrier_post((unsigned*)(args.ws + WS_CTL) + CW_BAR, MISC + 8);
#define GRID_BAR() xcd_barrier(bar)
#else
#define GRID_BAR() do { } while (0)
#endif
    const int lo = args.ph_lo, hi = args.ph_hi;
#define IN(k) (lo <= (k) && (k) < hi)
#define SEAM(k) do { if ((k) + 1 < hi) GRID_BAR(); } while (0)
#define WSP(T, off) ((T*)(ws + (off)))

    if (EN(0) && IN(0)) {
        unsigned char* ws = PWS();
        const int tid = opaque_tid(), lane = tid & 63, wave = tid >> 6, gw = vcu * 8 + wave, NGW = G * 8;
        float* scr = (float*)(lds + wave * 16384);
        for (int L = 0; L < NLAYER; ++L) {
            const int kind = L % 3, j = L / 3;
            const float* win = kind == 0 ? PIN(16) + (size_t)j * DM * 5132 : (kind == 1 ? PIN(19) : PIN(21)); const int nin = kind == 0 ? 5132 : (kind == 1 ? 5120 : 5136);
            const float* wout = kind == 0 ? PIN(18) + (size_t)j * DM * DM : (kind == 1 ? PIN(20) : PIN(26));
            for (int it = gw; it < 32 * ((nin + 31) / 32); it += NGW) tr_item(win, DM, nin, WSP(bf16_t, WS_WIN) + (size_t)L * ZLD * DM, kind, PIN(11) + L * DM, scr, it, lane);
            for (int it = gw; it < 32 * 64; it += NGW) tr_item(wout, DM, DM, WSP(bf16_t, WS_WOUT) + (size_t)L * DM * DM, 1, nullptr, scr, it, lane);
            for (int it = gw; it < 32 * 256; it += NGW) tr_item(PIN(27) + (size_t)L * DM * DFF, DM, DFF, WSP(bf16_t, WS_WUP) + (size_t)L * DFF * DM, 1, PIN(12) + L * DM, scr, it, lane);
            for (int it = gw; it < 128 * 64; it += NGW) tr_item(PIN(28) + (size_t)L * DFF * DM, DFF, DM, WSP(bf16_t, WS_WDN) + (size_t)L * DM * DFF, 1, nullptr, scr, it, lane);
            for (int it = gw; it < 32 * 32; it += NGW) tr_item(PIN(15) + (size_t)L * DM * 1024, DM, 1024, WSP(bf16_t, WS_WMKV) + (size_t)L * 1024 * DM, 1, nullptr, scr, it, lane);
        }
        { const float* xp = PIN(0); const float* xs = PIN(1); float* X = WSP(float, WS_X); bf16_t* XB = WSP(bf16_t, WS_XB); float* RSA = WSP(float, WS_RSS);
        for (int m = gw; m < MT; m += NGW) {
            const float* src = m < TP ? xp + (size_t)m * DM : xs + (size_t)(m - TP) * DM; float ss = 0.f;
#pragma unroll
            for (int q = 0; q < 8; ++q) { const int o = q * 256 + lane * 4; const f32x4 v = *(const f32x4*)(src + o); *(f32x4*)(X + (size_t)m * DM + o) = v;
                u32x2 w = {cvtpk(v[0], v[1]), cvtpk(v[2], v[3])}; *(u32x2*)(XB + (size_t)m * DM + o) = w; ss += (v[0] * v[0] + v[1] * v[1]) + (v[2] * v[2] + v[3] * v[3]); }
            ss = wave_sum(ss);
            if (lane < 32) RSA[(size_t)m * 32 + lane] = lane == 0 ? ss : 0.f;
        } }
        { const float* mp = PIN(10); const float* gm = PIN(13); bf16_t* MEMH = WSP(bf16_t, WS_MEMH);
        for (int it = gw; it < NLAYER * NMEM; it += NGW) { const int i = it / NMEM, r = it % NMEM; const float* src = mp + (size_t)r * DM; const float* g = gm + (size_t)i * DM;
            f32x4 v[8]; float ss = 0.f;
#pragma unroll
            for (int q = 0; q < 8; ++q) { v[q] = *(const f32x4*)(src + q * 256 + lane * 4); ss += (v[q][0] * v[q][0] + v[q][1] * v[q][1]) + (v[q][2] * v[q][2] + v[q][3] * v[q][3]); }
            const float rstd = rsqrtf(wave_sum(ss) * (1.0f / DM) + RMS_EPS);
#pragma unroll
            for (int q = 0; q < 8; ++q) { const f32x4 gg = *(const f32x4*)(g + q * 256 + lane * 4); u32x2 w = {cvtpk(v[q][0] * rstd * gg[0], v[q][1] * rstd * gg[1]), cvtpk(v[q][2] * rstd * gg[2], v[q][3] * rstd * gg[3])};
                *(u32x2*)(MEMH + ((size_t)i * NMEM + r) * DM + q * 256 + lane * 4) = w; } } }
        { const float* ck = PIN(2); const float* cv = PIN(3); bf16_t* KVF = WSP(bf16_t, WS_KVF);
        for (int it = gw; it < 4 * NB * PAST; it += NGW) { const int t = it / (NB * PAST), r = it % (NB * PAST), jj = t >> 1, kv = t & 1;
            cvt_row((kv ? cv : ck) + ((size_t)jj * NB * PAST + r) * AW, KVF + (size_t)t * (KVS_ONE / 2) + ((size_t)(r / PAST) * SKS + (r % PAST)) * AW, AW, lane); } }
        { const float* ck = PIN(5); const float* cv = PIN(6); bf16_t* KVS = WSP(bf16_t, WS_KVS);
        for (int it = gw; it < 2 * NB * PAST; it += NGW) { const int kv = it / (NB * PAST), r = it % (NB * PAST);
            cvt_row((kv ? cv : ck) + (size_t)r * AW, KVS + (size_t)kv * (KVS_ONE / 2) + ((size_t)(r / PAST) * SKS + (r % PAST)) * AW, AW, lane); } }
        { const float* ck = PIN(8); const float* cv = PIN(9); bf16_t* MEMC = WSP(bf16_t, WS_MEMC);
        for (int it = gw; it < 8 * NB * NMEM; it += NGW) { const int t = it / (NB * NMEM), r = it % (NB * NMEM), L = t >> 1, kv = t & 1;
            cvt_row((kv ? cv : ck) + ((size_t)L * NB * NMEM + r) * MEMW, MEMC + (size_t)t * (MEMC_ONE / 2) + (size_t)r * MEMW, MEMW, lane); } }
        SEAM(0);
    }

    for (int L = 0; L < NLAYER; ++L) {
        const int kind = L % 3, j = L / 3, base = 1 + 7 * L;
        if (EN(1) && IN(base + 0)) {
            unsigned char* ws = PWS();
            const int tid = opaque_tid();
            pg8::Sched S; S.nM = MT / 256; S.nN = kind == 1 ? 20 : 21; S.nwg = S.nM * S.nN; S.G = G; S.c = bx; S.nextra = L == 0 ? 16 : 0;
            S.A = (const char*)WSP(bf16_t, WS_XB); S.B = (const char*)(WSP(bf16_t, WS_WIN) + (size_t)L * ZLD * DM); S.tA = (size_t)256 * DM * 2; S.tB = (size_t)256 * DM * 2;
            S.Ae = (const char*)WSP(bf16_t, WS_MEMH); S.Be = (const char*)WSP(bf16_t, WS_WMKV); S.tAe = (size_t)NMEM * DM * 2; S.tBe = (size_t)256 * DM * 2;
            pg8::EpiIn E; E.z = WSP(bf16_t, WS_Z); E.rss = WSP(float, WS_RSS); E.out = POUT(); E.mkvb = WSP(bf16_t, WS_MKVB); E.kind = kind; E.j = j;
            E.kvb = kind == 0 ? WSP(bf16_t, WS_KVF) + (size_t)(2 * j) * (KVS_ONE / 2) : WSP(bf16_t, WS_KVS); E.bfg = PIN(17) + j * NH;
            pg8::gemm_phase<pg8::EpiIn>((LAS unsigned char*)lds_raw, DM, DM, DM, S, E, tid);
            SEAM(base + 0);
        }
        if (IN(base + 1) && kind != 0) {
            unsigned char* ws = PWS();
            if (EN(2) && kind == 1) {
                bf16_t* Z = WSP(bf16_t, WS_Z); bf16_t* OC = WSP(bf16_t, WS_OC); bf16_t* KVS = WSP(bf16_t, WS_KVS);
                for (int n = vcu; n < 480; n += G) { att::Blk b; b.ldq = ZLD; b.ldo = DM; b.bmode = 0; b.lf0 = b.lf1 = nullptr; b.n0 = 0;
                    if (n < 384) { const int h = n / 32, qb = n % 32; b.Q = Z + (size_t)qb * 256 * ZLD + h * HD; b.K = Z + AW + h * HD; b.V = Z + 2 * AW + h * HD; b.ldkv = ZLD;
                        b.O = OC + (size_t)qb * 256 * DM + h * HD; b.P0 = qb * 256; b.skv = TP; b.nrows = 256; }
                    else { const int m = n - 384, bb = m / NH, h = m % NH; b.Q = Z + (size_t)(TP + bb * 64) * ZLD + h * HD; b.K = KVS + (size_t)bb * SKS * AW + h * HD; b.V = KVS + KVS_ONE / 2 + (size_t)bb * SKS * AW + h * HD; b.ldkv = AW;
                        b.O = OC + (size_t)(TP + bb * 64) * DM + h * HD; b.P0 = PAST; b.skv = SKS; b.nrows = 64; }
                    att::sb_block(b, lds, g_wave); }
            } else if (EN(3) && kind == 2) {
                for (int u = vcu; u < NCHUNK * GH; u += G) gla::g1_unit(u / GH, u % GH, WSP(bf16_t, WS_Z), PIN(22), PIN(23), WSP(float, WS_GU), WSP(float, WS_GDEC), lds, g_wave);
            }
            SEAM(base + 1);
        }
        if (EN(4) && IN(base + 2) && kind == 2) {
            unsigned char* ws = PWS();
            const int tid = opaque_tid();
            if (vcu < 144) gla::g2_tile(vcu, WSP(float, WS_GU), WSP(float, WS_GDEC), PIN(7), POUT() + O_GSP, POUT() + O_GSS, lds, tid);
            SEAM(base + 2);
        }
        if (IN(base + 3)) {
            unsigned char* ws = PWS();
            if (EN(5) && kind == 2) for (int u = vcu; u < NCHUNK * GH; u += G) gla::g3_unit(u / GH, u % GH, WSP(bf16_t, WS_Z), PIN(22), PIN(23), WSP(float, WS_GU), PIN(25), PIN(24), WSP(bf16_t, WS_OC), lds, g_wave);
            const float* outp = POUT(); const float* lfc = PIN(4);
            auto get = [&](int i, att::Blk& b) -> bool {
                int type, a0, a1;
                if (kind == 0) {
                    if (vcu < 192) { if (i > 1) return false; type = 0; a0 = vcu / 16; a1 = i == 0 ? vcu % 16 : 31 - vcu % 16; }
                    else { if (i > 3) return false; const int s = (vcu - 192) + 64 * i; if (s < 96) { type = 1; a0 = s / NH; a1 = s % NH; } else if (s < 224) { type = 2; a0 = (s - 96) / 32; a1 = (s - 96) % 32; } else { type = 3; a0 = (s - 224) / MH; a1 = (s - 224) % MH; } }
                } else { const int n = vcu + G * i; if (n >= 160) return false; if (n < 128) { type = 2; a0 = n / 32; a1 = n % 32; } else { type = 3; a0 = (n - 128) / MH; a1 = (n - 128) % MH; } }
                bf16_t* Z = WSP(bf16_t, WS_Z); bf16_t* OC = WSP(bf16_t, WS_OC);
                b.ldq = ZLD; b.ldo = DM; b.lf0 = b.lf1 = nullptr; b.n0 = 0; b.bmode = 0;
                if (type == 0) { const int h = a0, qb = a1; b.Q = Z + (size_t)qb * 256 * ZLD + h * HD; b.K = Z + AW + h * HD; b.V = Z + 2 * AW + h * HD; b.ldkv = ZLD; b.O = OC + (size_t)qb * 256 * DM + h * HD;
                    b.P0 = qb * 256; b.skv = TP; b.nrows = 256; b.bmode = 1; b.lf0 = outp + O_FLP + (size_t)j * TP * NH + h; b.n0 = 1 << 30; }
                else if (type == 1) { const int bb = a0, h = a1; const bf16_t* fk = WSP(bf16_t, WS_KVF) + (size_t)(2 * j) * (KVS_ONE / 2);
                    b.Q = Z + (size_t)(TP + bb * 64) * ZLD + h * HD; b.K = fk + (size_t)bb * SKS * AW + h * HD; b.V = fk + KVS_ONE / 2 + (size_t)bb * SKS * AW + h * HD; b.ldkv = AW;
                    b.O = OC + (size_t)(TP + bb * 64) * DM + h * HD; b.P0 = PAST; b.skv = SKS; b.nrows = 64; b.bmode = 1; b.lf0 = lfc + ((size_t)j * NB + bb) * PAST * NH + h; b.n0 = PAST; b.lf1 = outp + O_FLS + (size_t)j * TS * NH + (size_t)bb * 64 * NH + h; }
                else if (type == 2) { const int h4 = a0, qb = a1; const bf16_t* mkb = WSP(bf16_t, WS_MKVB) + (size_t)L * NMEM * 1024;
                    b.Q = Z + (size_t)qb * 256 * ZLD + 4608 + h4 * HD; b.K = mkb + h4 * HD; b.V = mkb + MEMW + h4 * HD; b.ldkv = 1024; b.O = OC + (size_t)qb * 256 * DM + AW + h4 * HD;
                    b.P0 = 1 << 20; b.skv = NMEM; b.nrows = 256; }
                else { const int bb = a0, h4 = a1; const bf16_t* mck = WSP(bf16_t, WS_MEMC) + (size_t)(2 * L) * (MEMC_ONE / 2);
                    b.Q = Z + (size_t)(TP + bb * 64) * ZLD + 4608 + h4 * HD; b.K = mck + (size_t)bb * NMEM * MEMW + h4 * HD; b.V = mck + MEMC_ONE / 2 + (size_t)bb * NMEM * MEMW + h4 * HD; b.ldkv = MEMW;
                    b.O = OC + (size_t)(TP + bb * 64) * DM + AW + h4 * HD; b.P0 = 1 << 20; b.skv = NMEM; b.nrows = 64; }
                return true;
            };
            att::Blk cur, nxt;
            if (EN(6) && get(0, cur)) {
                att::Seam S; att::att_prime(cur, lds, S, g_wave);
                for (int i = 0;; ++i) { const bool more = get(i + 1, nxt); if (!more) nxt = cur;
                    att::prepare_bias(cur, lds, g_wave); att::att_block(cur, nxt, lds, S, g_wave);
                    if (!more) break; cur = nxt; }
            }
            SEAM(base + 3);
        }
        if (EN(7) && IN(base + 4)) {
            unsigned char* ws = PWS();
            const int tid = opaque_tid();
            pg8::Sched S; S.nM = MT / 256; S.nN = DM / 256; S.nwg = S.nM * S.nN; S.G = G; S.c = bx; S.nextra = 0;
            S.A = (const char*)WSP(bf16_t, WS_OC); S.B = (const char*)(WSP(bf16_t, WS_WOUT) + (size_t)L * DM * DM); S.tA = (size_t)256 * DM * 2; S.tB = (size_t)256 * DM * 2; S.Ae = S.Be = nullptr; S.tAe = S.tBe = 0;
            pg8::EpiRes E{WSP(float, WS_X), WSP(bf16_t, WS_XB), WSP(float, WS_RSS) + (size_t)MT * 32};
            pg8::gemm_phase<pg8::EpiRes>((LAS unsigned char*)lds_raw, DM, DM, DM, S, E, tid);
            SEAM(base + 4);
        }
        if (EN(8) && IN(base + 5)) {
            unsigned char* ws = PWS();
            const int tid = opaque_tid();
            pg8::Sched S; S.nM = MT / 256; S.nN = DFF / 256; S.nwg = S.nM * S.nN; S.G = G; S.c = bx; S.nextra = 0;
            S.A = (const char*)WSP(bf16_t, WS_XB); S.B = (const char*)(WSP(bf16_t, WS_WUP) + (size_t)L * DFF * DM); S.tA = (size_t)256 * DM * 2; S.tB = (size_t)256 * DM * 2; S.Ae = S.Be = nullptr; S.tAe = S.tBe = 0;
            pg8::EpiUp E{WSP(bf16_t, WS_U), WSP(float, WS_RSS) + (size_t)MT * 32};
            pg8::gemm_phase<pg8::EpiUp>((LAS unsigned char*)lds_raw, DM, DM, DM, S, E, tid);
            SEAM(base + 5);
        }
        if (EN(9) && IN(base + 6)) {
            unsigned char* ws = PWS();
            const int tid = opaque_tid();
            pg8::Sched S; S.nM = MT / 256; S.nN = DM / 256; S.nwg = S.nM * S.nN; S.G = G; S.c = bx; S.nextra = 0;
            S.A = (const char*)WSP(bf16_t, WS_U); S.B = (const char*)(WSP(bf16_t, WS_WDN) + (size_t)L * DM * DFF); S.tA = (size_t)256 * DFF * 2; S.tB = (size_t)256 * DFF * 2; S.Ae = S.Be = nullptr; S.tAe = S.tBe = 0;
            pg8::EpiRes E{WSP(float, WS_X), WSP(bf16_t, WS_XB), WSP(float, WS_RSS)};
            pg8::gemm_phase<pg8::EpiRes>((LAS unsigned char*)lds_raw, DFF, DFF, DFF, S, E, tid);
            SEAM(base + 6);
        }
    }
    if (EN(10) && IN(PH_FINAL)) {
        unsigned char* ws = PWS(); float* out = POUT();
        const int tid = opaque_tid(), lane = tid & 63, wave = tid >> 6, gw = vcu * 8 + wave, NGW = G * 8;
        const float* g = PIN(14); const float* X = WSP(float, WS_X); const float* RSA = WSP(float, WS_RSS);
        for (int m = gw; m < MT; m += NGW) {
            const float rstd = rsqrtf(wave_sum(lane < 32 ? RSA[(size_t)m * 32 + lane] : 0.f) * (1.0f / DM) + RMS_EPS); float* dst = m < TP ? out + O_YP + (size_t)m * DM : out + O_YS + (size_t)(m - TP) * DM;
#pragma unroll
            for (int q = 0; q < 8; ++q) { const int o = q * 256 + lane * 4; const f32x4 v = *(const f32x4*)(X + (size_t)m * DM + o), gg = *(const f32x4*)(g + o); *(f32x4*)(dst + o) = v * rstd * gg; }
        }
    }
#undef IN
#undef SEAM
#undef GRID_BAR
}

extern "C" void kernel_launch(void* const* d_in, const int* in_sizes, int n_in, void* d_out, int out_size, void* d_ws, size_t ws_size, hipStream_t stream) {
    static int grid = 0;
    if (grid == 0) {
        if (n_in != 29 || (size_t)out_size != O_END || ws_size < WS_END) { fprintf(stderr, "kernel_launch: unexpected shapes (n_in %d, out %d vs %zu, ws %zu vs %zu); nothing launched\n", n_in, out_size, (size_t)O_END, ws_size, (size_t)WS_END); grid = -1; return; }
        int dev = 0, cus = 0, per_cu = 0;
        if (hipGetDevice(&dev) != hipSuccess || hipDeviceGetAttribute(&cus, hipDeviceAttributeMultiprocessorCount, dev) != hipSuccess) { grid = -1; return; }
        if (hipFuncSetAttribute((const void*)trunk_fwd, hipFuncAttributeMaxDynamicSharedMemorySize, LDS_BYTES) != hipSuccess) { fprintf(stderr, "kernel_launch: hipFuncSetAttribute failed\n"); grid = -1; return; }
        if (hipOccupancyMaxActiveBlocksPerMultiprocessor(&per_cu, (const void*)trunk_fwd, 512, LDS_BYTES) != hipSuccess || per_cu < 1) fprintf(stderr, "kernel_launch: occupancy query reports %d workgroups per CU\n", per_cu);
        (void)hipGetLastError();
        grid = cus;
    }
    if (grid < 0) return;
    if (hipMemsetAsync((char*)d_ws + WS_CTL, 0, CTL_BYTES, stream) != hipSuccess) return;
    Args a{};
    for (int i = 0; i < 29; ++i) a.in[i] = (const float*)d_in[i];
    a.out = (float*)d_out; a.ws = (unsigned char*)d_ws;
#if MK_PER_PHASE
    for (int p = 0; p < PH_END; ++p) {
        if (p >= 1 && p < PH_FINAL) { const int L = (p - 1) / 7, q = (p - 1) % 7, kind = L % 3; if ((q == 1 && kind == 0) || (q == 2 && kind != 2)) continue; }
        a.ph_lo = p; a.ph_hi = p + 1;
        hipLaunchKernelGGL(trunk_fwd, dim3(grid), dim3(512), LDS_BYTES, stream, a);
    }
#else
    a.ph_lo = 0; a.ph_hi = PH_END;
    hipLaunchKernelGGL(trunk_fwd, dim3(grid), dim3(512), LDS_BYTES, stream, a);
#endif
}
```

```cpp
#include <hip/hip_runtime.h>
#include <hip/hip_bf16.h>
#include <cstdio>
#include <cstdint>

#define MK_PER_PHASE 0
#ifndef MK_PER_PHASE
#define MK_PER_PHASE 0
#endif

constexpr int DM = 2048, TP = 8192, TS = 512, MT = TP + TS, NB = 8, CSEQ = 64, PAST = 1024, SKS = PAST + CSEQ;
constexpr int HD = 128, NH = 12, AW = NH * HD, MEMW = 512, NMEM = 256, MH = 4;
constexpr int GH = 4, GDK = 192, GDV = 384, GKW = GH * GDK, GVW = GH * GDV, GRANK = 16;
constexpr int DFF = 8192, ZLD = 5376, NLAYER = 4;
constexpr int NCHUNK = TP / 64 + NB;
constexpr float RMS_EPS = 1e-6f;

constexpr size_t O_YP = 0;
constexpr size_t O_YS = O_YP + (size_t)TP * DM;
constexpr size_t O_FKP = O_YS + (size_t)TS * DM;
constexpr size_t O_FVP = O_FKP + (size_t)2 * TP * AW;
constexpr size_t O_FLP = O_FVP + (size_t)2 * TP * AW;
constexpr size_t O_SKP = O_FLP + (size_t)2 * TP * NH;
constexpr size_t O_SVP = O_SKP + (size_t)TP * AW;
constexpr size_t O_GSP = O_SVP + (size_t)TP * AW;
constexpr size_t O_MKP = O_GSP + (size_t)GH * GDK * GDV;
constexpr size_t O_MVP = O_MKP + (size_t)NLAYER * NMEM * MEMW;
constexpr size_t O_FKS = O_MVP + (size_t)NLAYER * NMEM * MEMW;
constexpr size_t O_FVS = O_FKS + (size_t)2 * TS * AW;
constexpr size_t O_FLS = O_FVS + (size_t)2 * TS * AW;
constexpr size_t O_SKS = O_FLS + (size_t)2 * TS * NH;
constexpr size_t O_SVS = O_SKS + (size_t)TS * AW;
constexpr size_t O_GSS = O_SVS + (size_t)TS * AW;
constexpr size_t O_END = O_GSS + (size_t)NB * GH * GDK * GDV;

constexpr size_t al256(size_t x) { return (x + 255) & ~(size_t)255; }
constexpr size_t WS_CTL = 0, CTL_BYTES = 2u << 20;
constexpr size_t WS_WIN = CTL_BYTES;
constexpr size_t WS_WOUT = WS_WIN + (size_t)NLAYER * ZLD * DM * 2;
constexpr size_t WS_WUP = WS_WOUT + (size_t)NLAYER * DM * DM * 2;
constexpr size_t WS_WDN = WS_WUP + (size_t)NLAYER * DFF * DM * 2;
constexpr size_t WS_WMKV = WS_WDN + (size_t)NLAYER * DM * DFF * 2;
constexpr size_t WS_X = WS_WMKV + (size_t)NLAYER * 1024 * DM * 2;
constexpr size_t WS_XB = WS_X + (size_t)MT * DM * 4;
constexpr size_t WS_Z = WS_XB + (size_t)MT * DM * 2;
constexpr size_t WS_OC = WS_Z + (size_t)MT * ZLD * 2;
constexpr size_t WS_U = WS_OC + (size_t)MT * DM * 2;
constexpr size_t WS_GU = WS_U + (size_t)MT * DFF * 2;
constexpr size_t WS_GDEC = WS_GU + (size_t)NCHUNK * GH * GDV * GDK * 4;
constexpr size_t WS_KVF = al256(WS_GDEC + (size_t)NCHUNK * GH * GDK * 4);
constexpr size_t KVS_ONE = (size_t)NB * SKS * AW * 2;
constexpr size_t WS_KVS = WS_KVF + 4 * KVS_ONE;
constexpr size_t WS_MEMC = WS_KVS + 2 * KVS_ONE;
constexpr size_t MEMC_ONE = (size_t)NB * NMEM * MEMW * 2;
constexpr size_t WS_MEMH = WS_MEMC + 8 * MEMC_ONE;
constexpr size_t WS_MKVB = WS_MEMH + (size_t)NLAYER * NMEM * DM * 2;
constexpr size_t WS_RSS = WS_MKVB + (size_t)NLAYER * NMEM * 1024 * 2;
constexpr size_t WS_END = WS_RSS + (size_t)2 * MT * 32 * 4;

constexpr int CW_BAR = 4096;

constexpr int LDS_WORK = 136 * 1024;
constexpr int MISC_OFF = LDS_WORK;
constexpr int LDS_BYTES = 147456;

#define GAS __attribute__((address_space(1)))
#define LAS __attribute__((address_space(3)))
typedef unsigned short bf16_t;
typedef unsigned u32x4 __attribute__((ext_vector_type(4)));
typedef unsigned u32x2 __attribute__((ext_vector_type(2)));
typedef float f32x4 __attribute__((ext_vector_type(4)));
typedef float f32x2 __attribute__((ext_vector_type(2)));
typedef float f32x16 __attribute__((ext_vector_type(16)));
typedef short bf16x8 __attribute__((ext_vector_type(8)));
typedef short s16x4 __attribute__((ext_vector_type(4)));
#define LDS_WAIT() asm volatile("s_waitcnt lgkmcnt(0)" ::: "memory")
#define VM_WAIT() asm volatile("s_waitcnt vmcnt(0)" ::: "memory")
#define SBAR() __builtin_amdgcn_sched_barrier(0)
__device__ __forceinline__ unsigned cvtpk(float lo, float hi) { unsigned r; asm volatile("v_cvt_pk_bf16_f32 %0, %1, %2" : "=v"(r) : "v"(lo), "v"(hi)); return r; }
__device__ __forceinline__ float bf2f(unsigned short b) { return __uint_as_float((unsigned)b << 16); }
__device__ __forceinline__ u32x4 pack8u(f32x4 a, f32x4 b) { u32x4 w = {cvtpk(a[0], a[1]), cvtpk(a[2], a[3]), cvtpk(b[0], b[1]), cvtpk(b[2], b[3])}; return w; }
__device__ __forceinline__ bf16x8 pack8(f32x4 a, f32x4 b) { u32x4 w = pack8u(a, b); return *reinterpret_cast<bf16x8*>(&w); }
__device__ __forceinline__ float wave_sum(float v) {
#pragma unroll
    for (int o = 1; o < 64; o <<= 1) v += __shfl_xor(v, o);
    return v;
}
__device__ __forceinline__ float log_sigmoidf(float x) { return fminf(x, 0.f) - log1pf(expf(-fabsf(x))); }
__device__ __forceinline__ int opaque_tid_w(int wave) { int l; asm volatile("v_mbcnt_lo_u32_b32 %0, -1, 0\n\tv_mbcnt_hi_u32_b32 %0, -1, %0" : "=v"(l)); return wave * 64 + l; }
#define opaque_tid() opaque_tid_w(g_wave)
template <class T> __device__ __forceinline__ T* launder_s(T* p) { asm volatile("" : "+s"(p)); return p; }
#define XB_TMO      128
#define XB_XCNT(j)  (256  + 64 * (j))
#define XB_XSUB(j)  (1280 + 64 * (j))
#define XB_XGEN(j)  (2304 + 64 * (j))
#define XB_TOP      3328
#define XB_TOPGEN   3392
#define XCD_BAR_WORDS 3456
#define XB_SPIN_CAP (1u << 18)
__device__ __forceinline__ unsigned xb_ld(unsigned* p)              { return __hip_atomic_load(p, __ATOMIC_RELAXED, __HIP_MEMORY_SCOPE_AGENT); }
__device__ __forceinline__ unsigned xb_add(unsigned* p, unsigned v) { return __hip_atomic_fetch_add(p, v, __ATOMIC_RELAXED, __HIP_MEMORY_SCOPE_AGENT); }
__device__ __forceinline__ unsigned xb_xcc_id() { return (unsigned)__builtin_amdgcn_s_getreg((3 << 11) | 20) & 0xFu; }
#define XB_SPIN(cond, bar) do { unsigned _sp = 0; while (cond) { __builtin_amdgcn_s_sleep(1); \
    if ((++_sp & 255u) == 0u) { if (xb_ld(&(bar)[XB_TMO])) break; if (_sp > XB_SPIN_CAP) { atomicAdd(&(bar)[XB_TMO], 1u); break; } } } } while (0)
struct XcdBarrier { unsigned* bar; unsigned x; volatile LAS unsigned* st; };
__device__ __forceinline__ XcdBarrier xcd_barrier_post(unsigned* bar, volatile LAS unsigned* st) {
    XcdBarrier b; b.bar = bar; b.x = xb_xcc_id(); b.st = st;
    if (threadIdx.x == 0) (void)xb_add(&bar[XB_XCNT(b.x)], 1u);
    return b;
}
__device__ __forceinline__ void xcd_barrier_complete(unsigned* bar, unsigned x, unsigned& nloc, unsigned& nx) {
    const unsigned G = gridDim.x * gridDim.y * gridDim.z;
    unsigned sum, cnt, mine, sp = 0u;
    for (;;) {
        sum = 0u; cnt = 0u; mine = 0u;
#pragma unroll
        for (unsigned j = 0; j < 16; ++j) { const unsigned c = xb_ld(&bar[XB_XCNT(j)]); sum += c; cnt += (c > 0u) ? 1u : 0u; mine = (j == x) ? c : mine; }
        if (sum == G) break;
        __builtin_amdgcn_s_sleep(1);
        if ((++sp & 255u) == 0u) { if (xb_ld(&bar[XB_TMO])) break; if (sp > XB_SPIN_CAP) { atomicAdd(&bar[XB_TMO], 1u); break; } }
    }
    nloc = mine > 0u ? mine : 1u; nx = cnt > 0u ? cnt : 1u;
}
__device__ __forceinline__ void xcd_barrier(const XcdBarrier& b) {
    asm volatile("s_waitcnt vmcnt(0)" ::: "memory");
    __syncthreads();
    if (threadIdx.x == 0) {
        unsigned* bar = b.bar;
        __builtin_amdgcn_s_waitcnt(0);
        unsigned nloc = b.st[0], nx = b.st[1];
        if (nloc == 0u) { xcd_barrier_complete(bar, b.x, nloc, nx); b.st[0] = nloc; b.st[1] = nx; }
        const unsigned old = xb_add(&bar[XB_XSUB(b.x)], 1u);
        const unsigned gen = old / nloc;
        if (old + 1u == (gen + 1u) * nloc) {
            __builtin_amdgcn_fence(__ATOMIC_RELEASE, "agent");
            asm volatile("s_waitcnt vmcnt(0)" ::: "memory");
            const unsigned og = xb_add(&bar[XB_TOP], 1u);
            const unsigned tg = og / nx;
            if (og + 1u == (tg + 1u) * nx) xb_add(&bar[XB_TOPGEN], 1u);
            else XB_SPIN(xb_ld(&bar[XB_TOPGEN]) == tg, bar);
            __builtin_amdgcn_fence(__ATOMIC_ACQUIRE, "agent");
            xb_add(&bar[XB_XGEN(b.x)], 1u);
            asm volatile("s_waitcnt vmcnt(0)" ::: "memory");
        } else {
            XB_SPIN(xb_ld(&bar[XB_XGEN(b.x)]) == gen, bar);
            __builtin_amdgcn_fence(__ATOMIC_ACQUIRE, "agent");
            asm volatile("s_waitcnt vmcnt(0)" ::: "memory");
        }
    }
    __syncthreads();
}

namespace pg8 {
constexpr int BM = 256, BK = 64, HALF = 128, HTB = HALF * BK * 2, STAGE_BYTES = 8 * HTB, NXCD = 8, WGM = 8;
__host__ __device__ __forceinline__ int lds_byte(int r, int c) { const int st = (r >> 4) * 2 + (c >> 5), rr = r & 15, cc = c & 31, ob = rr * 64 + cc * 2; return st * 1024 + (ob ^ (((ob >> 9) & 1) << 5)); }
__host__ __device__ __forceinline__ void stage_rc(int b, int& R, int& C) { const int st = b / 1024, sb = b % 1024, swz = sb ^ (((sb >> 9) & 1) << 5); R = (st >> 1) * 16 + swz / 64; C = (st & 1) * 32 + (swz % 64) / 2; }
__host__ __device__ __forceinline__ int perm32(int rho) { const int n = rho >> 4, i = rho & 15; return 8 * (i >> 2) + 4 * n + (i & 3); }

struct Unit { int pm, pn, g; const char* A; const char* B; };

struct Sched {
    int nM, nN, nwg, G, c, nextra;
    const char* A; const char* B; size_t tA, tB;
    const char* Ae; const char* Be; size_t tAe, tBe;
    __device__ __forceinline__ bool next(int i, Unit& u) const {
        const long L = (long)i * G + c; if (L >= nwg + nextra) return false;
        if (L >= nwg) { const int e = (int)(L - nwg); u.g = 1 + (e >> 2); u.pm = 0; u.pn = e & 3; u.A = Ae + (size_t)(e >> 2) * tAe; u.B = Be + (size_t)e * tBe; return true; }
        int wgid = (int)L; { const int q = nwg / NXCD, r = nwg % NXCD, xcd = wgid % NXCD, off = wgid / NXCD; wgid = (xcd < r ? xcd * (q + 1) : r * (q + 1) + (xcd - r) * q) + off; }
        const int nig = WGM * nN, gid = wgid / nig, fm = gid * WGM, gsz = (nM - fm) < WGM ? (nM - fm) : WGM;
        u.pm = fm + ((wgid % nig) % gsz); u.pn = (wgid % nig) / gsz; u.g = 0; u.A = A + (size_t)u.pm * tA; u.B = B + (size_t)u.pn * tB; return true;
    }
};

__device__ __forceinline__ void row_rstd8(const float* rss, int row0, int fq, float (&rs)[2][4]) {
    f32x4 a[2][4], b[2][4];
#pragma unroll
    for (int ai = 0; ai < 2; ++ai)
#pragma unroll
        for (int m = 0; m < 4; ++m) { const f32x4* p = (const f32x4*)(rss + (size_t)(row0 + ai * HALF + m * 16) * 32 + fq * 8); a[ai][m] = p[0]; b[ai][m] = p[1]; }
#pragma unroll
    for (int ai = 0; ai < 2; ++ai)
#pragma unroll
        for (int m = 0; m < 4; ++m) { const f32x4 v = a[ai][m] + b[ai][m]; float s = (v[0] + v[1]) + (v[2] + v[3]); s += __shfl_xor(s, 16); s += __shfl_xor(s, 32); rs[ai][m] = rsqrtf(s * (1.0f / DM) + RMS_EPS); }
}
struct EpiIn {
    static constexpr bool PERM = true, AFTER_DRAIN = false;
    bf16_t* z; const float* rss; float* out; bf16_t* kvb; bf16_t* mkvb; const float* bfg; int kind, j;
    __device__ __forceinline__ void operator()(const f32x4 (&acc)[2][2][4][2], const Unit& u, int wr, int wc, int fr, int fq) const {
        const int row0 = u.pm * BM + wr * 64 + fr, colt = u.pn * BM, col0 = colt + wc * 32 + 8 * fq;
        if (u.g != 0) {
            const int e = u.g - 1; const bool isv = colt >= MEMW; float* of = out + (isv ? O_MVP : O_MKP) + (size_t)e * NMEM * MEMW; bf16_t* ob = mkvb + (size_t)e * NMEM * 1024;
#pragma unroll
            for (int ai = 0; ai < 2; ++ai)
#pragma unroll
                for (int m = 0; m < 4; ++m) { const int row = row0 + ai * HALF + m * 16;
#pragma unroll
                    for (int bj = 0; bj < 2; ++bj) { const int c = col0 + bj * HALF; const f32x4 v0 = acc[ai][bj][m][0], v1 = acc[ai][bj][m][1];
                        *(u32x4*)(ob + (size_t)row * 1024 + c) = pack8u(v0, v1);
                        float* o = of + (size_t)row * MEMW + (c - (isv ? MEMW : 0)); *(f32x4*)o = v0; *(f32x4*)(o + 4) = v1; } }
            return;
        }
        float rs[2][4]; row_rstd8(rss, row0, fq, rs);
        const bool kt = kind != 2 && colt >= AW && colt < 2 * AW, vt = kind != 2 && colt >= 2 * AW && colt < 3 * AW, smp = u.pm >= TP / BM;
        const int cbase = kt ? AW : 2 * AW;
        const size_t ocache = kind == 0 ? (smp ? (kt ? O_FKS : O_FVS) + (size_t)j * TS * AW : (kt ? O_FKP : O_FVP) + (size_t)j * TP * AW) : (smp ? (kt ? O_SKS : O_SVS) : (kt ? O_SKP : O_SVP));
        float* oc = out + ocache; bf16_t* kvs = kvb + (kt ? 0 : KVS_ONE / 2);
        const bool lft = kind == 0 && colt == 5120 && wc == 0 && fq < 2;
        float* lfo = out + (smp ? O_FLS + (size_t)j * TS * NH : O_FLP + (size_t)j * TP * NH);
#pragma unroll
        for (int ai = 0; ai < 2; ++ai)
#pragma unroll
            for (int m = 0; m < 4; ++m) { const int row = row0 + ai * HALF + m * 16, rr = smp ? row - TP : row; const float sc = rs[ai][m];
#pragma unroll
                for (int bj = 0; bj < 2; ++bj) { const int c = col0 + bj * HALF; const f32x4 v0 = acc[ai][bj][m][0] * sc, v1 = acc[ai][bj][m][1] * sc; const u32x4 w = pack8u(v0, v1);
                    *(u32x4*)(z + (size_t)row * ZLD + c) = w;
                    if (kt || vt) { const int cc = c - cbase; float* o = oc + (size_t)rr * AW + cc; *(f32x4*)o = v0; *(f32x4*)(o + 4) = v1;
                        if (smp) *(u32x4*)(kvs + ((size_t)(rr >> 6) * SKS + PAST + (rr & 63)) * AW + cc) = w; }
                    if (lft && bj == 0) {
                        float* o = lfo + (size_t)rr * NH;
#pragma unroll
                        for (int e = 0; e < 8; ++e) { const int h = 8 * fq + e; if (h < NH) o[h] = log_sigmoidf((e < 4 ? v0[e & 3] : v1[e & 3]) + bfg[h]); } } } }
    }
};
struct EpiRes {
    static constexpr bool PERM = true, AFTER_DRAIN = false;
    float* x; bf16_t* xb; float* rss;
    __device__ __forceinline__ void operator()(const f32x4 (&acc)[2][2][4][2], const Unit& u, int wr, int wc, int fr, int fq) const {
        const int row0 = u.pm * BM + wr * 64 + fr, col0 = u.pn * BM + wc * 32 + 8 * fq;
#pragma unroll
        for (int ai = 0; ai < 2; ++ai)
#pragma unroll
            for (int m = 0; m < 4; ++m) { const int row = row0 + ai * HALF + m * 16; float ss = 0.f;
#pragma unroll
                for (int bj = 0; bj < 2; ++bj) { float* p = x + (size_t)row * DM + col0 + bj * HALF;
                    const f32x4 a = *(const f32x4*)p + acc[ai][bj][m][0], b = *(const f32x4*)(p + 4) + acc[ai][bj][m][1];
                    *(f32x4*)p = a; *(f32x4*)(p + 4) = b; *(u32x4*)(xb + (size_t)row * DM + col0 + bj * HALF) = pack8u(a, b);
                    ss += (a[0] * a[0] + a[1] * a[1]) + (a[2] * a[2] + a[3] * a[3]) + (b[0] * b[0] + b[1] * b[1]) + (b[2] * b[2] + b[3] * b[3]); }
                ss += __shfl_xor(ss, 16); ss += __shfl_xor(ss, 32);
                if (fq == 0) rss[(size_t)row * 32 + u.pn * 4 + wc] = ss;
                if (m & 1) asm volatile("" ::: "memory"); }
    }
};
struct EpiUp {
    static constexpr bool PERM = true, AFTER_DRAIN = false;
    bf16_t* o; const float* rss;
    __device__ __forceinline__ void operator()(const f32x4 (&acc)[2][2][4][2], const Unit& u, int wr, int wc, int fr, int fq) const {
        const int row0 = u.pm * BM + wr * 64 + fr, col0 = u.pn * BM + wc * 32 + 8 * fq;
        float rs[2][4]; row_rstd8(rss, row0, fq, rs);
#pragma unroll
        for (int ai = 0; ai < 2; ++ai)
#pragma unroll
            for (int m = 0; m < 4; ++m) { const int row = row0 + ai * HALF + m * 16; const float sc = rs[ai][m];
#pragma unroll
                for (int bj = 0; bj < 2; ++bj) { f32x4 v0 = acc[ai][bj][m][0] * sc, v1 = acc[ai][bj][m][1] * sc;
#pragma unroll
                    for (int e = 0; e < 4; ++e) { const float a = fmaxf(v0[e], 0.f), b = fmaxf(v1[e], 0.f); v0[e] = a * a; v1[e] = b * b; }
                    *(u32x4*)(o + (size_t)row * DFF + col0 + bj * HALF) = pack8u(v0, v1); } }
    }
};

template <class Epi>
__device__ __forceinline__ void gemm_phase(LAS unsigned char* lds, const int K, const int lda, const int ldb, const Sched& S, const Epi& E, const int tid) {
    const int wid = __builtin_amdgcn_readfirstlane(tid >> 6), lane = tid & 63, wr = wid >> 2, wc = wid & 3, fr = lane & 15, fq = lane >> 4;
    const int nt = K / BK;
    unsigned voffA[2], voffB[2];
#pragma unroll
    for (int i = 0; i < 2; ++i) { int R, C; stage_rc(tid * 16 + i * 8192, R, C); const int Rb = Epi::PERM ? ((R & ~31) + perm32(R & 31)) : R;
        voffA[i] = (unsigned)(R * lda + C) * 2u; voffB[i] = (unsigned)(Rb * ldb + C) * 2u; }
    const size_t kstep = (size_t)(BK * 2);
    const size_t hstepA = (size_t)HALF * lda * 2, hstepB = (size_t)HALF * ldb * 2;
    const unsigned ldsw = (unsigned)wid * 1024u;
    const int aoff = lds_byte(wr * 64 + fr, fq * 8), boff = lds_byte(wc * 32 + fr, fq * 8);
#define PG8_SA(b, h) (((b) * 2 + (h)) * HTB)
#define PG8_SB(b, h) ((4 + (b) * 2 + (h)) * HTB)
#define PG8_STAGE(bufoff, gbase, voff) do { _Pragma("unroll") for (int _i = 0; _i < 2; ++_i) \
        __builtin_amdgcn_global_load_lds((const unsigned*)((const char*)(gbase) + (voff)[_i]), (LAS unsigned*)(lds + (bufoff) + ldsw + _i * 8192), 16, 0, 0); } while (0)
#define PG8_LDA(dst, b, h) do { _Pragma("unroll") for (int m = 0; m < 4; ++m) _Pragma("unroll") for (int k = 0; k < 2; ++k) dst[m][k] = *(const LAS bf16x8*)(lds + PG8_SA(b, h) + aoff + m * 2048 + k * 1024); } while (0)
#define PG8_LDB(dst, b, h) do { _Pragma("unroll") for (int n = 0; n < 2; ++n) _Pragma("unroll") for (int k = 0; k < 2; ++k) dst[n][k] = *(const LAS bf16x8*)(lds + PG8_SB(b, h) + boff + n * 2048 + k * 1024); } while (0)
#define PG8_MMA(ai, bj, At, Bt) do { __builtin_amdgcn_s_setprio(1); _Pragma("unroll") for (int m = 0; m < 4; ++m) _Pragma("unroll") for (int n = 0; n < 2; ++n) _Pragma("unroll") for (int k = 0; k < 2; ++k) \
        acc[ai][bj][m][n] = __builtin_amdgcn_mfma_f32_16x16x32_bf16(Bt[n][k], At[m][k], acc[ai][bj][m][n], 0, 0, 0); __builtin_amdgcn_s_setprio(0); } while (0)
#define PG8_WAIT_V(n) asm volatile("s_waitcnt vmcnt(" #n ")" ::: "memory")
#define PG8_WAIT_L(n) asm volatile("s_waitcnt lgkmcnt(" #n ")" ::: "memory")
#define PG8_BAR __builtin_amdgcn_s_barrier()
#define PG8_SCHED __builtin_amdgcn_sched_barrier(0)
    Unit cur, nxt; int ui = 0;
    if (!S.next(0, cur)) return;
    f32x4 acc[2][2][4][2];
#pragma unroll
    for (int a = 0; a < 2; ++a)
#pragma unroll
        for (int b = 0; b < 2; ++b)
#pragma unroll
            for (int m = 0; m < 4; ++m)
#pragma unroll
                for (int n = 0; n < 2; ++n) acc[a][b][m][n] = (f32x4){0.f, 0.f, 0.f, 0.f};
    bf16x8 At[4][2], B0[2][2], B1[2][2];
    const char* cA = cur.A; const char* cB = cur.B;
    PG8_STAGE(PG8_SB(0, 0), cB, voffB); PG8_STAGE(PG8_SB(0, 1), cB + hstepB, voffB); PG8_STAGE(PG8_SA(0, 0), cA, voffA); PG8_STAGE(PG8_SA(0, 1), cA + hstepA, voffA);
    if (wr == 1) PG8_BAR;
    PG8_WAIT_V(2); PG8_BAR;
    PG8_STAGE(PG8_SB(1, 0), cB + kstep, voffB); PG8_STAGE(PG8_SA(1, 0), cA + kstep, voffA); PG8_STAGE(PG8_SB(1, 1), cB + hstepB + kstep, voffB);
    PG8_WAIT_V(6); PG8_BAR;
    for (;;) {
        const bool has_next = S.next(ui + 1, nxt);
        const char* nA = has_next ? nxt.A : cA; const char* nB = has_next ? nxt.B : cB;
        for (int t = 0; t < nt; t += 2) {
            const bool last = (t == nt - 2);
            const char* a1 = cA + (size_t)(t + 1) * kstep;
            const char* a2 = last ? nA : cA + (size_t)(t + 2) * kstep; const char* b2 = last ? nB : cB + (size_t)(t + 2) * kstep;
            const char* a3 = a2 + kstep; const char* b3 = b2 + kstep;
            PG8_LDB(B0, 0, 0); PG8_LDB(B1, 0, 1); PG8_SCHED; PG8_LDA(At, 0, 0); PG8_STAGE(PG8_SA(1, 1), a1 + hstepA, voffA);
            PG8_WAIT_V(8); PG8_WAIT_L(0); PG8_BAR; PG8_MMA(0, 0, At, B0); PG8_MMA(0, 1, At, B1); PG8_BAR; PG8_SCHED;
            PG8_LDA(At, 0, 1); PG8_STAGE(PG8_SB(0, 0), b2, voffB); PG8_STAGE(PG8_SB(0, 1), b2 + hstepB, voffB); PG8_STAGE(PG8_SA(0, 0), a2, voffA);
            PG8_WAIT_V(8); PG8_WAIT_L(0); PG8_BAR; PG8_MMA(1, 0, At, B0); PG8_MMA(1, 1, At, B1); PG8_BAR; PG8_SCHED;
            PG8_LDB(B0, 1, 0); PG8_LDB(B1, 1, 1); PG8_SCHED; PG8_LDA(At, 1, 0); PG8_STAGE(PG8_SA(0, 1), a2 + hstepA, voffA);
            PG8_WAIT_V(8); PG8_WAIT_L(0); PG8_BAR; PG8_MMA(0, 0, At, B0); PG8_MMA(0, 1, At, B1); PG8_BAR; PG8_SCHED;
            PG8_LDA(At, 1, 1); PG8_STAGE(PG8_SB(1, 0), b3, voffB); PG8_STAGE(PG8_SB(1, 1), b3 + hstepB, voffB); PG8_STAGE(PG8_SA(1, 0), a3, voffA);
            PG8_WAIT_V(8); PG8_WAIT_L(0); PG8_BAR; PG8_MMA(1, 0, At, B0); PG8_MMA(1, 1, At, B1); PG8_BAR; PG8_SCHED;
        }
        if (wr == 0) PG8_BAR;
        E(acc, cur, wr, wc, fr, fq);
        if (!has_next) break;
#pragma unroll
        for (int a = 0; a < 2; ++a)
#pragma unroll
            for (int b = 0; b < 2; ++b)
#pragma unroll
                for (int m = 0; m < 4; ++m)
#pragma unroll
                    for (int n = 0; n < 2; ++n) acc[a][b][m][n] = (f32x4){0.f, 0.f, 0.f, 0.f};
        cur = nxt; cA = nA; cB = nB; ++ui;
        if (wr == 1) PG8_BAR;
    }
    PG8_WAIT_V(0);
    PG8_BAR;
#undef PG8_SA
#undef PG8_SB
#undef PG8_STAGE
#undef PG8_LDA
#undef PG8_LDB
#undef PG8_MMA
#undef PG8_WAIT_V
#undef PG8_WAIT_L
#undef PG8_BAR
#undef PG8_SCHED
}
}

namespace att {
constexpr float SCALE = 0.08838834764831845f;
constexpr float THR = 8.f;
constexpr int NW = 8, QBLK = 32, KVBLK = 64, QB = NW * QBLK, D = 128;
constexpr int SHM_V = KVBLK * D * 2, SHM_K = KVBLK * D * 2;
constexpr int ATT_LDS = 2 * SHM_V + 2 * SHM_K + NW * 64 * 4;
constexpr int BOS_OFF = ATT_LDS;
constexpr int BOS_BYTES = 8192 * 4;
constexpr int SCR_OFF = BOS_OFF + BOS_BYTES;
constexpr int WINF = 1 << 30;
static_assert(SCR_OFF + 256 <= LDS_WORK, "attention LDS map");

#define KSWZ(row, colB) ((row) * 256 + ((colB) ^ (((row) & 7) << 4)))
__device__ __forceinline__ int v_st(int k, int c) { const int kk = (k & ~0xC) | ((k & 4) << 1) | ((k & 8) >> 1); return ((kk >> 3) * 4 + (c >> 5)) * 512 + ((kk & 7) * 32 + (c & 31)) * 2; }
__device__ __forceinline__ int v_rd_base(int lane) { return ((lane & 3) << 3) | (((lane >> 2) & 3) << 6) | (((lane >> 4) & 1) << 5) | (((lane >> 5) & 1) << 8); }
constexpr int v_rd_off(int d0, int ks, int half) { return d0 * 512 + ks * 4096 + half * 2048; }
__device__ __forceinline__ int crow(int r, int hi) { return (r & 3) + 8 * (r >> 2) + 4 * hi; }
__device__ __forceinline__ bf16x8 load8(const bf16_t* p) { return *reinterpret_cast<const bf16x8*>(p); }

__device__ __forceinline__ void mask_tile(f32x16& p0, f32x16& p1, int dq, unsigned W) {
    const float NEG = -__builtin_inff();
#pragma unroll
    for (int r = 0; r < 16; ++r) {
        const int c = (r & 3) + 8 * (r >> 2);
        if ((unsigned)(dq - c) >= W) p0[r] = NEG;
        if ((unsigned)(dq - c - 32) >= W) p1[r] = NEG;
    }
}
__device__ __forceinline__ void partialSM(f32x16& p0, f32x16& p1, float& m_reg, float& mn, float& alpha) {
    float pmax = p0[0]; for (int r = 1; r < 16; ++r) pmax = fmaxf(pmax, p0[r]); for (int r = 0; r < 16; ++r) pmax = fmaxf(pmax, p1[r]);
    { auto rr = __builtin_amdgcn_permlane32_swap(__float_as_uint(pmax), __float_as_uint(pmax), false, false);
      pmax = fmaxf(__uint_as_float(rr[0]), __uint_as_float(rr[1])); }
    constexpr float C2 = 1.4426950408889634f * SCALE;
    if (__builtin_expect(__all((pmax - m_reg) * SCALE <= THR), 1)) { mn = m_reg; alpha = 1.f; }
    else { mn = fmaxf(m_reg, pmax); alpha = __builtin_amdgcn_exp2f((m_reg - mn) * C2); m_reg = mn; }
    const float mnL = -mn * C2;
    for (int r = 0; r < 16; ++r) p0[r] = fmaf(p0[r], C2, mnL); for (int r = 0; r < 16; ++r) p1[r] = fmaf(p1[r], C2, mnL);
    for (int r = 0; r < 16; ++r) p0[r] = __builtin_amdgcn_exp2f(p0[r]);
}
#define PK4(P, B_, OUT) do { unsigned a0 = cvtpk(P[B_+0], P[B_+1]), a1 = cvtpk(P[B_+2], P[B_+3]);                          \
        unsigned b0 = cvtpk(P[B_+4], P[B_+5]), b1 = cvtpk(P[B_+6], P[B_+7]);                                             \
        auto r0 = __builtin_amdgcn_permlane32_swap(a0, b0, false, false); auto r1 = __builtin_amdgcn_permlane32_swap(a1, b1, false, false); \
        u32x4 w = {r0[0], r1[0], r0[1], r1[1]}; OUT = *reinterpret_cast<bf16x8*>(&w); } while (0)
__device__ __forceinline__ void finishSM(f32x16& p0, f32x16& p1, float alpha, float& l_reg, bf16x8& pa0, bf16x8& pa1, bf16x8& pa2, bf16x8& pa3) {
    for (int r = 0; r < 16; ++r) p1[r] = __builtin_amdgcn_exp2f(p1[r]);
    float ps = 0; for (int r = 0; r < 16; ++r) ps += p0[r]; for (int r = 0; r < 16; ++r) ps += p1[r];
    { auto rr = __builtin_amdgcn_permlane32_swap(__float_as_uint(ps), __float_as_uint(ps), false, false);
      ps = __uint_as_float(rr[0]) + __uint_as_float(rr[1]); }
    l_reg = l_reg * alpha + ps;
    PK4(p0, 0, pa0); PK4(p0, 8, pa1); PK4(p1, 0, pa2); PK4(p1, 8, pa3);
}
template <int KB, bool BIAS>
__device__ __forceinline__ void qkt(f32x16& p0, f32x16& p1, const char* K_lds, int r32, int hi, const bf16x8* qr, const float* bk) {
    if constexpr (BIAS) {
#pragma unroll
        for (int i = 0; i < 4; ++i) { const f32x4 a = *(const f32x4*)(bk + 8 * i), b = *(const f32x4*)(bk + 32 + 8 * i);
            p0[4 * i] = a[0]; p0[4 * i + 1] = a[1]; p0[4 * i + 2] = a[2]; p0[4 * i + 3] = a[3];
            p1[4 * i] = b[0]; p1[4 * i + 1] = b[1]; p1[4 * i + 2] = b[2]; p1[4 * i + 3] = b[3]; }
    } else { p0 = f32x16{}; p1 = f32x16{}; }
    const char* kb[4];
#pragma unroll
    for (int dd = 0; dd < 4; ++dd) kb[dd] = K_lds + KB * SHM_K + KSWZ(r32, (dd * 16 + hi * 8) * 2);
#pragma unroll
    for (int d0 = 0; d0 < 8; ++d0) { const char* a = kb[d0 & 3] + (d0 >> 2) * 128;
        bf16x8 b0 = *reinterpret_cast<const bf16x8*>(a);
        bf16x8 b1 = *reinterpret_cast<const bf16x8*>(a + 32 * 256);
        p0 = __builtin_amdgcn_mfma_f32_32x32x16_bf16(b0, qr[d0], p0, 0, 0, 0);
        p1 = __builtin_amdgcn_mfma_f32_32x32x16_bf16(b1, qr[d0], p1, 0, 0, 0); }
}
template <int VB>
__device__ __forceinline__ void pv_tile(f32x16* o, int vb0, bf16x8 pa0, bf16x8 pa1, bf16x8 pa2, bf16x8 pa3) {
#define TRRD(dst, off) asm volatile("ds_read_b64_tr_b16 %0, %1 offset:%2" : "=&v"(dst) : "v"(vb0), "i"(off) : "memory")
#define PV_D0(d0) do { s16x4 l0, l1, l2, l3, h0, h1, h2, h3; constexpr int b_ = VB * SHM_V + v_rd_off(d0, 0, 0); \
        TRRD(l0, b_); TRRD(h0, b_ + 2048); TRRD(l1, b_ + 4096); TRRD(h1, b_ + 6144); TRRD(l2, b_ + 8192); TRRD(h2, b_ + 10240); TRRD(l3, b_ + 12288); TRRD(h3, b_ + 14336); \
        asm volatile("s_waitcnt lgkmcnt(0)" ::: "memory"); SBAR();   \
        o[d0] = __builtin_amdgcn_mfma_f32_32x32x16_bf16(pa0, (bf16x8){l0[0], l0[1], l0[2], l0[3], h0[0], h0[1], h0[2], h0[3]}, o[d0], 0, 0, 0);   \
        o[d0] = __builtin_amdgcn_mfma_f32_32x32x16_bf16(pa1, (bf16x8){l1[0], l1[1], l1[2], l1[3], h1[0], h1[1], h1[2], h1[3]}, o[d0], 0, 0, 0);   \
        o[d0] = __builtin_amdgcn_mfma_f32_32x32x16_bf16(pa2, (bf16x8){l2[0], l2[1], l2[2], l2[3], h2[0], h2[1], h2[2], h2[3]}, o[d0], 0, 0, 0);   \
        o[d0] = __builtin_amdgcn_mfma_f32_32x32x16_bf16(pa3, (bf16x8){l3[0], l3[1], l3[2], l3[3], h3[0], h3[1], h3[2], h3[3]}, o[d0], 0, 0, 0); } while (0)
    PV_D0(0); PV_D0(1); PV_D0(2); PV_D0(3);
#undef PV_D0
#undef TRRD
}

struct Blk { const bf16_t* Q; const bf16_t* K; const bf16_t* V; bf16_t* O; int ldq, ldkv, ldo; int P0, skv, nrows; int bmode; const float* lf0; int n0; const float* lf1; };
struct Seam { bf16x8 qr[8]; bf16x8 st_v0, st_v1, st_k0, st_k1; };
__device__ __forceinline__ int blk_jhi(const Blk& b) { int j = (b.P0 + QB - 1) / KVBLK + 1; const int m = b.skv / KVBLK; return j > m ? m : j; }

__device__ __forceinline__ void prepare_bias(const Blk& b, char* lds, int g_wave) {
    const int tid = opaque_tid();
    float* bos = (float*)(lds + BOS_OFF); float* scr = (float*)(lds + SCR_OFF);
    const int nk = blk_jhi(b) * KVBLK, lane = tid & 63, wid = tid >> 6;
    if (b.bmode == 0) { for (int k = tid; k < nk; k += 512) bos[k] = 0.f; __syncthreads(); return; }
    float v[16]; float tot = 0.f; const int k0 = tid * 16; const bool in = k0 < nk;
#pragma unroll
    for (int i = 0; i < 16; ++i) { const int k = k0 + i; v[i] = in ? (k < b.n0 ? b.lf0[(size_t)k * NH] : b.lf1[(size_t)(k - b.n0) * NH]) : 0.f; tot += v[i]; }
    float inc = tot;
#pragma unroll
    for (int o = 1; o < 64; o <<= 1) { const float y = __shfl_down(inc, o); if (lane + o < 64) inc += y; }
    if (lane == 0) scr[wid] = inc;
    __syncthreads();
    float hiw = 0.f;
#pragma unroll
    for (int w = 0; w < 8; ++w) if (w > wid) hiw += scr[w];
    float run = (inc - tot) + hiw;
    if (in) {
#pragma unroll
        for (int i = 15; i >= 0; --i) { bos[k0 + i] = run * (1.0f / SCALE); run += v[i]; }
    }
    __syncthreads();
}

#define ROWK(p, ld, k0, rr) ((p) + (size_t)((k0) + (rr)) * (ld) + sc)
#define VMW() asm volatile("s_waitcnt vmcnt(0)" ::: "memory")
#define VMWN(n) asm volatile("s_waitcnt vmcnt(%0)" :: "i"(n) : "memory")
#define SLOAD_H(Kp, Vp, ld, k0) do { S.st_v0 = load8(ROWK(Vp, ld, k0, sr)); S.st_v1 = load8(ROWK(Vp, ld, k0, 32 + sr));              \
                         S.st_k0 = load8(ROWK(Kp, ld, k0, sr)); S.st_k1 = load8(ROWK(Kp, ld, k0, 32 + sr)); } while (0)
#define SWRITE_HK(bf) do { *(bf16x8*)(K_lds + (bf) * SHM_K + kws) = S.st_k0; *(bf16x8*)(K_lds + (bf) * SHM_K + kws + 32 * 256) = S.st_k1; } while (0)
#define SWRITE_HV(bf) do { *(bf16x8*)(V_lds + (bf) * SHM_V + vst0) = S.st_v0; *(bf16x8*)(V_lds + (bf) * SHM_V + vst1) = S.st_v1; } while (0)
#define SWRITE_H(bf) do { SWRITE_HV(bf); SWRITE_HK(bf); } while (0)
#define QROWP(b_) ((b_).Q + (size_t)((wid * QBLK + r32) & ((b_).nrows - 1)) * (b_).ldq + hi * 8)
__device__ __forceinline__ void att_prime(const Blk& cur, char* lds, Seam& S, int g_wave) {
    const int tid = opaque_tid();
    const int wid = __builtin_amdgcn_readfirstlane(tid >> 6), lane = tid & 63, r32 = lane & 31, hi = lane >> 5;
    const int sr = tid >> 4, sc = (tid & 15) * 8, kws = KSWZ(sr, sc * 2); char* K_lds = lds + 2 * SHM_V;
    const bf16_t* qp = QROWP(cur);
#pragma unroll
    for (int d0 = 0; d0 < 8; ++d0) S.qr[d0] = load8(qp + d0 * 16);
    SLOAD_H(cur.K, cur.V, cur.ldkv, 0); VMW(); SWRITE_HK(0);
    __syncthreads();
}
__device__ __forceinline__ void att_block(const Blk& cur, const Blk& nxt, char* lds, Seam& S, int g_wave) {
    const int tid = opaque_tid();
    const int wid = __builtin_amdgcn_readfirstlane(tid >> 6), lane = tid & 63, r32 = lane & 31, hi = lane >> 5;
    constexpr int W = WINF;
    const int NT = blk_jhi(cur);
    const int qlo = cur.P0 + wid * QBLK, qm = qlo + r32 - 4 * hi;
    char* V_lds = lds; char* K_lds = lds + 2 * SHM_V;
    float* ws = (float*)(lds + 2 * SHM_V + 2 * SHM_K) + wid * 64; float* li_l = ws, * al_l = ws + 32;
    const float* bos = (const float*)(lds + BOS_OFF) + 4 * hi;
    float m_reg = -1e30f, l_reg = 0; f32x16 o[4] = {};
    const int sr = tid >> 4, sc = (tid & 15) * 8, vst0 = v_st(sr, sc), vst1 = v_st(32 + sr, sc), kws = KSWZ(sr, sc * 2);
    const int vb0 = (int)(uintptr_t)V_lds + v_rd_base(lane);
    const bf16_t* Kh = cur.K; const bf16_t* Vh = cur.V; const int ldkv = cur.ldkv;
#define RESC(a) do { if (__any((a) < 1.f)) { if (hi == 0) al_l[r32] = (a); asm volatile("s_waitcnt lgkmcnt(0)" ::: "memory");              \
                     for (int d_ = 0; d_ < 4; ++d_) for (int r = 0; r < 16; ++r) o[d_][r] *= al_l[crow(r, hi)]; } } while (0)
#define KBASE(t) ((t) * KVBLK)
#define MASKT(P0_, P1_, t) do { const int kb_ = KBASE(t); if (kb_ + KVBLK - 1 > qlo) mask_tile(P0_, P1_, qm - kb_, (unsigned)W); } while (0)
    constexpr int NQL = 8;
#define SEAM_K0() do { VMWN(NQL); SWRITE_HK(0); SBAR(); } while (0)
    f32x16 pA0, pA1, pB0, pB1; float mnA, mnB, alA, alB; bf16x8 pa0, pa1, pa2, pa3;
    SWRITE_HV(0); SBAR();
    if (NT > 1) SLOAD_H(Kh, Vh, ldkv, KBASE(1));
    SBAR(); qkt<0, true>(pA0, pA1, K_lds, r32, hi, S.qr, bos + KBASE(0));
    MASKT(pA0, pA1, 0); partialSM(pA0, pA1, m_reg, mnA, alA);
    if (NT > 1) { VMW(); SWRITE_H(1); }
    __syncthreads();
#define HALF_STEP(PX0, PX1, mnX, alX, PY0, PY1, alY, t, KB, VB, SB) do {                                                      \
        SBAR(); qkt<KB, true>(PX0, PX1, K_lds, r32, hi, S.qr, bos + KBASE(t));                                                \
        finishSM(PY0, PY1, alY, l_reg, pa0, pa1, pa2, pa3); SBAR();                                                           \
        if ((t) + 1 < NT) { SLOAD_H(Kh, Vh, ldkv, KBASE((t) + 1)); SBAR(); }                                                  \
        pv_tile<VB>(o, vb0, pa0, pa1, pa2, pa3); MASKT(PX0, PX1, (t)); partialSM(PX0, PX1, m_reg, mnX, alX);                  \
        __syncthreads();                                                                                                      \
        if ((t) + 1 < NT) { VMW(); SWRITE_H(SB); }                                                                            \
        RESC(alX); __syncthreads(); } while (0)
    for (int t = 1; t + 1 < NT; t += 2) {
        HALF_STEP(pB0, pB1, mnB, alB, pA0, pA1, alA, t, 1, 0, 0);
        HALF_STEP(pA0, pA1, mnA, alA, pB0, pB1, alB, t + 1, 0, 1, 1);
    }
    const bool even = (NT & 1) == 0;
    if (even) { SBAR(); qkt<1, true>(pB0, pB1, K_lds, r32, hi, S.qr, bos + KBASE(NT - 1)); SBAR(); }
    SLOAD_H(nxt.K, nxt.V, nxt.ldkv, 0); SBAR();
    { const bf16_t* qp = QROWP(nxt);
#pragma unroll
      for (int d0 = 0; d0 < 8; ++d0) S.qr[d0] = load8(qp + d0 * 16); }
    SBAR();
    finishSM(pA0, pA1, alA, l_reg, pa0, pa1, pa2, pa3); SBAR();
    pv_tile<0>(o, vb0, pa0, pa1, pa2, pa3);
    if (even) { MASKT(pB0, pB1, NT - 1); partialSM(pB0, pB1, m_reg, mnB, alB); __syncthreads(); RESC(alB);
        finishSM(pB0, pB1, alB, l_reg, pa0, pa1, pa2, pa3); SBAR(); pv_tile<1>(o, vb0, pa0, pa1, pa2, pa3); }
    SBAR(); SEAM_K0();
    if (hi == 0) li_l[r32] = l_reg; asm volatile("s_waitcnt lgkmcnt(0)" ::: "memory");
    float rli[16];
#pragma unroll
    for (int r = 0; r < 16; ++r) rli[r] = __builtin_amdgcn_rcpf(li_l[crow(r, hi)]);
    if (wid * QBLK < cur.nrows) {
        bf16_t* Ow = cur.O + (size_t)(wid * QBLK) * cur.ldo;
#pragma unroll
        for (int r = 0; r < 16; ++r) { const int orow = crow(r, hi);
#pragma unroll
            for (int d0 = 0; d0 < 4; ++d0) { const float v = o[d0][r] * rli[r]; const float vn = __shfl_xor(v, 1);
                if ((r32 & 1) == 0) *(unsigned*)(Ow + (size_t)orow * cur.ldo + d0 * 32 + r32) = cvtpk(v, vn); } }
    }
    __syncthreads();
#undef RESC
#undef MASKT
#undef SEAM_K0
#undef HALF_STEP
}

__device__ __forceinline__ void sb_block(const Blk& b, char* lds, int g_wave) {
    const int tid = opaque_tid();
    const int wid = __builtin_amdgcn_readfirstlane(tid >> 6), lane = tid & 63, r32 = lane & 31, hi = lane >> 5;
    char* V_lds = lds; char* K_lds = lds + 2 * SHM_V; int* flags = (int*)(lds + 2 * SHM_V + 2 * SHM_K);
    const int sr = tid >> 4, sc = (tid & 15) * 8, vst0 = v_st(sr, sc), vst1 = v_st(32 + sr, sc), kws = KSWZ(sr, sc * 2);
    const int vb0 = (int)(uintptr_t)V_lds + v_rd_base(lane);
    bf16x8 qr[8];
    { const bf16_t* qp = QROWP(b);
#pragma unroll
      for (int d0 = 0; d0 < 8; ++d0) qr[d0] = load8(qp + d0 * 16); }
    const int NT = blk_jhi(b), qlo = b.P0 + wid * QBLK, pos = qlo + r32;
    bool wdead = wid * QBLK >= b.nrows;
    float prun = 1.f; f32x16 o[4] = {};
    constexpr float C2 = 1.4426950408889634f * SCALE;
    for (int t = NT - 1; t >= 0; --t) {
        const int kb = t * KVBLK;
        const bf16x8 k0 = load8(ROWK(b.K, b.ldkv, kb, sr)), k1 = load8(ROWK(b.K, b.ldkv, kb, 32 + sr)), v0 = load8(ROWK(b.V, b.ldkv, kb, sr)), v1 = load8(ROWK(b.V, b.ldkv, kb, 32 + sr));
        __syncthreads();
        *(bf16x8*)(K_lds + kws) = k0; *(bf16x8*)(K_lds + kws + 32 * 256) = k1; *(bf16x8*)(V_lds + vst0) = v0; *(bf16x8*)(V_lds + vst1) = v1;
        __syncthreads();
        if (!wdead && kb < qlo + QBLK - 1) {
            f32x16 p0, p1; qkt<0, false>(p0, p1, K_lds, r32, hi, qr, nullptr);
            if (kb + KVBLK - 1 >= qlo) {
                const float NEG = -__builtin_inff();
#pragma unroll
                for (int r = 0; r < 16; ++r) { const int key = kb + crow(r, hi); if (key >= pos) p0[r] = NEG; if (key + 32 >= pos) p1[r] = NEG; }
            }
#pragma unroll
            for (int r = 0; r < 16; ++r) {
                p0[r] = __builtin_amdgcn_rcpf(1.f + __builtin_amdgcn_exp2f(fminf(p0[r] * C2, 60.f))); p1[r] = __builtin_amdgcn_rcpf(1.f + __builtin_amdgcn_exp2f(fminf(p1[r] * C2, 60.f))); }
            float gl[8], gu[8];
#pragma unroll
            for (int g = 0; g < 8; ++g) { const float gp = g < 4 ? (p0[4 * g] * p0[4 * g + 1]) * (p0[4 * g + 2] * p0[4 * g + 3]) : (p1[4 * g - 16] * p1[4 * g - 15]) * (p1[4 * g - 14] * p1[4 * g - 13]);
                auto x = __builtin_amdgcn_permlane32_swap(__float_as_uint(gp), __float_as_uint(gp), false, false); gl[g] = __uint_as_float(x[0]); gu[g] = __uint_as_float(x[1]); }
            float s = 1.f, sown[8];
#pragma unroll
            for (int g = 7; g >= 0; --g) { const float su = s; s *= gu[g]; const float sl = s; s *= gl[g]; sown[g] = hi ? su : sl; }
#define SB_EL(P, q) do { const float rr_ = P[q]; P[q] = (1.f - rr_) * tt; tt *= rr_; } while (0)
#pragma unroll
            for (int g = 0; g < 8; ++g) { float tt = sown[g] * prun;
                if (g < 4) { const int q = 4 * g; SB_EL(p0, q + 3); SB_EL(p0, q + 2); SB_EL(p0, q + 1); SB_EL(p0, q); }
                else { const int q = 4 * g - 16; SB_EL(p1, q + 3); SB_EL(p1, q + 2); SB_EL(p1, q + 1); SB_EL(p1, q); } }
#undef SB_EL
            prun *= s;
            bf16x8 pa0, pa1, pa2, pa3;
            PK4(p0, 0, pa0); PK4(p0, 8, pa1); PK4(p1, 0, pa2); PK4(p1, 8, pa3);
            pv_tile<0>(o, vb0, pa0, pa1, pa2, pa3);
            wdead = __all(prun < 8.67e-19f);
        }
        if (lane == 0) flags[wid] = wdead ? 1 : 0;
        __syncthreads();
        const int alld = flags[0] & flags[1] & flags[2] & flags[3] & flags[4] & flags[5] & flags[6] & flags[7];
        if (alld) break;
    }
    if (wid * QBLK < b.nrows) {
        bf16_t* Ow = b.O + (size_t)(wid * QBLK) * b.ldo;
#pragma unroll
        for (int r = 0; r < 16; ++r) { const int orow = crow(r, hi);
#pragma unroll
            for (int d0 = 0; d0 < 4; ++d0) { const float v = o[d0][r]; const float vn = __shfl_xor(v, 1);
                if ((r32 & 1) == 0) *(unsigned*)(Ow + (size_t)orow * b.ldo + d0 * 32 + r32) = cvtpk(v, vn); } }
    }
    __syncthreads();
}
#undef ROWK
#undef VMW
#undef VMWN
#undef SLOAD_H
#undef SWRITE_HK
#undef SWRITE_HV
#undef SWRITE_H
#undef QROWP
#undef PK4
#undef KSWZ
#undef KBASE
}

namespace gla {
constexpr int ZQ = 0, ZK = GKW, ZV = 2 * GKW, ZR = 2 * GKW + GVW, ZG = 5120;
constexpr int KP = 72, QP = 200;
constexpr int L_G = 0;
constexpr int L_GLOW = 49152;
constexpr int L_TOT = 53248;
constexpr int L_QP = 54272;
constexpr int L_KPB = L_QP + 64 * QP * 2;
constexpr int L_AB = L_KPB + 64 * QP * 2;
constexpr int L_VT = L_AB + 64 * KP * 2;
constexpr int L_RS = L_VT + 128 * KP * 2;
constexpr int L_ST = 0;
constexpr int L1_KD = 54272;
constexpr int L1_VT = L1_KD + 192 * KP * 2;
static_assert(L_RS + 1024 <= LDS_WORK && L1_VT + 384 * KP * 2 <= LDS_WORK, "GLA LDS map");

__device__ __forceinline__ int chunk_row0(int c) { return c < TP / 64 ? c * 64 : TP + (c - TP / 64) * 64; }

__device__ __forceinline__ void decay_scan(const bf16_t* z, const float* wg2, const float* bg, int row0, int h, char* lds, int tid) {
    float* G = (float*)(lds + L_G); float* glow = (float*)(lds + L_GLOW); float* tot = (float*)(lds + L_TOT);
    for (int i = tid; i < 64 * 16; i += 512) glow[i] = bf2f(z[(size_t)(row0 + (i >> 4)) * ZLD + ZG + (i & 15)]);
    __syncthreads();
    if (tid < 384) {
        const int k = tid % 192, half = tid / 192; float w[16];
#pragma unroll
        for (int j = 0; j < 16; ++j) w[j] = wg2[(size_t)j * GKW + h * GDK + k];
        const float b = bg[h * GDK + k]; float g = 0.f;
        for (int s = half * 32; s < half * 32 + 32; ++s) { float a = b;
#pragma unroll
            for (int j = 0; j < 16; ++j) a += glow[s * 16 + j] * w[j];
            g += log_sigmoidf(a) * (1.0f / 16.0f); G[s * GDK + k] = g; }
        if (half == 0) tot[k] = g;
    }
    __syncthreads();
}

__device__ __forceinline__ void g1_unit(int c, int h, const bf16_t* z, const float* wg2, const float* bg, float* UT, float* DEC, char* lds, int g_wave) {
    const int tid = opaque_tid(); const int row0 = chunk_row0(c);
    decay_scan(z, wg2, bg, row0, h, lds, tid);
    const float* G = (const float*)(lds + L_G); const float* tot = (const float*)(lds + L_TOT);
    bf16_t* KD = (bf16_t*)(lds + L1_KD); bf16_t* VT = (bf16_t*)(lds + L1_VT);
    for (int it = tid; it < 192 * 8; it += 512) {
        const int k = it % 192, sb = it / 192; const float t0 = tot[k], glast = G[63 * GDK + k] + t0; float v[8];
#pragma unroll
        for (int i = 0; i < 8; ++i) { const int s = sb * 8 + i; const float g = G[s * GDK + k] + (s >= 32 ? t0 : 0.f);
            v[i] = bf2f(z[(size_t)(row0 + s) * ZLD + ZK + h * GDK + k]) * __expf(glast - g); }
        u32x4 w = {cvtpk(v[0], v[1]), cvtpk(v[2], v[3]), cvtpk(v[4], v[5]), cvtpk(v[6], v[7])};
        *(u32x4*)(KD + k * KP + sb * 8) = w;
        if (sb == 0) DEC[(size_t)(c * GH + h) * GDK + k] = __expf(glast);
    }
    for (int it = tid; it < 64 * 48; it += 512) {
        const int s = it & 63, vb = it >> 6; const u32x4 w = *(const u32x4*)(z + (size_t)(row0 + s) * ZLD + ZV + h * GDV + vb * 8);
#pragma unroll
        for (int i = 0; i < 4; ++i) { VT[(vb * 8 + 2 * i) * KP + s] = (bf16_t)(w[i] & 0xffffu); VT[(vb * 8 + 2 * i + 1) * KP + s] = (bf16_t)(w[i] >> 16); }
    }
    __syncthreads();
    const int wid = tid >> 6, lane = tid & 63, l32 = lane & 31, hi = lane >> 5, mq = wid & 3, nh = wid >> 2;
    f32x16 acc[3][3];
#pragma unroll
    for (int i = 0; i < 3; ++i)
#pragma unroll
        for (int j = 0; j < 3; ++j) acc[i][j] = f32x16{};
#pragma unroll
    for (int ks = 0; ks < 4; ++ks) { bf16x8 a[3], bb[3];
#pragma unroll
        for (int i = 0; i < 3; ++i) { a[i] = *(const bf16x8*)(VT + ((mq * 3 + i) * 32 + l32) * KP + ks * 16 + hi * 8); bb[i] = *(const bf16x8*)(KD + ((nh * 3 + i) * 32 + l32) * KP + ks * 16 + hi * 8); }
#pragma unroll
        for (int i = 0; i < 3; ++i)
#pragma unroll
            for (int j = 0; j < 3; ++j) acc[i][j] = __builtin_amdgcn_mfma_f32_32x32x16_bf16(a[i], bb[j], acc[i][j], 0, 0, 0); }
    float* out = UT + (size_t)(c * GH + h) * GDV * GDK;
#pragma unroll
    for (int i = 0; i < 3; ++i)
#pragma unroll
        for (int j = 0; j < 3; ++j)
#pragma unroll
            for (int r = 0; r < 16; ++r) out[(size_t)((mq * 3 + i) * 32 + att::crow(r, hi)) * GDK + (nh * 3 + j) * 32 + l32] = acc[i][j][r];
    __syncthreads();
}

__device__ __forceinline__ void g2_tile(int tile, float* UT, const float* DEC, const float* s0in, float* outp, float* outs, char* lds, int tid) {
    const int h = tile / 36, vt = (tile % 36) / 3, kt = tile % 3, vi = tid >> 4, kg = tid & 15, v = vt * 32 + vi, k = kt * 64 + kg * 4;
    float* T = (float*)lds;
    const size_t cstride = (size_t)GH * GDV * GDK; float* up = UT + ((size_t)h * GDV + v) * GDK + k; const float* dp = DEC + h * GDK + k;
    float zz = 0.f; asm volatile("" : "+v"(zz)); f32x4 S = {zz, zz, zz, zz};
    for (int c0 = 0; c0 < TP / 64; c0 += 8) { f32x4 u[8], d[8];
#pragma unroll
        for (int i = 0; i < 8; ++i) { u[i] = *(const f32x4*)(up + (size_t)(c0 + i) * cstride); d[i] = *(const f32x4*)(dp + (size_t)(c0 + i) * GH * GDK); }
#pragma unroll
        for (int i = 0; i < 8; ++i) { *(f32x4*)(up + (size_t)(c0 + i) * cstride) = S; S = d[i] * S + u[i]; } }
    const int kr = tid >> 3, v4 = (tid & 7) * 4;
    T[(kg * 4 + 0) * 33 + vi] = S[0]; T[(kg * 4 + 1) * 33 + vi] = S[1]; T[(kg * 4 + 2) * 33 + vi] = S[2]; T[(kg * 4 + 3) * 33 + vi] = S[3];
    __syncthreads();
    { f32x4 o = {T[kr * 33 + v4], T[kr * 33 + v4 + 1], T[kr * 33 + v4 + 2], T[kr * 33 + v4 + 3]}; *(f32x4*)(outp + ((size_t)h * GDK + kt * 64 + kr) * GDV + vt * 32 + v4) = o; }
    __syncthreads();
    for (int b = 0; b < NB; ++b) {
        const int c = TP / 64 + b; const size_t sb = ((size_t)b * GH + h) * GDK * GDV;
        { const f32x4 i4 = *(const f32x4*)(s0in + sb + (size_t)(kt * 64 + kr) * GDV + vt * 32 + v4); T[kr * 33 + v4] = i4[0]; T[kr * 33 + v4 + 1] = i4[1]; T[kr * 33 + v4 + 2] = i4[2]; T[kr * 33 + v4 + 3] = i4[3]; }
        __syncthreads();
        f32x4 s0 = {T[(kg * 4 + 0) * 33 + vi], T[(kg * 4 + 1) * 33 + vi], T[(kg * 4 + 2) * 33 + vi], T[(kg * 4 + 3) * 33 + vi]};
        const f32x4 u = *(const f32x4*)(up + (size_t)c * cstride), d = *(const f32x4*)(dp + (size_t)c * GH * GDK);
        *(f32x4*)(up + (size_t)c * cstride) = s0; const f32x4 sn = d * s0 + u;
        __syncthreads();
        T[(kg * 4 + 0) * 33 + vi] = sn[0]; T[(kg * 4 + 1) * 33 + vi] = sn[1]; T[(kg * 4 + 2) * 33 + vi] = sn[2]; T[(kg * 4 + 3) * 33 + vi] = sn[3];
        __syncthreads();
        { f32x4 o = {T[kr * 33 + v4], T[kr * 33 + v4 + 1], T[kr * 33 + v4 + 2], T[kr * 33 + v4 + 3]}; *(f32x4*)(outs + sb + (size_t)(kt * 64 + kr) * GDV + vt * 32 + v4) = o; }
        __syncthreads();
    }
}

__device__ __forceinline__ void g3_unit(int c, int h, const bf16_t* z, const float* wg2, const float* bg, const float* UT, const float* ng, const float* br, bf16_t* oc, char* lds, int g_wave) {
    const int tid = opaque_tid(); const int row0 = chunk_row0(c);
    decay_scan(z, wg2, bg, row0, h, lds, tid);
    const float* G = (const float*)(lds + L_G); const float* tot = (const float*)(lds + L_TOT);
    bf16_t* Qp = (bf16_t*)(lds + L_QP); bf16_t* Kp = (bf16_t*)(lds + L_KPB); bf16_t* Ab = (bf16_t*)(lds + L_AB); bf16_t* VT = (bf16_t*)(lds + L_VT); bf16_t* ST = (bf16_t*)(lds + L_ST);
    float* RS = (float*)(lds + L_RS);
    const float qs = 0.07216878364870322f;
    for (int it = tid; it < 64 * 24; it += 512) {
        const int s = it / 24, kb = (it % 24) * 8; float g[8];
#pragma unroll
        for (int i = 0; i < 8; ++i) g[i] = G[s * GDK + kb + i] + (s >= 32 ? tot[kb + i] : 0.f);
        const u32x4 qw = *(const u32x4*)(z + (size_t)(row0 + s) * ZLD + ZQ + h * GDK + kb), kw = *(const u32x4*)(z + (size_t)(row0 + s) * ZLD + ZK + h * GDK + kb);
        u32x4 qo, ko;
#pragma unroll
        for (int i = 0; i < 4; ++i) { const float e0 = __expf(g[2 * i]), e1 = __expf(g[2 * i + 1]);
            qo[i] = cvtpk(__uint_as_float(qw[i] << 16) * qs * e0, __uint_as_float(qw[i] & 0xffff0000u) * qs * e1);
            ko[i] = cvtpk(__uint_as_float(kw[i] << 16) * __builtin_amdgcn_rcpf(e0), __uint_as_float(kw[i] & 0xffff0000u) * __builtin_amdgcn_rcpf(e1)); }
        *(u32x4*)(Qp + s * QP + kb) = qo; *(u32x4*)(Kp + s * QP + kb) = ko;
    }
    __syncthreads();
    const int wid = tid >> 6, lane = tid & 63, l32 = lane & 31, hi = lane >> 5;
    if (wid < 4) {
        const int mt = wid & 1, nt = wid >> 1; f32x16 a = f32x16{};
        if (nt <= mt) {
#pragma unroll
            for (int ks = 0; ks < 12; ++ks) { const bf16x8 x = *(const bf16x8*)(Qp + (mt * 32 + l32) * QP + ks * 16 + hi * 8), y = *(const bf16x8*)(Kp + (nt * 32 + l32) * QP + ks * 16 + hi * 8);
                a = __builtin_amdgcn_mfma_f32_32x32x16_bf16(x, y, a, 0, 0, 0); }
        }
#pragma unroll
        for (int r = 0; r < 16; ++r) { const int t = mt * 32 + att::crow(r, hi), s = nt * 32 + l32; const float v = (s <= t) ? a[r] : 0.f; Ab[t * KP + s] = (bf16_t)(cvtpk(v, 0.f) & 0xffffu); }
    }
    __syncthreads();
    const int mt = wid & 1, nt = wid >> 1;
    f32x16 oacc[3];
    const float* Sb = UT + (size_t)(c * GH + h) * GDV * GDK;
#pragma unroll
    for (int vs = 0; vs < 3; ++vs) {
        for (int it = tid; it < 128 * 24; it += 512) { const int v = it / 24, kb = (it % 24) * 8; const float* p = Sb + (size_t)(vs * 128 + v) * GDK + kb;
            *(u32x4*)(ST + v * QP + kb) = pack8u(*(const f32x4*)p, *(const f32x4*)(p + 4)); }
        for (int it = tid; it < 64 * 16; it += 512) { const int s = it & 63, vb = it >> 6; const u32x4 w = *(const u32x4*)(z + (size_t)(row0 + s) * ZLD + ZV + h * GDV + vs * 128 + vb * 8);
#pragma unroll
            for (int i = 0; i < 4; ++i) { VT[(vb * 8 + 2 * i) * KP + s] = (bf16_t)(w[i] & 0xffffu); VT[(vb * 8 + 2 * i + 1) * KP + s] = (bf16_t)(w[i] >> 16); } }
        __syncthreads();
        f32x16 a = f32x16{};
#pragma unroll
        for (int ks = 0; ks < 12; ++ks) { const bf16x8 x = *(const bf16x8*)(Qp + (mt * 32 + l32) * QP + ks * 16 + hi * 8), y = *(const bf16x8*)(ST + (nt * 32 + l32) * QP + ks * 16 + hi * 8);
            a = __builtin_amdgcn_mfma_f32_32x32x16_bf16(x, y, a, 0, 0, 0); }
#pragma unroll
        for (int ks = 0; ks < 4; ++ks) { const bf16x8 x = *(const bf16x8*)(Ab + (mt * 32 + l32) * KP + ks * 16 + hi * 8), y = *(const bf16x8*)(VT + (nt * 32 + l32) * KP + ks * 16 + hi * 8);
            a = __builtin_amdgcn_mfma_f32_32x32x16_bf16(x, y, a, 0, 0, 0); }
        oacc[vs] = a;
        __syncthreads();
    }
#pragma unroll
    for (int r = 0; r < 16; ++r) { float q = oacc[0][r] * oacc[0][r] + oacc[1][r] * oacc[1][r] + oacc[2][r] * oacc[2][r];
        q += __shfl_xor(q, 1); q += __shfl_xor(q, 2); q += __shfl_xor(q, 4); q += __shfl_xor(q, 8); q += __shfl_xor(q, 16);
        if (l32 == 0) RS[(mt * 32 + att::crow(r, hi)) * 4 + nt] = q; }
    __syncthreads();
#pragma unroll
    for (int r = 0; r < 16; ++r) { const int t = mt * 32 + att::crow(r, hi); const f32x4 q4 = *(const f32x4*)(RS + t * 4);
        const float rstd = rsqrtf(((q4[0] + q4[1]) + (q4[2] + q4[3])) * (1.0f / GDV) + RMS_EPS);
#pragma unroll
        for (int vs = 0; vs < 3; ++vs) { const int cv = h * GDV + vs * 128 + nt * 32 + l32;
            const float gate = bf2f(z[(size_t)(row0 + t) * ZLD + ZR + cv]) + br[cv]; const float sg = gate / (1.f + __expf(-gate));
            const float val = oacc[vs][r] * rstd * ng[cv] * sg; const float vn = __shfl_xor(val, 1);
            if ((l32 & 1) == 0) *(unsigned*)(oc + (size_t)(row0 + t) * DM + cv) = cvtpk(val, vn); } }
    __syncthreads();
}
}

__device__ __forceinline__ int in_rowmap(int kind, int c) {
    if (kind == 0) return c < 4608 ? c : (c < 4620 ? 5120 + (c - 4608) : 4608 + (c - 4620));
    if (kind == 2) return c < 4608 ? c : (c < 4624 ? 5120 + (c - 4608) : 4608 + (c - 4624));
    return c;
}
__device__ __forceinline__ void tr_item(const float* W, int K, int N, bf16_t* WT, int kind, const float* gain, float* scr, int item, int lane) {
    const int nblk = (N + 31) >> 5, kb = item / nblk, nb = item - kb * nblk, k0 = 64 * kb, n0 = 32 * nb;
    const int nn = n0 + (lane & 31); const bool ok = nn < N;
#pragma unroll 8
    for (int i = 0; i < 32; ++i) { const int kk = 2 * i + (lane >> 5); float v = ok ? W[(size_t)(k0 + kk) * N + nn] : 0.f; if (gain) v *= gain[k0 + kk]; scr[kk * 33 + (lane & 31)] = v; }
    LDS_WAIT(); asm volatile("" ::: "memory");
    const int c = lane & 7;
#pragma unroll
    for (int j = 0; j < 4; ++j) { const int n = (lane >> 3) + 8 * j; const float* s = scr + (8 * c) * 33 + n;
        if (n0 + n < N) { u32x4 o; o[0] = cvtpk(s[0 * 33], s[1 * 33]); o[1] = cvtpk(s[2 * 33], s[3 * 33]); o[2] = cvtpk(s[4 * 33], s[5 * 33]); o[3] = cvtpk(s[6 * 33], s[7 * 33]);
            *(u32x4*)(WT + (size_t)in_rowmap(kind, n0 + n) * K + k0 + 8 * c) = o; } }
    LDS_WAIT(); asm volatile("" ::: "memory");
}
__device__ __forceinline__ void cvt_row(const float* src, bf16_t* dst, int n, int lane) {
    for (int o = lane * 4; o < n; o += 256) { const f32x4 v = *(const f32x4*)(src + o); u32x2 w = {cvtpk(v[0], v[1]), cvtpk(v[2], v[3])}; *(u32x2*)(dst + o) = w; }
}

#ifndef EN_MASK
#define EN_MASK 0xFFFF
#endif
#define EN(k) ((EN_MASK >> (k)) & 1)
struct Args { const float* in[29]; float* out; unsigned char* ws; int ph_lo, ph_hi; };
constexpr int PH_FINAL = 1 + 7 * NLAYER, PH_END = PH_FINAL + 1;
constexpr int PT_OFF = MISC_OFF + 256;
__device__ __forceinline__ unsigned long long ptab_raw(const char* lds, int k) {
    const unsigned long long v = ((const unsigned long long*)(lds + PT_OFF))[k];
    const unsigned l = __builtin_amdgcn_readfirstlane((unsigned)v), h = __builtin_amdgcn_readfirstlane((unsigned)(v >> 32));
    return ((unsigned long long)h << 32) | l;
}
#define PIN(k) ((const float*)(const GAS float*)ptab_raw(lds, (k)))
#define POUT() ((float*)(GAS float*)ptab_raw(lds, 29))
#define PWS() ((unsigned char*)(GAS unsigned char*)ptab_raw(lds, 30))

__global__ void __launch_bounds__(512, 2) trunk_fwd(Args args) {
    extern __shared__ __attribute__((aligned(16))) unsigned char lds_raw[];
    char* lds = (char*)lds_raw;
    volatile LAS unsigned* MISC = (volatile LAS unsigned*)((LAS unsigned char*)lds_raw + MISC_OFF);
    for (int u = threadIdx.x; u < 64; u += 512) MISC[u] = 0u;
    if (threadIdx.x < 29) ((unsigned long long*)(lds + PT_OFF))[threadIdx.x] = (unsigned long long)args.in[threadIdx.x];
    if (threadIdx.x == 29) ((unsigned long long*)(lds + PT_OFF))[29] = (unsigned long long)args.out;
    if (threadIdx.x == 30) ((unsigned long long*)(lds + PT_OFF))[30] = (unsigned long long)args.ws;
    const int g_wave = __builtin_amdgcn_readfirstlane(threadIdx.x >> 6);
    __syncthreads();
    const int G = gridDim.x, bx = blockIdx.x, vcu = (G % 8 == 0) ? (bx % 8) * (G / 8) + bx / 8 : bx;
#if !MK_PER_PHASE
    const XcdBarrier bar = xcd_barrier_post((unsigned*)(args.ws + WS_CTL) + CW_BAR, MISC + 8);
#define GRID_BAR() xcd_barrier(bar)
#else
#define GRID_BAR() do { } while (0)
#endif
    const int lo = args.ph_lo, hi = args.ph_hi;
#define IN(k) (lo <= (k) && (k) < hi)
#define SEAM(k) do { if ((k) + 1 < hi) GRID_BAR(); } while (0)
#define WSP(T, off) ((T*)(ws + (off)))

    if (EN(0) && IN(0)) {
        unsigned char* ws = PWS();
        const int tid = opaque_tid(), lane = tid & 63, wave = tid >> 6, gw = vcu * 8 + wave, NGW = G * 8;
        float* scr = (float*)(lds + wave * 16384);
        for (int L = 0; L < NLAYER; ++L) {
            const int kind = L % 3, j = L / 3;
            const float* win = kind == 0 ? PIN(16) + (size_t)j * DM * 5132 : (kind == 1 ? PIN(19) : PIN(21)); const int nin = kind == 0 ? 5132 : (kind == 1 ? 5120 : 5136);
            const float* wout = kind == 0 ? PIN(18) + (size_t)j * DM * DM : (kind == 1 ? PIN(20) : PIN(26));
            for (int it = gw; it < 32 * ((nin + 31) / 32); it += NGW) tr_item(win, DM, nin, WSP(bf16_t, WS_WIN) + (size_t)L * ZLD * DM, kind, PIN(11) + L * DM, scr, it, lane);
            for (int it = gw; it < 32 * 64; it += NGW) tr_item(wout, DM, DM, WSP(bf16_t, WS_WOUT) + (size_t)L * DM * DM, 1, nullptr, scr, it, lane);
            for (int it = gw; it < 32 * 256; it += NGW) tr_item(PIN(27) + (size_t)L * DM * DFF, DM, DFF, WSP(bf16_t, WS_WUP) + (size_t)L * DFF * DM, 1, PIN(12) + L * DM, scr, it, lane);
            for (int it = gw; it < 128 * 64; it += NGW) tr_item(PIN(28) + (size_t)L * DFF * DM, DFF, DM, WSP(bf16_t, WS_WDN) + (size_t)L * DM * DFF, 1, nullptr, scr, it, lane);
            for (int it = gw; it < 32 * 32; it += NGW) tr_item(PIN(15) + (size_t)L * DM * 1024, DM, 1024, WSP(bf16_t, WS_WMKV) + (size_t)L * 1024 * DM, 1, nullptr, scr, it, lane);
        }
        { const float* xp = PIN(0); const float* xs = PIN(1); float* X = WSP(float, WS_X); bf16_t* XB = WSP(bf16_t, WS_XB); float* RSA = WSP(float, WS_RSS);
        for (int m = gw; m < MT; m += NGW) {
            const float* src = m < TP ? xp + (size_t)m * DM : xs + (size_t)(m - TP) * DM; float ss = 0.f;
#pragma unroll
            for (int q = 0; q < 8; ++q) { const int o = q * 256 + lane * 4; const f32x4 v = *(const f32x4*)(src + o); *(f32x4*)(X + (size_t)m * DM + o) = v;
                u32x2 w = {cvtpk(v[0], v[1]), cvtpk(v[2], v[3])}; *(u32x2*)(XB + (size_t)m * DM + o) = w; ss += (v[0] * v[0] + v[1] * v[1]) + (v[2] * v[2] + v[3] * v[3]); }
            ss = wave_sum(ss);
            if (lane < 32) RSA[(size_t)m * 32 + lane] = lane == 0 ? ss : 0.f;
        } }
        { const float* mp = PIN(10); const float* gm = PIN(13); bf16_t* MEMH = WSP(bf16_t, WS_MEMH);
        for (int it = gw; it < NLAYER * NMEM; it += NGW) { const int i = it / NMEM, r = it % NMEM; const float* src = mp + (size_t)r * DM; const float* g = gm + (size_t)i * DM;
            f32x4 v[8]; float ss = 0.f;
#pragma unroll
            for (int q = 0; q < 8; ++q) { v[q] = *(const f32x4*)(src + q * 256 + lane * 4); ss += (v[q][0] * v[q][0] + v[q][1] * v[q][1]) + (v[q][2] * v[q][2] + v[q][3] * v[q][3]); }
            const float rstd = rsqrtf(wave_sum(ss) * (1.0f / DM) + RMS_EPS);
#pragma unroll
            for (int q = 0; q < 8; ++q) { const f32x4 gg = *(const f32x4*)(g + q * 256 + lane * 4); u32x2 w = {cvtpk(v[q][0] * rstd * gg[0], v[q][1] * rstd * gg[1]), cvtpk(v[q][2] * rstd * gg[2], v[q][3] * rstd * gg[3])};
                *(u32x2*)(MEMH + ((size_t)i * NMEM + r) * DM + q * 256 + lane * 4) = w; } } }
        { const float* ck = PIN(2); const float* cv = PIN(3); bf16_t* KVF = WSP(bf16_t, WS_KVF);
        for (int it = gw; it < 4 * NB * PAST; it += NGW) { const int t = it / (NB * PAST), r = it % (NB * PAST), jj = t >> 1, kv = t & 1;
            cvt_row((kv ? cv : ck) + ((size_t)jj * NB * PAST + r) * AW, KVF + (size_t)t * (KVS_ONE / 2) + ((size_t)(r / PAST) * SKS + (r % PAST)) * AW, AW, lane); } }
        { const float* ck = PIN(5); const float* cv = PIN(6); bf16_t* KVS = WSP(bf16_t, WS_KVS);
        for (int it = gw; it < 2 * NB * PAST; it += NGW) { const int kv = it / (NB * PAST), r = it % (NB * PAST);
            cvt_row((kv ? cv : ck) + (size_t)r * AW, KVS + (size_t)kv * (KVS_ONE / 2) + ((size_t)(r / PAST) * SKS + (r % PAST)) * AW, AW, lane); } }
        { const float* ck = PIN(8); const float* cv = PIN(9); bf16_t* MEMC = WSP(bf16_t, WS_MEMC);
        for (int it = gw; it < 8 * NB * NMEM; it += NGW) { const int t = it / (NB * NMEM), r = it % (NB * NMEM), L = t >> 1, kv = t & 1;
            cvt_row((kv ? cv : ck) + ((size_t)L * NB * NMEM + r) * MEMW, MEMC + (size_t)t * (MEMC_ONE / 2) + (size_t)r * MEMW, MEMW, lane); } }
        SEAM(0);
    }

    for (int L = 0; L < NLAYER; ++L) {
        const int kind = L % 3, j = L / 3, base = 1 + 7 * L;
        if (EN(1) && IN(base + 0)) {
            unsigned char* ws = PWS();
            const int tid = opaque_tid();
            pg8::Sched S; S.nM = MT / 256; S.nN = kind == 1 ? 20 : 21; S.nwg = S.nM * S.nN; S.G = G; S.c = bx; S.nextra = L == 0 ? 16 : 0;
            S.A = (const char*)WSP(bf16_t, WS_XB); S.B = (const char*)(WSP(bf16_t, WS_WIN) + (size_t)L * ZLD * DM); S.tA = (size_t)256 * DM * 2; S.tB = (size_t)256 * DM * 2;
            S.Ae = (const char*)WSP(bf16_t, WS_MEMH); S.Be = (const char*)WSP(bf16_t, WS_WMKV); S.tAe = (size_t)NMEM * DM * 2; S.tBe = (size_t)256 * DM * 2;
            pg8::EpiIn E; E.z = WSP(bf16_t, WS_Z); E.rss = WSP(float, WS_RSS); E.out = POUT(); E.mkvb = WSP(bf16_t, WS_MKVB); E.kind = kind; E.j = j;
            E.kvb = kind == 0 ? WSP(bf16_t, WS_KVF) + (size_t)(2 * j) * (KVS_ONE / 2) : WSP(bf16_t, WS_KVS); E.bfg = PIN(17) + j * NH;
            pg8::gemm_phase<pg8::EpiIn>((LAS unsigned char*)lds_raw, DM, DM, DM, S, E, tid);
            SEAM(base + 0);
        }
        if (IN(base + 1) && kind != 0) {
            unsigned char* ws = PWS();
            if (EN(2) && kind == 1) {
                bf16_t* Z = WSP(bf16_t, WS_Z); bf16_t* OC = WSP(bf16_t, WS_OC); bf16_t* KVS = WSP(bf16_t, WS_KVS);
                for (int n = vcu; n < 480; n += G) { att::Blk b; b.ldq = ZLD; b.ldo = DM; b.bmode = 0; b.lf0 = b.lf1 = nullptr; b.n0 = 0;
                    if (n < 384) { const int h = n / 32, qb = n % 32; b.Q = Z + (size_t)qb * 256 * ZLD + h * HD; b.K = Z + AW + h * HD; b.V = Z + 2 * AW + h * HD; b.ldkv = ZLD;
                        b.O = OC + (size_t)qb * 256 * DM + h * HD; b.P0 = qb * 256; b.skv = TP; b.nrows = 256; }
                    else { const int m = n - 384, bb = m / NH, h = m % NH; b.Q = Z + (size_t)(TP + bb * 64) * ZLD + h * HD; b.K = KVS + (size_t)bb * SKS * AW + h * HD; b.V = KVS + KVS_ONE / 2 + (size_t)bb * SKS * AW + h * HD; b.ldkv = AW;
                        b.O = OC + (size_t)(TP + bb * 64) * DM + h * HD; b.P0 = PAST; b.skv = SKS; b.nrows = 64; }
                    att::sb_block(b, lds, g_wave); }
            } else if (EN(3) && kind == 2) {
                for (int u = vcu; u < NCHUNK * GH; u += G) gla::g1_unit(u / GH, u % GH, WSP(bf16_t, WS_Z), PIN(22), PIN(23), WSP(float, WS_GU), WSP(float, WS_GDEC), lds, g_wave);
            }
            SEAM(base + 1);
        }
        if (EN(4) && IN(base + 2) && kind == 2) {
            unsigned char* ws = PWS();
            const int tid = opaque_tid();
            if (vcu < 144) gla::g2_tile(vcu, WSP(float, WS_GU), WSP(float, WS_GDEC), PIN(7), POUT() + O_GSP, POUT() + O_GSS, lds, tid);
            SEAM(base + 2);
        }
        if (IN(base + 3)) {
            unsigned char* ws = PWS();
            if (EN(5) && kind == 2) for (int u = vcu; u < NCHUNK * GH; u += G) gla::g3_unit(u / GH, u % GH, WSP(bf16_t, WS_Z), PIN(22), PIN(23), WSP(float, WS_GU), PIN(25), PIN(24), WSP(bf16_t, WS_OC), lds, g_wave);
            const float* outp = POUT(); const float* lfc = PIN(4);
            auto get = [&](int i, att::Blk& b) -> bool {
                int type, a0, a1;
                if (kind == 0) {
                    if (vcu < 192) { if (i > 1) return false; type = 0; a0 = vcu / 16; a1 = i == 0 ? vcu % 16 : 31 - vcu % 16; }
                    else { if (i > 3) return false; const int s = (vcu - 192) + 64 * i; if (s < 96) { type = 1; a0 = s / NH; a1 = s % NH; } else if (s < 224) { type = 2; a0 = (s - 96) / 32; a1 = (s - 96) % 32; } else { type = 3; a0 = (s - 224) / MH; a1 = (s - 224) % MH; } }
                } else { const int n = vcu + G * i; if (n >= 160) return false; if (n < 128) { type = 2; a0 = n / 32; a1 = n % 32; } else { type = 3; a0 = (n - 128) / MH; a1 = (n - 128) % MH; } }
                bf16_t* Z = WSP(bf16_t, WS_Z); bf16_t* OC = WSP(bf16_t, WS_OC);
                b.ldq = ZLD; b.ldo = DM; b.lf0 = b.lf1 = nullptr; b.n0 = 0; b.bmode = 0;
                if (type == 0) { const int h = a0, qb = a1; b.Q = Z + (size_t)qb * 256 * ZLD + h * HD; b.K = Z + AW + h * HD; b.V = Z + 2 * AW + h * HD; b.ldkv = ZLD; b.O = OC + (size_t)qb * 256 * DM + h * HD;
                    b.P0 = qb * 256; b.skv = TP; b.nrows = 256; b.bmode = 1; b.lf0 = outp + O_FLP + (size_t)j * TP * NH + h; b.n0 = 1 << 30; }
                else if (type == 1) { const int bb = a0, h = a1; const bf16_t* fk = WSP(bf16_t, WS_KVF) + (size_t)(2 * j) * (KVS_ONE / 2);
                    b.Q = Z + (size_t)(TP + bb * 64) * ZLD + h * HD; b.K = fk + (size_t)bb * SKS * AW + h * HD; b.V = fk + KVS_ONE / 2 + (size_t)bb * SKS * AW + h * HD; b.ldkv = AW;
                    b.O = OC + (size_t)(TP + bb * 64) * DM + h * HD; b.P0 = PAST; b.skv = SKS; b.nrows = 64; b.bmode = 1; b.lf0 = lfc + ((size_t)j * NB + bb) * PAST * NH + h; b.n0 = PAST; b.lf1 = outp + O_FLS + (size_t)j * TS * NH + (size_t)bb * 64 * NH + h; }
                else if (type == 2) { const int h4 = a0, qb = a1; const bf16_t* mkb = WSP(bf16_t, WS_MKVB) + (size_t)L * NMEM * 1024;
                    b.Q = Z + (size_t)qb * 256 * ZLD + 4608 + h4 * HD; b.K = mkb + h4 * HD; b.V = mkb + MEMW + h4 * HD; b.ldkv = 1024; b.O = OC + (size_t)qb * 256 * DM + AW + h4 * HD;
                    b.P0 = 1 << 20; b.skv = NMEM; b.nrows = 256; }
                else { const int bb = a0, h4 = a1; const bf16_t* mck = WSP(bf16_t, WS_MEMC) + (size_t)(2 * L) * (MEMC_ONE / 2);
                    b.Q = Z + (size_t)(TP + bb * 64) * ZLD + 4608 + h4 * HD; b.K = mck + (size_t)bb * NMEM * MEMW + h4 * HD; b.V = mck + MEMC_ONE / 2 + (size_t)bb * NMEM * MEMW + h4 * HD; b.ldkv = MEMW;
                    b.O = OC + (size_t)(TP + bb * 64) * DM + AW + h4 * HD; b.P0 = 1 << 20; b.skv = NMEM; b.nrows = 64; }
                return true;
            };
            att::Blk cur, nxt;
            if (EN(6) && get(0, cur)) {
                att::Seam S; att::att_prime(cur, lds, S, g_wave);
                for (int i = 0;; ++i) { const bool more = get(i + 1, nxt); if (!more) nxt = cur;
                    att::prepare_bias(cur, lds, g_wave); att::att_block(cur, nxt, lds, S, g_wave);
                    if (!more) break; cur = nxt; }
            }
            SEAM(base + 3);
        }
        if (EN(7) && IN(base + 4)) {
            unsigned char* ws = PWS();
            const int tid = opaque_tid();
            pg8::Sched S; S.nM = MT / 256; S.nN = DM / 256; S.nwg = S.nM * S.nN; S.G = G; S.c = bx; S.nextra = 0;
            S.A = (const char*)WSP(bf16_t, WS_OC); S.B = (const char*)(WSP(bf16_t, WS_WOUT) + (size_t)L * DM * DM); S.tA = (size_t)256 * DM * 2; S.tB = (size_t)256 * DM * 2; S.Ae = S.Be = nullptr; S.tAe = S.tBe = 0;
            pg8::EpiRes E{WSP(float, WS_X), WSP(bf16_t, WS_XB), WSP(float, WS_RSS) + (size_t)MT * 32};
            pg8::gemm_phase<pg8::EpiRes>((LAS unsigned char*)lds_raw, DM, DM, DM, S, E, tid);
            SEAM(base + 4);
        }
        if (EN(8) && IN(base + 5)) {
            unsigned char* ws = PWS();
            const int tid = opaque_tid();
            pg8::Sched S; S.nM = MT / 256; S.nN = DFF / 256; S.nwg = S.nM * S.nN; S.G = G; S.c = bx; S.nextra = 0;
            S.A = (const char*)WSP(bf16_t, WS_XB); S.B = (const char*)(WSP(bf16_t, WS_WUP) + (size_t)L * DFF * DM); S.tA = (size_t)256 * DM * 2; S.tB = (size_t)256 * DM * 2; S.Ae = S.Be = nullptr; S.tAe = S.tBe = 0;
            pg8::EpiUp E{WSP(bf16_t, WS_U), WSP(float, WS_RSS) + (size_t)MT * 32};
            pg8::gemm_phase<pg8::EpiUp>((LAS unsigned char*)lds_raw, DM, DM, DM, S, E, tid);
            SEAM(base + 5);
        }
        if (EN(9) && IN(base + 6)) {
            unsigned char* ws = PWS();
            const int tid = opaque_tid();
            pg8::Sched S; S.nM = MT / 256; S.nN = DM / 256; S.nwg = S.nM * S.nN; S.G = G; S.c = bx; S.nextra = 0;
            S.A = (const char*)WSP(bf16_t, WS_U); S.B = (const char*)(WSP(bf16_t, WS_WDN) + (size_t)L * DM * DFF); S.tA = (size_t)256 * DFF * 2; S.tB = (size_t)256 * DFF * 2; S.Ae = S.Be = nullptr; S.tAe = S.tBe = 0;
            pg8::EpiRes E{WSP(float, WS_X), WSP(bf16_t, WS_XB), WSP(float, WS_RSS)};
            pg8::gemm_phase<pg8::EpiRes>((LAS unsigned char*)lds_raw, DFF, DFF, DFF, S, E, tid);
            SEAM(base + 6);
        }
    }
    if (EN(10) && IN(PH_FINAL)) {
        unsigned char* ws = PWS(); float* out = POUT();
        const int tid = opaque_tid(), lane = tid & 63, wave = tid >> 6, gw = vcu * 8 + wave, NGW = G * 8;
        const float* g = PIN(14); const float* X = WSP(float, WS_X); const float* RSA = WSP(float, WS_RSS);
        for (int m = gw; m < MT; m += NGW) {
            const float rstd = rsqrtf(wave_sum(lane < 32 ? RSA[(size_t)m * 32 + lane] : 0.f) * (1.0f / DM) + RMS_EPS); float* dst = m < TP ? out + O_YP + (size_t)m * DM : out + O_YS + (size_t)(m - TP) * DM;
#pragma unroll
            for (int q = 0; q < 8; ++q) { const int o = q * 256 + lane * 4; const f32x4 v = *(const f32x4*)(X + (size_t)m * DM + o), gg = *(const f32x4*)(g + o); *(f32x4*)(dst + o) = v * rstd * gg; }
        }
    }
#undef IN
#undef SEAM
#undef GRID_BAR
}

extern "C" void kernel_launch(void* const* d_in, const int* in_sizes, int n_in, void* d_out, int out_size, void* d_ws, size_t ws_size, hipStream_t stream) {
    static int grid = 0;
    if (grid == 0) {
        if (n_in != 29 || (size_t)out_size != O_END || ws_size < WS_END) { fprintf(stderr, "kernel_launch: unexpected shapes (n_in %d, out %d vs %zu, ws %zu vs %zu); nothing launched\n", n_in, out_size, (size_t)O_END, ws_size, (size_t)WS_END); grid = -1; return; }
        int dev = 0, cus = 0, per_cu = 0;
        if (hipGetDevice(&dev) != hipSuccess || hipDeviceGetAttribute(&cus, hipDeviceAttributeMultiprocessorCount, dev) != hipSuccess) { grid = -1; return; }
        if (hipFuncSetAttribute((const void*)trunk_fwd, hipFuncAttributeMaxDynamicSharedMemorySize, LDS_BYTES) != hipSuccess) { fprintf(stderr, "kernel_launch: hipFuncSetAttribute failed\n"); grid = -1; return; }
        if (hipOccupancyMaxActiveBlocksPerMultiprocessor(&per_cu, (const void*)trunk_fwd, 512, LDS_BYTES) != hipSuccess || per_cu < 1) fprintf(stderr, "kernel_launch: occupancy query reports %d workgroups per CU\n", per_cu);
        (void)hipGetLastError();
        grid = cus;
    }
    if (grid < 0) return;
    if (hipMemsetAsync((char*)d_ws + WS_CTL, 0, CTL_BYTES, stream) != hipSuccess) return;
    Args a{};
    for (int i = 0; i < 29; ++i) a.in[i] = (const float*)d_in[i];
    a.out = (float*)d_out; a.ws = (unsigned char*)d_ws;
#if MK_PER_PHASE
    for (int p = 0; p < PH_END; ++p) {
        if (p >= 1 && p < PH_FINAL) { const int L = (p - 1) / 7, q = (p - 1) % 7, kind = L % 3; if ((q == 1 && kind == 0) || (q == 2 && kind != 2)) continue; }
        a.ph_lo = p; a.ph_hi = p + 1;
        hipLaunchKernelGGL(trunk_fwd, dim3(grid), dim3(512), LDS_BYTES, stream, a);
    }
#else
    a.ph_lo = 0; a.ph_hi = PH_END;
    hipLaunchKernelGGL(trunk_fwd, dim3(grid), dim3(512), LDS_BYTES, stream, a);
#endif
}
```

```cpp
#include <hip/hip_runtime.h>
#include <hip/hip_bf16.h>
#include <cstdio>
#include <cstdint>

#define MK_PER_PHASE 0
#ifndef MK_PER_PHASE
#define MK_PER_PHASE 0
#endif

constexpr int DM = 2048, TP = 8192, TS = 512, MT = TP + TS, NB = 8, CSEQ = 64, PAST = 1024, SKS = PAST + CSEQ;
constexpr int HD = 128, NH = 12, AW = NH * HD, MEMW = 512, NMEM = 256, MH = 4;
constexpr int GH = 4, GDK = 192, GDV = 384, GKW = GH * GDK, GVW = GH * GDV, GRANK = 16;
constexpr int DFF = 8192, ZLD = 5376, NLAYER = 4;
constexpr int NCHUNK = TP / 64 + NB;
constexpr float RMS_EPS = 1e-6f;

constexpr size_t O_YP = 0;
constexpr size_t O_YS = O_YP + (size_t)TP * DM;
constexpr size_t O_FKP = O_YS + (size_t)TS * DM;
constexpr size_t O_FVP = O_FKP + (size_t)2 * TP * AW;
constexpr size_t O_FLP = O_FVP + (size_t)2 * TP * AW;
constexpr size_t O_SKP = O_FLP + (size_t)2 * TP * NH;
constexpr size_t O_SVP = O_SKP + (size_t)TP * AW;
constexpr size_t O_GSP = O_SVP + (size_t)TP * AW;
constexpr size_t O_MKP = O_GSP + (size_t)GH * GDK * GDV;
constexpr size_t O_MVP = O_MKP + (size_t)NLAYER * NMEM * MEMW;
constexpr size_t O_FKS = O_MVP + (size_t)NLAYER * NMEM * MEMW;
constexpr size_t O_FVS = O_FKS + (size_t)2 * TS * AW;
constexpr size_t O_FLS = O_FVS + (size_t)2 * TS * AW;
constexpr size_t O_SKS = O_FLS + (size_t)2 * TS * NH;
constexpr size_t O_SVS = O_SKS + (size_t)TS * AW;
constexpr size_t O_GSS = O_SVS + (size_t)TS * AW;
constexpr size_t O_END = O_GSS + (size_t)NB * GH * GDK * GDV;

constexpr size_t al256(size_t x) { return (x + 255) & ~(size_t)255; }
constexpr size_t WS_CTL = 0, CTL_BYTES = 2u << 20;
constexpr size_t WS_WIN = CTL_BYTES;
constexpr size_t WS_WOUT = WS_WIN + (size_t)NLAYER * ZLD * DM * 2;
constexpr size_t WS_WUP = WS_WOUT + (size_t)NLAYER * DM * DM * 2;
constexpr size_t WS_WDN = WS_WUP + (size_t)NLAYER * DFF * DM * 2;
constexpr size_t WS_WMKV = WS_WDN + (size_t)NLAYER * DM * DFF * 2;
constexpr size_t WS_X = WS_WMKV + (size_t)NLAYER * 1024 * DM * 2;
constexpr size_t WS_XB = WS_X + (size_t)MT * DM * 4;
constexpr size_t WS_Z = WS_XB + (size_t)MT * DM * 2;
constexpr size_t WS_OC = WS_Z + (size_t)MT * ZLD * 2;
constexpr size_t WS_U = WS_OC + (size_t)MT * DM * 2;
constexpr size_t WS_GU = WS_U + (size_t)MT * DFF * 2;
constexpr size_t WS_GDEC = WS_GU + (size_t)NCHUNK * GH * GDV * GDK * 4;
constexpr size_t WS_KVF = al256(WS_GDEC + (size_t)NCHUNK * GH * GDK * 4);
constexpr size_t KVS_ONE = (size_t)NB * SKS * AW * 2;
constexpr size_t WS_KVS = WS_KVF + 4 * KVS_ONE;
constexpr size_t WS_MEMC = WS_KVS + 2 * KVS_ONE;
constexpr size_t MEMC_ONE = (size_t)NB * NMEM * MEMW * 2;
constexpr size_t WS_MEMH = WS_MEMC + 8 * MEMC_ONE;
constexpr size_t WS_MKVB = WS_MEMH + (size_t)NLAYER * NMEM * DM * 2;
constexpr size_t WS_RSS = WS_MKVB + (size_t)NLAYER * NMEM * 1024 * 2;
constexpr size_t WS_END = WS_RSS + (size_t)2 * MT * 32 * 4;

constexpr int CW_BAR = 4096;

constexpr int LDS_WORK = 136 * 1024;
constexpr int MISC_OFF = LDS_WORK;
constexpr int LDS_BYTES = 147456;

#define GAS __attribute__((address_space(1)))
#define LAS __attribute__((address_space(3)))
typedef unsigned short bf16_t;
typedef unsigned u32x4 __attribute__((ext_vector_type(4)));
typedef unsigned u32x2 __attribute__((ext_vector_type(2)));
typedef float f32x4 __attribute__((ext_vector_type(4)));
typedef float f32x2 __attribute__((ext_vector_type(2)));
typedef float f32x16 __attribute__((ext_vector_type(16)));
typedef short bf16x8 __attribute__((ext_vector_type(8)));
typedef short s16x4 __attribute__((ext_vector_type(4)));
#define LDS_WAIT() asm volatile("s_waitcnt lgkmcnt(0)" ::: "memory")
#define VM_WAIT() asm volatile("s_waitcnt vmcnt(0)" ::: "memory")
#define SBAR() __builtin_amdgcn_sched_barrier(0)
__device__ __forceinline__ unsigned cvtpk(float lo, float hi) { unsigned r; asm volatile("v_cvt_pk_bf16_f32 %0, %1, %2" : "=v"(r) : "v"(lo), "v"(hi)); return r; }
__device__ __forceinline__ float bf2f(unsigned short b) { return __uint_as_float((unsigned)b << 16); }
__device__ __forceinline__ u32x4 pack8u(f32x4 a, f32x4 b) { u32x4 w = {cvtpk(a[0], a[1]), cvtpk(a[2], a[3]), cvtpk(b[0], b[1]), cvtpk(b[2], b[3])}; return w; }
__device__ __forceinline__ bf16x8 pack8(f32x4 a, f32x4 b) { u32x4 w = pack8u(a, b); return *reinterpret_cast<bf16x8*>(&w); }
__device__ __forceinline__ float wave_sum(float v) {
#pragma unroll
    for (int o = 1; o < 64; o <<= 1) v += __shfl_xor(v, o);
    return v;
}
__device__ __forceinline__ float log_sigmoidf(float x) { return fminf(x, 0.f) - log1pf(expf(-fabsf(x))); }
__device__ __forceinline__ int opaque_tid_w(int wave) { int l; asm volatile("v_mbcnt_lo_u32_b32 %0, -1, 0\n\tv_mbcnt_hi_u32_b32 %0, -1, %0" : "=v"(l)); return wave * 64 + l; }
#define opaque_tid() opaque_tid_w(g_wave)
template <class T> __device__ __forceinline__ T* launder_s(T* p) { asm volatile("" : "+s"(p)); return p; }
#define XB_TMO      128
#define XB_XCNT(j)  (256  + 64 * (j))
#define XB_XSUB(j)  (1280 + 64 * (j))
#define XB_XGEN(j)  (2304 + 64 * (j))
#define XB_TOP      3328
#define XB_TOPGEN   3392
#define XCD_BAR_WORDS 3456
#define XB_SPIN_CAP (1u << 18)
__device__ __forceinline__ unsigned xb_ld(unsigned* p)              { return __hip_atomic_load(p, __ATOMIC_RELAXED, __HIP_MEMORY_SCOPE_AGENT); }
__device__ __forceinline__ unsigned xb_add(unsigned* p, unsigned v) { return __hip_atomic_fetch_add(p, v, __ATOMIC_RELAXED, __HIP_MEMORY_SCOPE_AGENT); }
__device__ __forceinline__ unsigned xb_xcc_id() { return (unsigned)__builtin_amdgcn_s_getreg((3 << 11) | 20) & 0xFu; }
#define XB_SPIN(cond, bar) do { unsigned _sp = 0; while (cond) { __builtin_amdgcn_s_sleep(1); \
    if ((++_sp & 255u) == 0u) { if (xb_ld(&(bar)[XB_TMO])) break; if (_sp > XB_SPIN_CAP) { atomicAdd(&(bar)[XB_TMO], 1u); break; } } } } while (0)
struct XcdBarrier { unsigned* bar; unsigned x; volatile LAS unsigned* st; };
__device__ __forceinline__ XcdBarrier xcd_barrier_post(unsigned* bar, volatile LAS unsigned* st) {
    XcdBarrier b; b.bar = bar; b.x = xb_xcc_id(); b.st = st;
    if (threadIdx.x == 0) (void)xb_add(&bar[XB_XCNT(b.x)], 1u);
    return b;
}
__device__ __forceinline__ void xcd_barrier_complete(unsigned* bar, unsigned x, unsigned& nloc, unsigned& nx) {
    const unsigned G = gridDim.x * gridDim.y * gridDim.z;
    unsigned sum, cnt, mine, sp = 0u;
    for (;;) {
        sum = 0u; cnt = 0u; mine = 0u;
#pragma unroll
        for (unsigned j = 0; j < 16; ++j) { const unsigned c = xb_ld(&bar[XB_XCNT(j)]); sum += c; cnt += (c > 0u) ? 1u : 0u; mine = (j == x) ? c : mine; }
        if (sum == G) break;
        __builtin_amdgcn_s_sleep(1);
        if ((++sp & 255u) == 0u) { if (xb_ld(&bar[XB_TMO])) break; if (sp > XB_SPIN_CAP) { atomicAdd(&bar[XB_TMO], 1u); break; } }
    }
    nloc = mine > 0u ? mine : 1u; nx = cnt > 0u ? cnt : 1u;
}
__device__ __forceinline__ void xcd_barrier(const XcdBarrier& b) {
    asm volatile("s_waitcnt vmcnt(0)" ::: "memory");
    __syncthreads();
    if (threadIdx.x == 0) {
        unsigned* bar = b.bar;
        __builtin_amdgcn_s_waitcnt(0);
        unsigned nloc = b.st[0], nx = b.st[1];
        if (nloc == 0u) { xcd_barrier_complete(bar, b.x, nloc, nx); b.st[0] = nloc; b.st[1] = nx; }
        const unsigned old = xb_add(&bar[XB_XSUB(b.x)], 1u);
        const unsigned gen = old / nloc;
        if (old + 1u == (gen + 1u) * nloc) {
            __builtin_amdgcn_fence(__ATOMIC_RELEASE, "agent");
            asm volatile("s_waitcnt vmcnt(0)" ::: "memory");
            const unsigned og = xb_add(&bar[XB_TOP], 1u);
            const unsigned tg = og / nx;
            if (og + 1u == (tg + 1u) * nx) xb_add(&bar[XB_TOPGEN], 1u);
            else XB_SPIN(xb_ld(&bar[XB_TOPGEN]) == tg, bar);
            __builtin_amdgcn_fence(__ATOMIC_ACQUIRE, "agent");
            xb_add(&bar[XB_XGEN(b.x)], 1u);
            asm volatile("s_waitcnt vmcnt(0)" ::: "memory");
        } else {
            XB_SPIN(xb_ld(&bar[XB_XGEN(b.x)]) == gen, bar);
            __builtin_amdgcn_fence(__ATOMIC_ACQUIRE, "agent");
            asm volatile("s_waitcnt vmcnt(0)" ::: "memory");
        }
    }
    __syncthreads();
}

namespace pg8 {
constexpr int BM = 256, BK = 64, HALF = 128, HTB = HALF * BK * 2, STAGE_BYTES = 8 * HTB, NXCD = 8, WGM = 8;
__host__ __device__ __forceinline__ int lds_byte(int r, int c) { const int st = (r >> 4) * 2 + (c >> 5), rr = r & 15, cc = c & 31, ob = rr * 64 + cc * 2; return st * 1024 + (ob ^ (((ob >> 9) & 1) << 5)); }
__host__ __device__ __forceinline__ void stage_rc(int b, int& R, int& C) { const int st = b / 1024, sb = b % 1024, swz = sb ^ (((sb >> 9) & 1) << 5); R = (st >> 1) * 16 + swz / 64; C = (st & 1) * 32 + (swz % 64) / 2; }
__host__ __device__ __forceinline__ int perm32(int rho) { const int n = rho >> 4, i = rho & 15; return 8 * (i >> 2) + 4 * n + (i & 3); }

struct Unit { int pm, pn, g; const char* A; const char* B; };

struct Sched {
    int nM, nN, nwg, G, c, nextra;
    const char* A; const char* B; size_t tA, tB;
    const char* Ae; const char* Be; size_t tAe, tBe;
    __device__ __forceinline__ bool next(int i, Unit& u) const {
        const long L = (long)i * G + c; if (L >= nwg + nextra) return false;
        if (L >= nwg) { const int e = (int)(L - nwg); u.g = 1 + (e >> 2); u.pm = 0; u.pn = e & 3; u.A = Ae + (size_t)(e >> 2) * tAe; u.B = Be + (size_t)e * tBe; return true; }
        int wgid = (int)L; { const int q = nwg / NXCD, r = nwg % NXCD, xcd = wgid % NXCD, off = wgid / NXCD; wgid = (xcd < r ? xcd * (q + 1) : r * (q + 1) + (xcd - r) * q) + off; }
        const int nig = WGM * nN, gid = wgid / nig, fm = gid * WGM, gsz = (nM - fm) < WGM ? (nM - fm) : WGM;
        u.pm = fm + ((wgid % nig) % gsz); u.pn = (wgid % nig) / gsz; u.g = 0; u.A = A + (size_t)u.pm * tA; u.B = B + (size_t)u.pn * tB; return true;
    }
};

__device__ __forceinline__ void row_rstd8(const float* rss, int row0, int fq, float (&rs)[2][4]) {
    f32x4 a[2][4], b[2][4];
#pragma unroll
    for (int ai = 0; ai < 2; ++ai)
#pragma unroll
        for (int m = 0; m < 4; ++m) { const f32x4* p = (const f32x4*)(rss + (size_t)(row0 + ai * HALF + m * 16) * 32 + fq * 8); a[ai][m] = p[0]; b[ai][m] = p[1]; }
#pragma unroll
    for (int ai = 0; ai < 2; ++ai)
#pragma unroll
        for (int m = 0; m < 4; ++m) { const f32x4 v = a[ai][m] + b[ai][m]; float s = (v[0] + v[1]) + (v[2] + v[3]); s += __shfl_xor(s, 16); s += __shfl_xor(s, 32); rs[ai][m] = rsqrtf(s * (1.0f / DM) + RMS_EPS); }
}
struct EpiIn {
    static constexpr bool PERM = true, AFTER_DRAIN = false;
    bf16_t* z; const float* rss; float* out; bf16_t* kvb; bf16_t* mkvb; const float* bfg; int kind, j;
    __device__ __forceinline__ void operator()(const f32x4 (&acc)[2][2][4][2], const Unit& u, int wr, int wc, int fr, int fq) const {
        const int row0 = u.pm * BM + wr * 64 + fr, colt = u.pn * BM, col0 = colt + wc * 32 + 8 * fq;
        if (u.g != 0) {
            const int e = u.g - 1; const bool isv = colt >= MEMW; float* of = out + (isv ? O_MVP : O_MKP) + (size_t)e * NMEM * MEMW; bf16_t* ob = mkvb + (size_t)e * NMEM * 1024;
#pragma unroll
            for (int ai = 0; ai < 2; ++ai)
#pragma unroll
                for (int m = 0; m < 4; ++m) { const int row = row0 + ai * HALF + m * 16;
#pragma unroll
                    for (int bj = 0; bj < 2; ++bj) { const int c = col0 + bj * HALF; const f32x4 v0 = acc[ai][bj][m][0], v1 = acc[ai][bj][m][1];
                        *(u32x4*)(ob + (size_t)row * 1024 + c) = pack8u(v0, v1);
                        float* o = of + (size_t)row * MEMW + (c - (isv ? MEMW : 0)); *(f32x4*)o = v0; *(f32x4*)(o + 4) = v1; } }
            return;
        }
        float rs[2][4]; row_rstd8(rss, row0, fq, rs);
        const bool kt = kind != 2 && colt >= AW && colt < 2 * AW, vt = kind != 2 && colt >= 2 * AW && colt < 3 * AW, smp = u.pm >= TP / BM;
        const int cbase = kt ? AW : 2 * AW;
        const size_t ocache = kind == 0 ? (smp ? (kt ? O_FKS : O_FVS) + (size_t)j * TS * AW : (kt ? O_FKP : O_FVP) + (size_t)j * TP * AW) : (smp ? (kt ? O_SKS : O_SVS) : (kt ? O_SKP : O_SVP));
        float* oc = out + ocache; bf16_t* kvs = kvb + (kt ? 0 : KVS_ONE / 2);
        const bool lft = kind == 0 && colt == 5120 && wc == 0 && fq < 2;
        float* lfo = out + (smp ? O_FLS + (size_t)j * TS * NH : O_FLP + (size_t)j * TP * NH);
#pragma unroll
        for (int ai = 0; ai < 2; ++ai)
#pragma unroll
            for (int m = 0; m < 4; ++m) { const int row = row0 + ai * HALF + m * 16, rr = smp ? row - TP : row; const float sc = rs[ai][m];
#pragma unroll
                for (int bj = 0; bj < 2; ++bj) { const int c = col0 + bj * HALF; const f32x4 v0 = acc[ai][bj][m][0] * sc, v1 = acc[ai][bj][m][1] * sc; const u32x4 w = pack8u(v0, v1);
                    *(u32x4*)(z + (size_t)row * ZLD + c) = w;
                    if (kt || vt) { const int cc = c - cbase; float* o = oc + (size_t)rr * AW + cc; *(f32x4*)o = v0; *(f32x4*)(o + 4) = v1;
                        if (smp) *(u32x4*)(kvs + ((size_t)(rr >> 6) * SKS + PAST + (rr & 63)) * AW + cc) = w; }
                    if (lft && bj == 0) {
                        float* o = lfo + (size_t)rr * NH;
#pragma unroll
                        for (int e = 0; e < 8; ++e) { const int h = 8 * fq + e; if (h < NH) o[h] = log_sigmoidf((e < 4 ? v0[e & 3] : v1[e & 3]) + bfg[h]); } } } }
    }
};
struct EpiRes {
    static constexpr bool PERM = true, AFTER_DRAIN = false;
    float* x; bf16_t* xb; float* rss;
    __device__ __forceinline__ void operator()(const f32x4 (&acc)[2][2][4][2], const Unit& u, int wr, int wc, int fr, int fq) const {
        const int row0 = u.pm * BM + wr * 64 + fr, col0 = u.pn * BM + wc * 32 + 8 * fq;
#pragma unroll
        for (int ai = 0; ai < 2; ++ai)
#pragma unroll
            for (int m = 0; m < 4; ++m) { const int row = row0 + ai * HALF + m * 16; float ss = 0.f;
#pragma unroll
                for (int bj = 0; bj < 2; ++bj) { float* p = x + (size_t)row * DM + col0 + bj * HALF;
                    const f32x4 a = *(const f32x4*)p + acc[ai][bj][m][0], b = *(const f32x4*)(p + 4) + acc[ai][bj][m][1];
                    *(f32x4*)p = a; *(f32x4*)(p + 4) = b; *(u32x4*)(xb + (size_t)row * DM + col0 + bj * HALF) = pack8u(a, b);
                    ss += (a[0] * a[0] + a[1] * a[1]) + (a[2] * a[2] + a[3] * a[3]) + (b[0] * b[0] + b[1] * b[1]) + (b[2] * b[2] + b[3] * b[3]); }
                ss += __shfl_xor(ss, 16); ss += __shfl_xor(ss, 32);
                if (fq == 0) rss[(size_t)row * 32 + u.pn * 4 + wc] = ss;
                if (m & 1) asm volatile("" ::: "memory"); }
    }
};
struct EpiUp {
    static constexpr bool PERM = true, AFTER_DRAIN = false;
    bf16_t* o; const float* rss;
    __device__ __forceinline__ void operator()(const f32x4 (&acc)[2][2][4][2], const Unit& u, int wr, int wc, int fr, int fq) const {
        const int row0 = u.pm * BM + wr * 64 + fr, col0 = u.pn * BM + wc * 32 + 8 * fq;
        float rs[2][4]; row_rstd8(rss, row0, fq, rs);
#pragma unroll
        for (int ai = 0; ai < 2; ++ai)
#pragma unroll
            for (int m = 0; m < 4; ++m) { const int row = row0 + ai * HALF + m * 16; const float sc = rs[ai][m];
#pragma unroll
                for (int bj = 0; bj < 2; ++bj) { f32x4 v0 = acc[ai][bj][m][0] * sc, v1 = acc[ai][bj][m][1] * sc;
#pragma unroll
                    for (int e = 0; e < 4; ++e) { const float a = fmaxf(v0[e], 0.f), b = fmaxf(v1[e], 0.f); v0[e] = a * a; v1[e] = b * b; }
                    *(u32x4*)(o + (size_t)row * DFF + col0 + bj * HALF) = pack8u(v0, v1); } }
    }
};

template <class Epi>
__device__ __forceinline__ void gemm_phase(LAS unsigned char* lds, const int K, const int lda, const int ldb, const Sched& S, const Epi& E, const int tid) {
    const int wid = __builtin_amdgcn_readfirstlane(tid >> 6), lane = tid & 63, wr = wid >> 2, wc = wid & 3, fr = lane & 15, fq = lane >> 4;
    const int nt = K / BK;
    unsigned voffA[2], voffB[2];
#pragma unroll
    for (int i = 0; i < 2; ++i) { int R, C; stage_rc(tid * 16 + i * 8192, R, C); const int Rb = Epi::PERM ? ((R & ~31) + perm32(R & 31)) : R;
        voffA[i] = (unsigned)(R * lda + C) * 2u; voffB[i] = (unsigned)(Rb * ldb + C) * 2u; }
    const size_t kstep = (size_t)(BK * 2);
    const size_t hstepA = (size_t)HALF * lda * 2, hstepB = (size_t)HALF * ldb * 2;
    const unsigned ldsw = (unsigned)wid * 1024u;
    const int aoff = lds_byte(wr * 64 + fr, fq * 8), boff = lds_byte(wc * 32 + fr, fq * 8);
#define PG8_SA(b, h) (((b) * 2 + (h)) * HTB)
#define PG8_SB(b, h) ((4 + (b) * 2 + (h)) * HTB)
#define PG8_STAGE(bufoff, gbase, voff) do { _Pragma("unroll") for (int _i = 0; _i < 2; ++_i) \
        __builtin_amdgcn_global_load_lds((const unsigned*)((const char*)(gbase) + (voff)[_i]), (LAS unsigned*)(lds + (bufoff) + ldsw + _i * 8192), 16, 0, 0); } while (0)
#define PG8_LDA(dst, b, h) do { _Pragma("unroll") for (int m = 0; m < 4; ++m) _Pragma("unroll") for (int k = 0; k < 2; ++k) dst[m][k] = *(const LAS bf16x8*)(lds + PG8_SA(b, h) + aoff + m * 2048 + k * 1024); } while (0)
#define PG8_LDB(dst, b, h) do { _Pragma("unroll") for (int n = 0; n < 2; ++n) _Pragma("unroll") for (int k = 0; k < 2; ++k) dst[n][k] = *(const LAS bf16x8*)(lds + PG8_SB(b, h) + boff + n * 2048 + k * 1024); } while (0)
#define PG8_MMA(ai, bj, At, Bt) do { __builtin_amdgcn_s_setprio(1); _Pragma("unroll") for (int m = 0; m < 4; ++m) _Pragma("unroll") for (int n = 0; n < 2; ++n) _Pragma("unroll") for (int k = 0; k < 2; ++k) \
        acc[ai][bj][m][n] = __builtin_amdgcn_mfma_f32_16x16x32_bf16(Bt[n][k], At[m][k], acc[ai][bj][m][n], 0, 0, 0); __builtin_amdgcn_s_setprio(0); } while (0)
#define PG8_WAIT_V(n) asm volatile("s_waitcnt vmcnt(" #n ")" ::: "memory")
#define PG8_WAIT_L(n) asm volatile("s_waitcnt lgkmcnt(" #n ")" ::: "memory")
#define PG8_BAR __builtin_amdgcn_s_barrier()
#define PG8_SCHED __builtin_amdgcn_sched_barrier(0)
    Unit cur, nxt; int ui = 0;
    if (!S.next(0, cur)) return;
    f32x4 acc[2][2][4][2];
#pragma unroll
    for (int a = 0; a < 2; ++a)
#pragma unroll
        for (int b = 0; b < 2; ++b)
#pragma unroll
            for (int m = 0; m < 4; ++m)
#pragma unroll
                for (int n = 0; n < 2; ++n) acc[a][b][m][n] = (f32x4){0.f, 0.f, 0.f, 0.f};
    bf16x8 At[4][2], B0[2][2], B1[2][2];
    const char* cA = cur.A; const char* cB = cur.B;
    PG8_STAGE(PG8_SB(0, 0), cB, voffB); PG8_STAGE(PG8_SB(0, 1), cB + hstepB, voffB); PG8_STAGE(PG8_SA(0, 0), cA, voffA); PG8_STAGE(PG8_SA(0, 1), cA + hstepA, voffA);
    if (wr == 1) PG8_BAR;
    PG8_WAIT_V(2); PG8_BAR;
    PG8_STAGE(PG8_SB(1, 0), cB + kstep, voffB); PG8_STAGE(PG8_SA(1, 0), cA + kstep, voffA); PG8_STAGE(PG8_SB(1, 1), cB + hstepB + kstep, voffB);
    PG8_WAIT_V(6); PG8_BAR;
    for (;;) {
        const bool has_next = S.next(ui + 1, nxt);
        const char* nA = has_next ? nxt.A : cA; const char* nB = has_next ? nxt.B : cB;
        for (int t = 0; t < nt; t += 2) {
            const bool last = (t == nt - 2);
            const char* a1 = cA + (size_t)(t + 1) * kstep;
            const char* a2 = last ? nA : cA + (size_t)(t + 2) * kstep; const char* b2 = last ? nB : cB + (size_t)(t + 2) * kstep;
            const char* a3 = a2 + kstep; const char* b3 = b2 + kstep;
            PG8_LDB(B0, 0, 0); PG8_LDB(B1, 0, 1); PG8_SCHED; PG8_LDA(At, 0, 0); PG8_STAGE(PG8_SA(1, 1), a1 + hstepA, voffA);
            PG8_WAIT_V(8); PG8_WAIT_L(0); PG8_BAR; PG8_MMA(0, 0, At, B0); PG8_MMA(0, 1, At, B1); PG8_BAR; PG8_SCHED;
            PG8_LDA(At, 0, 1); PG8_STAGE(PG8_SB(0, 0), b2, voffB); PG8_STAGE(PG8_SB(0, 1), b2 + hstepB, voffB); PG8_STAGE(PG8_SA(0, 0), a2, voffA);
            PG8_WAIT_V(8); PG8_WAIT_L(0); PG8_BAR; PG8_MMA(1, 0, At, B0); PG8_MMA(1, 1, At, B1); PG8_BAR; PG8_SCHED;
            PG8_LDB(B0, 1, 0); PG8_LDB(B1, 1, 1); PG8_SCHED; PG8_LDA(At, 1, 0); PG8_STAGE(PG8_SA(0, 1), a2 + hstepA, voffA);
            PG8_WAIT_V(8); PG8_WAIT_L(0); PG8_BAR; PG8_MMA(0, 0, At, B0); PG8_MMA(0, 1, At, B1); PG8_BAR; PG8_SCHED;
            PG8_LDA(At, 1, 1); PG8_STAGE(PG8_SB(1, 0), b3, voffB); PG8_STAGE(PG8_SB(1, 1), b3 + hstepB, voffB); PG8_STAGE(PG8_SA(1, 0), a3, voffA);
            PG8_WAIT_V(8); PG8_WAIT_L(0); PG8_BAR; PG8_MMA(1, 0, At, B0); PG8_MMA(1, 1, At, B1); PG8_BAR; PG8_SCHED;
        }
        if (wr == 0) PG8_BAR;
        E(acc, cur, wr, wc, fr, fq);
        if (!has_next) break;
#pragma unroll
        for (int a = 0; a < 2; ++a)
#pragma unroll
            for (int b = 0; b < 2; ++b)
#pragma unroll
                for (int m = 0; m < 4; ++m)
#pragma unroll
                    for (int n = 0; n < 2; ++n) acc[a][b][m][n] = (f32x4){0.f, 0.f, 0.f, 0.f};
        cur = nxt; cA = nA; cB = nB; ++ui;
        if (wr == 1) PG8_BAR;
    }
    PG8_WAIT_V(0);
    PG8_BAR;
#undef PG8_SA
#undef PG8_SB
#undef PG8_STAGE
#undef PG8_LDA
#undef PG8_LDB
#undef PG8_MMA
#undef PG8_WAIT_V
#undef PG8_WAIT_L
#undef PG8_BAR
#undef PG8_SCHED
}
}

namespace att {
constexpr float SCALE = 0.08838834764831845f;
constexpr float THR = 8.f;
constexpr int NW = 8, QBLK = 32, KVBLK = 64, QB = NW * QBLK, D = 128;
constexpr int SHM_V = KVBLK * D * 2, SHM_K = KVBLK * D * 2;
constexpr int ATT_LDS = 2 * SHM_V + 2 * SHM_K + NW * 64 * 4;
constexpr int BOS_OFF = ATT_LDS;
constexpr int BOS_BYTES = 8192 * 4;
constexpr int SCR_OFF = BOS_OFF + BOS_BYTES;
constexpr int WINF = 1 << 30;
static_assert(SCR_OFF + 256 <= LDS_WORK, "attention LDS map");

#define KSWZ(row, colB) ((row) * 256 + ((colB) ^ (((row) & 7) << 4)))
__device__ __forceinline__ int v_st(int k, int c) { const int kk = (k & ~0xC) | ((k & 4) << 1) | ((k & 8) >> 1); return ((kk >> 3) * 4 + (c >> 5)) * 512 + ((kk & 7) * 32 + (c & 31)) * 2; }
__device__ __forceinline__ int v_rd_base(int lane) { return ((lane & 3) << 3) | (((lane >> 2) & 3) << 6) | (((lane >> 4) & 1) << 5) | (((lane >> 5) & 1) << 8); }
constexpr int v_rd_off(int d0, int ks, int half) { return d0 * 512 + ks * 4096 + half * 2048; }
__device__ __forceinline__ int crow(int r, int hi) { return (r & 3) + 8 * (r >> 2) + 4 * hi; }
__device__ __forceinline__ bf16x8 load8(const bf16_t* p) { return *reinterpret_cast<const bf16x8*>(p); }

__device__ __forceinline__ void mask_tile(f32x16& p0, f32x16& p1, int dq, unsigned W) {
    const float NEG = -__builtin_inff();
#pragma unroll
    for (int r = 0; r < 16; ++r) {
        const int c = (r & 3) + 8 * (r >> 2);
        if ((unsigned)(dq - c) >= W) p0[r] = NEG;
        if ((unsigned)(dq - c - 32) >= W) p1[r] = NEG;
    }
}
__device__ __forceinline__ void partialSM(f32x16& p0, f32x16& p1, float& m_reg, float& mn, float& alpha) {
    float pmax = p0[0]; for (int r = 1; r < 16; ++r) pmax = fmaxf(pmax, p0[r]); for (int r = 0; r < 16; ++r) pmax = fmaxf(pmax, p1[r]);
    { auto rr = __builtin_amdgcn_permlane32_swap(__float_as_uint(pmax), __float_as_uint(pmax), false, false);
      pmax = fmaxf(__uint_as_float(rr[0]), __uint_as_float(rr[1])); }
    constexpr float C2 = 1.4426950408889634f * SCALE;
    if (__builtin_expect(__all((pmax - m_reg) * SCALE <= THR), 1)) { mn = m_reg; alpha = 1.f; }
    else { mn = fmaxf(m_reg, pmax); alpha = __builtin_amdgcn_exp2f((m_reg - mn) * C2); m_reg = mn; }
    const float mnL = -mn * C2;
    for (int r = 0; r < 16; ++r) p0[r] = fmaf(p0[r], C2, mnL); for (int r = 0; r < 16; ++r) p1[r] = fmaf(p1[r], C2, mnL);
    for (int r = 0; r < 16; ++r) p0[r] = __builtin_amdgcn_exp2f(p0[r]);
}
#define PK4(P, B_, OUT) do { unsigned a0 = cvtpk(P[B_+0], P[B_+1]), a1 = cvtpk(P[B_+2], P[B_+3]);                          \
        unsigned b0 = cvtpk(P[B_+4], P[B_+5]), b1 = cvtpk(P[B_+6], P[B_+7]);                                             \
        auto r0 = __builtin_amdgcn_permlane32_swap(a0, b0, false, false); auto r1 = __builtin_amdgcn_permlane32_swap(a1, b1, false, false); \
        u32x4 w = {r0[0], r1[0], r0[1], r1[1]}; OUT = *reinterpret_cast<bf16x8*>(&w); } while (0)
__device__ __forceinline__ void finishSM(f32x16& p0, f32x16& p1, float alpha, float& l_reg, bf16x8& pa0, bf16x8& pa1, bf16x8& pa2, bf16x8& pa3) {
    for (int r = 0; r < 16; ++r) p1[r] = __builtin_amdgcn_exp2f(p1[r]);
    float ps = 0; for (int r = 0; r < 16; ++r) ps += p0[r]; for (int r = 0; r < 16; ++r) ps += p1[r];
    { auto rr = __builtin_amdgcn_permlane32_swap(__float_as_uint(ps), __float_as_uint(ps), false, false);
      ps = __uint_as_float(rr[0]) + __uint_as_float(rr[1]); }
    l_reg = l_reg * alpha + ps;
    PK4(p0, 0, pa0); PK4(p0, 8, pa1); PK4(p1, 0, pa2); PK4(p1, 8, pa3);
}
template <int KB, bool BIAS>
__device__ __forceinline__ void qkt(f32x16& p0, f32x16& p1, const char* K_lds, int r32, int hi, const bf16x8* qr, const float* bk) {
    if constexpr (BIAS) {
#pragma unroll
        for (int i = 0; i < 4; ++i) { const f32x4 a = *(const f32x4*)(bk + 8 * i), b = *(const f32x4*)(bk + 32 + 8 * i);
            p0[4 * i] = a[0]; p0[4 * i + 1] = a[1]; p0[4 * i + 2] = a[2]; p0[4 * i + 3] = a[3];
            p1[4 * i] = b[0]; p1[4 * i + 1] = b[1]; p1[4 * i + 2] = b[2]; p1[4 * i + 3] = b[3]; }
    } else { p0 = f32x16{}; p1 = f32x16{}; }
    const char* kb[4];
#pragma unroll
    for (int dd = 0; dd < 4; ++dd) kb[dd] = K_lds + KB * SHM_K + KSWZ(r32, (dd * 16 + hi * 8) * 2);
#pragma unroll
    for (int d0 = 0; d0 < 8; ++d0) { const char* a = kb[d0 & 3] + (d0 >> 2) * 128;
        bf16x8 b0 = *reinterpret_cast<const bf16x8*>(a);
        bf16x8 b1 = *reinterpret_cast<const bf16x8*>(a + 32 * 256);
        p0 = __builtin_amdgcn_mfma_f32_32x32x16_bf16(b0, qr[d0], p0, 0, 0, 0);
        p1 = __builtin_amdgcn_mfma_f32_32x32x16_bf16(b1, qr[d0], p1, 0, 0, 0); }
}
template <int VB>
__device__ __forceinline__ void pv_tile(f32x16* o, int vb0, bf16x8 pa0, bf16x8 pa1, bf16x8 pa2, bf16x8 pa3) {
#define TRRD(dst, off) asm volatile("ds_read_b64_tr_b16 %0, %1 offset:%2" : "=&v"(dst) : "v"(vb0), "i"(off) : "memory")
#define PV_D0(d0) do { s16x4 l0, l1, l2, l3, h0, h1, h2, h3; constexpr int b_ = VB * SHM_V + v_rd_off(d0, 0, 0); \
        TRRD(l0, b_); TRRD(h0, b_ + 2048); TRRD(l1, b_ + 4096); TRRD(h1, b_ + 6144); TRRD(l2, b_ + 8192); TRRD(h2, b_ + 10240); TRRD(l3, b_ + 12288); TRRD(h3, b_ + 14336); \
        asm volatile("s_waitcnt lgkmcnt(0)" ::: "memory"); SBAR();   \
        o[d0] = __builtin_amdgcn_mfma_f32_32x32x16_bf16(pa0, (bf16x8){l0[0], l0[1], l0[2], l0[3], h0[0], h0[1], h0[2], h0[3]}, o[d0], 0, 0, 0);   \
        o[d0] = __builtin_amdgcn_mfma_f32_32x32x16_bf16(pa1, (bf16x8){l1[0], l1[1], l1[2], l1[3], h1[0], h1[1], h1[2], h1[3]}, o[d0], 0, 0, 0);   \
        o[d0] = __builtin_amdgcn_mfma_f32_32x32x16_bf16(pa2, (bf16x8){l2[0], l2[1], l2[2], l2[3], h2[0], h2[1], h2[2], h2[3]}, o[d0], 0, 0, 0);   \
        o[d0] = __builtin_amdgcn_mfma_f32_32x32x16_bf16(pa3, (bf16x8){l3[0], l3[1], l3[2], l3[3], h3[0], h3[1], h3[2], h3[3]}, o[d0], 0, 0, 0); } while (0)
    PV_D0(0); PV_D0(1); PV_D0(2); PV_D0(3);
#undef PV_D0
#undef TRRD
}

struct Blk { const bf16_t* Q; const bf16_t* K; const bf16_t* V; bf16_t* O; int ldq, ldkv, ldo; int P0, skv, nrows; int bmode; const float* lf0; int n0; const float* lf1; };
struct Seam { bf16x8 qr[8]; bf16x8 st_v0, st_v1, st_k0, st_k1; };
__device__ __forceinline__ int blk_jhi(const Blk& b) { int j = (b.P0 + QB - 1) / KVBLK + 1; const int m = b.skv / KVBLK; return j > m ? m : j; }

__device__ __forceinline__ void prepare_bias(const Blk& b, char* lds, int g_wave) {
    const int tid = opaque_tid();
    float* bos = (float*)(lds + BOS_OFF); float* scr = (float*)(lds + SCR_OFF);
    const int nk = blk_jhi(b) * KVBLK, lane = tid & 63, wid = tid >> 6;
    if (b.bmode == 0) { for (int k = tid; k < nk; k += 512) bos[k] = 0.f; __syncthreads(); return; }
    float v[16]; float tot = 0.f; const int k0 = tid * 16; const bool in = k0 < nk;
#pragma unroll
    for (int i = 0; i < 16; ++i) { const int k = k0 + i; v[i] = in ? (k < b.n0 ? b.lf0[(size_t)k * NH] : b.lf1[(size_t)(k - b.n0) * NH]) : 0.f; tot += v[i]; }
    float inc = tot;
#pragma unroll
    for (int o = 1; o < 64; o <<= 1) { const float y = __shfl_down(inc, o); if (lane + o < 64) inc += y; }
    if (lane == 0) scr[wid] = inc;
    __syncthreads();
    float hiw = 0.f;
#pragma unroll
    for (int w = 0; w < 8; ++w) if (w > wid) hiw += scr[w];
    float run = (inc - tot) + hiw;
    if (in) {
#pragma unroll
        for (int i = 15; i >= 0; --i) { bos[k0 + i] = run * (1.0f / SCALE); run += v[i]; }
    }
    __syncthreads();
}

#define ROWK(p, ld, k0, rr) ((p) + (size_t)((k0) + (rr)) * (ld) + sc)
#define VMW() asm volatile("s_waitcnt vmcnt(0)" ::: "memory")
#define VMWN(n) asm volatile("s_waitcnt vmcnt(%0)" :: "i"(n) : "memory")
#define SLOAD_H(Kp, Vp, ld, k0) do { S.st_v0 = load8(ROWK(Vp, ld, k0, sr)); S.st_v1 = load8(ROWK(Vp, ld, k0, 32 + sr));              \
                         S.st_k0 = load8(ROWK(Kp, ld, k0, sr)); S.st_k1 = load8(ROWK(Kp, ld, k0, 32 + sr)); } while (0)
#define SWRITE_HK(bf) do { *(bf16x8*)(K_lds + (bf) * SHM_K + kws) = S.st_k0; *(bf16x8*)(K_lds + (bf) * SHM_K + kws + 32 * 256) = S.st_k1; } while (0)
#define SWRITE_HV(bf) do { *(bf16x8*)(V_lds + (bf) * SHM_V + vst0) = S.st_v0; *(bf16x8*)(V_lds + (bf) * SHM_V + vst1) = S.st_v1; } while (0)
#define SWRITE_H(bf) do { SWRITE_HV(bf); SWRITE_HK(bf); } while (0)
#define QROWP(b_) ((b_).Q + (size_t)((wid * QBLK + r32) & ((b_).nrows - 1)) * (b_).ldq + hi * 8)
__device__ __forceinline__ void att_prime(const Blk& cur, char* lds, Seam& S, int g_wave) {
    const int tid = opaque_tid();
    const int wid = __builtin_amdgcn_readfirstlane(tid >> 6), lane = tid & 63, r32 = lane & 31, hi = lane >> 5;
    const int sr = tid >> 4, sc = (tid & 15) * 8, kws = KSWZ(sr, sc * 2); char* K_lds = lds + 2 * SHM_V;
    const bf16_t* qp = QROWP(cur);
#pragma unroll
    for (int d0 = 0; d0 < 8; ++d0) S.qr[d0] = load8(qp + d0 * 16);
    SLOAD_H(cur.K, cur.V, cur.ldkv, 0); VMW(); SWRITE_HK(0);
    __syncthreads();
}
__device__ __forceinline__ void att_block(const Blk& cur, const Blk& nxt, char* lds, Seam& S, int g_wave) {
    const int tid = opaque_tid();
    const int wid = __builtin_amdgcn_readfirstlane(tid >> 6), lane = tid & 63, r32 = lane & 31, hi = lane >> 5;
    constexpr int W = WINF;
    const int NT = blk_jhi(cur);
    const int qlo = cur.P0 + wid * QBLK, qm = qlo + r32 - 4 * hi;
    char* V_lds = lds; char* K_lds = lds + 2 * SHM_V;
    float* ws = (float*)(lds + 2 * SHM_V + 2 * SHM_K) + wid * 64; float* li_l = ws, * al_l = ws + 32;
    const float* bos = (const float*)(lds + BOS_OFF) + 4 * hi;
    float m_reg = -1e30f, l_reg = 0; f32x16 o[4] = {};
    const int sr = tid >> 4, sc = (tid & 15) * 8, vst0 = v_st(sr, sc), vst1 = v_st(32 + sr, sc), kws = KSWZ(sr, sc * 2);
    const int vb0 = (int)(uintptr_t)V_lds + v_rd_base(lane);
    const bf16_t* Kh = cur.K; const bf16_t* Vh = cur.V; const int ldkv = cur.ldkv;
#define RESC(a) do { if (__any((a) < 1.f)) { if (hi == 0) al_l[r32] = (a); asm volatile("s_waitcnt lgkmcnt(0)" ::: "memory");              \
                     for (int d_ = 0; d_ < 4; ++d_) for (int r = 0; r < 16; ++r) o[d_][r] *= al_l[crow(r, hi)]; } } while (0)
#define KBASE(t) ((t) * KVBLK)
#define MASKT(P0_, P1_, t) do { const int kb_ = KBASE(t); if (kb_ + KVBLK - 1 > qlo) mask_tile(P0_, P1_, qm - kb_, (unsigned)W); } while (0)
    constexpr int NQL = 8;
#define SEAM_K0() do { VMWN(NQL); SWRITE_HK(0); SBAR(); } while (0)
    f32x16 pA0, pA1, pB0, pB1; float mnA, mnB, alA, alB; bf16x8 pa0, pa1, pa2, pa3;
    SWRITE_HV(0); SBAR();
    if (NT > 1) SLOAD_H(Kh, Vh, ldkv, KBASE(1));
    SBAR(); qkt<0, true>(pA0, pA1, K_lds, r32, hi, S.qr, bos + KBASE(0));
    MASKT(pA0, pA1, 0); partialSM(pA0, pA1, m_reg, mnA, alA);
    if (NT > 1) { VMW(); SWRITE_H(1); }
    __syncthreads();
#define HALF_STEP(PX0, PX1, mnX, alX, PY0, PY1, alY, t, KB, VB, SB) do {                                                      \
        SBAR(); qkt<KB, true>(PX0, PX1, K_lds, r32, hi, S.qr, bos + KBASE(t));                                                \
        finishSM(PY0, PY1, alY, l_reg, pa0, pa1, pa2, pa3); SBAR();                                                           \
        if ((t) + 1 < NT) { SLOAD_H(Kh, Vh, ldkv, KBASE((t) + 1)); SBAR(); }                                                  \
        pv_tile<VB>(o, vb0, pa0, pa1, pa2, pa3); MASKT(PX0, PX1, (t)); partialSM(PX0, PX1, m_reg, mnX, alX);                  \
        __syncthreads();                                                                                                      \
        if ((t) + 1 < NT) { VMW(); SWRITE_H(SB); }                                                                            \
        RESC(alX); __syncthreads(); } while (0)
    for (int t = 1; t + 1 < NT; t += 2) {
        HALF_STEP(pB0, pB1, mnB, alB, pA0, pA1, alA, t, 1, 0, 0);
        HALF_STEP(pA0, pA1, mnA, alA, pB0, pB1, alB, t + 1, 0, 1, 1);
    }
    const bool even = (NT & 1) == 0;
    if (even) { SBAR(); qkt<1, true>(pB0, pB1, K_lds, r32, hi, S.qr, bos + KBASE(NT - 1)); SBAR(); }
    SLOAD_H(nxt.K, nxt.V, nxt.ldkv, 0); SBAR();
    { const bf16_t* qp = QROWP(nxt);
#pragma unroll
      for (int d0 = 0; d0 < 8; ++d0) S.qr[d0] = load8(qp + d0 * 16); }
    SBAR();
    finishSM(pA0, pA1, alA, l_reg, pa0, pa1, pa2, pa3); SBAR();
    pv_tile<0>(o, vb0, pa0, pa1, pa2, pa3);
    if (even) { MASKT(pB0, pB1, NT - 1); partialSM(pB0, pB1, m_reg, mnB, alB); __syncthreads(); RESC(alB);
        finishSM(pB0, pB1, alB, l_reg, pa0, pa1, pa2, pa3); SBAR(); pv_tile<1>(o, vb0, pa0, pa1, pa2, pa3); }
    SBAR(); SEAM_K0();
    if (hi == 0) li_l[r32] = l_reg; asm volatile("s_waitcnt lgkmcnt(0)" ::: "memory");
    float rli[16];
#pragma unroll
    for (int r = 0; r < 16; ++r) rli[r] = __builtin_amdgcn_rcpf(li_l[crow(r, hi)]);
    if (wid * QBLK < cur.nrows) {
        bf16_t* Ow = cur.O + (size_t)(wid * QBLK) * cur.ldo;
#pragma unroll
        for (int r = 0; r < 16; ++r) { const int orow = crow(r, hi);
#pragma unroll
            for (int d0 = 0; d0 < 4; ++d0) { const float v = o[d0][r] * rli[r]; const float vn = __shfl_xor(v, 1);
                if ((r32 & 1) == 0) *(unsigned*)(Ow + (size_t)orow * cur.ldo + d0 * 32 + r32) = cvtpk(v, vn); } }
    }
    __syncthreads();
#undef RESC
#undef MASKT
#undef SEAM_K0
#undef HALF_STEP
}

__device__ __forceinline__ void sb_block(const Blk& b, char* lds, int g_wave) {
    const int tid = opaque_tid();
    const int wid = __builtin_amdgcn_readfirstlane(tid >> 6), lane = tid & 63, r32 = lane & 31, hi = lane >> 5;
    char* V_lds = lds; char* K_lds = lds + 2 * SHM_V; int* flags = (int*)(lds + 2 * SHM_V + 2 * SHM_K);
    const int sr = tid >> 4, sc = (tid & 15) * 8, vst0 = v_st(sr, sc), vst1 = v_st(32 + sr, sc), kws = KSWZ(sr, sc * 2);
    const int vb0 = (int)(uintptr_t)V_lds + v_rd_base(lane);
    bf16x8 qr[8];
    { const bf16_t* qp = QROWP(b);
#pragma unroll
      for (int d0 = 0; d0 < 8; ++d0) qr[d0] = load8(qp + d0 * 16); }
    const int NT = blk_jhi(b), qlo = b.P0 + wid * QBLK, pos = qlo + r32;
    bool wdead = wid * QBLK >= b.nrows;
    float prun = 1.f; f32x16 o[4] = {};
    constexpr float C2 = 1.4426950408889634f * SCALE;
    for (int t = NT - 1; t >= 0; --t) {
        const int kb = t * KVBLK;
        const bf16x8 k0 = load8(ROWK(b.K, b.ldkv, kb, sr)), k1 = load8(ROWK(b.K, b.ldkv, kb, 32 + sr)), v0 = load8(ROWK(b.V, b.ldkv, kb, sr)), v1 = load8(ROWK(b.V, b.ldkv, kb, 32 + sr));
        __syncthreads();
        *(bf16x8*)(K_lds + kws) = k0; *(bf16x8*)(K_lds + kws + 32 * 256) = k1; *(bf16x8*)(V_lds + vst0) = v0; *(bf16x8*)(V_lds + vst1) = v1;
        __syncthreads();
        if (!wdead && kb < qlo + QBLK - 1) {
            f32x16 p0, p1; qkt<0, false>(p0, p1, K_lds, r32, hi, qr, nullptr);
            if (kb + KVBLK - 1 >= qlo) {
                const float NEG = -__builtin_inff();
#pragma unroll
                for (int r = 0; r < 16; ++r) { const int key = kb + crow(r, hi); if (key >= pos) p0[r] = NEG; if (key + 32 >= pos) p1[r] = NEG; }
            }
#pragma unroll
            for (int r = 0; r < 16; ++r) {
                p0[r] = __builtin_amdgcn_rcpf(1.f + __builtin_amdgcn_exp2f(fminf(p0[r] * C2, 60.f))); p1[r] = __builtin_amdgcn_rcpf(1.f + __builtin_amdgcn_exp2f(fminf(p1[r] * C2, 60.f))); }
            float gl[8], gu[8];
#pragma unroll
            for (int g = 0; g < 8; ++g) { const float gp = g < 4 ? (p0[4 * g] * p0[4 * g + 1]) * (p0[4 * g + 2] * p0[4 * g + 3]) : (p1[4 * g - 16] * p1[4 * g - 15]) * (p1[4 * g - 14] * p1[4 * g - 13]);
                auto x = __builtin_amdgcn_permlane32_swap(__float_as_uint(gp), __float_as_uint(gp), false, false); gl[g] = __uint_as_float(x[0]); gu[g] = __uint_as_float(x[1]); }
            float s = 1.f, sown[8];
#pragma unroll
            for (int g = 7; g >= 0; --g) { const float su = s; s *= gu[g]; const float sl = s; s *= gl[g]; sown[g] = hi ? su : sl; }
#define SB_EL(P, q) do { const float rr_ = P[q]; P[q] = (1.f - rr_) * tt; tt *= rr_; } while (0)
#pragma unroll
            for (int g = 0; g < 8; ++g) { float tt = sown[g] * prun;
                if (g < 4) { const int q = 4 * g; SB_EL(p0, q + 3); SB_EL(p0, q + 2); SB_EL(p0, q + 1); SB_EL(p0, q); }
                else { const int q = 4 * g - 16; SB_EL(p1, q + 3); SB_EL(p1, q + 2); SB_EL(p1, q + 1); SB_EL(p1, q); } }
#undef SB_EL
            prun *= s;
            bf16x8 pa0, pa1, pa2, pa3;
            PK4(p0, 0, pa0); PK4(p0, 8, pa1); PK4(p1, 0, pa2); PK4(p1, 8, pa3);
            pv_tile<0>(o, vb0, pa0, pa1, pa2, pa3);
            wdead = __all(prun < 8.67e-19f);
        }
        if (lane == 0) flags[wid] = wdead ? 1 : 0;
        __syncthreads();
        const int alld = flags[0] & flags[1] & flags[2] & flags[3] & flags[4] & flags[5] & flags[6] & flags[7];
        if (alld) break;
    }
    if (wid * QBLK < b.nrows) {
        bf16_t* Ow = b.O + (size_t)(wid * QBLK) * b.ldo;
#pragma unroll
        for (int r = 0; r < 16; ++r) { const int orow = crow(r, hi);
#pragma unroll
            for (int d0 = 0; d0 < 4; ++d0) { const float v = o[d0][r]; const float vn = __shfl_xor(v, 1);
                if ((r32 & 1) == 0) *(unsigned*)(Ow + (size_t)orow * b.ldo + d0 * 32 + r32) = cvtpk(v, vn); } }
    }
    __syncthreads();
}
#undef ROWK
#undef VMW
#undef VMWN
#undef SLOAD_H
#undef SWRITE_HK
#undef SWRITE_HV
#undef SWRITE_H
#undef QROWP
#undef PK4
#undef KSWZ
#undef KBASE
}

namespace gla {
constexpr int ZQ = 0, ZK = GKW, ZV = 2 * GKW, ZR = 2 * GKW + GVW, ZG = 5120;
constexpr int KP = 72, QP = 200;
constexpr int L_G = 0;
constexpr int L_GLOW = 49152;
constexpr int L_TOT = 53248;
constexpr int L_QP = 54272;
constexpr int L_KPB = L_QP + 64 * QP * 2;
constexpr int L_AB = L_KPB + 64 * QP * 2;
constexpr int L_VT = L_AB + 64 * KP * 2;
constexpr int L_RS = L_VT + 128 * KP * 2;
constexpr int L_ST = 0;
constexpr int L1_KD = 54272;
constexpr int L1_VT = L1_KD + 192 * KP * 2;
static_assert(L_RS + 1024 <= LDS_WORK && L1_VT + 384 * KP * 2 <= LDS_WORK, "GLA LDS map");

__device__ __forceinline__ int chunk_row0(int c) { return c < TP / 64 ? c * 64 : TP + (c - TP / 64) * 64; }

__device__ __forceinline__ void decay_scan(const bf16_t* z, const float* wg2, const float* bg, int row0, int h, char* lds, int tid) {
    float* G = (float*)(lds + L_G); float* glow = (float*)(lds + L_GLOW); float* tot = (float*)(lds + L_TOT);
    for (int i = tid; i < 64 * 16; i += 512) glow[i] = bf2f(z[(size_t)(row0 + (i >> 4)) * ZLD + ZG + (i & 15)]);
    __syncthreads();
    if (tid < 384) {
        const int k = tid % 192, half = tid / 192; float w[16];
#pragma unroll
        for (int j = 0; j < 16; ++j) w[j] = wg2[(size_t)j * GKW + h * GDK + k];
        const float b = bg[h * GDK + k]; float g = 0.f;
        for (int s = half * 32; s < half * 32 + 32; ++s) { float a = b;
#pragma unroll
            for (int j = 0; j < 16; ++j) a += glow[s * 16 + j] * w[j];
            g += log_sigmoidf(a) * (1.0f / 16.0f); G[s * GDK + k] = g; }
        if (half == 0) tot[k] = g;
    }
    __syncthreads();
}

__device__ __forceinline__ void g1_unit(int c, int h, const bf16_t* z, const float* wg2, const float* bg, float* UT, float* DEC, char* lds, int g_wave) {
    const int tid = opaque_tid(); const int row0 = chunk_row0(c);
    decay_scan(z, wg2, bg, row0, h, lds, tid);
    const float* G = (const float*)(lds + L_G); const float* tot = (const float*)(lds + L_TOT);
    bf16_t* KD = (bf16_t*)(lds + L1_KD); bf16_t* VT = (bf16_t*)(lds + L1_VT);
    for (int it = tid; it < 192 * 8; it += 512) {
        const int k = it % 192, sb = it / 192; const float t0 = tot[k], glast = G[63 * GDK + k] + t0; float v[8];
#pragma unroll
        for (int i = 0; i < 8; ++i) { const int s = sb * 8 + i; const float g = G[s * GDK + k] + (s >= 32 ? t0 : 0.f);
            v[i] = bf2f(z[(size_t)(row0 + s) * ZLD + ZK + h * GDK + k]) * __expf(glast - g); }
        u32x4 w = {cvtpk(v[0], v[1]), cvtpk(v[2], v[3]), cvtpk(v[4], v[5]), cvtpk(v[6], v[7])};
        *(u32x4*)(KD + k * KP + sb * 8) = w;
        if (sb == 0) DEC[(size_t)(c * GH + h) * GDK + k] = __expf(glast);
    }
    for (int it = tid; it < 64 * 48; it += 512) {
        const int s = it & 63, vb = it >> 6; const u32x4 w = *(const u32x4*)(z + (size_t)(row0 + s) * ZLD + ZV + h * GDV + vb * 8);
#pragma unroll
        for (int i = 0; i < 4; ++i) { VT[(vb * 8 + 2 * i) * KP + s] = (bf16_t)(w[i] & 0xffffu); VT[(vb * 8 + 2 * i + 1) * KP + s] = (bf16_t)(w[i] >> 16); }
    }
    __syncthreads();
    const int wid = tid >> 6, lane = tid & 63, l32 = lane & 31, hi = lane >> 5, mq = wid & 3, nh = wid >> 2;
    f32x16 acc[3][3];
#pragma unroll
    for (int i = 0; i < 3; ++i)
#pragma unroll
        for (int j = 0; j < 3; ++j) acc[i][j] = f32x16{};
#pragma unroll
    for (int ks = 0; ks < 4; ++ks) { bf16x8 a[3], bb[3];
#pragma unroll
        for (int i = 0; i < 3; ++i) { a[i] = *(const bf16x8*)(VT + ((mq * 3 + i) * 32 + l32) * KP + ks * 16 + hi * 8); bb[i] = *(const bf16x8*)(KD + ((nh * 3 + i) * 32 + l32) * KP + ks * 16 + hi * 8); }
#pragma unroll
        for (int i = 0; i < 3; ++i)
#pragma unroll
            for (int j = 0; j < 3; ++j) acc[i][j] = __builtin_amdgcn_mfma_f32_32x32x16_bf16(a[i], bb[j], acc[i][j], 0, 0, 0); }
    float* out = UT + (size_t)(c * GH + h) * GDV * GDK;
#pragma unroll
    for (int i = 0; i < 3; ++i)
#pragma unroll
        for (int j = 0; j < 3; ++j)
#pragma unroll
            for (int r = 0; r < 16; ++r) out[(size_t)((mq * 3 + i) * 32 + att::crow(r, hi)) * GDK + (nh * 3 + j) * 32 + l32] = acc[i][j][r];
    __syncthreads();
}

__device__ __forceinline__ void g2_tile(int tile, float* UT, const float* DEC, const float* s0in, float* outp, float* outs, char* lds, int tid) {
    const int h = tile / 36, vt = (tile % 36) / 3, kt = tile % 3, vi = tid >> 4, kg = tid & 15, v = vt * 32 + vi, k = kt * 64 + kg * 4;
    float* T = (float*)lds;
    const size_t cstride = (size_t)GH * GDV * GDK; float* up = UT + ((size_t)h * GDV + v) * GDK + k; const float* dp = DEC + h * GDK + k;
    float zz = 0.f; asm volatile("" : "+v"(zz)); f32x4 S = {zz, zz, zz, zz};
    for (int c0 = 0; c0 < TP / 64; c0 += 8) { f32x4 u[8], d[8];
#pragma unroll
        for (int i = 0; i < 8; ++i) { u[i] = *(const f32x4*)(up + (size_t)(c0 + i) * cstride); d[i] = *(const f32x4*)(dp + (size_t)(c0 + i) * GH * GDK); }
#pragma unroll
        for (int i = 0; i < 8; ++i) { *(f32x4*)(up + (size_t)(c0 + i) * cstride) = S; S = d[i] * S + u[i]; } }
    const int kr = tid >> 3, v4 = (tid & 7) * 4;
    T[(kg * 4 + 0) * 33 + vi] = S[0]; T[(kg * 4 + 1) * 33 + vi] = S[1]; T[(kg * 4 + 2) * 33 + vi] = S[2]; T[(kg * 4 + 3) * 33 + vi] = S[3];
    __syncthreads();
    { f32x4 o = {T[kr * 33 + v4], T[kr * 33 + v4 + 1], T[kr * 33 + v4 + 2], T[kr * 33 + v4 + 3]}; *(f32x4*)(outp + ((size_t)h * GDK + kt * 64 + kr) * GDV + vt * 32 + v4) = o; }
    __syncthreads();
    for (int b = 0; b < NB; ++b) {
        const int c = TP / 64 + b; const size_t sb = ((size_t)b * GH + h) * GDK * GDV;
        { const f32x4 i4 = *(const f32x4*)(s0in + sb + (size_t)(kt * 64 + kr) * GDV + vt * 32 + v4); T[kr * 33 + v4] = i4[0]; T[kr * 33 + v4 + 1] = i4[1]; T[kr * 33 + v4 + 2] = i4[2]; T[kr * 33 + v4 + 3] = i4[3]; }
        __syncthreads();
        f32x4 s0 = {T[(kg * 4 + 0) * 33 + vi], T[(kg * 4 + 1) * 33 + vi], T[(kg * 4 + 2) * 33 + vi], T[(kg * 4 + 3) * 33 + vi]};
        const f32x4 u = *(const f32x4*)(up + (size_t)c * cstride), d = *(const f32x4*)(dp + (size_t)c * GH * GDK);
        *(f32x4*)(up + (size_t)c * cstride) = s0; const f32x4 sn = d * s0 + u;
        __syncthreads();
        T[(kg * 4 + 0) * 33 + vi] = sn[0]; T[(kg * 4 + 1) * 33 + vi] = sn[1]; T[(kg * 4 + 2) * 33 + vi] = sn[2]; T[(kg * 4 + 3) * 33 + vi] = sn[3];
        __syncthreads();
        { f32x4 o = {T[kr * 33 + v4], T[kr * 33 + v4 + 1], T[kr * 33 + v4 + 2], T[kr * 33 + v4 + 3]}; *(f32x4*)(outs + sb + (size_t)(kt * 64 + kr) * GDV + vt * 32 + v4) = o; }
        __syncthreads();
    }
}

__device__ __forceinline__ void g3_unit(int c, int h, const bf16_t* z, const float* wg2, const float* bg, const float* UT, const float* ng, const float* br, bf16_t* oc, char* lds, int g_wave) {
    const int tid = opaque_tid(); const int row0 = chunk_row0(c);
    decay_scan(z, wg2, bg, row0, h, lds, tid);
    const float* G = (const float*)(lds + L_G); const float* tot = (const float*)(lds + L_TOT);
    bf16_t* Qp = (bf16_t*)(lds + L_QP); bf16_t* Kp = (bf16_t*)(lds + L_KPB); bf16_t* Ab = (bf16_t*)(lds + L_AB); bf16_t* VT = (bf16_t*)(lds + L_VT); bf16_t* ST = (bf16_t*)(lds + L_ST);
    float* RS = (float*)(lds + L_RS);
    const float qs = 0.07216878364870322f;
    for (int it = tid; it < 64 * 24; it += 512) {
        const int s = it / 24, kb = (it % 24) * 8; float g[8];
#pragma unroll
        for (int i = 0; i < 8; ++i) g[i] = G[s * GDK + kb + i] + (s >= 32 ? tot[kb + i] : 0.f);
        const u32x4 qw = *(const u32x4*)(z + (size_t)(row0 + s) * ZLD + ZQ + h * GDK + kb), kw = *(const u32x4*)(z + (size_t)(row0 + s) * ZLD + ZK + h * GDK + kb);
        u32x4 qo, ko;
#pragma unroll
        for (int i = 0; i < 4; ++i) { const float e0 = __expf(g[2 * i]), e1 = __expf(g[2 * i + 1]);
            qo[i] = cvtpk(__uint_as_float(qw[i] << 16) * qs * e0, __uint_as_float(qw[i] & 0xffff0000u) * qs * e1);
            ko[i] = cvtpk(__uint_as_float(kw[i] << 16) * __builtin_amdgcn_rcpf(e0), __uint_as_float(kw[i] & 0xffff0000u) * __builtin_amdgcn_rcpf(e1)); }
        *(u32x4*)(Qp + s * QP + kb) = qo; *(u32x4*)(Kp + s * QP + kb) = ko;
    }
    __syncthreads();
    const int wid = tid >> 6, lane = tid & 63, l32 = lane & 31, hi = lane >> 5;
    if (wid < 4) {
        const int mt = wid & 1, nt = wid >> 1; f32x16 a = f32x16{};
        if (nt <= mt) {
#pragma unroll
            for (int ks = 0; ks < 12; ++ks) { const bf16x8 x = *(const bf16x8*)(Qp + (mt * 32 + l32) * QP + ks * 16 + hi * 8), y = *(const bf16x8*)(Kp + (nt * 32 + l32) * QP + ks * 16 + hi * 8);
                a = __builtin_amdgcn_mfma_f32_32x32x16_bf16(x, y, a, 0, 0, 0); }
        }
#pragma unroll
        for (int r = 0; r < 16; ++r) { const int t = mt * 32 + att::crow(r, hi), s = nt * 32 + l32; const float v = (s <= t) ? a[r] : 0.f; Ab[t * KP + s] = (bf16_t)(cvtpk(v, 0.f) & 0xffffu); }
    }
    __syncthreads();
    const int mt = wid & 1, nt = wid >> 1;
    f32x16 oacc[3];
    const float* Sb = UT + (size_t)(c * GH + h) * GDV * GDK;
#pragma unroll
    for (int vs = 0; vs < 3; ++vs) {
        for (int it = tid; it < 128 * 24; it += 512) { const int v = it / 24, kb = (it % 24) * 8; const float* p = Sb + (size_t)(vs * 128 + v) * GDK + kb;
            *(u32x4*)(ST + v * QP + kb) = pack8u(*(const f32x4*)p, *(const f32x4*)(p + 4)); }
        for (int it = tid; it < 64 * 16; it += 512) { const int s = it & 63, vb = it >> 6; const u32x4 w = *(const u32x4*)(z + (size_t)(row0 + s) * ZLD + ZV + h * GDV + vs * 128 + vb * 8);
#pragma unroll
            for (int i = 0; i < 4; ++i) { VT[(vb * 8 + 2 * i) * KP + s] = (bf16_t)(w[i] & 0xffffu); VT[(vb * 8 + 2 * i + 1) * KP + s] = (bf16_t)(w[i] >> 16); } }
        __syncthreads();
        f32x16 a = f32x16{};
#pragma unroll
        for (int ks = 0; ks < 12; ++ks) { const bf16x8 x = *(const bf16x8*)(Qp + (mt * 32 + l32) * QP + ks * 16 + hi * 8), y = *(const bf16x8*)(ST + (nt * 32 + l32) * QP + ks * 16 + hi * 8);
            a = __builtin_amdgcn_mfma_f32_32x32x16_bf16(x, y, a, 0, 0, 0); }
#pragma unroll
        for (int ks = 0; ks < 4; ++ks) { const bf16x8 x = *(const bf16x8*)(Ab + (mt * 32 + l32) * KP + ks * 16 + hi * 8), y = *(const bf16x8*)(VT + (nt * 32 + l32) * KP + ks * 16 + hi * 8);
            a = __builtin_amdgcn_mfma_f32_32x32x16_bf16(x, y, a, 0, 0, 0); }
        oacc[vs] = a;
        __syncthreads();
    }
#pragma unroll
    for (int r = 0; r < 16; ++r) { float q = oacc[0][r] * oacc[0][r] + oacc[1][r] * oacc[1][r] + oacc[2][r] * oacc[2][r];
        q += __shfl_xor(q, 1); q += __shfl_xor(q, 2); q += __shfl_xor(q, 4); q += __shfl_xor(q, 8); q += __shfl_xor(q, 16);
        if (l32 == 0) RS[(mt * 32 + att::crow(r, hi)) * 4 + nt] = q; }
    __syncthreads();
#pragma unroll
    for (int r = 0; r < 16; ++r) { const int t = mt * 32 + att::crow(r, hi); const f32x4 q4 = *(const f32x4*)(RS + t * 4);
        const float rstd = rsqrtf(((q4[0] + q4[1]) + (q4[2] + q4[3])) * (1.0f / GDV) + RMS_EPS);
#pragma unroll
        for (int vs = 0; vs < 3; ++vs) { const int cv = h * GDV + vs * 128 + nt * 32 + l32;
            const float gate = bf2f(z[(size_t)(row0 + t) * ZLD + ZR + cv]) + br[cv]; const float sg = gate / (1.f + __expf(-gate));
            const float val = oacc[vs][r] * rstd * ng[cv] * sg; const float vn = __shfl_xor(val, 1);
            if ((l32 & 1) == 0) *(unsigned*)(oc + (size_t)(row0 + t) * DM + cv) = cvtpk(val, vn); } }
    __syncthreads();
}
}

__device__ __forceinline__ int in_rowmap(int kind, int c) {
    if (kind == 0) return c < 4608 ? c : (c < 4620 ? 5120 + (c - 4608) : 4608 + (c - 4620));
    if (kind == 2) return c < 4608 ? c : (c < 4624 ? 5120 + (c - 4608) : 4608 + (c - 4624));
    return c;
}
__device__ __forceinline__ void tr_item(const float* W, int K, int N, bf16_t* WT, int kind, const float* gain, float* scr, int item, int lane) {
    const int nblk = (N + 31) >> 5, kb = item / nblk, nb = item - kb * nblk, k0 = 64 * kb, n0 = 32 * nb;
    const int nn = n0 + (lane & 31); const bool ok = nn < N;
    const float* src = W + (size_t)(k0 + (lane >> 5)) * N + (ok ? nn : 0);
    float v[32];
#pragma unroll
    for (int i = 0; i < 32; ++i) v[i] = src[(size_t)(2 * i) * N];
    if (gain) {
#pragma unroll
        for (int i = 0; i < 32; ++i) v[i] *= gain[k0 + 2 * i + (lane >> 5)];
    }
#pragma unroll
    for (int i = 0; i < 32; ++i) scr[(2 * i + (lane >> 5)) * 33 + (lane & 31)] = ok ? v[i] : 0.f;
    LDS_WAIT(); asm volatile("" ::: "memory");
    const int c = lane & 7;
#pragma unroll
    for (int j = 0; j < 4; ++j) { const int n = (lane >> 3) + 8 * j; const float* s = scr + (8 * c) * 33 + n;
        if (n0 + n < N) { u32x4 o; o[0] = cvtpk(s[0 * 33], s[1 * 33]); o[1] = cvtpk(s[2 * 33], s[3 * 33]); o[2] = cvtpk(s[4 * 33], s[5 * 33]); o[3] = cvtpk(s[6 * 33], s[7 * 33]);
            *(u32x4*)(WT + (size_t)in_rowmap(kind, n0 + n) * K + k0 + 8 * c) = o; } }
    LDS_WAIT(); asm volatile("" ::: "memory");
}
template <int NF4>
__device__ __forceinline__ void cvt_row2(const float* s0, bf16_t* d0, const float* s1, bf16_t* d1, int lane) {
    f32x4 a[NF4], b[NF4];
#pragma unroll
    for (int q = 0; q < NF4; ++q) { a[q] = *(const f32x4*)(s0 + q * 256 + lane * 4); b[q] = *(const f32x4*)(s1 + q * 256 + lane * 4); }
#pragma unroll
    for (int q = 0; q < NF4; ++q) { u32x2 w = {cvtpk(a[q][0], a[q][1]), cvtpk(a[q][2], a[q][3])}; *(u32x2*)(d0 + q * 256 + lane * 4) = w;
        u32x2 x = {cvtpk(b[q][0], b[q][1]), cvtpk(b[q][2], b[q][3])}; *(u32x2*)(d1 + q * 256 + lane * 4) = x; }
}

#ifndef EN_MASK
#define EN_MASK 0xFFFF
#endif
#define EN(k) ((EN_MASK >> (k)) & 1)
struct Args { const float* in[29]; float* out; unsigned char* ws; int ph_lo, ph_hi; };
constexpr int PH_FINAL = 1 + 7 * NLAYER, PH_END = PH_FINAL + 1;
constexpr int PT_OFF = MISC_OFF + 256;
__device__ __forceinline__ unsigned long long ptab_raw(const char* lds, int k) {
    const unsigned long long v = ((const unsigned long long*)(lds + PT_OFF))[k];
    const unsigned l = __builtin_amdgcn_readfirstlane((unsigned)v), h = __builtin_amdgcn_readfirstlane((unsigned)(v >> 32));
    return ((unsigned long long)h << 32) | l;
}
#define PIN(k) ((const float*)(const GAS float*)ptab_raw(lds, (k)))
#define POUT() ((float*)(GAS float*)ptab_raw(lds, 29))
#define PWS() ((unsigned char*)(GAS unsigned char*)ptab_raw(lds, 30))

__global__ void __launch_bounds__(512, 2) trunk_fwd(Args args) {
    extern __shared__ __attribute__((aligned(16))) unsigned char lds_raw[];
    char* lds = (char*)lds_raw;
    volatile LAS unsigned* MISC = (volatile LAS unsigned*)((LAS unsigned char*)lds_raw + MISC_OFF);
    for (int u = threadIdx.x; u < 64; u += 512) MISC[u] = 0u;
    if (threadIdx.x < 29) ((unsigned long long*)(lds + PT_OFF))[threadIdx.x] = (unsigned long long)args.in[threadIdx.x];
    if (threadIdx.x == 29) ((unsigned long long*)(lds + PT_OFF))[29] = (unsigned long long)args.out;
    if (threadIdx.x == 30) ((unsigned long long*)(lds + PT_OFF))[30] = (unsigned long long)args.ws;
    const int g_wave = __builtin_amdgcn_readfirstlane(threadIdx.x >> 6);
    __syncthreads();
    const int G = gridDim.x, bx = blockIdx.x, vcu = (G % 8 == 0) ? (bx % 8) * (G / 8) + bx / 8 : bx;
#if !MK_PER_PHASE
    const XcdBarrier bar = xcd_barrier_post((unsigned*)(args.ws + WS_CTL) + CW_BAR, MISC + 8);
#define GRID_BAR() xcd_barrier(bar)
#else
#define GRID_BAR() do { } while (0)
#endif
    const int lo = args.ph_lo, hi = args.ph_hi;
#define IN(k) (lo <= (k) && (k) < hi)
#define SEAM(k) do { if ((k) + 1 < hi) GRID_BAR(); } while (0)
#define WSP(T, off) ((T*)(ws + (off)))

    if (EN(0) && IN(0)) {
        unsigned char* ws = PWS();
        const int tid = opaque_tid(), lane = tid & 63, wave = tid >> 6, gw = vcu * 8 + wave, NGW = G * 8;
        float* scr = (float*)(lds + wave * 16384);
        for (int L = 0; L < NLAYER; ++L) {
            const int kind = L % 3, j = L / 3;
            const float* win = kind == 0 ? PIN(16) + (size_t)j * DM * 5132 : (kind == 1 ? PIN(19) : PIN(21)); const int nin = kind == 0 ? 5132 : (kind == 1 ? 5120 : 5136);
            const float* wout = kind == 0 ? PIN(18) + (size_t)j * DM * DM : (kind == 1 ? PIN(20) : PIN(26));
            for (int it = gw; it < 32 * ((nin + 31) / 32); it += NGW) tr_item(win, DM, nin, WSP(bf16_t, WS_WIN) + (size_t)L * ZLD * DM, kind, PIN(11) + L * DM, scr, it, lane);
            for (int it = gw; it < 32 * 64; it += NGW) tr_item(wout, DM, DM, WSP(bf16_t, WS_WOUT) + (size_t)L * DM * DM, 1, nullptr, scr, it, lane);
            for (int it = gw; it < 32 * 256; it += NGW) tr_item(PIN(27) + (size_t)L * DM * DFF, DM, DFF, WSP(bf16_t, WS_WUP) + (size_t)L * DFF * DM, 1, PIN(12) + L * DM, scr, it, lane);
            for (int it = gw; it < 128 * 64; it += NGW) tr_item(PIN(28) + (size_t)L * DFF * DM, DFF, DM, WSP(bf16_t, WS_WDN) + (size_t)L * DM * DFF, 1, nullptr, scr, it, lane);
            for (int it = gw; it < 32 * 32; it += NGW) tr_item(PIN(15) + (size_t)L * DM * 1024, DM, 1024, WSP(bf16_t, WS_WMKV) + (size_t)L * 1024 * DM, 1, nullptr, scr, it, lane);
        }
        { const float* xp = PIN(0); const float* xs = PIN(1); float* X = WSP(float, WS_X); bf16_t* XB = WSP(bf16_t, WS_XB); float* RSA = WSP(float, WS_RSS);
        for (int m = gw; m < MT; m += NGW) {
            const float* src = m < TP ? xp + (size_t)m * DM : xs + (size_t)(m - TP) * DM; float ss = 0.f;
#pragma unroll
            for (int q = 0; q < 8; ++q) { const int o = q * 256 + lane * 4; const f32x4 v = *(const f32x4*)(src + o); *(f32x4*)(X + (size_t)m * DM + o) = v;
                u32x2 w = {cvtpk(v[0], v[1]), cvtpk(v[2], v[3])}; *(u32x2*)(XB + (size_t)m * DM + o) = w; ss += (v[0] * v[0] + v[1] * v[1]) + (v[2] * v[2] + v[3] * v[3]); }
            ss = wave_sum(ss);
            if (lane < 32) RSA[(size_t)m * 32 + lane] = lane == 0 ? ss : 0.f;
        } }
        { const float* mp = PIN(10); const float* gm = PIN(13); bf16_t* MEMH = WSP(bf16_t, WS_MEMH);
        for (int it = gw; it < NLAYER * NMEM; it += NGW) { const int i = it / NMEM, r = it % NMEM; const float* src = mp + (size_t)r * DM; const float* g = gm + (size_t)i * DM;
            f32x4 v[8]; float ss = 0.f;
#pragma unroll
            for (int q = 0; q < 8; ++q) { v[q] = *(const f32x4*)(src + q * 256 + lane * 4); ss += (v[q][0] * v[q][0] + v[q][1] * v[q][1]) + (v[q][2] * v[q][2] + v[q][3] * v[q][3]); }
            const float rstd = rsqrtf(wave_sum(ss) * (1.0f / DM) + RMS_EPS);
#pragma unroll
            for (int q = 0; q < 8; ++q) { const f32x4 gg = *(const f32x4*)(g + q * 256 + lane * 4); u32x2 w = {cvtpk(v[q][0] * rstd * gg[0], v[q][1] * rstd * gg[1]), cvtpk(v[q][2] * rstd * gg[2], v[q][3] * rstd * gg[3])};
                *(u32x2*)(MEMH + ((size_t)i * NMEM + r) * DM + q * 256 + lane * 4) = w; } } }
        { const float* ck = PIN(2); const float* cv = PIN(3); bf16_t* KVF = WSP(bf16_t, WS_KVF);
        for (int it = gw; it < 2 * NB * PAST; it += NGW) { const int jj = it / (NB * PAST), r = it % (NB * PAST); const size_t so = ((size_t)jj * NB * PAST + r) * AW, dof = ((size_t)(r / PAST) * SKS + (r % PAST)) * AW;
            cvt_row2<6>(ck + so, KVF + (size_t)(2 * jj) * (KVS_ONE / 2) + dof, cv + so, KVF + (size_t)(2 * jj + 1) * (KVS_ONE / 2) + dof, lane); } }
        { const float* ck = PIN(5); const float* cv = PIN(6); bf16_t* KVS = WSP(bf16_t, WS_KVS);
        for (int r = gw; r < NB * PAST; r += NGW) { const size_t so = (size_t)r * AW, dof = ((size_t)(r / PAST) * SKS + (r % PAST)) * AW;
            cvt_row2<6>(ck + so, KVS + dof, cv + so, KVS + KVS_ONE / 2 + dof, lane); } }
        { const float* ck = PIN(8); const float* cv = PIN(9); bf16_t* MEMC = WSP(bf16_t, WS_MEMC);
        for (int it = gw; it < NLAYER * NB * NMEM; it += NGW) { const int L = it / (NB * NMEM), r = it % (NB * NMEM); const size_t so = ((size_t)L * NB * NMEM + r) * MEMW, dof = (size_t)r * MEMW;
            cvt_row2<2>(ck + so, MEMC + (size_t)(2 * L) * (MEMC_ONE / 2) + dof, cv + so, MEMC + (size_t)(2 * L + 1) * (MEMC_ONE / 2) + dof, lane); } }
        SEAM(0);
    }

    for (int L = 0; L < NLAYER; ++L) {
        const int kind = L % 3, j = L / 3, base = 1 + 7 * L;
        if (EN(1) && IN(base + 0)) {
            unsigned char* ws = PWS();
            const int tid = opaque_tid();
            pg8::Sched S; S.nM = MT / 256; S.nN = kind == 1 ? 20 : 21; S.nwg = S.nM * S.nN; S.G = G; S.c = bx; S.nextra = L == 0 ? 16 : 0;
            S.A = (const char*)WSP(bf16_t, WS_XB); S.B = (const char*)(WSP(bf16_t, WS_WIN) + (size_t)L * ZLD * DM); S.tA = (size_t)256 * DM * 2; S.tB = (size_t)256 * DM * 2;
            S.Ae = (const char*)WSP(bf16_t, WS_MEMH); S.Be = (const char*)WSP(bf16_t, WS_WMKV); S.tAe = (size_t)NMEM * DM * 2; S.tBe = (size_t)256 * DM * 2;
            pg8::EpiIn E; E.z = WSP(bf16_t, WS_Z); E.rss = WSP(float, WS_RSS); E.out = POUT(); E.mkvb = WSP(bf16_t, WS_MKVB); E.kind = kind; E.j = j;
            E.kvb = kind == 0 ? WSP(bf16_t, WS_KVF) + (size_t)(2 * j) * (KVS_ONE / 2) : WSP(bf16_t, WS_KVS); E.bfg = PIN(17) + j * NH;
            pg8::gemm_phase<pg8::EpiIn>((LAS unsigned char*)lds_raw, DM, DM, DM, S, E, tid);
            SEAM(base + 0);
        }
        if (IN(base + 1) && kind != 0) {
            unsigned char* ws = PWS();
            if (EN(2) && kind == 1) {
                bf16_t* Z = WSP(bf16_t, WS_Z); bf16_t* OC = WSP(bf16_t, WS_OC); bf16_t* KVS = WSP(bf16_t, WS_KVS);
                for (int n = vcu; n < 480; n += G) { att::Blk b; b.ldq = ZLD; b.ldo = DM; b.bmode = 0; b.lf0 = b.lf1 = nullptr; b.n0 = 0;
                    if (n < 384) { const int h = n / 32, qb = n % 32; b.Q = Z + (size_t)qb * 256 * ZLD + h * HD; b.K = Z + AW + h * HD; b.V = Z + 2 * AW + h * HD; b.ldkv = ZLD;
                        b.O = OC + (size_t)qb * 256 * DM + h * HD; b.P0 = qb * 256; b.skv = TP; b.nrows = 256; }
                    else { const int m = n - 384, bb = m / NH, h = m % NH; b.Q = Z + (size_t)(TP + bb * 64) * ZLD + h * HD; b.K = KVS + (size_t)bb * SKS * AW + h * HD; b.V = KVS + KVS_ONE / 2 + (size_t)bb * SKS * AW + h * HD; b.ldkv = AW;
                        b.O = OC + (size_t)(TP + bb * 64) * DM + h * HD; b.P0 = PAST; b.skv = SKS; b.nrows = 64; }
                    att::sb_block(b, lds, g_wave); }
            } else if (EN(3) && kind == 2) {
                for (int u = vcu; u < NCHUNK * GH; u += G) gla::g1_unit(u / GH, u % GH, WSP(bf16_t, WS_Z), PIN(22), PIN(23), WSP(float, WS_GU), WSP(float, WS_GDEC), lds, g_wave);
            }
            SEAM(base + 1);
        }
        if (EN(4) && IN(base + 2) && kind == 2) {
            unsigned char* ws = PWS();
            const int tid = opaque_tid();
            if (vcu < 144) gla::g2_tile(vcu, WSP(float, WS_GU), WSP(float, WS_GDEC), PIN(7), POUT() + O_GSP, POUT() + O_GSS, lds, tid);
            SEAM(base + 2);
        }
        if (IN(base + 3)) {
            unsigned char* ws = PWS();
            if (EN(5) && kind == 2) for (int u = vcu; u < NCHUNK * GH; u += G) gla::g3_unit(u / GH, u % GH, WSP(bf16_t, WS_Z), PIN(22), PIN(23), WSP(float, WS_GU), PIN(25), PIN(24), WSP(bf16_t, WS_OC), lds, g_wave);
            const float* outp = POUT(); const float* lfc = PIN(4);
            auto get = [&](int i, att::Blk& b) -> bool {
                int type, a0, a1;
                if (kind == 0) {
                    if (vcu < 192) { if (i > 1) return false; type = 0; a0 = vcu / 16; a1 = i == 0 ? vcu % 16 : 31 - vcu % 16; }
                    else { if (i > 3) return false; const int s = (vcu - 192) + 64 * i; if (s < 96) { type = 1; a0 = s / NH; a1 = s % NH; } else if (s < 224) { type = 2; a0 = (s - 96) / 32; a1 = (s - 96) % 32; } else { type = 3; a0 = (s - 224) / MH; a1 = (s - 224) % MH; } }
                } else { const int n = vcu + G * i; if (n >= 160) return false; if (n < 128) { type = 2; a0 = n / 32; a1 = n % 32; } else { type = 3; a0 = (n - 128) / MH; a1 = (n - 128) % MH; } }
                bf16_t* Z = WSP(bf16_t, WS_Z); bf16_t* OC = WSP(bf16_t, WS_OC);
                b.ldq = ZLD; b.ldo = DM; b.lf0 = b.lf1 = nullptr; b.n0 = 0; b.bmode = 0;
                if (type == 0) { const int h = a0, qb = a1; b.Q = Z + (size_t)qb * 256 * ZLD + h * HD; b.K = Z + AW + h * HD; b.V = Z + 2 * AW + h * HD; b.ldkv = ZLD; b.O = OC + (size_t)qb * 256 * DM + h * HD;
                    b.P0 = qb * 256; b.skv = TP; b.nrows = 256; b.bmode = 1; b.lf0 = outp + O_FLP + (size_t)j * TP * NH + h; b.n0 = 1 << 30; }
                else if (type == 1) { const int bb = a0, h = a1; const bf16_t* fk = WSP(bf16_t, WS_KVF) + (size_t)(2 * j) * (KVS_ONE / 2);
                    b.Q = Z + (size_t)(TP + bb * 64) * ZLD + h * HD; b.K = fk + (size_t)bb * SKS * AW + h * HD; b.V = fk + KVS_ONE / 2 + (size_t)bb * SKS * AW + h * HD; b.ldkv = AW;
                    b.O = OC + (size_t)(TP + bb * 64) * DM + h * HD; b.P0 = PAST; b.skv = SKS; b.nrows = 64; b.bmode = 1; b.lf0 = lfc + ((size_t)j * NB + bb) * PAST * NH + h; b.n0 = PAST; b.lf1 = outp + O_FLS + (size_t)j * TS * NH + (size_t)bb * 64 * NH + h; }
                else if (type == 2) { const int h4 = a0, qb = a1; const bf16_t* mkb = WSP(bf16_t, WS_MKVB) + (size_t)L * NMEM * 1024;
                    b.Q = Z + (size_t)qb * 256 * ZLD + 4608 + h4 * HD; b.K = mkb + h4 * HD; b.V = mkb + MEMW + h4 * HD; b.ldkv = 1024; b.O = OC + (size_t)qb * 256 * DM + AW + h4 * HD;
                    b.P0 = 1 << 20; b.skv = NMEM; b.nrows = 256; }
                else { const int bb = a0, h4 = a1; const bf16_t* mck = WSP(bf16_t, WS_MEMC) + (size_t)(2 * L) * (MEMC_ONE / 2);
                    b.Q = Z + (size_t)(TP + bb * 64) * ZLD + 4608 + h4 * HD; b.K = mck + (size_t)bb * NMEM * MEMW + h4 * HD; b.V = mck + MEMC_ONE / 2 + (size_t)bb * NMEM * MEMW + h4 * HD; b.ldkv = MEMW;
                    b.O = OC + (size_t)(TP + bb * 64) * DM + AW + h4 * HD; b.P0 = 1 << 20; b.skv = NMEM; b.nrows = 64; }
                return true;
            };
            att::Blk cur, nxt;
            if (EN(6) && get(0, cur)) {
                att::Seam S; att::att_prime(cur, lds, S, g_wave);
                for (int i = 0;; ++i) { const bool more = get(i + 1, nxt); if (!more) nxt = cur;
                    att::prepare_bias(cur, lds, g_wave); att::att_block(cur, nxt, lds, S, g_wave);
                    if (!more) break; cur = nxt; }
            }
            SEAM(base + 3);
        }
        if (EN(7) && IN(base + 4)) {
            unsigned char* ws = PWS();
            const int tid = opaque_tid();
            pg8::Sched S; S.nM = MT / 256; S.nN = DM / 256; S.nwg = S.nM * S.nN; S.G = G; S.c = bx; S.nextra = 0;
            S.A = (const char*)WSP(bf16_t, WS_OC); S.B = (const char*)(WSP(bf16_t, WS_WOUT) + (size_t)L * DM * DM); S.tA = (size_t)256 * DM * 2; S.tB = (size_t)256 * DM * 2; S.Ae = S.Be = nullptr; S.tAe = S.tBe = 0;
            pg8::EpiRes E{WSP(float, WS_X), WSP(bf16_t, WS_XB), WSP(float, WS_RSS) + (size_t)MT * 32};
            pg8::gemm_phase<pg8::EpiRes>((LAS unsigned char*)lds_raw, DM, DM, DM, S, E, tid);
            SEAM(base + 4);
        }
        if (EN(8) && IN(base + 5)) {
            unsigned char* ws = PWS();
            const int tid = opaque_tid();
            pg8::Sched S; S.nM = MT / 256; S.nN = DFF / 256; S.nwg = S.nM * S.nN; S.G = G; S.c = bx; S.nextra = 0;
            S.A = (const char*)WSP(bf16_t, WS_XB); S.B = (const char*)(WSP(bf16_t, WS_WUP) + (size_t)L * DFF * DM); S.tA = (size_t)256 * DM * 2; S.tB = (size_t)256 * DM * 2; S.Ae = S.Be = nullptr; S.tAe = S.tBe = 0;
            pg8::EpiUp E{WSP(bf16_t, WS_U), WSP(float, WS_RSS) + (size_t)MT * 32};
            pg8::gemm_phase<pg8::EpiUp>((LAS unsigned char*)lds_raw, DM, DM, DM, S, E, tid);
            SEAM(base + 5);
        }
        if (EN(9) && IN(base + 6)) {
            unsigned char* ws = PWS();
            const int tid = opaque_tid();
            pg8::Sched S; S.nM = MT / 256; S.nN = DM / 256; S.nwg = S.nM * S.nN; S.G = G; S.c = bx; S.nextra = 0;
            S.A = (const char*)WSP(bf16_t, WS_U); S.B = (const char*)(WSP(bf16_t, WS_WDN) + (size_t)L * DM * DFF); S.tA = (size_t)256 * DFF * 2; S.tB = (size_t)256 * DFF * 2; S.Ae = S.Be = nullptr; S.tAe = S.tBe = 0;
            pg8::EpiRes E{WSP(float, WS_X), WSP(bf16_t, WS_XB), WSP(float, WS_RSS)};
            pg8::gemm_phase<pg8::EpiRes>((LAS unsigned char*)lds_raw, DFF, DFF, DFF, S, E, tid);
            SEAM(base + 6);
        }
    }
    if (EN(10) && IN(PH_FINAL)) {
        unsigned char* ws = PWS(); float* out = POUT();
        const int tid = opaque_tid(), lane = tid & 63, wave = tid >> 6, gw = vcu * 8 + wave, NGW = G * 8;
        const float* g = PIN(14); const float* X = WSP(float, WS_X); const float* RSA = WSP(float, WS_RSS);
        for (int m = gw; m < MT; m += NGW) {
            const float rstd = rsqrtf(wave_sum(lane < 32 ? RSA[(size_t)m * 32 + lane] : 0.f) * (1.0f / DM) + RMS_EPS); float* dst = m < TP ? out + O_YP + (size_t)m * DM : out + O_YS + (size_t)(m - TP) * DM;
#pragma unroll
            for (int q = 0; q < 8; ++q) { const int o = q * 256 + lane * 4; const f32x4 v = *(const f32x4*)(X + (size_t)m * DM + o), gg = *(const f32x4*)(g + o); *(f32x4*)(dst + o) = v * rstd * gg; }
        }
    }
#undef IN
#undef SEAM
#undef GRID_BAR
}

extern "C" void kernel_launch(void* const* d_in, const int* in_sizes, int n_in, void* d_out, int out_size, void* d_ws, size_t ws_size, hipStream_t stream) {
    static int grid = 0;
    if (grid == 0) {
        if (n_in != 29 || (size_t)out_size != O_END || ws_size < WS_END) { fprintf(stderr, "kernel_launch: unexpected shapes (n_in %d, out %d vs %zu, ws %zu vs %zu); nothing launched\n", n_in, out_size, (size_t)O_END, ws_size, (size_t)WS_END); grid = -1; return; }
        int dev = 0, cus = 0, per_cu = 0;
        if (hipGetDevice(&dev) != hipSuccess || hipDeviceGetAttribute(&cus, hipDeviceAttributeMultiprocessorCount, dev) != hipSuccess) { grid = -1; return; }
        if (hipFuncSetAttribute((const void*)trunk_fwd, hipFuncAttributeMaxDynamicSharedMemorySize, LDS_BYTES) != hipSuccess) { fprintf(stderr, "kernel_launch: hipFuncSetAttribute failed\n"); grid = -1; return; }
        if (hipOccupancyMaxActiveBlocksPerMultiprocessor(&per_cu, (const void*)trunk_fwd, 512, LDS_BYTES) != hipSuccess || per_cu < 1) fprintf(stderr, "kernel_launch: occupancy query reports %d workgroups per CU\n", per_cu);
        (void)hipGetLastError();
        grid = cus;
    }
    if (grid < 0) return;
    if (hipMemsetAsync((char*)d_ws + WS_CTL, 0, CTL_BYTES, stream) != hipSuccess) return;
    Args a{};
    for (int i = 0; i < 29; ++i) a.in[i] = (const float*)d_in[i];
    a.out = (float*)d_out; a.ws = (unsigned char*)d_ws;
#if MK_PER_PHASE
    for (int p = 0; p < PH_END; ++p) {
        if (p >= 1 && p < PH_FINAL) { const int L = (p - 1) / 7, q = (p - 1) % 7, kind = L % 3; if ((q == 1 && kind == 0) || (q == 2 && kind != 2)) continue; }
        a.ph_lo = p; a.ph_hi = p + 1;
        hipLaunchKernelGGL(trunk_fwd, dim3(grid), dim3(512), LDS_BYTES, stream, a);
#ifdef PROBE_REPEAT_PHASE
        if (p == PROBE_REPEAT_PHASE) hipLaunchKernelGGL(trunk_fwd, dim3(grid), dim3(512), LDS_BYTES, stream, a);
#endif
    }
#else
    a.ph_lo = 0; a.ph_hi = PH_END;
    hipLaunchKernelGGL(trunk_fwd, dim3(grid), dim3(512), LDS_BYTES, stream, a);
#endif
}
```

```cpp
#include <hip/hip_runtime.h>
#include <hip/hip_bf16.h>
#include <cstdio>
#include <cstdint>

#define MK_PER_PHASE 0
#ifndef MK_PER_PHASE
#define MK_PER_PHASE 0
#endif

constexpr int DM = 2048, TP = 8192, TS = 512, MT = TP + TS, NB = 8, CSEQ = 64, PAST = 1024, SKS = PAST + CSEQ;
constexpr int HD = 128, NH = 12, AW = NH * HD, MEMW = 512, NMEM = 256, MH = 4;
constexpr int GH = 4, GDK = 192, GDV = 384, GKW = GH * GDK, GVW = GH * GDV, GRANK = 16;
constexpr int DFF = 8192, ZLD = 5376, NLAYER = 4;
constexpr int NCHUNK = TP / 64 + NB;
constexpr float RMS_EPS = 1e-6f;

constexpr size_t O_YP = 0;
constexpr size_t O_YS = O_YP + (size_t)TP * DM;
constexpr size_t O_FKP = O_YS + (size_t)TS * DM;
constexpr size_t O_FVP = O_FKP + (size_t)2 * TP * AW;
constexpr size_t O_FLP = O_FVP + (size_t)2 * TP * AW;
constexpr size_t O_SKP = O_FLP + (size_t)2 * TP * NH;
constexpr size_t O_SVP = O_SKP + (size_t)TP * AW;
constexpr size_t O_GSP = O_SVP + (size_t)TP * AW;
constexpr size_t O_MKP = O_GSP + (size_t)GH * GDK * GDV;
constexpr size_t O_MVP = O_MKP + (size_t)NLAYER * NMEM * MEMW;
constexpr size_t O_FKS = O_MVP + (size_t)NLAYER * NMEM * MEMW;
constexpr size_t O_FVS = O_FKS + (size_t)2 * TS * AW;
constexpr size_t O_FLS = O_FVS + (size_t)2 * TS * AW;
constexpr size_t O_SKS = O_FLS + (size_t)2 * TS * NH;
constexpr size_t O_SVS = O_SKS + (size_t)TS * AW;
constexpr size_t O_GSS = O_SVS + (size_t)TS * AW;
constexpr size_t O_END = O_GSS + (size_t)NB * GH * GDK * GDV;

constexpr size_t al256(size_t x) { return (x + 255) & ~(size_t)255; }
constexpr size_t WS_CTL = 0, CTL_BYTES = 2u << 20;
constexpr size_t WS_WIN = CTL_BYTES;
constexpr size_t WS_WOUT = WS_WIN + (size_t)NLAYER * ZLD * DM * 2;
constexpr size_t WS_WUP = WS_WOUT + (size_t)NLAYER * DM * DM * 2;
constexpr size_t WS_WDN = WS_WUP + (size_t)NLAYER * DFF * DM * 2;
constexpr size_t WS_WMKV = WS_WDN + (size_t)NLAYER * DM * DFF * 2;
constexpr size_t WS_X = WS_WMKV + (size_t)NLAYER * 1024 * DM * 2;
constexpr size_t WS_XB = WS_X + (size_t)MT * DM * 4;
constexpr size_t WS_Z = WS_XB + (size_t)MT * DM * 2;
constexpr size_t WS_OC = WS_Z + (size_t)MT * ZLD * 2;
constexpr size_t WS_U = WS_OC + (size_t)MT * DM * 2;
constexpr size_t WS_GU = WS_U + (size_t)MT * DFF * 2;
constexpr size_t WS_GDEC = WS_GU + (size_t)NCHUNK * GH * GDV * GDK * 4;
constexpr size_t WS_KVF = al256(WS_GDEC + (size_t)NCHUNK * GH * GDK * 4);
constexpr size_t KVS_ONE = (size_t)NB * SKS * AW * 2;
constexpr size_t WS_KVS = WS_KVF + 4 * KVS_ONE;
constexpr size_t WS_MEMC = WS_KVS + 2 * KVS_ONE;
constexpr size_t MEMC_ONE = (size_t)NB * NMEM * MEMW * 2;
constexpr size_t WS_MEMH = WS_MEMC + 8 * MEMC_ONE;
constexpr size_t WS_MKVB = WS_MEMH + (size_t)NLAYER * NMEM * DM * 2;
constexpr size_t WS_RSS = WS_MKVB + (size_t)NLAYER * NMEM * 1024 * 2;
constexpr size_t WS_END = WS_RSS + (size_t)2 * MT * 32 * 4;

constexpr int CW_BAR = 4096;

constexpr int LDS_WORK = 136 * 1024;
constexpr int MISC_OFF = LDS_WORK;
constexpr int LDS_BYTES = 147456;

#define GAS __attribute__((address_space(1)))
#define LAS __attribute__((address_space(3)))
typedef unsigned short bf16_t;
typedef unsigned u32x4 __attribute__((ext_vector_type(4)));
typedef unsigned u32x2 __attribute__((ext_vector_type(2)));
typedef float f32x4 __attribute__((ext_vector_type(4)));
typedef float f32x2 __attribute__((ext_vector_type(2)));
typedef float f32x16 __attribute__((ext_vector_type(16)));
typedef short bf16x8 __attribute__((ext_vector_type(8)));
typedef short s16x4 __attribute__((ext_vector_type(4)));
#define LDS_WAIT() asm volatile("s_waitcnt lgkmcnt(0)" ::: "memory")
#define VM_WAIT() asm volatile("s_waitcnt vmcnt(0)" ::: "memory")
#define SBAR() __builtin_amdgcn_sched_barrier(0)
__device__ __forceinline__ unsigned cvtpk(float lo, float hi) { unsigned r; asm volatile("v_cvt_pk_bf16_f32 %0, %1, %2" : "=v"(r) : "v"(lo), "v"(hi)); return r; }
__device__ __forceinline__ float bf2f(unsigned short b) { return __uint_as_float((unsigned)b << 16); }
__device__ __forceinline__ u32x4 pack8u(f32x4 a, f32x4 b) { u32x4 w = {cvtpk(a[0], a[1]), cvtpk(a[2], a[3]), cvtpk(b[0], b[1]), cvtpk(b[2], b[3])}; return w; }
__device__ __forceinline__ bf16x8 pack8(f32x4 a, f32x4 b) { u32x4 w = pack8u(a, b); return *reinterpret_cast<bf16x8*>(&w); }
__device__ __forceinline__ float wave_sum(float v) {
#pragma unroll
    for (int o = 1; o < 64; o <<= 1) v += __shfl_xor(v, o);
    return v;
}
__device__ __forceinline__ float log_sigmoidf(float x) { return fminf(x, 0.f) - log1pf(expf(-fabsf(x))); }
__device__ __forceinline__ int opaque_tid_w(int wave) { int l; asm volatile("v_mbcnt_lo_u32_b32 %0, -1, 0\n\tv_mbcnt_hi_u32_b32 %0, -1, %0" : "=v"(l)); return wave * 64 + l; }
#define opaque_tid() opaque_tid_w(g_wave)
template <class T> __device__ __forceinline__ T* launder_s(T* p) { asm volatile("" : "+s"(p)); return p; }
#define XB_TMO      128
#define XB_XCNT(j)  (256  + 64 * (j))
#define XB_XSUB(j)  (1280 + 64 * (j))
#define XB_XGEN(j)  (2304 + 64 * (j))
#define XB_TOP      3328
#define XB_TOPGEN   3392
#define XCD_BAR_WORDS 3456
#define XB_SPIN_CAP (1u << 18)
__device__ __forceinline__ unsigned xb_ld(unsigned* p)              { return __hip_atomic_load(p, __ATOMIC_RELAXED, __HIP_MEMORY_SCOPE_AGENT); }
__device__ __forceinline__ unsigned xb_add(unsigned* p, unsigned v) { return __hip_atomic_fetch_add(p, v, __ATOMIC_RELAXED, __HIP_MEMORY_SCOPE_AGENT); }
__device__ __forceinline__ unsigned xb_xcc_id() { return (unsigned)__builtin_amdgcn_s_getreg((3 << 11) | 20) & 0xFu; }
#define XB_SPIN(cond, bar) do { unsigned _sp = 0; while (cond) { __builtin_amdgcn_s_sleep(1); \
    if ((++_sp & 255u) == 0u) { if (xb_ld(&(bar)[XB_TMO])) break; if (_sp > XB_SPIN_CAP) { atomicAdd(&(bar)[XB_TMO], 1u); break; } } } } while (0)
struct XcdBarrier { unsigned* bar; unsigned x; volatile LAS unsigned* st; };
__device__ __forceinline__ XcdBarrier xcd_barrier_post(unsigned* bar, volatile LAS unsigned* st) {
    XcdBarrier b; b.bar = bar; b.x = xb_xcc_id(); b.st = st;
    if (threadIdx.x == 0) (void)xb_add(&bar[XB_XCNT(b.x)], 1u);
    return b;
}
__device__ __forceinline__ void xcd_barrier_complete(unsigned* bar, unsigned x, unsigned& nloc, unsigned& nx) {
    const unsigned G = gridDim.x * gridDim.y * gridDim.z;
    unsigned sum, cnt, mine, sp = 0u;
    for (;;) {
        sum = 0u; cnt = 0u; mine = 0u;
#pragma unroll
        for (unsigned j = 0; j < 16; ++j) { const unsigned c = xb_ld(&bar[XB_XCNT(j)]); sum += c; cnt += (c > 0u) ? 1u : 0u; mine = (j == x) ? c : mine; }
        if (sum == G) break;
        __builtin_amdgcn_s_sleep(1);
        if ((++sp & 255u) == 0u) { if (xb_ld(&bar[XB_TMO])) break; if (sp > XB_SPIN_CAP) { atomicAdd(&bar[XB_TMO], 1u); break; } }
    }
    nloc = mine > 0u ? mine : 1u; nx = cnt > 0u ? cnt : 1u;
}
__device__ __forceinline__ void xcd_barrier(const XcdBarrier& b) {
    asm volatile("s_waitcnt vmcnt(0)" ::: "memory");
    __syncthreads();
    if (threadIdx.x == 0) {
        unsigned* bar = b.bar;
        __builtin_amdgcn_s_waitcnt(0);
        unsigned nloc = b.st[0], nx = b.st[1];
        if (nloc == 0u) { xcd_barrier_complete(bar, b.x, nloc, nx); b.st[0] = nloc; b.st[1] = nx; }
        const unsigned old = xb_add(&bar[XB_XSUB(b.x)], 1u);
        const unsigned gen = old / nloc;
        if (old + 1u == (gen + 1u) * nloc) {
            __builtin_amdgcn_fence(__ATOMIC_RELEASE, "agent");
            asm volatile("s_waitcnt vmcnt(0)" ::: "memory");
            const unsigned og = xb_add(&bar[XB_TOP], 1u);
            const unsigned tg = og / nx;
            if (og + 1u == (tg + 1u) * nx) xb_add(&bar[XB_TOPGEN], 1u);
            else XB_SPIN(xb_ld(&bar[XB_TOPGEN]) == tg, bar);
            __builtin_amdgcn_fence(__ATOMIC_ACQUIRE, "agent");
            xb_add(&bar[XB_XGEN(b.x)], 1u);
            asm volatile("s_waitcnt vmcnt(0)" ::: "memory");
        } else {
            XB_SPIN(xb_ld(&bar[XB_XGEN(b.x)]) == gen, bar);
            __builtin_amdgcn_fence(__ATOMIC_ACQUIRE, "agent");
            asm volatile("s_waitcnt vmcnt(0)" ::: "memory");
        }
    }
    __syncthreads();
}

namespace pg8 {
constexpr int BM = 256, BK = 64, HALF = 128, HTB = HALF * BK * 2, STAGE_BYTES = 8 * HTB, NXCD = 8, WGM = 8;
__host__ __device__ __forceinline__ int lds_byte(int r, int c) { const int st = (r >> 4) * 2 + (c >> 5), rr = r & 15, cc = c & 31, ob = rr * 64 + cc * 2; return st * 1024 + (ob ^ (((ob >> 9) & 1) << 5)); }
__host__ __device__ __forceinline__ void stage_rc(int b, int& R, int& C) { const int st = b / 1024, sb = b % 1024, swz = sb ^ (((sb >> 9) & 1) << 5); R = (st >> 1) * 16 + swz / 64; C = (st & 1) * 32 + (swz % 64) / 2; }
__host__ __device__ __forceinline__ int perm32(int rho) { const int n = rho >> 4, i = rho & 15; return 8 * (i >> 2) + 4 * n + (i & 3); }

struct Unit { int pm, pn, g; const char* A; const char* B; };

struct Sched {
    int nM, nN, nwg, G, c, nextra;
    const char* A; const char* B; size_t tA, tB;
    const char* Ae; const char* Be; size_t tAe, tBe;
    __device__ __forceinline__ bool next(int i, Unit& u) const {
        const long L = (long)i * G + c; if (L >= nwg + nextra) return false;
        if (L >= nwg) { const int e = (int)(L - nwg); u.g = 1 + (e >> 2); u.pm = 0; u.pn = e & 3; u.A = Ae + (size_t)(e >> 2) * tAe; u.B = Be + (size_t)e * tBe; return true; }
        int wgid = (int)L; { const int q = nwg / NXCD, r = nwg % NXCD, xcd = wgid % NXCD, off = wgid / NXCD; wgid = (xcd < r ? xcd * (q + 1) : r * (q + 1) + (xcd - r) * q) + off; }
        const int nig = WGM * nN, gid = wgid / nig, fm = gid * WGM, gsz = (nM - fm) < WGM ? (nM - fm) : WGM;
        u.pm = fm + ((wgid % nig) % gsz); u.pn = (wgid % nig) / gsz; u.g = 0; u.A = A + (size_t)u.pm * tA; u.B = B + (size_t)u.pn * tB; return true;
    }
};

__device__ __forceinline__ void row_rstd8(const float* rss, int row0, int fq, float (&rs)[2][4]) {
    f32x4 a[2][4], b[2][4];
#pragma unroll
    for (int ai = 0; ai < 2; ++ai)
#pragma unroll
        for (int m = 0; m < 4; ++m) { const f32x4* p = (const f32x4*)(rss + (size_t)(row0 + ai * HALF + m * 16) * 32 + fq * 8); a[ai][m] = p[0]; b[ai][m] = p[1]; }
#pragma unroll
    for (int ai = 0; ai < 2; ++ai)
#pragma unroll
        for (int m = 0; m < 4; ++m) { const f32x4 v = a[ai][m] + b[ai][m]; float s = (v[0] + v[1]) + (v[2] + v[3]); s += __shfl_xor(s, 16); s += __shfl_xor(s, 32); rs[ai][m] = rsqrtf(s * (1.0f / DM) + RMS_EPS); }
}
struct EpiIn {
    static constexpr bool PERM = true, AFTER_DRAIN = false;
    bf16_t* z; const float* rss; float* out; bf16_t* kvb; bf16_t* mkvb; const float* bfg; int kind, j;
    __device__ __forceinline__ void operator()(const f32x4 (&acc)[2][2][4][2], const Unit& u, int wr, int wc, int fr, int fq) const {
        const int row0 = u.pm * BM + wr * 64 + fr, colt = u.pn * BM, col0 = colt + wc * 32 + 8 * fq;
        if (u.g != 0) {
            const int e = u.g - 1; const bool isv = colt >= MEMW; float* of = out + (isv ? O_MVP : O_MKP) + (size_t)e * NMEM * MEMW; bf16_t* ob = mkvb + (size_t)e * NMEM * 1024;
#pragma unroll
            for (int ai = 0; ai < 2; ++ai)
#pragma unroll
                for (int m = 0; m < 4; ++m) { const int row = row0 + ai * HALF + m * 16;
#pragma unroll
                    for (int bj = 0; bj < 2; ++bj) { const int c = col0 + bj * HALF; const f32x4 v0 = acc[ai][bj][m][0], v1 = acc[ai][bj][m][1];
                        *(u32x4*)(ob + (size_t)row * 1024 + c) = pack8u(v0, v1);
                        float* o = of + (size_t)row * MEMW + (c - (isv ? MEMW : 0)); *(f32x4*)o = v0; *(f32x4*)(o + 4) = v1; } }
            return;
        }
        float rs[2][4]; row_rstd8(rss, row0, fq, rs);
        const bool kt = kind != 2 && colt >= AW && colt < 2 * AW, vt = kind != 2 && colt >= 2 * AW && colt < 3 * AW, smp = u.pm >= TP / BM;
        const int cbase = kt ? AW : 2 * AW;
        const size_t ocache = kind == 0 ? (smp ? (kt ? O_FKS : O_FVS) + (size_t)j * TS * AW : (kt ? O_FKP : O_FVP) + (size_t)j * TP * AW) : (smp ? (kt ? O_SKS : O_SVS) : (kt ? O_SKP : O_SVP));
        float* oc = out + ocache; bf16_t* kvs = kvb + (kt ? 0 : KVS_ONE / 2);
        const bool lft = kind == 0 && colt == 5120 && wc == 0 && fq < 2;
        float* lfo = out + (smp ? O_FLS + (size_t)j * TS * NH : O_FLP + (size_t)j * TP * NH);
#pragma unroll
        for (int ai = 0; ai < 2; ++ai)
#pragma unroll
            for (int m = 0; m < 4; ++m) { const int row = row0 + ai * HALF + m * 16, rr = smp ? row - TP : row; const float sc = rs[ai][m];
#pragma unroll
                for (int bj = 0; bj < 2; ++bj) { const int c = col0 + bj * HALF; const f32x4 v0 = acc[ai][bj][m][0] * sc, v1 = acc[ai][bj][m][1] * sc; const u32x4 w = pack8u(v0, v1);
                    *(u32x4*)(z + (size_t)row * ZLD + c) = w;
                    if (kt || vt) { const int cc = c - cbase; float* o = oc + (size_t)rr * AW + cc; *(f32x4*)o = v0; *(f32x4*)(o + 4) = v1;
                        if (smp) *(u32x4*)(kvs + ((size_t)(rr >> 6) * SKS + PAST + (rr & 63)) * AW + cc) = w; }
                    if (lft && bj == 0) {
                        float* o = lfo + (size_t)rr * NH;
#pragma unroll
                        for (int e = 0; e < 8; ++e) { const int h = 8 * fq + e; if (h < NH) o[h] = log_sigmoidf((e < 4 ? v0[e & 3] : v1[e & 3]) + bfg[h]); } } } }
    }
};
struct EpiRes {
    static constexpr bool PERM = true, AFTER_DRAIN = false;
    float* x; bf16_t* xb; float* rss;
    __device__ __forceinline__ void operator()(const f32x4 (&acc)[2][2][4][2], const Unit& u, int wr, int wc, int fr, int fq) const {
        const int row0 = u.pm * BM + wr * 64 + fr, col0 = u.pn * BM + wc * 32 + 8 * fq;
#pragma unroll
        for (int ai = 0; ai < 2; ++ai)
#pragma unroll
            for (int m = 0; m < 4; ++m) { const int row = row0 + ai * HALF + m * 16; float ss = 0.f;
#pragma unroll
                for (int bj = 0; bj < 2; ++bj) { float* p = x + (size_t)row * DM + col0 + bj * HALF;
                    const f32x4 a = *(const f32x4*)p + acc[ai][bj][m][0], b = *(const f32x4*)(p + 4) + acc[ai][bj][m][1];
                    *(f32x4*)p = a; *(f32x4*)(p + 4) = b; *(u32x4*)(xb + (size_t)row * DM + col0 + bj * HALF) = pack8u(a, b);
                    ss += (a[0] * a[0] + a[1] * a[1]) + (a[2] * a[2] + a[3] * a[3]) + (b[0] * b[0] + b[1] * b[1]) + (b[2] * b[2] + b[3] * b[3]); }
                ss += __shfl_xor(ss, 16); ss += __shfl_xor(ss, 32);
                if (fq == 0) rss[(size_t)row * 32 + u.pn * 4 + wc] = ss;
                if (m & 1) asm volatile("" ::: "memory"); }
    }
};
struct EpiUp {
    static constexpr bool PERM = true, AFTER_DRAIN = false;
    bf16_t* o; const float* rss;
    __device__ __forceinline__ void operator()(const f32x4 (&acc)[2][2][4][2], const Unit& u, int wr, int wc, int fr, int fq) const {
        const int row0 = u.pm * BM + wr * 64 + fr, col0 = u.pn * BM + wc * 32 + 8 * fq;
        float rs[2][4]; row_rstd8(rss, row0, fq, rs);
#pragma unroll
        for (int ai = 0; ai < 2; ++ai)
#pragma unroll
            for (int m = 0; m < 4; ++m) { const int row = row0 + ai * HALF + m * 16; const float sc = rs[ai][m];
#pragma unroll
                for (int bj = 0; bj < 2; ++bj) { f32x4 v0 = acc[ai][bj][m][0] * sc, v1 = acc[ai][bj][m][1] * sc;
#pragma unroll
                    for (int e = 0; e < 4; ++e) { const float a = fmaxf(v0[e], 0.f), b = fmaxf(v1[e], 0.f); v0[e] = a * a; v1[e] = b * b; }
                    *(u32x4*)(o + (size_t)row * DFF + col0 + bj * HALF) = pack8u(v0, v1); } }
    }
};

struct SchedSplit {
    int S, nu, G, c; const char* A; const char* B; size_t tA, tB, kbytes;
    __device__ __forceinline__ bool next(int i, Unit& u) const {
        const int e = i * G + c; if (e >= nu) return false;
        const int tile = e / S, sp = e - tile * S; u.pm = TP / BM + (tile >> 3); u.pn = tile & 7; u.g = sp;
        u.A = A + (size_t)u.pm * tA + (size_t)sp * kbytes; u.B = B + (size_t)u.pn * tB + (size_t)sp * kbytes; return true;
    }
};
struct EpiPart {
    static constexpr bool PERM = true, AFTER_DRAIN = false;
    float* part;
    __device__ __forceinline__ void operator()(const f32x4 (&acc)[2][2][4][2], const Unit& u, int wr, int wc, int fr, int fq) const {
        const int row0 = (u.pm - TP / BM) * BM + wr * 64 + fr, col0 = u.pn * BM + wc * 32 + 8 * fq; float* base = part + (size_t)u.g * TS * DM;
#pragma unroll
        for (int ai = 0; ai < 2; ++ai)
#pragma unroll
            for (int m = 0; m < 4; ++m) { const int row = row0 + ai * HALF + m * 16;
#pragma unroll
                for (int bj = 0; bj < 2; ++bj) { float* p = base + (size_t)row * DM + col0 + bj * HALF; *(f32x4*)p = acc[ai][bj][m][0]; *(f32x4*)(p + 4) = acc[ai][bj][m][1]; } }
    }
};

template <class Epi, class Sch>
__device__ __forceinline__ void gemm_phase(LAS unsigned char* lds, const int K, const int lda, const int ldb, const Sch& S, const Epi& E, const int tid) {
    const int wid = __builtin_amdgcn_readfirstlane(tid >> 6), lane = tid & 63, wr = wid >> 2, wc = wid & 3, fr = lane & 15, fq = lane >> 4;
    const int nt = K / BK;
    unsigned voffA[2], voffB[2];
#pragma unroll
    for (int i = 0; i < 2; ++i) { int R, C; stage_rc(tid * 16 + i * 8192, R, C); const int Rb = Epi::PERM ? ((R & ~31) + perm32(R & 31)) : R;
        voffA[i] = (unsigned)(R * lda + C) * 2u; voffB[i] = (unsigned)(Rb * ldb + C) * 2u; }
    const size_t kstep = (size_t)(BK * 2);
    const size_t hstepA = (size_t)HALF * lda * 2, hstepB = (size_t)HALF * ldb * 2;
    const unsigned ldsw = (unsigned)wid * 1024u;
    const int aoff = lds_byte(wr * 64 + fr, fq * 8), boff = lds_byte(wc * 32 + fr, fq * 8);
#define PG8_SA(b, h) (((b) * 2 + (h)) * HTB)
#define PG8_SB(b, h) ((4 + (b) * 2 + (h)) * HTB)
#define PG8_STAGE(bufoff, gbase, voff) do { _Pragma("unroll") for (int _i = 0; _i < 2; ++_i) \
        __builtin_amdgcn_global_load_lds((const unsigned*)((const char*)(gbase) + (voff)[_i]), (LAS unsigned*)(lds + (bufoff) + ldsw + _i * 8192), 16, 0, 0); } while (0)
#define PG8_LDA(dst, b, h) do { _Pragma("unroll") for (int m = 0; m < 4; ++m) _Pragma("unroll") for (int k = 0; k < 2; ++k) dst[m][k] = *(const LAS bf16x8*)(lds + PG8_SA(b, h) + aoff + m * 2048 + k * 1024); } while (0)
#define PG8_LDB(dst, b, h) do { _Pragma("unroll") for (int n = 0; n < 2; ++n) _Pragma("unroll") for (int k = 0; k < 2; ++k) dst[n][k] = *(const LAS bf16x8*)(lds + PG8_SB(b, h) + boff + n * 2048 + k * 1024); } while (0)
#define PG8_MMA(ai, bj, At, Bt) do { __builtin_amdgcn_s_setprio(1); _Pragma("unroll") for (int m = 0; m < 4; ++m) _Pragma("unroll") for (int n = 0; n < 2; ++n) _Pragma("unroll") for (int k = 0; k < 2; ++k) \
        acc[ai][bj][m][n] = __builtin_amdgcn_mfma_f32_16x16x32_bf16(Bt[n][k], At[m][k], acc[ai][bj][m][n], 0, 0, 0); __builtin_amdgcn_s_setprio(0); } while (0)
#define PG8_WAIT_V(n) asm volatile("s_waitcnt vmcnt(" #n ")" ::: "memory")
#define PG8_WAIT_L(n) asm volatile("s_waitcnt lgkmcnt(" #n ")" ::: "memory")
#define PG8_BAR __builtin_amdgcn_s_barrier()
#define PG8_SCHED __builtin_amdgcn_sched_barrier(0)
    Unit cur, nxt; int ui = 0;
    if (!S.next(0, cur)) return;
    f32x4 acc[2][2][4][2];
#pragma unroll
    for (int a = 0; a < 2; ++a)
#pragma unroll
        for (int b = 0; b < 2; ++b)
#pragma unroll
            for (int m = 0; m < 4; ++m)
#pragma unroll
                for (int n = 0; n < 2; ++n) acc[a][b][m][n] = (f32x4){0.f, 0.f, 0.f, 0.f};
    bf16x8 At[4][2], B0[2][2], B1[2][2];
    const char* cA = cur.A; const char* cB = cur.B;
    PG8_STAGE(PG8_SB(0, 0), cB, voffB); PG8_STAGE(PG8_SB(0, 1), cB + hstepB, voffB); PG8_STAGE(PG8_SA(0, 0), cA, voffA); PG8_STAGE(PG8_SA(0, 1), cA + hstepA, voffA);
    if (wr == 1) PG8_BAR;
    PG8_WAIT_V(2); PG8_BAR;
    PG8_STAGE(PG8_SB(1, 0), cB + kstep, voffB); PG8_STAGE(PG8_SA(1, 0), cA + kstep, voffA); PG8_STAGE(PG8_SB(1, 1), cB + hstepB + kstep, voffB);
    PG8_WAIT_V(6); PG8_BAR;
    for (;;) {
        const bool has_next = S.next(ui + 1, nxt);
        const char* nA = has_next ? nxt.A : cA; const char* nB = has_next ? nxt.B : cB;
        for (int t = 0; t < nt; t += 2) {
            const bool last = (t == nt - 2);
            const char* a1 = cA + (size_t)(t + 1) * kstep;
            const char* a2 = last ? nA : cA + (size_t)(t + 2) * kstep; const char* b2 = last ? nB : cB + (size_t)(t + 2) * kstep;
            const char* a3 = a2 + kstep; const char* b3 = b2 + kstep;
            PG8_LDB(B0, 0, 0); PG8_LDB(B1, 0, 1); PG8_SCHED; PG8_LDA(At, 0, 0); PG8_STAGE(PG8_SA(1, 1), a1 + hstepA, voffA);
            PG8_WAIT_V(8); PG8_WAIT_L(0); PG8_BAR; PG8_MMA(0, 0, At, B0); PG8_MMA(0, 1, At, B1); PG8_BAR; PG8_SCHED;
            PG8_LDA(At, 0, 1); PG8_STAGE(PG8_SB(0, 0), b2, voffB); PG8_STAGE(PG8_SB(0, 1), b2 + hstepB, voffB); PG8_STAGE(PG8_SA(0, 0), a2, voffA);
            PG8_WAIT_V(8); PG8_WAIT_L(0); PG8_BAR; PG8_MMA(1, 0, At, B0); PG8_MMA(1, 1, At, B1); PG8_BAR; PG8_SCHED;
            PG8_LDB(B0, 1, 0); PG8_LDB(B1, 1, 1); PG8_SCHED; PG8_LDA(At, 1, 0); PG8_STAGE(PG8_SA(0, 1), a2 + hstepA, voffA);
            PG8_WAIT_V(8); PG8_WAIT_L(0); PG8_BAR; PG8_MMA(0, 0, At, B0); PG8_MMA(0, 1, At, B1); PG8_BAR; PG8_SCHED;
            PG8_LDA(At, 1, 1); PG8_STAGE(PG8_SB(1, 0), b3, voffB); PG8_STAGE(PG8_SB(1, 1), b3 + hstepB, voffB); PG8_STAGE(PG8_SA(1, 0), a3, voffA);
            PG8_WAIT_V(8); PG8_WAIT_L(0); PG8_BAR; PG8_MMA(1, 0, At, B0); PG8_MMA(1, 1, At, B1); PG8_BAR; PG8_SCHED;
        }
        if (wr == 0) PG8_BAR;
        E(acc, cur, wr, wc, fr, fq);
        if (!has_next) break;
#pragma unroll
        for (int a = 0; a < 2; ++a)
#pragma unroll
            for (int b = 0; b < 2; ++b)
#pragma unroll
                for (int m = 0; m < 4; ++m)
#pragma unroll
                    for (int n = 0; n < 2; ++n) acc[a][b][m][n] = (f32x4){0.f, 0.f, 0.f, 0.f};
        cur = nxt; cA = nA; cB = nB; ++ui;
        if (wr == 1) PG8_BAR;
    }
    PG8_WAIT_V(0);
    PG8_BAR;
#undef PG8_SA
#undef PG8_SB
#undef PG8_STAGE
#undef PG8_LDA
#undef PG8_LDB
#undef PG8_MMA
#undef PG8_WAIT_V
#undef PG8_WAIT_L
#undef PG8_BAR
#undef PG8_SCHED
}
}

namespace att {
constexpr float SCALE = 0.08838834764831845f;
constexpr float THR = 8.f;
constexpr int NW = 8, QBLK = 32, KVBLK = 64, QB = NW * QBLK, D = 128;
constexpr int SHM_V = KVBLK * D * 2, SHM_K = KVBLK * D * 2;
constexpr int ATT_LDS = 2 * SHM_V + 2 * SHM_K + NW * 64 * 4;
constexpr int BOS_OFF = ATT_LDS;
constexpr int BOS_BYTES = 8192 * 4;
constexpr int SCR_OFF = BOS_OFF + BOS_BYTES;
constexpr int WINF = 1 << 30;
static_assert(SCR_OFF + 256 <= LDS_WORK, "attention LDS map");

#define KSWZ(row, colB) ((row) * 256 + ((colB) ^ (((row) & 7) << 4)))
__device__ __forceinline__ int v_st(int k, int c) { const int kk = (k & ~0xC) | ((k & 4) << 1) | ((k & 8) >> 1); return ((kk >> 3) * 4 + (c >> 5)) * 512 + ((kk & 7) * 32 + (c & 31)) * 2; }
__device__ __forceinline__ int v_rd_base(int lane) { return ((lane & 3) << 3) | (((lane >> 2) & 3) << 6) | (((lane >> 4) & 1) << 5) | (((lane >> 5) & 1) << 8); }
constexpr int v_rd_off(int d0, int ks, int half) { return d0 * 512 + ks * 4096 + half * 2048; }
__device__ __forceinline__ int crow(int r, int hi) { return (r & 3) + 8 * (r >> 2) + 4 * hi; }
__device__ __forceinline__ bf16x8 load8(const bf16_t* p) { return *reinterpret_cast<const bf16x8*>(p); }

__device__ __forceinline__ void mask_tile(f32x16& p0, f32x16& p1, int dq, unsigned W) {
    const float NEG = -__builtin_inff();
#pragma unroll
    for (int r = 0; r < 16; ++r) {
        const int c = (r & 3) + 8 * (r >> 2);
        if ((unsigned)(dq - c) >= W) p0[r] = NEG;
        if ((unsigned)(dq - c - 32) >= W) p1[r] = NEG;
    }
}
__device__ __forceinline__ void partialSM(f32x16& p0, f32x16& p1, float& m_reg, float& mn, float& alpha) {
    float pmax = p0[0]; for (int r = 1; r < 16; ++r) pmax = fmaxf(pmax, p0[r]); for (int r = 0; r < 16; ++r) pmax = fmaxf(pmax, p1[r]);
    { auto rr = __builtin_amdgcn_permlane32_swap(__float_as_uint(pmax), __float_as_uint(pmax), false, false);
      pmax = fmaxf(__uint_as_float(rr[0]), __uint_as_float(rr[1])); }
    constexpr float C2 = 1.4426950408889634f * SCALE;
    if (__builtin_expect(__all((pmax - m_reg) * SCALE <= THR), 1)) { mn = m_reg; alpha = 1.f; }
    else { mn = fmaxf(m_reg, pmax); alpha = __builtin_amdgcn_exp2f((m_reg - mn) * C2); m_reg = mn; }
    const float mnL = -mn * C2;
    for (int r = 0; r < 16; ++r) p0[r] = fmaf(p0[r], C2, mnL); for (int r = 0; r < 16; ++r) p1[r] = fmaf(p1[r], C2, mnL);
    for (int r = 0; r < 16; ++r) p0[r] = __builtin_amdgcn_exp2f(p0[r]);
}
#define PK4(P, B_, OUT) do { unsigned a0 = cvtpk(P[B_+0], P[B_+1]), a1 = cvtpk(P[B_+2], P[B_+3]);                          \
        unsigned b0 = cvtpk(P[B_+4], P[B_+5]), b1 = cvtpk(P[B_+6], P[B_+7]);                                             \
        auto r0 = __builtin_amdgcn_permlane32_swap(a0, b0, false, false); auto r1 = __builtin_amdgcn_permlane32_swap(a1, b1, false, false); \
        u32x4 w = {r0[0], r1[0], r0[1], r1[1]}; OUT = *reinterpret_cast<bf16x8*>(&w); } while (0)
__device__ __forceinline__ void finishSM(f32x16& p0, f32x16& p1, float alpha, float& l_reg, bf16x8& pa0, bf16x8& pa1, bf16x8& pa2, bf16x8& pa3) {
    for (int r = 0; r < 16; ++r) p1[r] = __builtin_amdgcn_exp2f(p1[r]);
    float ps = 0; for (int r = 0; r < 16; ++r) ps += p0[r]; for (int r = 0; r < 16; ++r) ps += p1[r];
    { auto rr = __builtin_amdgcn_permlane32_swap(__float_as_uint(ps), __float_as_uint(ps), false, false);
      ps = __uint_as_float(rr[0]) + __uint_as_float(rr[1]); }
    l_reg = l_reg * alpha + ps;
    PK4(p0, 0, pa0); PK4(p0, 8, pa1); PK4(p1, 0, pa2); PK4(p1, 8, pa3);
}
template <int KB, bool BIAS>
__device__ __forceinline__ void qkt(f32x16& p0, f32x16& p1, const char* K_lds, int r32, int hi, const bf16x8* qr, const float* bk) {
    if constexpr (BIAS) {
#pragma unroll
        for (int i = 0; i < 4; ++i) { const f32x4 a = *(const f32x4*)(bk + 8 * i), b = *(const f32x4*)(bk + 32 + 8 * i);
            p0[4 * i] = a[0]; p0[4 * i + 1] = a[1]; p0[4 * i + 2] = a[2]; p0[4 * i + 3] = a[3];
            p1[4 * i] = b[0]; p1[4 * i + 1] = b[1]; p1[4 * i + 2] = b[2]; p1[4 * i + 3] = b[3]; }
    } else { p0 = f32x16{}; p1 = f32x16{}; }
    const char* kb[4];
#pragma unroll
    for (int dd = 0; dd < 4; ++dd) kb[dd] = K_lds + KB * SHM_K + KSWZ(r32, (dd * 16 + hi * 8) * 2);
#pragma unroll
    for (int d0 = 0; d0 < 8; ++d0) { const char* a = kb[d0 & 3] + (d0 >> 2) * 128;
        bf16x8 b0 = *reinterpret_cast<const bf16x8*>(a);
        bf16x8 b1 = *reinterpret_cast<const bf16x8*>(a + 32 * 256);
        p0 = __builtin_amdgcn_mfma_f32_32x32x16_bf16(b0, qr[d0], p0, 0, 0, 0);
        p1 = __builtin_amdgcn_mfma_f32_32x32x16_bf16(b1, qr[d0], p1, 0, 0, 0); }
}
template <int VB>
__device__ __forceinline__ void pv_tile(f32x16* o, int vb0, bf16x8 pa0, bf16x8 pa1, bf16x8 pa2, bf16x8 pa3) {
#define TRRD(dst, off) asm volatile("ds_read_b64_tr_b16 %0, %1 offset:%2" : "=&v"(dst) : "v"(vb0), "i"(off) : "memory")
#define PV_D0(d0) do { s16x4 l0, l1, l2, l3, h0, h1, h2, h3; constexpr int b_ = VB * SHM_V + v_rd_off(d0, 0, 0); \
        TRRD(l0, b_); TRRD(h0, b_ + 2048); TRRD(l1, b_ + 4096); TRRD(h1, b_ + 6144); TRRD(l2, b_ + 8192); TRRD(h2, b_ + 10240); TRRD(l3, b_ + 12288); TRRD(h3, b_ + 14336); \
        asm volatile("s_waitcnt lgkmcnt(0)" ::: "memory"); SBAR();   \
        o[d0] = __builtin_amdgcn_mfma_f32_32x32x16_bf16(pa0, (bf16x8){l0[0], l0[1], l0[2], l0[3], h0[0], h0[1], h0[2], h0[3]}, o[d0], 0, 0, 0);   \
        o[d0] = __builtin_amdgcn_mfma_f32_32x32x16_bf16(pa1, (bf16x8){l1[0], l1[1], l1[2], l1[3], h1[0], h1[1], h1[2], h1[3]}, o[d0], 0, 0, 0);   \
        o[d0] = __builtin_amdgcn_mfma_f32_32x32x16_bf16(pa2, (bf16x8){l2[0], l2[1], l2[2], l2[3], h2[0], h2[1], h2[2], h2[3]}, o[d0], 0, 0, 0);   \
        o[d0] = __builtin_amdgcn_mfma_f32_32x32x16_bf16(pa3, (bf16x8){l3[0], l3[1], l3[2], l3[3], h3[0], h3[1], h3[2], h3[3]}, o[d0], 0, 0, 0); } while (0)
    PV_D0(0); PV_D0(1); PV_D0(2); PV_D0(3);
#undef PV_D0
#undef TRRD
}

struct Blk { const bf16_t* Q; const bf16_t* K; const bf16_t* V; bf16_t* O; int ldq, ldkv, ldo; int P0, skv, nrows; int bmode; const float* lf0; int n0; const float* lf1; };
struct Seam { bf16x8 qr[8]; bf16x8 st_v0, st_v1, st_k0, st_k1; };
__device__ __forceinline__ int blk_jhi(const Blk& b) { int j = (b.P0 + QB - 1) / KVBLK + 1; const int m = b.skv / KVBLK; return j > m ? m : j; }

__device__ __forceinline__ void prepare_bias(const Blk& b, char* lds, int g_wave) {
    const int tid = opaque_tid();
    float* bos = (float*)(lds + BOS_OFF); float* scr = (float*)(lds + SCR_OFF);
    const int nk = blk_jhi(b) * KVBLK, lane = tid & 63, wid = tid >> 6;
    if (b.bmode == 0) { for (int k = tid; k < nk; k += 512) bos[k] = 0.f; __syncthreads(); return; }
    float v[16]; float tot = 0.f; const int k0 = tid * 16; const bool in = k0 < nk;
#pragma unroll
    for (int i = 0; i < 16; ++i) { const int k = k0 + i; v[i] = in ? (k < b.n0 ? b.lf0[(size_t)k * NH] : b.lf1[(size_t)(k - b.n0) * NH]) : 0.f; tot += v[i]; }
    float inc = tot;
#pragma unroll
    for (int o = 1; o < 64; o <<= 1) { const float y = __shfl_down(inc, o); if (lane + o < 64) inc += y; }
    if (lane == 0) scr[wid] = inc;
    __syncthreads();
    float hiw = 0.f;
#pragma unroll
    for (int w = 0; w < 8; ++w) if (w > wid) hiw += scr[w];
    float run = (inc - tot) + hiw;
    if (in) {
#pragma unroll
        for (int i = 15; i >= 0; --i) { bos[k0 + i] = run * (1.0f / SCALE); run += v[i]; }
    }
    __syncthreads();
}

#define ROWK(p, ld, k0, rr) ((p) + (size_t)((k0) + (rr)) * (ld) + sc)
#define VMW() asm volatile("s_waitcnt vmcnt(0)" ::: "memory")
#define VMWN(n) asm volatile("s_waitcnt vmcnt(%0)" :: "i"(n) : "memory")
#define SLOAD_H(Kp, Vp, ld, k0) do { S.st_v0 = load8(ROWK(Vp, ld, k0, sr)); S.st_v1 = load8(ROWK(Vp, ld, k0, 32 + sr));              \
                         S.st_k0 = load8(ROWK(Kp, ld, k0, sr)); S.st_k1 = load8(ROWK(Kp, ld, k0, 32 + sr)); } while (0)
#define SWRITE_HK(bf) do { *(bf16x8*)(K_lds + (bf) * SHM_K + kws) = S.st_k0; *(bf16x8*)(K_lds + (bf) * SHM_K + kws + 32 * 256) = S.st_k1; } while (0)
#define SWRITE_HV(bf) do { *(bf16x8*)(V_lds + (bf) * SHM_V + vst0) = S.st_v0; *(bf16x8*)(V_lds + (bf) * SHM_V + vst1) = S.st_v1; } while (0)
#define SWRITE_H(bf) do { SWRITE_HV(bf); SWRITE_HK(bf); } while (0)
#define QROWP(b_) ((b_).Q + (size_t)((wid * QBLK + r32) & ((b_).nrows - 1)) * (b_).ldq + hi * 8)
__device__ __forceinline__ void att_prime(const Blk& cur, char* lds, Seam& S, int g_wave) {
    const int tid = opaque_tid();
    const int wid = __builtin_amdgcn_readfirstlane(tid >> 6), lane = tid & 63, r32 = lane & 31, hi = lane >> 5;
    const int sr = tid >> 4, sc = (tid & 15) * 8, kws = KSWZ(sr, sc * 2); char* K_lds = lds + 2 * SHM_V;
    const bf16_t* qp = QROWP(cur);
#pragma unroll
    for (int d0 = 0; d0 < 8; ++d0) S.qr[d0] = load8(qp + d0 * 16);
    SLOAD_H(cur.K, cur.V, cur.ldkv, 0); VMW(); SWRITE_HK(0);
    __syncthreads();
}
__device__ __forceinline__ void att_block(const Blk& cur, const Blk& nxt, char* lds, Seam& S, int g_wave) {
    const int tid = opaque_tid();
    const int wid = __builtin_amdgcn_readfirstlane(tid >> 6), lane = tid & 63, r32 = lane & 31, hi = lane >> 5;
    constexpr int W = WINF;
    const int NT = blk_jhi(cur);
    const int qlo = cur.P0 + wid * QBLK, qm = qlo + r32 - 4 * hi;
    char* V_lds = lds; char* K_lds = lds + 2 * SHM_V;
    float* ws = (float*)(lds + 2 * SHM_V + 2 * SHM_K) + wid * 64; float* li_l = ws, * al_l = ws + 32;
    const float* bos = (const float*)(lds + BOS_OFF) + 4 * hi;
    float m_reg = -1e30f, l_reg = 0; f32x16 o[4] = {};
    const int sr = tid >> 4, sc = (tid & 15) * 8, vst0 = v_st(sr, sc), vst1 = v_st(32 + sr, sc), kws = KSWZ(sr, sc * 2);
    const int vb0 = (int)(uintptr_t)V_lds + v_rd_base(lane);
    const bf16_t* Kh = cur.K; const bf16_t* Vh = cur.V; const int ldkv = cur.ldkv;
#define RESC(a) do { if (__any((a) < 1.f)) { if (hi == 0) al_l[r32] = (a); asm volatile("s_waitcnt lgkmcnt(0)" ::: "memory");              \
                     for (int d_ = 0; d_ < 4; ++d_) for (int r = 0; r < 16; ++r) o[d_][r] *= al_l[crow(r, hi)]; } } while (0)
#define KBASE(t) ((t) * KVBLK)
#define MASKT(P0_, P1_, t) do { const int kb_ = KBASE(t); if (kb_ + KVBLK - 1 > qlo) mask_tile(P0_, P1_, qm - kb_, (unsigned)W); } while (0)
    constexpr int NQL = 8;
#define SEAM_K0() do { VMWN(NQL); SWRITE_HK(0); SBAR(); } while (0)
    f32x16 pA0, pA1, pB0, pB1; float mnA, mnB, alA, alB; bf16x8 pa0, pa1, pa2, pa3;
    SWRITE_HV(0); SBAR();
    if (NT > 1) SLOAD_H(Kh, Vh, ldkv, KBASE(1));
    SBAR(); qkt<0, true>(pA0, pA1, K_lds, r32, hi, S.qr, bos + KBASE(0));
    MASKT(pA0, pA1, 0); partialSM(pA0, pA1, m_reg, mnA, alA);
    if (NT > 1) { VMW(); SWRITE_H(1); }
    __syncthreads();
#define HALF_STEP(PX0, PX1, mnX, alX, PY0, PY1, alY, t, KB, VB, SB) do {                                                      \
        SBAR(); qkt<KB, true>(PX0, PX1, K_lds, r32, hi, S.qr, bos + KBASE(t));                                                \
        finishSM(PY0, PY1, alY, l_reg, pa0, pa1, pa2, pa3); SBAR();                                                           \
        if ((t) + 1 < NT) { SLOAD_H(Kh, Vh, ldkv, KBASE((t) + 1)); SBAR(); }                                                  \
        pv_tile<VB>(o, vb0, pa0, pa1, pa2, pa3); MASKT(PX0, PX1, (t)); partialSM(PX0, PX1, m_reg, mnX, alX);                  \
        __syncthreads();                                                                                                      \
        if ((t) + 1 < NT) { VMW(); SWRITE_H(SB); }                                                                            \
        RESC(alX); __syncthreads(); } while (0)
    for (int t = 1; t + 1 < NT; t += 2) {
        HALF_STEP(pB0, pB1, mnB, alB, pA0, pA1, alA, t, 1, 0, 0);
        HALF_STEP(pA0, pA1, mnA, alA, pB0, pB1, alB, t + 1, 0, 1, 1);
    }
    const bool even = (NT & 1) == 0;
    if (even) { SBAR(); qkt<1, true>(pB0, pB1, K_lds, r32, hi, S.qr, bos + KBASE(NT - 1)); SBAR(); }
    SLOAD_H(nxt.K, nxt.V, nxt.ldkv, 0); SBAR();
    { const bf16_t* qp = QROWP(nxt);
#pragma unroll
      for (int d0 = 0; d0 < 8; ++d0) S.qr[d0] = load8(qp + d0 * 16); }
    SBAR();
    finishSM(pA0, pA1, alA, l_reg, pa0, pa1, pa2, pa3); SBAR();
    pv_tile<0>(o, vb0, pa0, pa1, pa2, pa3);
    if (even) { MASKT(pB0, pB1, NT - 1); partialSM(pB0, pB1, m_reg, mnB, alB); __syncthreads(); RESC(alB);
        finishSM(pB0, pB1, alB, l_reg, pa0, pa1, pa2, pa3); SBAR(); pv_tile<1>(o, vb0, pa0, pa1, pa2, pa3); }
    SBAR(); SEAM_K0();
    if (hi == 0) li_l[r32] = l_reg; asm volatile("s_waitcnt lgkmcnt(0)" ::: "memory");
    float rli[16];
#pragma unroll
    for (int r = 0; r < 16; ++r) rli[r] = __builtin_amdgcn_rcpf(li_l[crow(r, hi)]);
    if (wid * QBLK < cur.nrows) {
        bf16_t* Ow = cur.O + (size_t)(wid * QBLK) * cur.ldo;
#pragma unroll
        for (int r = 0; r < 16; ++r) { const int orow = crow(r, hi);
#pragma unroll
            for (int d0 = 0; d0 < 4; ++d0) { const float v = o[d0][r] * rli[r]; const float vn = __shfl_xor(v, 1);
                if ((r32 & 1) == 0) *(unsigned*)(Ow + (size_t)orow * cur.ldo + d0 * 32 + r32) = cvtpk(v, vn); } }
    }
    __syncthreads();
#undef RESC
#undef MASKT
#undef SEAM_K0
#undef HALF_STEP
}

__device__ __forceinline__ void sb_block(const Blk& b, char* lds, int g_wave) {
    const int tid = opaque_tid();
    const int wid = __builtin_amdgcn_readfirstlane(tid >> 6), lane = tid & 63, r32 = lane & 31, hi = lane >> 5;
    char* V_lds = lds; char* K_lds = lds + 2 * SHM_V; int* flags = (int*)(lds + 2 * SHM_V + 2 * SHM_K);
    const int sr = tid >> 4, sc = (tid & 15) * 8, vst0 = v_st(sr, sc), vst1 = v_st(32 + sr, sc), kws = KSWZ(sr, sc * 2);
    const int vb0 = (int)(uintptr_t)V_lds + v_rd_base(lane);
    bf16x8 qr[8];
    { const bf16_t* qp = QROWP(b);
#pragma unroll
      for (int d0 = 0; d0 < 8; ++d0) qr[d0] = load8(qp + d0 * 16); }
    const int NT = blk_jhi(b), qlo = b.P0 + wid * QBLK, pos = qlo + r32;
    bool wdead = wid * QBLK >= b.nrows;
    float prun = 1.f; f32x16 o[4] = {};
    constexpr float C2 = 1.4426950408889634f * SCALE;
    for (int t = NT - 1; t >= 0; --t) {
        const int kb = t * KVBLK;
        const bf16x8 k0 = load8(ROWK(b.K, b.ldkv, kb, sr)), k1 = load8(ROWK(b.K, b.ldkv, kb, 32 + sr)), v0 = load8(ROWK(b.V, b.ldkv, kb, sr)), v1 = load8(ROWK(b.V, b.ldkv, kb, 32 + sr));
        __syncthreads();
        *(bf16x8*)(K_lds + kws) = k0; *(bf16x8*)(K_lds + kws + 32 * 256) = k1; *(bf16x8*)(V_lds + vst0) = v0; *(bf16x8*)(V_lds + vst1) = v1;
        __syncthreads();
        if (!wdead && kb < qlo + QBLK - 1) {
            f32x16 p0, p1; qkt<0, false>(p0, p1, K_lds, r32, hi, qr, nullptr);
            if (kb + KVBLK - 1 >= qlo) {
                const float NEG = -__builtin_inff();
#pragma unroll
                for (int r = 0; r < 16; ++r) { const int key = kb + crow(r, hi); if (key >= pos) p0[r] = NEG; if (key + 32 >= pos) p1[r] = NEG; }
            }
#pragma unroll
            for (int r = 0; r < 16; ++r) {
                p0[r] = __builtin_amdgcn_rcpf(1.f + __builtin_amdgcn_exp2f(fminf(p0[r] * C2, 60.f))); p1[r] = __builtin_amdgcn_rcpf(1.f + __builtin_amdgcn_exp2f(fminf(p1[r] * C2, 60.f))); }
            float gl[8], gu[8];
#pragma unroll
            for (int g = 0; g < 8; ++g) { const float gp = g < 4 ? (p0[4 * g] * p0[4 * g + 1]) * (p0[4 * g + 2] * p0[4 * g + 3]) : (p1[4 * g - 16] * p1[4 * g - 15]) * (p1[4 * g - 14] * p1[4 * g - 13]);
                auto x = __builtin_amdgcn_permlane32_swap(__float_as_uint(gp), __float_as_uint(gp), false, false); gl[g] = __uint_as_float(x[0]); gu[g] = __uint_as_float(x[1]); }
            float s = 1.f, sown[8];
#pragma unroll
            for (int g = 7; g >= 0; --g) { const float su = s; s *= gu[g]; const float sl = s; s *= gl[g]; sown[g] = hi ? su : sl; }
#define SB_EL(P, q) do { const float rr_ = P[q]; P[q] = (1.f - rr_) * tt; tt *= rr_; } while (0)
#pragma unroll
            for (int g = 0; g < 8; ++g) { float tt = sown[g] * prun;
                if (g < 4) { const int q = 4 * g; SB_EL(p0, q + 3); SB_EL(p0, q + 2); SB_EL(p0, q + 1); SB_EL(p0, q); }
                else { const int q = 4 * g - 16; SB_EL(p1, q + 3); SB_EL(p1, q + 2); SB_EL(p1, q + 1); SB_EL(p1, q); } }
#undef SB_EL
            prun *= s;
            bf16x8 pa0, pa1, pa2, pa3;
            PK4(p0, 0, pa0); PK4(p0, 8, pa1); PK4(p1, 0, pa2); PK4(p1, 8, pa3);
            pv_tile<0>(o, vb0, pa0, pa1, pa2, pa3);
            wdead = __all(prun < 8.67e-19f);
        }
        if (lane == 0) flags[wid] = wdead ? 1 : 0;
        __syncthreads();
        const int alld = flags[0] & flags[1] & flags[2] & flags[3] & flags[4] & flags[5] & flags[6] & flags[7];
        if (alld) break;
    }
    if (wid * QBLK < b.nrows) {
        bf16_t* Ow = b.O + (size_t)(wid * QBLK) * b.ldo;
#pragma unroll
        for (int r = 0; r < 16; ++r) { const int orow = crow(r, hi);
#pragma unroll
            for (int d0 = 0; d0 < 4; ++d0) { const float v = o[d0][r]; const float vn = __shfl_xor(v, 1);
                if ((r32 & 1) == 0) *(unsigned*)(Ow + (size_t)orow * b.ldo + d0 * 32 + r32) = cvtpk(v, vn); } }
    }
    __syncthreads();
}
#undef ROWK
#undef VMW
#undef VMWN
#undef SLOAD_H
#undef SWRITE_HK
#undef SWRITE_HV
#undef SWRITE_H
#undef QROWP
#undef PK4
#undef KSWZ
#undef KBASE
}

namespace gla {
constexpr int ZQ = 0, ZK = GKW, ZV = 2 * GKW, ZR = 2 * GKW + GVW, ZG = 5120;
constexpr int KP = 72, QP = 200;
constexpr int L_G = 0;
constexpr int L_GLOW = 49152;
constexpr int L_TOT = 53248;
constexpr int L_QP = 54272;
constexpr int L_KPB = L_QP + 64 * QP * 2;
constexpr int L_AB = L_KPB + 64 * QP * 2;
constexpr int L_VT = L_AB + 64 * KP * 2;
constexpr int L_RS = L_VT + 128 * KP * 2;
constexpr int L_ST = 0;
constexpr int L1_KD = 54272;
constexpr int L1_VT = L1_KD + 192 * KP * 2;
static_assert(L_RS + 1024 <= LDS_WORK && L1_VT + 384 * KP * 2 <= LDS_WORK, "GLA LDS map");

__device__ __forceinline__ int chunk_row0(int c) { return c < TP / 64 ? c * 64 : TP + (c - TP / 64) * 64; }

__device__ __forceinline__ void decay_scan(const bf16_t* z, const float* wg2, const float* bg, int row0, int h, char* lds, int tid) {
    float* G = (float*)(lds + L_G); float* glow = (float*)(lds + L_GLOW); float* tot = (float*)(lds + L_TOT);
    for (int i = tid; i < 64 * 16; i += 512) glow[i] = bf2f(z[(size_t)(row0 + (i >> 4)) * ZLD + ZG + (i & 15)]);
    __syncthreads();
    if (tid < 384) {
        const int k = tid % 192, half = tid / 192; float w[16];
#pragma unroll
        for (int j = 0; j < 16; ++j) w[j] = wg2[(size_t)j * GKW + h * GDK + k];
        const float b = bg[h * GDK + k]; float g = 0.f;
        for (int s = half * 32; s < half * 32 + 32; ++s) { float a = b;
#pragma unroll
            for (int j = 0; j < 16; ++j) a += glow[s * 16 + j] * w[j];
            g += log_sigmoidf(a) * (1.0f / 16.0f); G[s * GDK + k] = g; }
        if (half == 0) tot[k] = g;
    }
    __syncthreads();
}

__device__ __forceinline__ void g1_unit(int c, int h, const bf16_t* z, const float* wg2, const float* bg, float* UT, float* DEC, char* lds, int g_wave) {
    const int tid = opaque_tid(); const int row0 = chunk_row0(c);
    decay_scan(z, wg2, bg, row0, h, lds, tid);
    const float* G = (const float*)(lds + L_G); const float* tot = (const float*)(lds + L_TOT);
    bf16_t* KD = (bf16_t*)(lds + L1_KD); bf16_t* VT = (bf16_t*)(lds + L1_VT);
    for (int it = tid; it < 192 * 8; it += 512) {
        const int k = it % 192, sb = it / 192; const float t0 = tot[k], glast = G[63 * GDK + k] + t0; float v[8];
#pragma unroll
        for (int i = 0; i < 8; ++i) { const int s = sb * 8 + i; const float g = G[s * GDK + k] + (s >= 32 ? t0 : 0.f);
            v[i] = bf2f(z[(size_t)(row0 + s) * ZLD + ZK + h * GDK + k]) * __expf(glast - g); }
        u32x4 w = {cvtpk(v[0], v[1]), cvtpk(v[2], v[3]), cvtpk(v[4], v[5]), cvtpk(v[6], v[7])};
        *(u32x4*)(KD + k * KP + sb * 8) = w;
        if (sb == 0) DEC[(size_t)(c * GH + h) * GDK + k] = __expf(glast);
    }
    for (int it = tid; it < 64 * 48; it += 512) {
        const int s = it & 63, vb = it >> 6; const u32x4 w = *(const u32x4*)(z + (size_t)(row0 + s) * ZLD + ZV + h * GDV + vb * 8);
#pragma unroll
        for (int i = 0; i < 4; ++i) { VT[(vb * 8 + 2 * i) * KP + s] = (bf16_t)(w[i] & 0xffffu); VT[(vb * 8 + 2 * i + 1) * KP + s] = (bf16_t)(w[i] >> 16); }
    }
    __syncthreads();
    const int wid = tid >> 6, lane = tid & 63, l32 = lane & 31, hi = lane >> 5, mq = wid & 3, nh = wid >> 2;
    f32x16 acc[3][3];
#pragma unroll
    for (int i = 0; i < 3; ++i)
#pragma unroll
        for (int j = 0; j < 3; ++j) acc[i][j] = f32x16{};
#pragma unroll
    for (int ks = 0; ks < 4; ++ks) { bf16x8 a[3], bb[3];
#pragma unroll
        for (int i = 0; i < 3; ++i) { a[i] = *(const bf16x8*)(VT + ((mq * 3 + i) * 32 + l32) * KP + ks * 16 + hi * 8); bb[i] = *(const bf16x8*)(KD + ((nh * 3 + i) * 32 + l32) * KP + ks * 16 + hi * 8); }
#pragma unroll
        for (int i = 0; i < 3; ++i)
#pragma unroll
            for (int j = 0; j < 3; ++j) acc[i][j] = __builtin_amdgcn_mfma_f32_32x32x16_bf16(a[i], bb[j], acc[i][j], 0, 0, 0); }
    float* out = UT + (size_t)(c * GH + h) * GDV * GDK;
#pragma unroll
    for (int i = 0; i < 3; ++i)
#pragma unroll
        for (int j = 0; j < 3; ++j)
#pragma unroll
            for (int r = 0; r < 16; ++r) out[(size_t)((mq * 3 + i) * 32 + att::crow(r, hi)) * GDK + (nh * 3 + j) * 32 + l32] = acc[i][j][r];
    __syncthreads();
}

__device__ __forceinline__ void g2_tile(int tile, float* UT, const float* DEC, const float* s0in, float* outp, float* outs, char* lds, int tid) {
    const int h = tile / 36, vt = (tile % 36) / 3, kt = tile % 3, vi = tid >> 4, kg = tid & 15, v = vt * 32 + vi, k = kt * 64 + kg * 4;
    float* T = (float*)lds;
    const size_t cstride = (size_t)GH * GDV * GDK; float* up = UT + ((size_t)h * GDV + v) * GDK + k; const float* dp = DEC + h * GDK + k;
    float zz = 0.f; asm volatile("" : "+v"(zz)); f32x4 S = {zz, zz, zz, zz};
    for (int c0 = 0; c0 < TP / 64; c0 += 8) { f32x4 u[8], d[8];
#pragma unroll
        for (int i = 0; i < 8; ++i) { u[i] = *(const f32x4*)(up + (size_t)(c0 + i) * cstride); d[i] = *(const f32x4*)(dp + (size_t)(c0 + i) * GH * GDK); }
#pragma unroll
        for (int i = 0; i < 8; ++i) { *(f32x4*)(up + (size_t)(c0 + i) * cstride) = S; S = d[i] * S + u[i]; } }
    const int kr = tid >> 3, v4 = (tid & 7) * 4;
    T[(kg * 4 + 0) * 33 + vi] = S[0]; T[(kg * 4 + 1) * 33 + vi] = S[1]; T[(kg * 4 + 2) * 33 + vi] = S[2]; T[(kg * 4 + 3) * 33 + vi] = S[3];
    __syncthreads();
    { f32x4 o = {T[kr * 33 + v4], T[kr * 33 + v4 + 1], T[kr * 33 + v4 + 2], T[kr * 33 + v4 + 3]}; *(f32x4*)(outp + ((size_t)h * GDK + kt * 64 + kr) * GDV + vt * 32 + v4) = o; }
    __syncthreads();
    for (int b = 0; b < NB; ++b) {
        const int c = TP / 64 + b; const size_t sb = ((size_t)b * GH + h) * GDK * GDV;
        { const f32x4 i4 = *(const f32x4*)(s0in + sb + (size_t)(kt * 64 + kr) * GDV + vt * 32 + v4); T[kr * 33 + v4] = i4[0]; T[kr * 33 + v4 + 1] = i4[1]; T[kr * 33 + v4 + 2] = i4[2]; T[kr * 33 + v4 + 3] = i4[3]; }
        __syncthreads();
        f32x4 s0 = {T[(kg * 4 + 0) * 33 + vi], T[(kg * 4 + 1) * 33 + vi], T[(kg * 4 + 2) * 33 + vi], T[(kg * 4 + 3) * 33 + vi]};
        const f32x4 u = *(const f32x4*)(up + (size_t)c * cstride), d = *(const f32x4*)(dp + (size_t)c * GH * GDK);
        *(f32x4*)(up + (size_t)c * cstride) = s0; const f32x4 sn = d * s0 + u;
        __syncthreads();
        T[(kg * 4 + 0) * 33 + vi] = sn[0]; T[(kg * 4 + 1) * 33 + vi] = sn[1]; T[(kg * 4 + 2) * 33 + vi] = sn[2]; T[(kg * 4 + 3) * 33 + vi] = sn[3];
        __syncthreads();
        { f32x4 o = {T[kr * 33 + v4], T[kr * 33 + v4 + 1], T[kr * 33 + v4 + 2], T[kr * 33 + v4 + 3]}; *(f32x4*)(outs + sb + (size_t)(kt * 64 + kr) * GDV + vt * 32 + v4) = o; }
        __syncthreads();
    }
}

__device__ __forceinline__ void g3_unit(int c, int h, const bf16_t* z, const float* wg2, const float* bg, const float* UT, const float* ng, const float* br, bf16_t* oc, char* lds, int g_wave) {
    const int tid = opaque_tid(); const int row0 = chunk_row0(c);
    decay_scan(z, wg2, bg, row0, h, lds, tid);
    const float* G = (const float*)(lds + L_G); const float* tot = (const float*)(lds + L_TOT);
    bf16_t* Qp = (bf16_t*)(lds + L_QP); bf16_t* Kp = (bf16_t*)(lds + L_KPB); bf16_t* Ab = (bf16_t*)(lds + L_AB); bf16_t* VT = (bf16_t*)(lds + L_VT); bf16_t* ST = (bf16_t*)(lds + L_ST);
    float* RS = (float*)(lds + L_RS);
    const float qs = 0.07216878364870322f;
    for (int it = tid; it < 64 * 24; it += 512) {
        const int s = it / 24, kb = (it % 24) * 8; float g[8];
#pragma unroll
        for (int i = 0; i < 8; ++i) g[i] = G[s * GDK + kb + i] + (s >= 32 ? tot[kb + i] : 0.f);
        const u32x4 qw = *(const u32x4*)(z + (size_t)(row0 + s) * ZLD + ZQ + h * GDK + kb), kw = *(const u32x4*)(z + (size_t)(row0 + s) * ZLD + ZK + h * GDK + kb);
        u32x4 qo, ko;
#pragma unroll
        for (int i = 0; i < 4; ++i) { const float e0 = __expf(g[2 * i]), e1 = __expf(g[2 * i + 1]);
            qo[i] = cvtpk(__uint_as_float(qw[i] << 16) * qs * e0, __uint_as_float(qw[i] & 0xffff0000u) * qs * e1);
            ko[i] = cvtpk(__uint_as_float(kw[i] << 16) * __builtin_amdgcn_rcpf(e0), __uint_as_float(kw[i] & 0xffff0000u) * __builtin_amdgcn_rcpf(e1)); }
        *(u32x4*)(Qp + s * QP + kb) = qo; *(u32x4*)(Kp + s * QP + kb) = ko;
    }
    __syncthreads();
    const int wid = tid >> 6, lane = tid & 63, l32 = lane & 31, hi = lane >> 5;
    if (wid < 4) {
        const int mt = wid & 1, nt = wid >> 1; f32x16 a = f32x16{};
        if (nt <= mt) {
#pragma unroll
            for (int ks = 0; ks < 12; ++ks) { const bf16x8 x = *(const bf16x8*)(Qp + (mt * 32 + l32) * QP + ks * 16 + hi * 8), y = *(const bf16x8*)(Kp + (nt * 32 + l32) * QP + ks * 16 + hi * 8);
                a = __builtin_amdgcn_mfma_f32_32x32x16_bf16(x, y, a, 0, 0, 0); }
        }
#pragma unroll
        for (int r = 0; r < 16; ++r) { const int t = mt * 32 + att::crow(r, hi), s = nt * 32 + l32; const float v = (s <= t) ? a[r] : 0.f; Ab[t * KP + s] = (bf16_t)(cvtpk(v, 0.f) & 0xffffu); }
    }
    __syncthreads();
    const int mt = wid & 1, nt = wid >> 1;
    f32x16 oacc[3];
    const float* Sb = UT + (size_t)(c * GH + h) * GDV * GDK;
#pragma unroll
    for (int vs = 0; vs < 3; ++vs) {
        for (int it = tid; it < 128 * 24; it += 512) { const int v = it / 24, kb = (it % 24) * 8; const float* p = Sb + (size_t)(vs * 128 + v) * GDK + kb;
            *(u32x4*)(ST + v * QP + kb) = pack8u(*(const f32x4*)p, *(const f32x4*)(p + 4)); }
        for (int it = tid; it < 64 * 16; it += 512) { const int s = it & 63, vb = it >> 6; const u32x4 w = *(const u32x4*)(z + (size_t)(row0 + s) * ZLD + ZV + h * GDV + vs * 128 + vb * 8);
#pragma unroll
            for (int i = 0; i < 4; ++i) { VT[(vb * 8 + 2 * i) * KP + s] = (bf16_t)(w[i] & 0xffffu); VT[(vb * 8 + 2 * i + 1) * KP + s] = (bf16_t)(w[i] >> 16); } }
        __syncthreads();
        f32x16 a = f32x16{};
#pragma unroll
        for (int ks = 0; ks < 12; ++ks) { const bf16x8 x = *(const bf16x8*)(Qp + (mt * 32 + l32) * QP + ks * 16 + hi * 8), y = *(const bf16x8*)(ST + (nt * 32 + l32) * QP + ks * 16 + hi * 8);
            a = __builtin_amdgcn_mfma_f32_32x32x16_bf16(x, y, a, 0, 0, 0); }
#pragma unroll
        for (int ks = 0; ks < 4; ++ks) { const bf16x8 x = *(const bf16x8*)(Ab + (mt * 32 + l32) * KP + ks * 16 + hi * 8), y = *(const bf16x8*)(VT + (nt * 32 + l32) * KP + ks * 16 + hi * 8);
            a = __builtin_amdgcn_mfma_f32_32x32x16_bf16(x, y, a, 0, 0, 0); }
        oacc[vs] = a;
        __syncthreads();
    }
#pragma unroll
    for (int r = 0; r < 16; ++r) { float q = oacc[0][r] * oacc[0][r] + oacc[1][r] * oacc[1][r] + oacc[2][r] * oacc[2][r];
        q += __shfl_xor(q, 1); q += __shfl_xor(q, 2); q += __shfl_xor(q, 4); q += __shfl_xor(q, 8); q += __shfl_xor(q, 16);
        if (l32 == 0) RS[(mt * 32 + att::crow(r, hi)) * 4 + nt] = q; }
    __syncthreads();
#pragma unroll
    for (int r = 0; r < 16; ++r) { const int t = mt * 32 + att::crow(r, hi); const f32x4 q4 = *(const f32x4*)(RS + t * 4);
        const float rstd = rsqrtf(((q4[0] + q4[1]) + (q4[2] + q4[3])) * (1.0f / GDV) + RMS_EPS);
#pragma unroll
        for (int vs = 0; vs < 3; ++vs) { const int cv = h * GDV + vs * 128 + nt * 32 + l32;
            const float gate = bf2f(z[(size_t)(row0 + t) * ZLD + ZR + cv]) + br[cv]; const float sg = gate / (1.f + __expf(-gate));
            const float val = oacc[vs][r] * rstd * ng[cv] * sg; const float vn = __shfl_xor(val, 1);
            if ((l32 & 1) == 0) *(unsigned*)(oc + (size_t)(row0 + t) * DM + cv) = cvtpk(val, vn); } }
    __syncthreads();
}
}

__device__ __forceinline__ int in_rowmap(int kind, int c) {
    if (kind == 0) return c < 4608 ? c : (c < 4620 ? 5120 + (c - 4608) : 4608 + (c - 4620));
    if (kind == 2) return c < 4608 ? c : (c < 4624 ? 5120 + (c - 4608) : 4608 + (c - 4624));
    return c;
}
__device__ __forceinline__ void tr_item(const float* W, int K, int N, bf16_t* WT, int kind, const float* gain, float* scr, int item, int lane) {
    const int nblk = (N + 31) >> 5, kb = item / nblk, nb = item - kb * nblk, k0 = 64 * kb, n0 = 32 * nb;
    const int nn = n0 + (lane & 31); const bool ok = nn < N;
    const float* src = W + (size_t)(k0 + (lane >> 5)) * N + (ok ? nn : 0);
    float v[32];
#pragma unroll
    for (int i = 0; i < 32; ++i) v[i] = src[(size_t)(2 * i) * N];
    if (gain) {
#pragma unroll
        for (int i = 0; i < 32; ++i) v[i] *= gain[k0 + 2 * i + (lane >> 5)];
    }
#pragma unroll
    for (int i = 0; i < 32; ++i) scr[(2 * i + (lane >> 5)) * 33 + (lane & 31)] = ok ? v[i] : 0.f;
    LDS_WAIT(); asm volatile("" ::: "memory");
    const int c = lane & 7;
#pragma unroll
    for (int j = 0; j < 4; ++j) { const int n = (lane >> 3) + 8 * j; const float* s = scr + (8 * c) * 33 + n;
        if (n0 + n < N) { u32x4 o; o[0] = cvtpk(s[0 * 33], s[1 * 33]); o[1] = cvtpk(s[2 * 33], s[3 * 33]); o[2] = cvtpk(s[4 * 33], s[5 * 33]); o[3] = cvtpk(s[6 * 33], s[7 * 33]);
            *(u32x4*)(WT + (size_t)in_rowmap(kind, n0 + n) * K + k0 + 8 * c) = o; } }
    LDS_WAIT(); asm volatile("" ::: "memory");
}
template <int NF4>
__device__ __forceinline__ void cvt_row2(const float* s0, bf16_t* d0, const float* s1, bf16_t* d1, int lane) {
    f32x4 a[NF4], b[NF4];
#pragma unroll
    for (int q = 0; q < NF4; ++q) { a[q] = *(const f32x4*)(s0 + q * 256 + lane * 4); b[q] = *(const f32x4*)(s1 + q * 256 + lane * 4); }
#pragma unroll
    for (int q = 0; q < NF4; ++q) { u32x2 w = {cvtpk(a[q][0], a[q][1]), cvtpk(a[q][2], a[q][3])}; *(u32x2*)(d0 + q * 256 + lane * 4) = w;
        u32x2 x = {cvtpk(b[q][0], b[q][1]), cvtpk(b[q][2], b[q][3])}; *(u32x2*)(d1 + q * 256 + lane * 4) = x; }
}

#ifndef EN_MASK
#define EN_MASK 0xFFFF
#endif
#define EN(k) ((EN_MASK >> (k)) & 1)
struct Args { const float* in[29]; float* out; unsigned char* ws; int ph_lo, ph_hi; };
constexpr int PPL = 9;
constexpr int PH_FINAL = 1 + PPL * NLAYER, PH_END = PH_FINAL + 1;
constexpr int PT_OFF = MISC_OFF + 256;
__device__ __forceinline__ unsigned long long ptab_raw(const char* lds, int k) {
    const unsigned long long v = ((const unsigned long long*)(lds + PT_OFF))[k];
    const unsigned l = __builtin_amdgcn_readfirstlane((unsigned)v), h = __builtin_amdgcn_readfirstlane((unsigned)(v >> 32));
    return ((unsigned long long)h << 32) | l;
}
#define PIN(k) ((const float*)(const GAS float*)ptab_raw(lds, (k)))
#define POUT() ((float*)(GAS float*)ptab_raw(lds, 29))
#define PWS() ((unsigned char*)(GAS unsigned char*)ptab_raw(lds, 30))

__global__ void __launch_bounds__(512, 2) trunk_fwd(Args args) {
    extern __shared__ __attribute__((aligned(16))) unsigned char lds_raw[];
    char* lds = (char*)lds_raw;
    volatile LAS unsigned* MISC = (volatile LAS unsigned*)((LAS unsigned char*)lds_raw + MISC_OFF);
    for (int u = threadIdx.x; u < 64; u += 512) MISC[u] = 0u;
    if (threadIdx.x < 29) ((unsigned long long*)(lds + PT_OFF))[threadIdx.x] = (unsigned long long)args.in[threadIdx.x];
    if (threadIdx.x == 29) ((unsigned long long*)(lds + PT_OFF))[29] = (unsigned long long)args.out;
    if (threadIdx.x == 30) ((unsigned long long*)(lds + PT_OFF))[30] = (unsigned long long)args.ws;
    const int g_wave = __builtin_amdgcn_readfirstlane(threadIdx.x >> 6);
    __syncthreads();
    const int G = gridDim.x, bx = blockIdx.x, vcu = (G % 8 == 0) ? (bx % 8) * (G / 8) + bx / 8 : bx;
#if !MK_PER_PHASE
    const XcdBarrier bar = xcd_barrier_post((unsigned*)(args.ws + WS_CTL) + CW_BAR, MISC + 8);
#define GRID_BAR() xcd_barrier(bar)
#else
#define GRID_BAR() do { } while (0)
#endif
    const int lo = args.ph_lo, hi = args.ph_hi;
#define IN(k) (lo <= (k) && (k) < hi)
#define SEAM(k) do { if ((k) + 1 < hi) GRID_BAR(); } while (0)
#define WSP(T, off) ((T*)(ws + (off)))

    if (EN(0) && IN(0)) {
        unsigned char* ws = PWS();
        const int tid = opaque_tid(), lane = tid & 63, wave = tid >> 6, gw = vcu * 8 + wave, NGW = G * 8;
        float* scr = (float*)(lds + wave * 16384);
        for (int L = 0; L < NLAYER; ++L) {
            const int kind = L % 3, j = L / 3;
            const float* win = kind == 0 ? PIN(16) + (size_t)j * DM * 5132 : (kind == 1 ? PIN(19) : PIN(21)); const int nin = kind == 0 ? 5132 : (kind == 1 ? 5120 : 5136);
            const float* wout = kind == 0 ? PIN(18) + (size_t)j * DM * DM : (kind == 1 ? PIN(20) : PIN(26));
            for (int it = gw; it < 32 * ((nin + 31) / 32); it += NGW) tr_item(win, DM, nin, WSP(bf16_t, WS_WIN) + (size_t)L * ZLD * DM, kind, PIN(11) + L * DM, scr, it, lane);
            for (int it = gw; it < 32 * 64; it += NGW) tr_item(wout, DM, DM, WSP(bf16_t, WS_WOUT) + (size_t)L * DM * DM, 1, nullptr, scr, it, lane);
            for (int it = gw; it < 32 * 256; it += NGW) tr_item(PIN(27) + (size_t)L * DM * DFF, DM, DFF, WSP(bf16_t, WS_WUP) + (size_t)L * DFF * DM, 1, PIN(12) + L * DM, scr, it, lane);
            for (int it = gw; it < 128 * 64; it += NGW) tr_item(PIN(28) + (size_t)L * DFF * DM, DFF, DM, WSP(bf16_t, WS_WDN) + (size_t)L * DM * DFF, 1, nullptr, scr, it, lane);
            for (int it = gw; it < 32 * 32; it += NGW) tr_item(PIN(15) + (size_t)L * DM * 1024, DM, 1024, WSP(bf16_t, WS_WMKV) + (size_t)L * 1024 * DM, 1, nullptr, scr, it, lane);
        }
        { const float* xp = PIN(0); const float* xs = PIN(1); float* X = WSP(float, WS_X); bf16_t* XB = WSP(bf16_t, WS_XB); float* RSA = WSP(float, WS_RSS);
        for (int m = gw; m < MT; m += NGW) {
            const float* src = m < TP ? xp + (size_t)m * DM : xs + (size_t)(m - TP) * DM; float ss = 0.f;
#pragma unroll
            for (int q = 0; q < 8; ++q) { const int o = q * 256 + lane * 4; const f32x4 v = *(const f32x4*)(src + o); *(f32x4*)(X + (size_t)m * DM + o) = v;
                u32x2 w = {cvtpk(v[0], v[1]), cvtpk(v[2], v[3])}; *(u32x2*)(XB + (size_t)m * DM + o) = w; ss += (v[0] * v[0] + v[1] * v[1]) + (v[2] * v[2] + v[3] * v[3]); }
            ss = wave_sum(ss);
            if (lane < 32) RSA[(size_t)m * 32 + lane] = lane == 0 ? ss : 0.f;
        } }
        { const float* mp = PIN(10); const float* gm = PIN(13); bf16_t* MEMH = WSP(bf16_t, WS_MEMH);
        for (int it = gw; it < NLAYER * NMEM; it += NGW) { const int i = it / NMEM, r = it % NMEM; const float* src = mp + (size_t)r * DM; const float* g = gm + (size_t)i * DM;
            f32x4 v[8]; float ss = 0.f;
#pragma unroll
            for (int q = 0; q < 8; ++q) { v[q] = *(const f32x4*)(src + q * 256 + lane * 4); ss += (v[q][0] * v[q][0] + v[q][1] * v[q][1]) + (v[q][2] * v[q][2] + v[q][3] * v[q][3]); }
            const float rstd = rsqrtf(wave_sum(ss) * (1.0f / DM) + RMS_EPS);
#pragma unroll
            for (int q = 0; q < 8; ++q) { const f32x4 gg = *(const f32x4*)(g + q * 256 + lane * 4); u32x2 w = {cvtpk(v[q][0] * rstd * gg[0], v[q][1] * rstd * gg[1]), cvtpk(v[q][2] * rstd * gg[2], v[q][3] * rstd * gg[3])};
                *(u32x2*)(MEMH + ((size_t)i * NMEM + r) * DM + q * 256 + lane * 4) = w; } } }
        { const float* ck = PIN(2); const float* cv = PIN(3); bf16_t* KVF = WSP(bf16_t, WS_KVF);
        for (int it = gw; it < 2 * NB * PAST; it += NGW) { const int jj = it / (NB * PAST), r = it % (NB * PAST); const size_t so = ((size_t)jj * NB * PAST + r) * AW, dof = ((size_t)(r / PAST) * SKS + (r % PAST)) * AW;
            cvt_row2<6>(ck + so, KVF + (size_t)(2 * jj) * (KVS_ONE / 2) + dof, cv + so, KVF + (size_t)(2 * jj + 1) * (KVS_ONE / 2) + dof, lane); } }
        { const float* ck = PIN(5); const float* cv = PIN(6); bf16_t* KVS = WSP(bf16_t, WS_KVS);
        for (int r = gw; r < NB * PAST; r += NGW) { const size_t so = (size_t)r * AW, dof = ((size_t)(r / PAST) * SKS + (r % PAST)) * AW;
            cvt_row2<6>(ck + so, KVS + dof, cv + so, KVS + KVS_ONE / 2 + dof, lane); } }
        { const float* ck = PIN(8); const float* cv = PIN(9); bf16_t* MEMC = WSP(bf16_t, WS_MEMC);
        for (int it = gw; it < NLAYER * NB * NMEM; it += NGW) { const int L = it / (NB * NMEM), r = it % (NB * NMEM); const size_t so = ((size_t)L * NB * NMEM + r) * MEMW, dof = (size_t)r * MEMW;
            cvt_row2<2>(ck + so, MEMC + (size_t)(2 * L) * (MEMC_ONE / 2) + dof, cv + so, MEMC + (size_t)(2 * L + 1) * (MEMC_ONE / 2) + dof, lane); } }
        SEAM(0);
    }

    for (int L = 0; L < NLAYER; ++L) {
        const int kind = L % 3, j = L / 3, base = 1 + PPL * L;
        if (EN(1) && IN(base + 0)) {
            unsigned char* ws = PWS();
            const int tid = opaque_tid();
            pg8::Sched S; S.nM = MT / 256; S.nN = kind == 1 ? 20 : 21; S.nwg = S.nM * S.nN; S.G = G; S.c = bx; S.nextra = L == 0 ? 16 : 0;
            S.A = (const char*)WSP(bf16_t, WS_XB); S.B = (const char*)(WSP(bf16_t, WS_WIN) + (size_t)L * ZLD * DM); S.tA = (size_t)256 * DM * 2; S.tB = (size_t)256 * DM * 2;
            S.Ae = (const char*)WSP(bf16_t, WS_MEMH); S.Be = (const char*)WSP(bf16_t, WS_WMKV); S.tAe = (size_t)NMEM * DM * 2; S.tBe = (size_t)256 * DM * 2;
            pg8::EpiIn E; E.z = WSP(bf16_t, WS_Z); E.rss = WSP(float, WS_RSS); E.out = POUT(); E.mkvb = WSP(bf16_t, WS_MKVB); E.kind = kind; E.j = j;
            E.kvb = kind == 0 ? WSP(bf16_t, WS_KVF) + (size_t)(2 * j) * (KVS_ONE / 2) : WSP(bf16_t, WS_KVS); E.bfg = PIN(17) + j * NH;
            pg8::gemm_phase<pg8::EpiIn, pg8::Sched>((LAS unsigned char*)lds_raw, DM, DM, DM, S, E, tid);
            SEAM(base + 0);
        }
        if (IN(base + 1) && kind != 0) {
            unsigned char* ws = PWS();
            if (EN(2) && kind == 1) {
                bf16_t* Z = WSP(bf16_t, WS_Z); bf16_t* OC = WSP(bf16_t, WS_OC); bf16_t* KVS = WSP(bf16_t, WS_KVS);
                for (int n = vcu; n < 480; n += G) { att::Blk b; b.ldq = ZLD; b.ldo = DM; b.bmode = 0; b.lf0 = b.lf1 = nullptr; b.n0 = 0;
                    if (n < 384) { const int h = n / 32, qb = n % 32; b.Q = Z + (size_t)qb * 256 * ZLD + h * HD; b.K = Z + AW + h * HD; b.V = Z + 2 * AW + h * HD; b.ldkv = ZLD;
                        b.O = OC + (size_t)qb * 256 * DM + h * HD; b.P0 = qb * 256; b.skv = TP; b.nrows = 256; }
                    else { const int m = n - 384, bb = m / NH, h = m % NH; b.Q = Z + (size_t)(TP + bb * 64) * ZLD + h * HD; b.K = KVS + (size_t)bb * SKS * AW + h * HD; b.V = KVS + KVS_ONE / 2 + (size_t)bb * SKS * AW + h * HD; b.ldkv = AW;
                        b.O = OC + (size_t)(TP + bb * 64) * DM + h * HD; b.P0 = PAST; b.skv = SKS; b.nrows = 64; }
                    att::sb_block(b, lds, g_wave); }
            } else if (EN(3) && kind == 2) {
                for (int u = vcu; u < NCHUNK * GH; u += G) gla::g1_unit(u / GH, u % GH, WSP(bf16_t, WS_Z), PIN(22), PIN(23), WSP(float, WS_GU), WSP(float, WS_GDEC), lds, g_wave);
            }
            SEAM(base + 1);
        }
        if (EN(4) && IN(base + 2) && kind == 2) {
            unsigned char* ws = PWS();
            const int tid = opaque_tid();
            if (vcu < 144) gla::g2_tile(vcu, WSP(float, WS_GU), WSP(float, WS_GDEC), PIN(7), POUT() + O_GSP, POUT() + O_GSS, lds, tid);
            SEAM(base + 2);
        }
        if (IN(base + 3)) {
            unsigned char* ws = PWS();
            if (EN(5) && kind == 2) for (int u = vcu; u < NCHUNK * GH; u += G) gla::g3_unit(u / GH, u % GH, WSP(bf16_t, WS_Z), PIN(22), PIN(23), WSP(float, WS_GU), PIN(25), PIN(24), WSP(bf16_t, WS_OC), lds, g_wave);
            const float* outp = POUT(); const float* lfc = PIN(4);
            auto get = [&](int i, att::Blk& b) -> bool {
                int type, a0, a1;
                if (kind == 0) {
                    if (vcu < 192) { if (i > 1) return false; type = 0; a0 = vcu / 16; a1 = i == 0 ? vcu % 16 : 31 - vcu % 16; }
                    else { if (i > 3) return false; const int s = (vcu - 192) + 64 * i; if (s < 96) { type = 1; a0 = s / NH; a1 = s % NH; } else if (s < 224) { type = 2; a0 = (s - 96) / 32; a1 = (s - 96) % 32; } else { type = 3; a0 = (s - 224) / MH; a1 = (s - 224) % MH; } }
                } else { const int n = vcu + G * i; if (n >= 160) return false; if (n < 128) { type = 2; a0 = n / 32; a1 = n % 32; } else { type = 3; a0 = (n - 128) / MH; a1 = (n - 128) % MH; } }
                bf16_t* Z = WSP(bf16_t, WS_Z); bf16_t* OC = WSP(bf16_t, WS_OC);
                b.ldq = ZLD; b.ldo = DM; b.lf0 = b.lf1 = nullptr; b.n0 = 0; b.bmode = 0;
                if (type == 0) { const int h = a0, qb = a1; b.Q = Z + (size_t)qb * 256 * ZLD + h * HD; b.K = Z + AW + h * HD; b.V = Z + 2 * AW + h * HD; b.ldkv = ZLD; b.O = OC + (size_t)qb * 256 * DM + h * HD;
                    b.P0 = qb * 256; b.skv = TP; b.nrows = 256; b.bmode = 1; b.lf0 = outp + O_FLP + (size_t)j * TP * NH + h; b.n0 = 1 << 30; }
                else if (type == 1) { const int bb = a0, h = a1; const bf16_t* fk = WSP(bf16_t, WS_KVF) + (size_t)(2 * j) * (KVS_ONE / 2);
                    b.Q = Z + (size_t)(TP + bb * 64) * ZLD + h * HD; b.K = fk + (size_t)bb * SKS * AW + h * HD; b.V = fk + KVS_ONE / 2 + (size_t)bb * SKS * AW + h * HD; b.ldkv = AW;
                    b.O = OC + (size_t)(TP + bb * 64) * DM + h * HD; b.P0 = PAST; b.skv = SKS; b.nrows = 64; b.bmode = 1; b.lf0 = lfc + ((size_t)j * NB + bb) * PAST * NH + h; b.n0 = PAST; b.lf1 = outp + O_FLS + (size_t)j * TS * NH + (size_t)bb * 64 * NH + h; }
                else if (type == 2) { const int h4 = a0, qb = a1; const bf16_t* mkb = WSP(bf16_t, WS_MKVB) + (size_t)L * NMEM * 1024;
                    b.Q = Z + (size_t)qb * 256 * ZLD + 4608 + h4 * HD; b.K = mkb + h4 * HD; b.V = mkb + MEMW + h4 * HD; b.ldkv = 1024; b.O = OC + (size_t)qb * 256 * DM + AW + h4 * HD;
                    b.P0 = 1 << 20; b.skv = NMEM; b.nrows = 256; }
                else { const int bb = a0, h4 = a1; const bf16_t* mck = WSP(bf16_t, WS_MEMC) + (size_t)(2 * L) * (MEMC_ONE / 2);
                    b.Q = Z + (size_t)(TP + bb * 64) * ZLD + 4608 + h4 * HD; b.K = mck + (size_t)bb * NMEM * MEMW + h4 * HD; b.V = mck + MEMC_ONE / 2 + (size_t)bb * NMEM * MEMW + h4 * HD; b.ldkv = MEMW;
                    b.O = OC + (size_t)(TP + bb * 64) * DM + AW + h4 * HD; b.P0 = 1 << 20; b.skv = NMEM; b.nrows = 64; }
                return true;
            };
            att::Blk cur, nxt;
            if (EN(6) && get(0, cur)) {
                att::Seam S; att::att_prime(cur, lds, S, g_wave);
                for (int i = 0;; ++i) { const bool more = get(i + 1, nxt); if (!more) nxt = cur;
                    att::prepare_bias(cur, lds, g_wave); att::att_block(cur, nxt, lds, S, g_wave);
                    if (!more) break; cur = nxt; }
            }
            SEAM(base + 3);
        }
        for (int q = 4; q <= 8; ++q) {
            if (!IN(base + q)) continue;
            unsigned char* ws = PWS();
            const bool dn = q >= 7;
            float* rssw = WSP(float, WS_RSS) + (dn ? 0 : (size_t)MT * 32);
            const int SP = dn ? 16 : 8;
            if (q == 4 || q == 7) {
                if (EN(7)) {
                const int tid = opaque_tid();
                const int K = dn ? DFF : DM; const char* Ab = dn ? (const char*)WSP(bf16_t, WS_U) : (const char*)WSP(bf16_t, WS_OC);
                const char* Bb = dn ? (const char*)(WSP(bf16_t, WS_WDN) + (size_t)L * DM * DFF) : (const char*)(WSP(bf16_t, WS_WOUT) + (size_t)L * DM * DM);
                { pg8::Sched S; S.nM = TP / 256; S.nN = DM / 256; S.nwg = S.nM * S.nN; S.G = G; S.c = bx; S.nextra = 0;
                  S.A = Ab; S.B = Bb; S.tA = (size_t)256 * K * 2; S.tB = (size_t)256 * K * 2; S.Ae = S.Be = nullptr; S.tAe = S.tBe = 0;
                  pg8::EpiRes E{WSP(float, WS_X), WSP(bf16_t, WS_XB), rssw};
                  pg8::gemm_phase<pg8::EpiRes, pg8::Sched>((LAS unsigned char*)lds_raw, K, K, K, S, E, tid); }
                { pg8::SchedSplit S; S.S = SP; S.nu = 16 * SP; S.G = G; S.c = bx; S.A = Ab; S.B = Bb; S.tA = (size_t)256 * K * 2; S.tB = (size_t)256 * K * 2; S.kbytes = (size_t)(K / SP) * 2;
                  pg8::EpiPart E{WSP(float, WS_GU)};
                  pg8::gemm_phase<pg8::EpiPart, pg8::SchedSplit>((LAS unsigned char*)lds_raw, K / SP, K, K, S, E, tid); }
                }
            } else if (q == 5 || q == 8) {
                if (EN(8)) {
                const int tid = opaque_tid(), lane = tid & 63, wave = tid >> 6;
                float* X = WSP(float, WS_X); bf16_t* XB = WSP(bf16_t, WS_XB); const float* part = WSP(float, WS_GU);
                for (int r = vcu; r < TS; r += G) { const size_t o = (size_t)(TP + r) * DM + tid * 4; const float* pp = part + (size_t)r * DM + tid * 4;
                    f32x4 a = *(const f32x4*)(X + o); f32x4 p[16];
#pragma unroll
                    for (int s = 0; s < 16; ++s) p[s] = s < SP ? *(const f32x4*)(pp + (size_t)s * TS * DM) : (f32x4){0.f, 0.f, 0.f, 0.f};
#pragma unroll
                    for (int s = 0; s < 16; ++s) a += p[s];
                    *(f32x4*)(X + o) = a; u32x2 w = {cvtpk(a[0], a[1]), cvtpk(a[2], a[3])}; *(u32x2*)(XB + o) = w;
                    const float ss = wave_sum((a[0] * a[0] + a[1] * a[1]) + (a[2] * a[2] + a[3] * a[3]));
                    if (lane < 4) rssw[(size_t)(TP + r) * 32 + wave + 8 * lane] = lane == 0 ? ss : 0.f; }
                }
            } else {
                if (EN(9)) {
                const int tid = opaque_tid();
                pg8::Sched S; S.nM = MT / 256; S.nN = DFF / 256; S.nwg = S.nM * S.nN; S.G = G; S.c = bx; S.nextra = 0;
                S.A = (const char*)WSP(bf16_t, WS_XB); S.B = (const char*)(WSP(bf16_t, WS_WUP) + (size_t)L * DFF * DM); S.tA = (size_t)256 * DM * 2; S.tB = (size_t)256 * DM * 2; S.Ae = S.Be = nullptr; S.tAe = S.tBe = 0;
                pg8::EpiUp E{WSP(bf16_t, WS_U), WSP(float, WS_RSS) + (size_t)MT * 32};
                pg8::gemm_phase<pg8::EpiUp, pg8::Sched>((LAS unsigned char*)lds_raw, DM, DM, DM, S, E, tid);
                }
            }
            SEAM(base + q);
        }
    }
    if (EN(10) && IN(PH_FINAL)) {
        unsigned char* ws = PWS(); float* out = POUT();
        const int tid = opaque_tid(), lane = tid & 63, wave = tid >> 6, gw = vcu * 8 + wave, NGW = G * 8;
        const float* g = PIN(14); const float* X = WSP(float, WS_X); const float* RSA = WSP(float, WS_RSS);
        for (int m = gw; m < MT; m += NGW) {
            const float rstd = rsqrtf(wave_sum(lane < 32 ? RSA[(size_t)m * 32 + lane] : 0.f) * (1.0f / DM) + RMS_EPS); float* dst = m < TP ? out + O_YP + (size_t)m * DM : out + O_YS + (size_t)(m - TP) * DM;
#pragma unroll
            for (int q = 0; q < 8; ++q) { const int o = q * 256 + lane * 4; const f32x4 v = *(const f32x4*)(X + (size_t)m * DM + o), gg = *(const f32x4*)(g + o); *(f32x4*)(dst + o) = v * rstd * gg; }
        }
    }
#undef IN
#undef SEAM
#undef GRID_BAR
}

extern "C" void kernel_launch(void* const* d_in, const int* in_sizes, int n_in, void* d_out, int out_size, void* d_ws, size_t ws_size, hipStream_t stream) {
    static int grid = 0;
    if (grid == 0) {
        if (n_in != 29 || (size_t)out_size != O_END || ws_size < WS_END) { fprintf(stderr, "kernel_launch: unexpected shapes (n_in %d, out %d vs %zu, ws %zu vs %zu); nothing launched\n", n_in, out_size, (size_t)O_END, ws_size, (size_t)WS_END); grid = -1; return; }
        int dev = 0, cus = 0, per_cu = 0;
        if (hipGetDevice(&dev) != hipSuccess || hipDeviceGetAttribute(&cus, hipDeviceAttributeMultiprocessorCount, dev) != hipSuccess) { grid = -1; return; }
        if (hipFuncSetAttribute((const void*)trunk_fwd, hipFuncAttributeMaxDynamicSharedMemorySize, LDS_BYTES) != hipSuccess) { fprintf(stderr, "kernel_launch: hipFuncSetAttribute failed\n"); grid = -1; return; }
        if (hipOccupancyMaxActiveBlocksPerMultiprocessor(&per_cu, (const void*)trunk_fwd, 512, LDS_BYTES) != hipSuccess || per_cu < 1) fprintf(stderr, "kernel_launch: occupancy query reports %d workgroups per CU\n", per_cu);
        (void)hipGetLastError();
        grid = cus;
    }
    if (grid < 0) return;
    if (hipMemsetAsync((char*)d_ws + WS_CTL, 0, CTL_BYTES, stream) != hipSuccess) return;
    Args a{};
    for (int i = 0; i < 29; ++i) a.in[i] = (const float*)d_in[i];
    a.out = (float*)d_out; a.ws = (unsigned char*)d_ws;
#if MK_PER_PHASE
    for (int p = 0; p < PH_END; ++p) {
        if (p >= 1 && p < PH_FINAL) { const int L = (p - 1) / PPL, q = (p - 1) % PPL, kind = L % 3; if ((q == 1 && kind == 0) || (q == 2 && kind != 2)) continue; }
        a.ph_lo = p; a.ph_hi = p + 1;
        hipLaunchKernelGGL(trunk_fwd, dim3(grid), dim3(512), LDS_BYTES, stream, a);
#ifdef PROBE_REPEAT_PHASE
        if (p == PROBE_REPEAT_PHASE) hipLaunchKernelGGL(trunk_fwd, dim3(grid), dim3(512), LDS_BYTES, stream, a);
#endif
    }
#else
    a.ph_lo = 0; a.ph_hi = PH_END;
    hipLaunchKernelGGL(trunk_fwd, dim3(grid), dim3(512), LDS_BYTES, stream, a);
#endif
}
```

```cpp
#include <hip/hip_runtime.h>
#include <hip/hip_bf16.h>
#include <cstdio>
#include <cstdint>

#define MK_PER_PHASE 0
#ifndef MK_PER_PHASE
#define MK_PER_PHASE 0
#endif

constexpr int DM = 2048, TP = 8192, TS = 512, MT = TP + TS, NB = 8, CSEQ = 64, PAST = 1024, SKS = PAST + CSEQ;
constexpr int HD = 128, NH = 12, AW = NH * HD, MEMW = 512, NMEM = 256, MH = 4;
constexpr int GH = 4, GDK = 192, GDV = 384, GKW = GH * GDK, GVW = GH * GDV, GRANK = 16;
constexpr int DFF = 8192, ZLD = 5376, NLAYER = 4;
constexpr int NCHUNK = TP / 64 + NB;
constexpr float RMS_EPS = 1e-6f;

constexpr size_t O_YP = 0;
constexpr size_t O_YS = O_YP + (size_t)TP * DM;
constexpr size_t O_FKP = O_YS + (size_t)TS * DM;
constexpr size_t O_FVP = O_FKP + (size_t)2 * TP * AW;
constexpr size_t O_FLP = O_FVP + (size_t)2 * TP * AW;
constexpr size_t O_SKP = O_FLP + (size_t)2 * TP * NH;
constexpr size_t O_SVP = O_SKP + (size_t)TP * AW;
constexpr size_t O_GSP = O_SVP + (size_t)TP * AW;
constexpr size_t O_MKP = O_GSP + (size_t)GH * GDK * GDV;
constexpr size_t O_MVP = O_MKP + (size_t)NLAYER * NMEM * MEMW;
constexpr size_t O_FKS = O_MVP + (size_t)NLAYER * NMEM * MEMW;
constexpr size_t O_FVS = O_FKS + (size_t)2 * TS * AW;
constexpr size_t O_FLS = O_FVS + (size_t)2 * TS * AW;
constexpr size_t O_SKS = O_FLS + (size_t)2 * TS * NH;
constexpr size_t O_SVS = O_SKS + (size_t)TS * AW;
constexpr size_t O_GSS = O_SVS + (size_t)TS * AW;
constexpr size_t O_END = O_GSS + (size_t)NB * GH * GDK * GDV;

constexpr size_t al256(size_t x) { return (x + 255) & ~(size_t)255; }
constexpr size_t WS_CTL = 0, CTL_BYTES = 2u << 20;
constexpr size_t WS_WIN = CTL_BYTES;
constexpr size_t WS_WOUT = WS_WIN + (size_t)NLAYER * ZLD * DM * 2;
constexpr size_t WS_WUP = WS_WOUT + (size_t)NLAYER * DM * DM * 2;
constexpr size_t WS_WDN = WS_WUP + (size_t)NLAYER * DFF * DM * 2;
constexpr size_t WS_WMKV = WS_WDN + (size_t)NLAYER * DM * DFF * 2;
constexpr size_t WS_X = WS_WMKV + (size_t)NLAYER * 1024 * DM * 2;
constexpr size_t WS_XB = WS_X + (size_t)MT * DM * 4;
constexpr size_t WS_Z = WS_XB + (size_t)MT * DM * 2;
constexpr size_t WS_OC = WS_Z + (size_t)MT * ZLD * 2;
constexpr size_t WS_U = WS_OC + (size_t)MT * DM * 2;
constexpr size_t WS_GU = WS_U + (size_t)MT * DFF * 2;
constexpr size_t WS_GDEC = WS_GU + (size_t)NCHUNK * GH * GDV * GDK * 4;
constexpr size_t WS_KVF = al256(WS_GDEC + (size_t)NCHUNK * GH * GDK * 4);
constexpr size_t KVS_ONE = (size_t)NB * SKS * AW * 2;
constexpr size_t WS_KVS = WS_KVF + 4 * KVS_ONE;
constexpr size_t WS_MEMC = WS_KVS + 2 * KVS_ONE;
constexpr size_t MEMC_ONE = (size_t)NB * NMEM * MEMW * 2;
constexpr size_t WS_MEMH = WS_MEMC + 8 * MEMC_ONE;
constexpr size_t WS_MKVB = WS_MEMH + (size_t)NLAYER * NMEM * DM * 2;
constexpr size_t WS_RSS = WS_MKVB + (size_t)NLAYER * NMEM * 1024 * 2;
constexpr size_t WS_END = WS_RSS + (size_t)2 * MT * 32 * 4;

constexpr int CW_BAR = 4096;
constexpr int CW_QUEUE = 8192;
constexpr int CW_KQ = 12288;
constexpr int CW_QQ = 16384;

constexpr int LDS_WORK = 136 * 1024;
constexpr int MISC_OFF = LDS_WORK;
constexpr int LDS_BYTES = 147456;

#define GAS __attribute__((address_space(1)))
#define LAS __attribute__((address_space(3)))
typedef unsigned short bf16_t;
typedef unsigned u32x4 __attribute__((ext_vector_type(4)));
typedef unsigned u32x2 __attribute__((ext_vector_type(2)));
typedef float f32x4 __attribute__((ext_vector_type(4)));
typedef float f32x2 __attribute__((ext_vector_type(2)));
typedef float f32x16 __attribute__((ext_vector_type(16)));
typedef short bf16x8 __attribute__((ext_vector_type(8)));
typedef short s16x4 __attribute__((ext_vector_type(4)));
#define LDS_WAIT() asm volatile("s_waitcnt lgkmcnt(0)" ::: "memory")
#define VM_WAIT() asm volatile("s_waitcnt vmcnt(0)" ::: "memory")
#define SBAR() __builtin_amdgcn_sched_barrier(0)
__device__ __forceinline__ unsigned cvtpk(float lo, float hi) { unsigned r; asm volatile("v_cvt_pk_bf16_f32 %0, %1, %2" : "=v"(r) : "v"(lo), "v"(hi)); return r; }
__device__ __forceinline__ float bf2f(unsigned short b) { return __uint_as_float((unsigned)b << 16); }
__device__ __forceinline__ u32x4 pack8u(f32x4 a, f32x4 b) { u32x4 w = {cvtpk(a[0], a[1]), cvtpk(a[2], a[3]), cvtpk(b[0], b[1]), cvtpk(b[2], b[3])}; return w; }
__device__ __forceinline__ bf16x8 pack8(f32x4 a, f32x4 b) { u32x4 w = pack8u(a, b); return *reinterpret_cast<bf16x8*>(&w); }
__device__ __forceinline__ float wave_sum(float v) {
#pragma unroll
    for (int o = 1; o < 64; o <<= 1) v += __shfl_xor(v, o);
    return v;
}
__device__ __forceinline__ float log_sigmoidf(float x) { return fminf(x, 0.f) - log1pf(expf(-fabsf(x))); }
__device__ __forceinline__ int opaque_tid_w(int wave) { int l; asm volatile("v_mbcnt_lo_u32_b32 %0, -1, 0\n\tv_mbcnt_hi_u32_b32 %0, -1, %0" : "=v"(l)); return wave * 64 + l; }
#define opaque_tid() opaque_tid_w(g_wave)
template <class T> __device__ __forceinline__ T* launder_s(T* p) { asm volatile("" : "+s"(p)); return p; }
#define XB_TMO      128
#define XB_XCNT(j)  (256  + 64 * (j))
#define XB_XSUB(j)  (1280 + 64 * (j))
#define XB_XGEN(j)  (2304 + 64 * (j))
#define XB_TOP      3328
#define XB_TOPGEN   3392
#define XCD_BAR_WORDS 3456
#define XB_SPIN_CAP (1u << 18)
__device__ __forceinline__ unsigned xb_ld(unsigned* p)              { return __hip_atomic_load(p, __ATOMIC_RELAXED, __HIP_MEMORY_SCOPE_AGENT); }
__device__ __forceinline__ unsigned xb_add(unsigned* p, unsigned v) { return __hip_atomic_fetch_add(p, v, __ATOMIC_RELAXED, __HIP_MEMORY_SCOPE_AGENT); }
__device__ __forceinline__ unsigned xb_xcc_id() { return (unsigned)__builtin_amdgcn_s_getreg((3 << 11) | 20) & 0xFu; }
#define XB_SPIN(cond, bar) do { unsigned _sp = 0; while (cond) { __builtin_amdgcn_s_sleep(1); \
    if ((++_sp & 255u) == 0u) { if (xb_ld(&(bar)[XB_TMO])) break; if (_sp > XB_SPIN_CAP) { atomicAdd(&(bar)[XB_TMO], 1u); break; } } } } while (0)
struct XcdBarrier { unsigned* bar; unsigned x; volatile LAS unsigned* st; };
__device__ __forceinline__ XcdBarrier xcd_barrier_post(unsigned* bar, volatile LAS unsigned* st) {
    XcdBarrier b; b.bar = bar; b.x = xb_xcc_id(); b.st = st;
    if (threadIdx.x == 0) (void)xb_add(&bar[XB_XCNT(b.x)], 1u);
    return b;
}
__device__ __forceinline__ void xcd_barrier_complete(unsigned* bar, unsigned x, unsigned& nloc, unsigned& nx) {
    const unsigned G = gridDim.x * gridDim.y * gridDim.z;
    unsigned sum, cnt, mine, sp = 0u;
    for (;;) {
        sum = 0u; cnt = 0u; mine = 0u;
#pragma unroll
        for (unsigned j = 0; j < 16; ++j) { const unsigned c = xb_ld(&bar[XB_XCNT(j)]); sum += c; cnt += (c > 0u) ? 1u : 0u; mine = (j == x) ? c : mine; }
        if (sum == G) break;
        __builtin_amdgcn_s_sleep(1);
        if ((++sp & 255u) == 0u) { if (xb_ld(&bar[XB_TMO])) break; if (sp > XB_SPIN_CAP) { atomicAdd(&bar[XB_TMO], 1u); break; } }
    }
    nloc = mine > 0u ? mine : 1u; nx = cnt > 0u ? cnt : 1u;
}
__device__ __forceinline__ void xcd_barrier(const XcdBarrier& b) {
    asm volatile("s_waitcnt vmcnt(0)" ::: "memory");
    __syncthreads();
    if (threadIdx.x == 0) {
        unsigned* bar = b.bar;
        __builtin_amdgcn_s_waitcnt(0);
        unsigned nloc = b.st[0], nx = b.st[1];
        if (nloc == 0u) { xcd_barrier_complete(bar, b.x, nloc, nx); b.st[0] = nloc; b.st[1] = nx; }
        const unsigned old = xb_add(&bar[XB_XSUB(b.x)], 1u);
        const unsigned gen = old / nloc;
        if (old + 1u == (gen + 1u) * nloc) {
            __builtin_amdgcn_fence(__ATOMIC_RELEASE, "agent");
            asm volatile("s_waitcnt vmcnt(0)" ::: "memory");
            const unsigned og = xb_add(&bar[XB_TOP], 1u);
            const unsigned tg = og / nx;
            if (og + 1u == (tg + 1u) * nx) xb_add(&bar[XB_TOPGEN], 1u);
            else XB_SPIN(xb_ld(&bar[XB_TOPGEN]) == tg, bar);
            __builtin_amdgcn_fence(__ATOMIC_ACQUIRE, "agent");
            xb_add(&bar[XB_XGEN(b.x)], 1u);
            asm volatile("s_waitcnt vmcnt(0)" ::: "memory");
        } else {
            XB_SPIN(xb_ld(&bar[XB_XGEN(b.x)]) == gen, bar);
            __builtin_amdgcn_fence(__ATOMIC_ACQUIRE, "agent");
            asm volatile("s_waitcnt vmcnt(0)" ::: "memory");
        }
    }
    __syncthreads();
}

namespace pg8 {
constexpr int BM = 256, BK = 64, HALF = 128, HTB = HALF * BK * 2, STAGE_BYTES = 8 * HTB, NXCD = 8, WGM = 8;
__host__ __device__ __forceinline__ int lds_byte(int r, int c) { const int st = (r >> 4) * 2 + (c >> 5), rr = r & 15, cc = c & 31, ob = rr * 64 + cc * 2; return st * 1024 + (ob ^ (((ob >> 9) & 1) << 5)); }
__host__ __device__ __forceinline__ void stage_rc(int b, int& R, int& C) { const int st = b / 1024, sb = b % 1024, swz = sb ^ (((sb >> 9) & 1) << 5); R = (st >> 1) * 16 + swz / 64; C = (st & 1) * 32 + (swz % 64) / 2; }
__host__ __device__ __forceinline__ int perm32(int rho) { const int n = rho >> 4, i = rho & 15; return 8 * (i >> 2) + 4 * n + (i & 3); }

struct Unit { int pm, pn, g; const char* A; const char* B; };

struct Sched {
    int nM, nN, nwg, G, c, nextra;
    const char* A; const char* B; size_t tA, tB;
    const char* Ae; const char* Be; size_t tAe, tBe;
    __device__ __forceinline__ bool next(int i, Unit& u) const {
        const long L = (long)i * G + c; if (L >= nwg + nextra) return false;
        if (L >= nwg) { const int e = (int)(L - nwg); u.g = 1 + (e >> 2); u.pm = 0; u.pn = e & 3; u.A = Ae + (size_t)(e >> 2) * tAe; u.B = Be + (size_t)e * tBe; return true; }
        int wgid = (int)L; { const int q = nwg / NXCD, r = nwg % NXCD, xcd = wgid % NXCD, off = wgid / NXCD; wgid = (xcd < r ? xcd * (q + 1) : r * (q + 1) + (xcd - r) * q) + off; }
        const int nig = WGM * nN, gid = wgid / nig, fm = gid * WGM, gsz = (nM - fm) < WGM ? (nM - fm) : WGM;
        u.pm = fm + ((wgid % nig) % gsz); u.pn = (wgid % nig) / gsz; u.g = 0; u.A = A + (size_t)u.pm * tA; u.B = B + (size_t)u.pn * tB; return true;
    }
};

__device__ __forceinline__ void row_rstd8(const float* rss, int row0, int fq, float (&rs)[2][4]) {
    f32x4 a[2][4], b[2][4];
#pragma unroll
    for (int ai = 0; ai < 2; ++ai)
#pragma unroll
        for (int m = 0; m < 4; ++m) { const f32x4* p = (const f32x4*)(rss + (size_t)(row0 + ai * HALF + m * 16) * 32 + fq * 8); a[ai][m] = p[0]; b[ai][m] = p[1]; }
#pragma unroll
    for (int ai = 0; ai < 2; ++ai)
#pragma unroll
        for (int m = 0; m < 4; ++m) { const f32x4 v = a[ai][m] + b[ai][m]; float s = (v[0] + v[1]) + (v[2] + v[3]); s += __shfl_xor(s, 16); s += __shfl_xor(s, 32); rs[ai][m] = rsqrtf(s * (1.0f / DM) + RMS_EPS); }
}
struct EpiIn {
    static constexpr bool PERM = true, AFTER_DRAIN = false;
    bf16_t* z; const float* rss; float* out; bf16_t* kvb; bf16_t* mkvb; const float* bfg; unsigned* ctl; int kind, j;
    __device__ __forceinline__ void operator()(const f32x4 (&acc)[2][2][4][2], const Unit& u, int wr, int wc, int fr, int fq) const {
        const int row0 = u.pm * BM + wr * 64 + fr, colt = u.pn * BM, col0 = colt + wc * 32 + 8 * fq;
        if (u.g != 0) {
            const int e = u.g - 1; const bool isv = colt >= MEMW; float* of = out + (isv ? O_MVP : O_MKP) + (size_t)e * NMEM * MEMW; bf16_t* ob = mkvb + (size_t)e * NMEM * 1024;
#pragma unroll
            for (int ai = 0; ai < 2; ++ai)
#pragma unroll
                for (int m = 0; m < 4; ++m) { const int row = row0 + ai * HALF + m * 16;
#pragma unroll
                    for (int bj = 0; bj < 2; ++bj) { const int c = col0 + bj * HALF; const f32x4 v0 = acc[ai][bj][m][0], v1 = acc[ai][bj][m][1];
                        *(u32x4*)(ob + (size_t)row * 1024 + c) = pack8u(v0, v1);
                        float* o = of + (size_t)row * MEMW + (c - (isv ? MEMW : 0)); *(f32x4*)o = v0; *(f32x4*)(o + 4) = v1; } }
            return;
        }
        float rs[2][4]; row_rstd8(rss, row0, fq, rs);
        const bool kt = kind != 2 && colt >= AW && colt < 2 * AW, vt = kind != 2 && colt >= 2 * AW && colt < 3 * AW, smp = u.pm >= TP / BM;
        const int cbase = kt ? AW : 2 * AW;
        const size_t ocache = kind == 0 ? (smp ? (kt ? O_FKS : O_FVS) + (size_t)j * TS * AW : (kt ? O_FKP : O_FVP) + (size_t)j * TP * AW) : (smp ? (kt ? O_SKS : O_SVS) : (kt ? O_SKP : O_SVP));
        float* oc = out + ocache; bf16_t* kvs = kvb + (kt ? 0 : KVS_ONE / 2);
        const bool lft = kind == 0 && colt == 5120 && wc == 0 && fq < 2;
        float* lfo = out + (smp ? O_FLS + (size_t)j * TS * NH : O_FLP + (size_t)j * TP * NH);
        const bool nrm = kind == 0 && !smp && colt < 2 * AW;
        float nmx[2] = {0.f, 0.f};
#pragma unroll
        for (int ai = 0; ai < 2; ++ai)
#pragma unroll
            for (int m = 0; m < 4; ++m) { const int row = row0 + ai * HALF + m * 16, rr = smp ? row - TP : row; const float sc = rs[ai][m];
#pragma unroll
                for (int bj = 0; bj < 2; ++bj) { const int c = col0 + bj * HALF; const f32x4 v0 = acc[ai][bj][m][0] * sc, v1 = acc[ai][bj][m][1] * sc; const u32x4 w = pack8u(v0, v1);
                    *(u32x4*)(z + (size_t)row * ZLD + c) = w;
                    if (nrm) { float q = (v0[0] * v0[0] + v0[1] * v0[1]) + (v0[2] * v0[2] + v0[3] * v0[3]) + (v1[0] * v1[0] + v1[1] * v1[1]) + (v1[2] * v1[2] + v1[3] * v1[3]);
                        q += __shfl_xor(q, 16); q += __shfl_xor(q, 32); nmx[bj] = fmaxf(nmx[bj], q); }
                    if (kt || vt) { const int cc = c - cbase; float* o = oc + (size_t)rr * AW + cc; *(f32x4*)o = v0; *(f32x4*)(o + 4) = v1;
                        if (smp) *(u32x4*)(kvs + ((size_t)(rr >> 6) * SKS + PAST + (rr & 63)) * AW + cc) = w; }
                    if (lft && bj == 0) {
                        float* o = lfo + (size_t)rr * NH;
#pragma unroll
                        for (int e = 0; e < 8; ++e) { const int h = 8 * fq + e; if (h < NH) o[h] = log_sigmoidf((e < 4 ? v0[e & 3] : v1[e & 3]) + bfg[h]); } } } }
        if (nrm) {
#pragma unroll
            for (int bj = 0; bj < 2; ++bj) { float q = nmx[bj]; q = fmaxf(q, __shfl_xor(q, 1)); q = fmaxf(q, __shfl_xor(q, 2)); q = fmaxf(q, __shfl_xor(q, 4)); q = fmaxf(q, __shfl_xor(q, 8));
                if (fr == 0 && fq == 0) { const bool isq = colt < AW; const int h = (colt - (isq ? 0 : AW)) / HD + bj;
                    unsigned* t = isq ? ctl + CW_QQ + ((j * 32 + u.pm) * NH + h) * 4 + wc : ctl + CW_KQ + j * 64 + h * 4 + wc;
                    __hip_atomic_fetch_max(t, __float_as_uint(q), __ATOMIC_RELAXED, __HIP_MEMORY_SCOPE_AGENT); } }
        }
    }
};
struct EpiRes {
    static constexpr bool PERM = true, AFTER_DRAIN = false;
    float* x; bf16_t* xb; float* rss;
    __device__ __forceinline__ void operator()(const f32x4 (&acc)[2][2][4][2], const Unit& u, int wr, int wc, int fr, int fq) const {
        const int row0 = u.pm * BM + wr * 64 + fr, col0 = u.pn * BM + wc * 32 + 8 * fq;
#pragma unroll
        for (int ai = 0; ai < 2; ++ai)
#pragma unroll
            for (int m = 0; m < 4; ++m) { const int row = row0 + ai * HALF + m * 16; float ss = 0.f;
#pragma unroll
                for (int bj = 0; bj < 2; ++bj) { float* p = x + (size_t)row * DM + col0 + bj * HALF;
                    const f32x4 a = *(const f32x4*)p + acc[ai][bj][m][0], b = *(const f32x4*)(p + 4) + acc[ai][bj][m][1];
                    *(f32x4*)p = a; *(f32x4*)(p + 4) = b; *(u32x4*)(xb + (size_t)row * DM + col0 + bj * HALF) = pack8u(a, b);
                    ss += (a[0] * a[0] + a[1] * a[1]) + (a[2] * a[2] + a[3] * a[3]) + (b[0] * b[0] + b[1] * b[1]) + (b[2] * b[2] + b[3] * b[3]); }
                ss += __shfl_xor(ss, 16); ss += __shfl_xor(ss, 32);
                if (fq == 0) rss[(size_t)row * 32 + u.pn * 4 + wc] = ss;
                if (m & 1) asm volatile("" ::: "memory"); }
    }
};
struct EpiUp {
    static constexpr bool PERM = true, AFTER_DRAIN = false;
    bf16_t* o; const float* rss;
    __device__ __forceinline__ void operator()(const f32x4 (&acc)[2][2][4][2], const Unit& u, int wr, int wc, int fr, int fq) const {
        const int row0 = u.pm * BM + wr * 64 + fr, col0 = u.pn * BM + wc * 32 + 8 * fq;
        float rs[2][4]; row_rstd8(rss, row0, fq, rs);
#pragma unroll
        for (int ai = 0; ai < 2; ++ai)
#pragma unroll
            for (int m = 0; m < 4; ++m) { const int row = row0 + ai * HALF + m * 16; const float sc = rs[ai][m];
#pragma unroll
                for (int bj = 0; bj < 2; ++bj) { f32x4 v0 = acc[ai][bj][m][0] * sc, v1 = acc[ai][bj][m][1] * sc;
#pragma unroll
                    for (int e = 0; e < 4; ++e) { const float a = fmaxf(v0[e], 0.f), b = fmaxf(v1[e], 0.f); v0[e] = a * a; v1[e] = b * b; }
                    *(u32x4*)(o + (size_t)row * DFF + col0 + bj * HALF) = pack8u(v0, v1); } }
    }
};

struct SchedSplit {
    int S, nu, G, c; const char* A; const char* B; size_t tA, tB, kbytes;
    __device__ __forceinline__ bool next(int i, Unit& u) const {
        const int e = i * G + c; if (e >= nu) return false;
        const int tile = e / S, sp = e - tile * S; u.pm = TP / BM + (tile >> 3); u.pn = tile & 7; u.g = sp;
        u.A = A + (size_t)u.pm * tA + (size_t)sp * kbytes; u.B = B + (size_t)u.pn * tB + (size_t)sp * kbytes; return true;
    }
};
struct EpiPart {
    static constexpr bool PERM = true, AFTER_DRAIN = false;
    float* part;
    __device__ __forceinline__ void operator()(const f32x4 (&acc)[2][2][4][2], const Unit& u, int wr, int wc, int fr, int fq) const {
        const int row0 = (u.pm - TP / BM) * BM + wr * 64 + fr, col0 = u.pn * BM + wc * 32 + 8 * fq; float* base = part + (size_t)u.g * TS * DM;
#pragma unroll
        for (int ai = 0; ai < 2; ++ai)
#pragma unroll
            for (int m = 0; m < 4; ++m) { const int row = row0 + ai * HALF + m * 16;
#pragma unroll
                for (int bj = 0; bj < 2; ++bj) { float* p = base + (size_t)row * DM + col0 + bj * HALF; *(f32x4*)p = acc[ai][bj][m][0]; *(f32x4*)(p + 4) = acc[ai][bj][m][1]; } }
    }
};

template <class Epi, class Sch>
__device__ __forceinline__ void gemm_phase(LAS unsigned char* lds, const int K, const int lda, const int ldb, const Sch& S, const Epi& E, const int tid) {
    const int wid = __builtin_amdgcn_readfirstlane(tid >> 6), lane = tid & 63, wr = wid >> 2, wc = wid & 3, fr = lane & 15, fq = lane >> 4;
    const int nt = K / BK;
    unsigned voffA[2], voffB[2];
#pragma unroll
    for (int i = 0; i < 2; ++i) { int R, C; stage_rc(tid * 16 + i * 8192, R, C); const int Rb = Epi::PERM ? ((R & ~31) + perm32(R & 31)) : R;
        voffA[i] = (unsigned)(R * lda + C) * 2u; voffB[i] = (unsigned)(Rb * ldb + C) * 2u; }
    const size_t kstep = (size_t)(BK * 2);
    const size_t hstepA = (size_t)HALF * lda * 2, hstepB = (size_t)HALF * ldb * 2;
    const unsigned ldsw = (unsigned)wid * 1024u;
    const int aoff = lds_byte(wr * 64 + fr, fq * 8), boff = lds_byte(wc * 32 + fr, fq * 8);
#define PG8_SA(b, h) (((b) * 2 + (h)) * HTB)
#define PG8_SB(b, h) ((4 + (b) * 2 + (h)) * HTB)
#define PG8_STAGE(bufoff, gbase, voff) do { _Pragma("unroll") for (int _i = 0; _i < 2; ++_i) \
        __builtin_amdgcn_global_load_lds((const unsigned*)((const char*)(gbase) + (voff)[_i]), (LAS unsigned*)(lds + (bufoff) + ldsw + _i * 8192), 16, 0, 0); } while (0)
#define PG8_LDA(dst, b, h) do { _Pragma("unroll") for (int m = 0; m < 4; ++m) _Pragma("unroll") for (int k = 0; k < 2; ++k) dst[m][k] = *(const LAS bf16x8*)(lds + PG8_SA(b, h) + aoff + m * 2048 + k * 1024); } while (0)
#define PG8_LDB(dst, b, h) do { _Pragma("unroll") for (int n = 0; n < 2; ++n) _Pragma("unroll") for (int k = 0; k < 2; ++k) dst[n][k] = *(const LAS bf16x8*)(lds + PG8_SB(b, h) + boff + n * 2048 + k * 1024); } while (0)
#define PG8_MMA(ai, bj, At, Bt) do { __builtin_amdgcn_s_setprio(1); _Pragma("unroll") for (int m = 0; m < 4; ++m) _Pragma("unroll") for (int n = 0; n < 2; ++n) _Pragma("unroll") for (int k = 0; k < 2; ++k) \
        acc[ai][bj][m][n] = __builtin_amdgcn_mfma_f32_16x16x32_bf16(Bt[n][k], At[m][k], acc[ai][bj][m][n], 0, 0, 0); __builtin_amdgcn_s_setprio(0); } while (0)
#define PG8_WAIT_V(n) asm volatile("s_waitcnt vmcnt(" #n ")" ::: "memory")
#define PG8_WAIT_L(n) asm volatile("s_waitcnt lgkmcnt(" #n ")" ::: "memory")
#define PG8_BAR __builtin_amdgcn_s_barrier()
#define PG8_SCHED __builtin_amdgcn_sched_barrier(0)
    Unit cur, nxt; int ui = 0;
    if (!S.next(0, cur)) return;
    f32x4 acc[2][2][4][2];
#pragma unroll
    for (int a = 0; a < 2; ++a)
#pragma unroll
        for (int b = 0; b < 2; ++b)
#pragma unroll
            for (int m = 0; m < 4; ++m)
#pragma unroll
                for (int n = 0; n < 2; ++n) acc[a][b][m][n] = (f32x4){0.f, 0.f, 0.f, 0.f};
    bf16x8 At[4][2], B0[2][2], B1[2][2];
    const char* cA = cur.A; const char* cB = cur.B;
    PG8_STAGE(PG8_SB(0, 0), cB, voffB); PG8_STAGE(PG8_SB(0, 1), cB + hstepB, voffB); PG8_STAGE(PG8_SA(0, 0), cA, voffA); PG8_STAGE(PG8_SA(0, 1), cA + hstepA, voffA);
    if (wr == 1) PG8_BAR;
    PG8_WAIT_V(2); PG8_BAR;
    PG8_STAGE(PG8_SB(1, 0), cB + kstep, voffB); PG8_STAGE(PG8_SA(1, 0), cA + kstep, voffA); PG8_STAGE(PG8_SB(1, 1), cB + hstepB + kstep, voffB);
    PG8_WAIT_V(6); PG8_BAR;
    for (;;) {
        const bool has_next = S.next(ui + 1, nxt);
        const char* nA = has_next ? nxt.A : cA; const char* nB = has_next ? nxt.B : cB;
        for (int t = 0; t < nt; t += 2) {
            const bool last = (t == nt - 2);
            const char* a1 = cA + (size_t)(t + 1) * kstep;
            const char* a2 = last ? nA : cA + (size_t)(t + 2) * kstep; const char* b2 = last ? nB : cB + (size_t)(t + 2) * kstep;
            const char* a3 = a2 + kstep; const char* b3 = b2 + kstep;
            PG8_LDB(B0, 0, 0); PG8_LDB(B1, 0, 1); PG8_SCHED; PG8_LDA(At, 0, 0); PG8_STAGE(PG8_SA(1, 1), a1 + hstepA, voffA);
            PG8_WAIT_V(8); PG8_WAIT_L(0); PG8_BAR; PG8_MMA(0, 0, At, B0); PG8_MMA(0, 1, At, B1); PG8_BAR; PG8_SCHED;
            PG8_LDA(At, 0, 1); PG8_STAGE(PG8_SB(0, 0), b2, voffB); PG8_STAGE(PG8_SB(0, 1), b2 + hstepB, voffB); PG8_STAGE(PG8_SA(0, 0), a2, voffA);
            PG8_WAIT_V(8); PG8_WAIT_L(0); PG8_BAR; PG8_MMA(1, 0, At, B0); PG8_MMA(1, 1, At, B1); PG8_BAR; PG8_SCHED;
            PG8_LDB(B0, 1, 0); PG8_LDB(B1, 1, 1); PG8_SCHED; PG8_LDA(At, 1, 0); PG8_STAGE(PG8_SA(0, 1), a2 + hstepA, voffA);
            PG8_WAIT_V(8); PG8_WAIT_L(0); PG8_BAR; PG8_MMA(0, 0, At, B0); PG8_MMA(0, 1, At, B1); PG8_BAR; PG8_SCHED;
            PG8_LDA(At, 1, 1); PG8_STAGE(PG8_SB(1, 0), b3, voffB); PG8_STAGE(PG8_SB(1, 1), b3 + hstepB, voffB); PG8_STAGE(PG8_SA(1, 0), a3, voffA);
            PG8_WAIT_V(8); PG8_WAIT_L(0); PG8_BAR; PG8_MMA(1, 0, At, B0); PG8_MMA(1, 1, At, B1); PG8_BAR; PG8_SCHED;
        }
        if (wr == 0) PG8_BAR;
        E(acc, cur, wr, wc, fr, fq);
        if (!has_next) break;
#pragma unroll
        for (int a = 0; a < 2; ++a)
#pragma unroll
            for (int b = 0; b < 2; ++b)
#pragma unroll
                for (int m = 0; m < 4; ++m)
#pragma unroll
                    for (int n = 0; n < 2; ++n) acc[a][b][m][n] = (f32x4){0.f, 0.f, 0.f, 0.f};
        cur = nxt; cA = nA; cB = nB; ++ui;
        if (wr == 1) PG8_BAR;
    }
    PG8_WAIT_V(0);
    PG8_BAR;
#undef PG8_SA
#undef PG8_SB
#undef PG8_STAGE
#undef PG8_LDA
#undef PG8_LDB
#undef PG8_MMA
#undef PG8_WAIT_V
#undef PG8_WAIT_L
#undef PG8_BAR
#undef PG8_SCHED
}
}

namespace att {
constexpr float SCALE = 0.08838834764831845f;
constexpr float THR = 8.f;
constexpr int NW = 8, QBLK = 32, KVBLK = 64, QB = NW * QBLK, D = 128;
constexpr int SHM_V = KVBLK * D * 2, SHM_K = KVBLK * D * 2;
constexpr int ATT_LDS = 2 * SHM_V + 2 * SHM_K + NW * 64 * 4;
constexpr int BOS_OFF = ATT_LDS;
constexpr int BOS_BYTES = 8192 * 4;
constexpr int SCR_OFF = BOS_OFF + 2 * BOS_BYTES;
constexpr int WINF = 1 << 30;
static_assert(SCR_OFF + 256 <= LDS_WORK, "attention LDS map");

#define KSWZ(row, colB) ((row) * 256 + ((colB) ^ (((row) & 7) << 4)))
__device__ __forceinline__ int v_st(int k, int c) { const int kk = (k & ~0xC) | ((k & 4) << 1) | ((k & 8) >> 1); return ((kk >> 3) * 4 + (c >> 5)) * 512 + ((kk & 7) * 32 + (c & 31)) * 2; }
__device__ __forceinline__ int v_rd_base(int lane) { return ((lane & 3) << 3) | (((lane >> 2) & 3) << 6) | (((lane >> 4) & 1) << 5) | (((lane >> 5) & 1) << 8); }
constexpr int v_rd_off(int d0, int ks, int half) { return d0 * 512 + ks * 4096 + half * 2048; }
__device__ __forceinline__ int crow(int r, int hi) { return (r & 3) + 8 * (r >> 2) + 4 * hi; }
__device__ __forceinline__ bf16x8 load8(const bf16_t* p) { return *reinterpret_cast<const bf16x8*>(p); }

__device__ __forceinline__ void mask_tile(f32x16& p0, f32x16& p1, int dq, unsigned W) {
    const float NEG = -__builtin_inff();
#pragma unroll
    for (int r = 0; r < 16; ++r) {
        const int c = (r & 3) + 8 * (r >> 2);
        if ((unsigned)(dq - c) >= W) p0[r] = NEG;
        if ((unsigned)(dq - c - 32) >= W) p1[r] = NEG;
    }
}
__device__ __forceinline__ void partialSM(f32x16& p0, f32x16& p1, float& m_reg, float& mn, float& alpha) {
    float pmax = p0[0]; for (int r = 1; r < 16; ++r) pmax = fmaxf(pmax, p0[r]); for (int r = 0; r < 16; ++r) pmax = fmaxf(pmax, p1[r]);
    { auto rr = __builtin_amdgcn_permlane32_swap(__float_as_uint(pmax), __float_as_uint(pmax), false, false);
      pmax = fmaxf(__uint_as_float(rr[0]), __uint_as_float(rr[1])); }
    constexpr float C2 = 1.4426950408889634f * SCALE;
    if (__builtin_expect(__all((pmax - m_reg) * SCALE <= THR), 1)) { mn = m_reg; alpha = 1.f; }
    else { mn = fmaxf(m_reg, pmax); alpha = __builtin_amdgcn_exp2f((m_reg - mn) * C2); m_reg = mn; }
    const float mnL = -mn * C2;
    for (int r = 0; r < 16; ++r) p0[r] = fmaf(p0[r], C2, mnL); for (int r = 0; r < 16; ++r) p1[r] = fmaf(p1[r], C2, mnL);
    for (int r = 0; r < 16; ++r) p0[r] = __builtin_amdgcn_exp2f(p0[r]);
}
#define PK4(P, B_, OUT) do { unsigned a0 = cvtpk(P[B_+0], P[B_+1]), a1 = cvtpk(P[B_+2], P[B_+3]);                          \
        unsigned b0 = cvtpk(P[B_+4], P[B_+5]), b1 = cvtpk(P[B_+6], P[B_+7]);                                             \
        auto r0 = __builtin_amdgcn_permlane32_swap(a0, b0, false, false); auto r1 = __builtin_amdgcn_permlane32_swap(a1, b1, false, false); \
        u32x4 w = {r0[0], r1[0], r0[1], r1[1]}; OUT = *reinterpret_cast<bf16x8*>(&w); } while (0)
__device__ __forceinline__ void finishSM(f32x16& p0, f32x16& p1, float alpha, float& l_reg, bf16x8& pa0, bf16x8& pa1, bf16x8& pa2, bf16x8& pa3) {
    for (int r = 0; r < 16; ++r) p1[r] = __builtin_amdgcn_exp2f(p1[r]);
    float ps = 0; for (int r = 0; r < 16; ++r) ps += p0[r]; for (int r = 0; r < 16; ++r) ps += p1[r];
    { auto rr = __builtin_amdgcn_permlane32_swap(__float_as_uint(ps), __float_as_uint(ps), false, false);
      ps = __uint_as_float(rr[0]) + __uint_as_float(rr[1]); }
    l_reg = l_reg * alpha + ps;
    PK4(p0, 0, pa0); PK4(p0, 8, pa1); PK4(p1, 0, pa2); PK4(p1, 8, pa3);
}
template <int KB, bool BIAS>
__device__ __forceinline__ void qkt(f32x16& p0, f32x16& p1, const char* K_lds, int r32, int hi, const bf16x8* qr, const float* bk) {
    if constexpr (BIAS) {
#pragma unroll
        for (int i = 0; i < 4; ++i) { const f32x4 a = *(const f32x4*)(bk + 8 * i), b = *(const f32x4*)(bk + 32 + 8 * i);
            p0[4 * i] = a[0]; p0[4 * i + 1] = a[1]; p0[4 * i + 2] = a[2]; p0[4 * i + 3] = a[3];
            p1[4 * i] = b[0]; p1[4 * i + 1] = b[1]; p1[4 * i + 2] = b[2]; p1[4 * i + 3] = b[3]; }
    } else { p0 = f32x16{}; p1 = f32x16{}; }
    const char* kb[4];
#pragma unroll
    for (int dd = 0; dd < 4; ++dd) kb[dd] = K_lds + KB * SHM_K + KSWZ(r32, (dd * 16 + hi * 8) * 2);
#pragma unroll
    for (int d0 = 0; d0 < 8; ++d0) { const char* a = kb[d0 & 3] + (d0 >> 2) * 128;
        bf16x8 b0 = *reinterpret_cast<const bf16x8*>(a);
        bf16x8 b1 = *reinterpret_cast<const bf16x8*>(a + 32 * 256);
        p0 = __builtin_amdgcn_mfma_f32_32x32x16_bf16(b0, qr[d0], p0, 0, 0, 0);
        p1 = __builtin_amdgcn_mfma_f32_32x32x16_bf16(b1, qr[d0], p1, 0, 0, 0); }
}
template <int VB>
__device__ __forceinline__ void pv_tile(f32x16* o, int vb0, bf16x8 pa0, bf16x8 pa1, bf16x8 pa2, bf16x8 pa3) {
#define TRRD(dst, off) asm volatile("ds_read_b64_tr_b16 %0, %1 offset:%2" : "=&v"(dst) : "v"(vb0), "i"(off) : "memory")
#define PV_D0(d0) do { s16x4 l0, l1, l2, l3, h0, h1, h2, h3; constexpr int b_ = VB * SHM_V + v_rd_off(d0, 0, 0); \
        TRRD(l0, b_); TRRD(h0, b_ + 2048); TRRD(l1, b_ + 4096); TRRD(h1, b_ + 6144); TRRD(l2, b_ + 8192); TRRD(h2, b_ + 10240); TRRD(l3, b_ + 12288); TRRD(h3, b_ + 14336); \
        asm volatile("s_waitcnt lgkmcnt(0)" ::: "memory"); SBAR();   \
        o[d0] = __builtin_amdgcn_mfma_f32_32x32x16_bf16(pa0, (bf16x8){l0[0], l0[1], l0[2], l0[3], h0[0], h0[1], h0[2], h0[3]}, o[d0], 0, 0, 0);   \
        o[d0] = __builtin_amdgcn_mfma_f32_32x32x16_bf16(pa1, (bf16x8){l1[0], l1[1], l1[2], l1[3], h1[0], h1[1], h1[2], h1[3]}, o[d0], 0, 0, 0);   \
        o[d0] = __builtin_amdgcn_mfma_f32_32x32x16_bf16(pa2, (bf16x8){l2[0], l2[1], l2[2], l2[3], h2[0], h2[1], h2[2], h2[3]}, o[d0], 0, 0, 0);   \
        o[d0] = __builtin_amdgcn_mfma_f32_32x32x16_bf16(pa3, (bf16x8){l3[0], l3[1], l3[2], l3[3], h3[0], h3[1], h3[2], h3[3]}, o[d0], 0, 0, 0); } while (0)
    PV_D0(0); PV_D0(1); PV_D0(2); PV_D0(3);
#undef PV_D0
#undef TRRD
}

struct Blk { const bf16_t* Q; const bf16_t* K; const bf16_t* V; bf16_t* O; int ldq, ldkv, ldo; int P0, skv, nrows; int bmode; const float* lf0; int n0; const float* lf1;
             const unsigned* qq; const unsigned* kq; int jlo, bsel; };
struct Seam { bf16x8 qr[8]; bf16x8 st_v0, st_v1, st_k0, st_k1; };
__device__ __forceinline__ int blk_jhi(const Blk& b) { int j = (b.P0 + QB - 1) / KVBLK + 1; const int m = b.skv / KVBLK; return j > m ? m : j; }

__device__ __forceinline__ void prepare_bias(Blk& b, char* lds, int g_wave) {
    const int tid = opaque_tid();
    float* bos = (float*)(lds + BOS_OFF + b.bsel * BOS_BYTES); float* scr = (float*)(lds + SCR_OFF);
    const int nk = blk_jhi(b) * KVBLK, lane = tid & 63, wid = tid >> 6;
    b.jlo = 0;
    if (b.bmode == 0) { for (int k = tid; k < nk; k += 512) bos[k] = 0.f; __syncthreads(); return; }
    float v[16]; float tot = 0.f; const int k0 = tid * 16; const bool in = k0 < nk;
#pragma unroll
    for (int i = 0; i < 16; ++i) { const int k = k0 + i; v[i] = in ? (k < b.n0 ? b.lf0[(size_t)k * NH] : b.lf1[(size_t)(k - b.n0) * NH]) : 0.f; tot += v[i]; }
    float inc = tot;
#pragma unroll
    for (int o = 1; o < 64; o <<= 1) { const float y = __shfl_down(inc, o); if (lane + o < 64) inc += y; }
    if (lane == 0) scr[wid] = inc;
    if (tid == 0) ((int*)scr)[9] = 0;
    __syncthreads();
    float hiw = 0.f;
#pragma unroll
    for (int w = 0; w < 8; ++w) if (w > wid) hiw += scr[w];
    float run = (inc - tot) + hiw;
#pragma unroll
    for (int i = 15; i >= 0; --i) { const float lf = v[i]; v[i] = run; run += lf; }
    if (in) {
#pragma unroll
        for (int i = 0; i < 16; ++i) bos[k0 + i] = v[i] * (1.0f / SCALE);
    }
    if (b.qq != nullptr) {
        if (in && k0 == b.P0) scr[8] = v[0];
        __syncthreads();
        const float q2 = (__uint_as_float(b.qq[0]) + __uint_as_float(b.qq[1])) + (__uint_as_float(b.qq[2]) + __uint_as_float(b.qq[3]));
        const float k2 = (__uint_as_float(b.kq[0]) + __uint_as_float(b.kq[1])) + (__uint_as_float(b.kq[2]) + __uint_as_float(b.kq[3]));
        const float B = sqrtf(q2 * k2) * SCALE * 1.02f, cut = scr[8] - (2.f * B + 34.f);
        int cnt = 0;
#pragma unroll
        for (int i = 0; i < 16; ++i) cnt += (in && k0 + i < b.P0 && v[i] < cut) ? 1 : 0;
#pragma unroll
        for (int o = 1; o < 64; o <<= 1) cnt += __shfl_xor(cnt, o);
        if (lane == 0 && cnt) atomicAdd((int*)scr + 9, cnt);
        __syncthreads();
        b.jlo = ((int*)scr)[9] / KVBLK;
    }
    __syncthreads();
}

#define ROWK(p, ld, k0, rr) ((p) + (size_t)((k0) + (rr)) * (ld) + sc)
#define VMW() asm volatile("s_waitcnt vmcnt(0)" ::: "memory")
#define VMWN(n) asm volatile("s_waitcnt vmcnt(%0)" :: "i"(n) : "memory")
#define SLOAD_H(Kp, Vp, ld, k0) do { S.st_v0 = load8(ROWK(Vp, ld, k0, sr)); S.st_v1 = load8(ROWK(Vp, ld, k0, 32 + sr));              \
                         S.st_k0 = load8(ROWK(Kp, ld, k0, sr)); S.st_k1 = load8(ROWK(Kp, ld, k0, 32 + sr)); } while (0)
#define SWRITE_HK(bf) do { *(bf16x8*)(K_lds + (bf) * SHM_K + kws) = S.st_k0; *(bf16x8*)(K_lds + (bf) * SHM_K + kws + 32 * 256) = S.st_k1; } while (0)
#define SWRITE_HV(bf) do { *(bf16x8*)(V_lds + (bf) * SHM_V + vst0) = S.st_v0; *(bf16x8*)(V_lds + (bf) * SHM_V + vst1) = S.st_v1; } while (0)
#define SWRITE_H(bf) do { SWRITE_HV(bf); SWRITE_HK(bf); } while (0)
#define QROWP(b_) ((b_).Q + (size_t)((wid * QBLK + r32) & ((b_).nrows - 1)) * (b_).ldq + hi * 8)
__device__ __forceinline__ void att_prime(const Blk& cur, char* lds, Seam& S, int g_wave) {
    const int tid = opaque_tid();
    const int wid = __builtin_amdgcn_readfirstlane(tid >> 6), lane = tid & 63, r32 = lane & 31, hi = lane >> 5;
    const int sr = tid >> 4, sc = (tid & 15) * 8, kws = KSWZ(sr, sc * 2); char* K_lds = lds + 2 * SHM_V;
    const bf16_t* qp = QROWP(cur);
#pragma unroll
    for (int d0 = 0; d0 < 8; ++d0) S.qr[d0] = load8(qp + d0 * 16);
    SLOAD_H(cur.K, cur.V, cur.ldkv, cur.jlo * KVBLK); VMW(); SWRITE_HK(0);
    __syncthreads();
}
__device__ __forceinline__ void att_block(const Blk& cur, const Blk& nxt, char* lds, Seam& S, int g_wave) {
    const int tid = opaque_tid();
    const int wid = __builtin_amdgcn_readfirstlane(tid >> 6), lane = tid & 63, r32 = lane & 31, hi = lane >> 5;
    constexpr int W = WINF;
    const int j_lo = cur.jlo, NT = blk_jhi(cur) - j_lo;
    const int qlo = cur.P0 + wid * QBLK, qm = qlo + r32 - 4 * hi;
    char* V_lds = lds; char* K_lds = lds + 2 * SHM_V;
    float* ws = (float*)(lds + 2 * SHM_V + 2 * SHM_K) + wid * 64; float* li_l = ws, * al_l = ws + 32;
    const float* bos = (const float*)(lds + BOS_OFF + cur.bsel * BOS_BYTES) + 4 * hi;
    float m_reg = -1e30f, l_reg = 0; f32x16 o[4] = {};
    const int sr = tid >> 4, sc = (tid & 15) * 8, vst0 = v_st(sr, sc), vst1 = v_st(32 + sr, sc), kws = KSWZ(sr, sc * 2);
    const int vb0 = (int)(uintptr_t)V_lds + v_rd_base(lane);
    const bf16_t* Kh = cur.K; const bf16_t* Vh = cur.V; const int ldkv = cur.ldkv;
#define RESC(a) do { if (__any((a) < 1.f)) { if (hi == 0) al_l[r32] = (a); asm volatile("s_waitcnt lgkmcnt(0)" ::: "memory");              \
                     for (int d_ = 0; d_ < 4; ++d_) for (int r = 0; r < 16; ++r) o[d_][r] *= al_l[crow(r, hi)]; } } while (0)
#define KBASE(t) ((j_lo + (t)) * KVBLK)
#define MASKT(P0_, P1_, t) do { const int kb_ = KBASE(t); if (kb_ + KVBLK - 1 > qlo) mask_tile(P0_, P1_, qm - kb_, (unsigned)W); } while (0)
    constexpr int NQL = 8;
#define SEAM_K0() do { VMWN(NQL); SWRITE_HK(0); SBAR(); } while (0)
    f32x16 pA0, pA1, pB0, pB1; float mnA, mnB, alA, alB; bf16x8 pa0, pa1, pa2, pa3;
    SWRITE_HV(0); SBAR();
    if (NT > 1) SLOAD_H(Kh, Vh, ldkv, KBASE(1));
    SBAR(); qkt<0, true>(pA0, pA1, K_lds, r32, hi, S.qr, bos + KBASE(0));
    MASKT(pA0, pA1, 0); partialSM(pA0, pA1, m_reg, mnA, alA);
    if (NT > 1) { VMW(); SWRITE_H(1); }
    __syncthreads();
#define HALF_STEP(PX0, PX1, mnX, alX, PY0, PY1, alY, t, KB, VB, SB) do {                                                      \
        SBAR(); qkt<KB, true>(PX0, PX1, K_lds, r32, hi, S.qr, bos + KBASE(t));                                                \
        finishSM(PY0, PY1, alY, l_reg, pa0, pa1, pa2, pa3); SBAR();                                                           \
        if ((t) + 1 < NT) { SLOAD_H(Kh, Vh, ldkv, KBASE((t) + 1)); SBAR(); }                                                  \
        pv_tile<VB>(o, vb0, pa0, pa1, pa2, pa3); MASKT(PX0, PX1, (t)); partialSM(PX0, PX1, m_reg, mnX, alX);                  \
        __syncthreads();                                                                                                      \
        if ((t) + 1 < NT) { VMW(); SWRITE_H(SB); }                                                                            \
        RESC(alX); __syncthreads(); } while (0)
    for (int t = 1; t + 1 < NT; t += 2) {
        HALF_STEP(pB0, pB1, mnB, alB, pA0, pA1, alA, t, 1, 0, 0);
        HALF_STEP(pA0, pA1, mnA, alA, pB0, pB1, alB, t + 1, 0, 1, 1);
    }
    const bool even = (NT & 1) == 0;
    if (even) { SBAR(); qkt<1, true>(pB0, pB1, K_lds, r32, hi, S.qr, bos + KBASE(NT - 1)); SBAR(); }
    SLOAD_H(nxt.K, nxt.V, nxt.ldkv, nxt.jlo * KVBLK); SBAR();
    { const bf16_t* qp = QROWP(nxt);
#pragma unroll
      for (int d0 = 0; d0 < 8; ++d0) S.qr[d0] = load8(qp + d0 * 16); }
    SBAR();
    finishSM(pA0, pA1, alA, l_reg, pa0, pa1, pa2, pa3); SBAR();
    pv_tile<0>(o, vb0, pa0, pa1, pa2, pa3);
    if (even) { MASKT(pB0, pB1, NT - 1); partialSM(pB0, pB1, m_reg, mnB, alB); __syncthreads(); RESC(alB);
        finishSM(pB0, pB1, alB, l_reg, pa0, pa1, pa2, pa3); SBAR(); pv_tile<1>(o, vb0, pa0, pa1, pa2, pa3); }
    SBAR(); SEAM_K0();
    if (hi == 0) li_l[r32] = l_reg; asm volatile("s_waitcnt lgkmcnt(0)" ::: "memory");
    float rli[16];
#pragma unroll
    for (int r = 0; r < 16; ++r) rli[r] = __builtin_amdgcn_rcpf(li_l[crow(r, hi)]);
    if (wid * QBLK < cur.nrows) {
        bf16_t* Ow = cur.O + (size_t)(wid * QBLK) * cur.ldo;
#pragma unroll
        for (int r = 0; r < 16; ++r) { const int orow = crow(r, hi);
#pragma unroll
            for (int d0 = 0; d0 < 4; ++d0) { const float v = o[d0][r] * rli[r]; const float vn = __shfl_xor(v, 1);
                if ((r32 & 1) == 0) *(unsigned*)(Ow + (size_t)orow * cur.ldo + d0 * 32 + r32) = cvtpk(v, vn); } }
    }
    __syncthreads();
#undef RESC
#undef MASKT
#undef SEAM_K0
#undef HALF_STEP
}

__device__ __forceinline__ void sb_block(const Blk& b, char* lds, int g_wave) {
    const int tid = opaque_tid();
    const int wid = __builtin_amdgcn_readfirstlane(tid >> 6), lane = tid & 63, r32 = lane & 31, hi = lane >> 5;
    char* V_lds = lds; char* K_lds = lds + 2 * SHM_V; int* flags = (int*)(lds + 2 * SHM_V + 2 * SHM_K);
    const int sr = tid >> 4, sc = (tid & 15) * 8, vst0 = v_st(sr, sc), vst1 = v_st(32 + sr, sc), kws = KSWZ(sr, sc * 2);
    const int vb0 = (int)(uintptr_t)V_lds + v_rd_base(lane);
    bf16x8 qr[8];
    { const bf16_t* qp = QROWP(b);
#pragma unroll
      for (int d0 = 0; d0 < 8; ++d0) qr[d0] = load8(qp + d0 * 16); }
    const int NT = blk_jhi(b), qlo = b.P0 + wid * QBLK, pos = qlo + r32;
    bool wdead = wid * QBLK >= b.nrows;
    float prun = 1.f; f32x16 o[4] = {};
    constexpr float C2 = 1.4426950408889634f * SCALE;
    for (int t = NT - 1; t >= 0; --t) {
        const int kb = t * KVBLK;
        const bf16x8 k0 = load8(ROWK(b.K, b.ldkv, kb, sr)), k1 = load8(ROWK(b.K, b.ldkv, kb, 32 + sr)), v0 = load8(ROWK(b.V, b.ldkv, kb, sr)), v1 = load8(ROWK(b.V, b.ldkv, kb, 32 + sr));
        __syncthreads();
        *(bf16x8*)(K_lds + kws) = k0; *(bf16x8*)(K_lds + kws + 32 * 256) = k1; *(bf16x8*)(V_lds + vst0) = v0; *(bf16x8*)(V_lds + vst1) = v1;
        __syncthreads();
        if (!wdead && kb < qlo + QBLK - 1) {
            f32x16 p0, p1; qkt<0, false>(p0, p1, K_lds, r32, hi, qr, nullptr);
            if (kb + KVBLK - 1 >= qlo) {
                const float NEG = -__builtin_inff();
#pragma unroll
                for (int r = 0; r < 16; ++r) { const int key = kb + crow(r, hi); if (key >= pos) p0[r] = NEG; if (key + 32 >= pos) p1[r] = NEG; }
            }
#pragma unroll
            for (int r = 0; r < 16; ++r) {
                p0[r] = __builtin_amdgcn_rcpf(1.f + __builtin_amdgcn_exp2f(fminf(p0[r] * C2, 60.f))); p1[r] = __builtin_amdgcn_rcpf(1.f + __builtin_amdgcn_exp2f(fminf(p1[r] * C2, 60.f))); }
            float gl[8], gu[8];
#pragma unroll
            for (int g = 0; g < 8; ++g) { const float gp = g < 4 ? (p0[4 * g] * p0[4 * g + 1]) * (p0[4 * g + 2] * p0[4 * g + 3]) : (p1[4 * g - 16] * p1[4 * g - 15]) * (p1[4 * g - 14] * p1[4 * g - 13]);
                auto x = __builtin_amdgcn_permlane32_swap(__float_as_uint(gp), __float_as_uint(gp), false, false); gl[g] = __uint_as_float(x[0]); gu[g] = __uint_as_float(x[1]); }
            float s = 1.f, sown[8];
#pragma unroll
            for (int g = 7; g >= 0; --g) { const float su = s; s *= gu[g]; const float sl = s; s *= gl[g]; sown[g] = hi ? su : sl; }
#define SB_EL(P, q) do { const float rr_ = P[q]; P[q] = (1.f - rr_) * tt; tt *= rr_; } while (0)
#pragma unroll
            for (int g = 0; g < 8; ++g) { float tt = sown[g] * prun;
                if (g < 4) { const int q = 4 * g; SB_EL(p0, q + 3); SB_EL(p0, q + 2); SB_EL(p0, q + 1); SB_EL(p0, q); }
                else { const int q = 4 * g - 16; SB_EL(p1, q + 3); SB_EL(p1, q + 2); SB_EL(p1, q + 1); SB_EL(p1, q); } }
#undef SB_EL
            prun *= s;
            bf16x8 pa0, pa1, pa2, pa3;
            PK4(p0, 0, pa0); PK4(p0, 8, pa1); PK4(p1, 0, pa2); PK4(p1, 8, pa3);
            pv_tile<0>(o, vb0, pa0, pa1, pa2, pa3);
            wdead = __all(prun < 8.67e-19f);
        }
        if (lane == 0) flags[wid] = wdead ? 1 : 0;
        __syncthreads();
        const int alld = flags[0] & flags[1] & flags[2] & flags[3] & flags[4] & flags[5] & flags[6] & flags[7];
        if (alld) break;
    }
    if (wid * QBLK < b.nrows) {
        bf16_t* Ow = b.O + (size_t)(wid * QBLK) * b.ldo;
#pragma unroll
        for (int r = 0; r < 16; ++r) { const int orow = crow(r, hi);
#pragma unroll
            for (int d0 = 0; d0 < 4; ++d0) { const float v = o[d0][r]; const float vn = __shfl_xor(v, 1);
                if ((r32 & 1) == 0) *(unsigned*)(Ow + (size_t)orow * b.ldo + d0 * 32 + r32) = cvtpk(v, vn); } }
    }
    __syncthreads();
}
#undef ROWK
#undef VMW
#undef VMWN
#undef SLOAD_H
#undef SWRITE_HK
#undef SWRITE_HV
#undef SWRITE_H
#undef QROWP
#undef PK4
#undef KSWZ
#undef KBASE
}

namespace gla {
constexpr int ZQ = 0, ZK = GKW, ZV = 2 * GKW, ZR = 2 * GKW + GVW, ZG = 5120;
constexpr int KP = 72, QP = 200;
constexpr int L_G = 0;
constexpr int L_GLOW = 49152;
constexpr int L_TOT = 53248;
constexpr int L_QP = 54272;
constexpr int L_KPB = L_QP + 64 * QP * 2;
constexpr int L_AB = L_KPB + 64 * QP * 2;
constexpr int L_VT = L_AB + 64 * KP * 2;
constexpr int L_RS = L_VT + 128 * KP * 2;
constexpr int L_ST = 0;
constexpr int L1_KD = 54272;
constexpr int L1_VT = L1_KD + 192 * KP * 2;
static_assert(L_RS + 1024 <= LDS_WORK && L1_VT + 384 * KP * 2 <= LDS_WORK, "GLA LDS map");

__device__ __forceinline__ int chunk_row0(int c) { return c < TP / 64 ? c * 64 : TP + (c - TP / 64) * 64; }

__device__ __forceinline__ void decay_scan(const bf16_t* z, const float* wg2, const float* bg, int row0, int h, char* lds, int tid) {
    float* G = (float*)(lds + L_G); float* glow = (float*)(lds + L_GLOW); float* tot = (float*)(lds + L_TOT);
    for (int i = tid; i < 64 * 16; i += 512) glow[i] = bf2f(z[(size_t)(row0 + (i >> 4)) * ZLD + ZG + (i & 15)]);
    __syncthreads();
    if (tid < 384) {
        const int k = tid % 192, half = tid / 192; float w[16];
#pragma unroll
        for (int j = 0; j < 16; ++j) w[j] = wg2[(size_t)j * GKW + h * GDK + k];
        const float b = bg[h * GDK + k]; float g = 0.f;
        for (int s = half * 32; s < half * 32 + 32; ++s) { float a = b;
#pragma unroll
            for (int j = 0; j < 16; ++j) a += glow[s * 16 + j] * w[j];
            g += log_sigmoidf(a) * (1.0f / 16.0f); G[s * GDK + k] = g; }
        if (half == 0) tot[k] = g;
    }
    __syncthreads();
}

__device__ __forceinline__ void g1_unit(int c, int h, const bf16_t* z, const float* wg2, const float* bg, float* UT, float* DEC, char* lds, int g_wave) {
    const int tid = opaque_tid(); const int row0 = chunk_row0(c);
    decay_scan(z, wg2, bg, row0, h, lds, tid);
    const float* G = (const float*)(lds + L_G); const float* tot = (const float*)(lds + L_TOT);
    bf16_t* KD = (bf16_t*)(lds + L1_KD); bf16_t* VT = (bf16_t*)(lds + L1_VT);
    for (int it = tid; it < 192 * 8; it += 512) {
        const int k = it % 192, sb = it / 192; const float t0 = tot[k], glast = G[63 * GDK + k] + t0; float v[8];
#pragma unroll
        for (int i = 0; i < 8; ++i) { const int s = sb * 8 + i; const float g = G[s * GDK + k] + (s >= 32 ? t0 : 0.f);
            v[i] = bf2f(z[(size_t)(row0 + s) * ZLD + ZK + h * GDK + k]) * __expf(glast - g); }
        u32x4 w = {cvtpk(v[0], v[1]), cvtpk(v[2], v[3]), cvtpk(v[4], v[5]), cvtpk(v[6], v[7])};
        *(u32x4*)(KD + k * KP + sb * 8) = w;
        if (sb == 0) DEC[(size_t)(c * GH + h) * GDK + k] = __expf(glast);
    }
    for (int it = tid; it < 64 * 48; it += 512) {
        const int s = it & 63, vb = it >> 6; const u32x4 w = *(const u32x4*)(z + (size_t)(row0 + s) * ZLD + ZV + h * GDV + vb * 8);
#pragma unroll
        for (int i = 0; i < 4; ++i) { VT[(vb * 8 + 2 * i) * KP + s] = (bf16_t)(w[i] & 0xffffu); VT[(vb * 8 + 2 * i + 1) * KP + s] = (bf16_t)(w[i] >> 16); }
    }
    __syncthreads();
    const int wid = tid >> 6, lane = tid & 63, l32 = lane & 31, hi = lane >> 5, mq = wid & 3, nh = wid >> 2;
    f32x16 acc[3][3];
#pragma unroll
    for (int i = 0; i < 3; ++i)
#pragma unroll
        for (int j = 0; j < 3; ++j) acc[i][j] = f32x16{};
#pragma unroll
    for (int ks = 0; ks < 4; ++ks) { bf16x8 a[3], bb[3];
#pragma unroll
        for (int i = 0; i < 3; ++i) { a[i] = *(const bf16x8*)(VT + ((mq * 3 + i) * 32 + l32) * KP + ks * 16 + hi * 8); bb[i] = *(const bf16x8*)(KD + ((nh * 3 + i) * 32 + l32) * KP + ks * 16 + hi * 8); }
#pragma unroll
        for (int i = 0; i < 3; ++i)
#pragma unroll
            for (int j = 0; j < 3; ++j) acc[i][j] = __builtin_amdgcn_mfma_f32_32x32x16_bf16(a[i], bb[j], acc[i][j], 0, 0, 0); }
    float* out = UT + (size_t)(c * GH + h) * GDV * GDK;
#pragma unroll
    for (int i = 0; i < 3; ++i)
#pragma unroll
        for (int j = 0; j < 3; ++j)
#pragma unroll
            for (int r = 0; r < 16; ++r) out[(size_t)((mq * 3 + i) * 32 + att::crow(r, hi)) * GDK + (nh * 3 + j) * 32 + l32] = acc[i][j][r];
    __syncthreads();
}

__device__ __forceinline__ void g2_tile(int tile, float* UT, const float* DEC, const float* s0in, float* outp, float* outs, char* lds, int tid) {
    const int h = tile / 36, vt = (tile % 36) / 3, kt = tile % 3, vi = tid >> 4, kg = tid & 15, v = vt * 32 + vi, k = kt * 64 + kg * 4;
    float* T = (float*)lds;
    const size_t cstride = (size_t)GH * GDV * GDK; float* up = UT + ((size_t)h * GDV + v) * GDK + k; const float* dp = DEC + h * GDK + k;
    float zz = 0.f; asm volatile("" : "+v"(zz)); f32x4 S = {zz, zz, zz, zz};
    for (int c0 = 0; c0 < TP / 64; c0 += 8) { f32x4 u[8], d[8];
#pragma unroll
        for (int i = 0; i < 8; ++i) { u[i] = *(const f32x4*)(up + (size_t)(c0 + i) * cstride); d[i] = *(const f32x4*)(dp + (size_t)(c0 + i) * GH * GDK); }
#pragma unroll
        for (int i = 0; i < 8; ++i) { *(f32x4*)(up + (size_t)(c0 + i) * cstride) = S; S = d[i] * S + u[i]; } }
    const int kr = tid >> 3, v4 = (tid & 7) * 4;
    T[(kg * 4 + 0) * 33 + vi] = S[0]; T[(kg * 4 + 1) * 33 + vi] = S[1]; T[(kg * 4 + 2) * 33 + vi] = S[2]; T[(kg * 4 + 3) * 33 + vi] = S[3];
    __syncthreads();
    { f32x4 o = {T[kr * 33 + v4], T[kr * 33 + v4 + 1], T[kr * 33 + v4 + 2], T[kr * 33 + v4 + 3]}; *(f32x4*)(outp + ((size_t)h * GDK + kt * 64 + kr) * GDV + vt * 32 + v4) = o; }
    __syncthreads();
    for (int b = 0; b < NB; ++b) {
        const int c = TP / 64 + b; const size_t sb = ((size_t)b * GH + h) * GDK * GDV;
        { const f32x4 i4 = *(const f32x4*)(s0in + sb + (size_t)(kt * 64 + kr) * GDV + vt * 32 + v4); T[kr * 33 + v4] = i4[0]; T[kr * 33 + v4 + 1] = i4[1]; T[kr * 33 + v4 + 2] = i4[2]; T[kr * 33 + v4 + 3] = i4[3]; }
        __syncthreads();
        f32x4 s0 = {T[(kg * 4 + 0) * 33 + vi], T[(kg * 4 + 1) * 33 + vi], T[(kg * 4 + 2) * 33 + vi], T[(kg * 4 + 3) * 33 + vi]};
        const f32x4 u = *(const f32x4*)(up + (size_t)c * cstride), d = *(const f32x4*)(dp + (size_t)c * GH * GDK);
        *(f32x4*)(up + (size_t)c * cstride) = s0; const f32x4 sn = d * s0 + u;
        __syncthreads();
        T[(kg * 4 + 0) * 33 + vi] = sn[0]; T[(kg * 4 + 1) * 33 + vi] = sn[1]; T[(kg * 4 + 2) * 33 + vi] = sn[2]; T[(kg * 4 + 3) * 33 + vi] = sn[3];
        __syncthreads();
        { f32x4 o = {T[kr * 33 + v4], T[kr * 33 + v4 + 1], T[kr * 33 + v4 + 2], T[kr * 33 + v4 + 3]}; *(f32x4*)(outs + sb + (size_t)(kt * 64 + kr) * GDV + vt * 32 + v4) = o; }
        __syncthreads();
    }
}

__device__ __forceinline__ void g3_unit(int c, int h, const bf16_t* z, const float* wg2, const float* bg, const float* UT, const float* ng, const float* br, bf16_t* oc, char* lds, int g_wave) {
    const int tid = opaque_tid(); const int row0 = chunk_row0(c);
    decay_scan(z, wg2, bg, row0, h, lds, tid);
    const float* G = (const float*)(lds + L_G); const float* tot = (const float*)(lds + L_TOT);
    bf16_t* Qp = (bf16_t*)(lds + L_QP); bf16_t* Kp = (bf16_t*)(lds + L_KPB); bf16_t* Ab = (bf16_t*)(lds + L_AB); bf16_t* VT = (bf16_t*)(lds + L_VT); bf16_t* ST = (bf16_t*)(lds + L_ST);
    float* RS = (float*)(lds + L_RS);
    const float qs = 0.07216878364870322f;
    for (int it = tid; it < 64 * 24; it += 512) {
        const int s = it / 24, kb = (it % 24) * 8; float g[8];
#pragma unroll
        for (int i = 0; i < 8; ++i) g[i] = G[s * GDK + kb + i] + (s >= 32 ? tot[kb + i] : 0.f);
        const u32x4 qw = *(const u32x4*)(z + (size_t)(row0 + s) * ZLD + ZQ + h * GDK + kb), kw = *(const u32x4*)(z + (size_t)(row0 + s) * ZLD + ZK + h * GDK + kb);
        u32x4 qo, ko;
#pragma unroll
        for (int i = 0; i < 4; ++i) { const float e0 = __expf(g[2 * i]), e1 = __expf(g[2 * i + 1]);
            qo[i] = cvtpk(__uint_as_float(qw[i] << 16) * qs * e0, __uint_as_float(qw[i] & 0xffff0000u) * qs * e1);
            ko[i] = cvtpk(__uint_as_float(kw[i] << 16) * __builtin_amdgcn_rcpf(e0), __uint_as_float(kw[i] & 0xffff0000u) * __builtin_amdgcn_rcpf(e1)); }
        *(u32x4*)(Qp + s * QP + kb) = qo; *(u32x4*)(Kp + s * QP + kb) = ko;
    }
    __syncthreads();
    const int wid = tid >> 6, lane = tid & 63, l32 = lane & 31, hi = lane >> 5;
    if (wid < 4) {
        const int mt = wid & 1, nt = wid >> 1; f32x16 a = f32x16{};
        if (nt <= mt) {
#pragma unroll
            for (int ks = 0; ks < 12; ++ks) { const bf16x8 x = *(const bf16x8*)(Qp + (mt * 32 + l32) * QP + ks * 16 + hi * 8), y = *(const bf16x8*)(Kp + (nt * 32 + l32) * QP + ks * 16 + hi * 8);
                a = __builtin_amdgcn_mfma_f32_32x32x16_bf16(x, y, a, 0, 0, 0); }
        }
#pragma unroll
        for (int r = 0; r < 16; ++r) { const int t = mt * 32 + att::crow(r, hi), s = nt * 32 + l32; const float v = (s <= t) ? a[r] : 0.f; Ab[t * KP + s] = (bf16_t)(cvtpk(v, 0.f) & 0xffffu); }
    }
    __syncthreads();
    const int mt = wid & 1, nt = wid >> 1;
    f32x16 oacc[3];
    const float* Sb = UT + (size_t)(c * GH + h) * GDV * GDK;
#pragma unroll
    for (int vs = 0; vs < 3; ++vs) {
        for (int it = tid; it < 128 * 24; it += 512) { const int v = it / 24, kb = (it % 24) * 8; const float* p = Sb + (size_t)(vs * 128 + v) * GDK + kb;
            *(u32x4*)(ST + v * QP + kb) = pack8u(*(const f32x4*)p, *(const f32x4*)(p + 4)); }
        for (int it = tid; it < 64 * 16; it += 512) { const int s = it & 63, vb = it >> 6; const u32x4 w = *(const u32x4*)(z + (size_t)(row0 + s) * ZLD + ZV + h * GDV + vs * 128 + vb * 8);
#pragma unroll
            for (int i = 0; i < 4; ++i) { VT[(vb * 8 + 2 * i) * KP + s] = (bf16_t)(w[i] & 0xffffu); VT[(vb * 8 + 2 * i + 1) * KP + s] = (bf16_t)(w[i] >> 16); } }
        __syncthreads();
        f32x16 a = f32x16{};
#pragma unroll
        for (int ks = 0; ks < 12; ++ks) { const bf16x8 x = *(const bf16x8*)(Qp + (mt * 32 + l32) * QP + ks * 16 + hi * 8), y = *(const bf16x8*)(ST + (nt * 32 + l32) * QP + ks * 16 + hi * 8);
            a = __builtin_amdgcn_mfma_f32_32x32x16_bf16(x, y, a, 0, 0, 0); }
#pragma unroll
        for (int ks = 0; ks < 4; ++ks) { const bf16x8 x = *(const bf16x8*)(Ab + (mt * 32 + l32) * KP + ks * 16 + hi * 8), y = *(const bf16x8*)(VT + (nt * 32 + l32) * KP + ks * 16 + hi * 8);
            a = __builtin_amdgcn_mfma_f32_32x32x16_bf16(x, y, a, 0, 0, 0); }
        oacc[vs] = a;
        __syncthreads();
    }
#pragma unroll
    for (int r = 0; r < 16; ++r) { float q = oacc[0][r] * oacc[0][r] + oacc[1][r] * oacc[1][r] + oacc[2][r] * oacc[2][r];
        q += __shfl_xor(q, 1); q += __shfl_xor(q, 2); q += __shfl_xor(q, 4); q += __shfl_xor(q, 8); q += __shfl_xor(q, 16);
        if (l32 == 0) RS[(mt * 32 + att::crow(r, hi)) * 4 + nt] = q; }
    __syncthreads();
#pragma unroll
    for (int r = 0; r < 16; ++r) { const int t = mt * 32 + att::crow(r, hi); const f32x4 q4 = *(const f32x4*)(RS + t * 4);
        const float rstd = rsqrtf(((q4[0] + q4[1]) + (q4[2] + q4[3])) * (1.0f / GDV) + RMS_EPS);
#pragma unroll
        for (int vs = 0; vs < 3; ++vs) { const int cv = h * GDV + vs * 128 + nt * 32 + l32;
            const float gate = bf2f(z[(size_t)(row0 + t) * ZLD + ZR + cv]) + br[cv]; const float sg = gate / (1.f + __expf(-gate));
            const float val = oacc[vs][r] * rstd * ng[cv] * sg; const float vn = __shfl_xor(val, 1);
            if ((l32 & 1) == 0) *(unsigned*)(oc + (size_t)(row0 + t) * DM + cv) = cvtpk(val, vn); } }
    __syncthreads();
}
}

__device__ __forceinline__ int in_rowmap(int kind, int c) {
    if (kind == 0) return c < 4608 ? c : (c < 4620 ? 5120 + (c - 4608) : 4608 + (c - 4620));
    if (kind == 2) return c < 4608 ? c : (c < 4624 ? 5120 + (c - 4608) : 4608 + (c - 4624));
    return c;
}
__device__ __forceinline__ void tr_item(const float* W, int K, int N, bf16_t* WT, int kind, const float* gain, float* scr, int item, int lane) {
    const int nblk = (N + 31) >> 5, kb = item / nblk, nb = item - kb * nblk, k0 = 64 * kb, n0 = 32 * nb;
    const int nn = n0 + (lane & 31); const bool ok = nn < N;
    const float* src = W + (size_t)(k0 + (lane >> 5)) * N + (ok ? nn : 0);
    float v[32];
#pragma unroll
    for (int i = 0; i < 32; ++i) v[i] = src[(size_t)(2 * i) * N];
    if (gain) {
#pragma unroll
        for (int i = 0; i < 32; ++i) v[i] *= gain[k0 + 2 * i + (lane >> 5)];
    }
#pragma unroll
    for (int i = 0; i < 32; ++i) scr[(2 * i + (lane >> 5)) * 33 + (lane & 31)] = ok ? v[i] : 0.f;
    LDS_WAIT(); asm volatile("" ::: "memory");
    const int c = lane & 7;
#pragma unroll
    for (int j = 0; j < 4; ++j) { const int n = (lane >> 3) + 8 * j; const float* s = scr + (8 * c) * 33 + n;
        if (n0 + n < N) { u32x4 o; o[0] = cvtpk(s[0 * 33], s[1 * 33]); o[1] = cvtpk(s[2 * 33], s[3 * 33]); o[2] = cvtpk(s[4 * 33], s[5 * 33]); o[3] = cvtpk(s[6 * 33], s[7 * 33]);
            *(u32x4*)(WT + (size_t)in_rowmap(kind, n0 + n) * K + k0 + 8 * c) = o; } }
    LDS_WAIT(); asm volatile("" ::: "memory");
}
template <int NF4>
__device__ __forceinline__ void cvt_row2(const float* s0, bf16_t* d0, const float* s1, bf16_t* d1, int lane) {
    f32x4 a[NF4], b[NF4];
#pragma unroll
    for (int q = 0; q < NF4; ++q) { a[q] = *(const f32x4*)(s0 + q * 256 + lane * 4); b[q] = *(const f32x4*)(s1 + q * 256 + lane * 4); }
#pragma unroll
    for (int q = 0; q < NF4; ++q) { u32x2 w = {cvtpk(a[q][0], a[q][1]), cvtpk(a[q][2], a[q][3])}; *(u32x2*)(d0 + q * 256 + lane * 4) = w;
        u32x2 x = {cvtpk(b[q][0], b[q][1]), cvtpk(b[q][2], b[q][3])}; *(u32x2*)(d1 + q * 256 + lane * 4) = x; }
}

#ifndef EN_MASK
#define EN_MASK 0xFFFF
#endif
#define EN(k) ((EN_MASK >> (k)) & 1)
struct Args { const float* in[29]; float* out; unsigned char* ws; int ph_lo, ph_hi; };
constexpr int PPL = 9;
constexpr int PH_FINAL = 1 + PPL * NLAYER, PH_END = PH_FINAL + 1;
constexpr int PT_OFF = MISC_OFF + 256;
__device__ __forceinline__ unsigned long long ptab_raw(const char* lds, int k) {
    const unsigned long long v = ((const unsigned long long*)(lds + PT_OFF))[k];
    const unsigned l = __builtin_amdgcn_readfirstlane((unsigned)v), h = __builtin_amdgcn_readfirstlane((unsigned)(v >> 32));
    return ((unsigned long long)h << 32) | l;
}
#define PIN(k) ((const float*)(const GAS float*)ptab_raw(lds, (k)))
#define POUT() ((float*)(GAS float*)ptab_raw(lds, 29))
#define PWS() ((unsigned char*)(GAS unsigned char*)ptab_raw(lds, 30))

__global__ void __launch_bounds__(512, 2) trunk_fwd(Args args) {
    extern __shared__ __attribute__((aligned(16))) unsigned char lds_raw[];
    char* lds = (char*)lds_raw;
    volatile LAS unsigned* MISC = (volatile LAS unsigned*)((LAS unsigned char*)lds_raw + MISC_OFF);
    for (int u = threadIdx.x; u < 64; u += 512) MISC[u] = 0u;
    if (threadIdx.x < 29) ((unsigned long long*)(lds + PT_OFF))[threadIdx.x] = (unsigned long long)args.in[threadIdx.x];
    if (threadIdx.x == 29) ((unsigned long long*)(lds + PT_OFF))[29] = (unsigned long long)args.out;
    if (threadIdx.x == 30) ((unsigned long long*)(lds + PT_OFF))[30] = (unsigned long long)args.ws;
    const int g_wave = __builtin_amdgcn_readfirstlane(threadIdx.x >> 6);
    __syncthreads();
    const int G = gridDim.x, bx = blockIdx.x, vcu = (G % 8 == 0) ? (bx % 8) * (G / 8) + bx / 8 : bx;
#if !MK_PER_PHASE
    const XcdBarrier bar = xcd_barrier_post((unsigned*)(args.ws + WS_CTL) + CW_BAR, MISC + 8);
#define GRID_BAR() xcd_barrier(bar)
#else
#define GRID_BAR() do { } while (0)
#endif
    const int lo = args.ph_lo, hi = args.ph_hi;
#define IN(k) (lo <= (k) && (k) < hi)
#define SEAM(k) do { if ((k) + 1 < hi) GRID_BAR(); } while (0)
#define WSP(T, off) ((T*)(ws + (off)))

    if (EN(0) && IN(0)) {
        unsigned char* ws = PWS();
        const int tid = opaque_tid(), lane = tid & 63, wave = tid >> 6, gw = vcu * 8 + wave, NGW = G * 8;
        float* scr = (float*)(lds + wave * 16384);
        for (int L = 0; L < NLAYER; ++L) {
            const int kind = L % 3, j = L / 3;
            const float* win = kind == 0 ? PIN(16) + (size_t)j * DM * 5132 : (kind == 1 ? PIN(19) : PIN(21)); const int nin = kind == 0 ? 5132 : (kind == 1 ? 5120 : 5136);
            const float* wout = kind == 0 ? PIN(18) + (size_t)j * DM * DM : (kind == 1 ? PIN(20) : PIN(26));
            for (int it = gw; it < 32 * ((nin + 31) / 32); it += NGW) tr_item(win, DM, nin, WSP(bf16_t, WS_WIN) + (size_t)L * ZLD * DM, kind, PIN(11) + L * DM, scr, it, lane);
            for (int it = gw; it < 32 * 64; it += NGW) tr_item(wout, DM, DM, WSP(bf16_t, WS_WOUT) + (size_t)L * DM * DM, 1, nullptr, scr, it, lane);
            for (int it = gw; it < 32 * 256; it += NGW) tr_item(PIN(27) + (size_t)L * DM * DFF, DM, DFF, WSP(bf16_t, WS_WUP) + (size_t)L * DFF * DM, 1, PIN(12) + L * DM, scr, it, lane);
            for (int it = gw; it < 128 * 64; it += NGW) tr_item(PIN(28) + (size_t)L * DFF * DM, DFF, DM, WSP(bf16_t, WS_WDN) + (size_t)L * DM * DFF, 1, nullptr, scr, it, lane);
            for (int it = gw; it < 32 * 32; it += NGW) tr_item(PIN(15) + (size_t)L * DM * 1024, DM, 1024, WSP(bf16_t, WS_WMKV) + (size_t)L * 1024 * DM, 1, nullptr, scr, it, lane);
        }
        { const float* xp = PIN(0); const float* xs = PIN(1); float* X = WSP(float, WS_X); bf16_t* XB = WSP(bf16_t, WS_XB); float* RSA = WSP(float, WS_RSS);
        for (int m = gw; m < MT; m += NGW) {
            const float* src = m < TP ? xp + (size_t)m * DM : xs + (size_t)(m - TP) * DM; float ss = 0.f;
#pragma unroll
            for (int q = 0; q < 8; ++q) { const int o = q * 256 + lane * 4; const f32x4 v = *(const f32x4*)(src + o); *(f32x4*)(X + (size_t)m * DM + o) = v;
                u32x2 w = {cvtpk(v[0], v[1]), cvtpk(v[2], v[3])}; *(u32x2*)(XB + (size_t)m * DM + o) = w; ss += (v[0] * v[0] + v[1] * v[1]) + (v[2] * v[2] + v[3] * v[3]); }
            ss = wave_sum(ss);
            if (lane < 32) RSA[(size_t)m * 32 + lane] = lane == 0 ? ss : 0.f;
        } }
        { const float* mp = PIN(10); const float* gm = PIN(13); bf16_t* MEMH = WSP(bf16_t, WS_MEMH);
        for (int it = gw; it < NLAYER * NMEM; it += NGW) { const int i = it / NMEM, r = it % NMEM; const float* src = mp + (size_t)r * DM; const float* g = gm + (size_t)i * DM;
            f32x4 v[8]; float ss = 0.f;
#pragma unroll
            for (int q = 0; q < 8; ++q) { v[q] = *(const f32x4*)(src + q * 256 + lane * 4); ss += (v[q][0] * v[q][0] + v[q][1] * v[q][1]) + (v[q][2] * v[q][2] + v[q][3] * v[q][3]); }
            const float rstd = rsqrtf(wave_sum(ss) * (1.0f / DM) + RMS_EPS);
#pragma unroll
            for (int q = 0; q < 8; ++q) { const f32x4 gg = *(const f32x4*)(g + q * 256 + lane * 4); u32x2 w = {cvtpk(v[q][0] * rstd * gg[0], v[q][1] * rstd * gg[1]), cvtpk(v[q][2] * rstd * gg[2], v[q][3] * rstd * gg[3])};
                *(u32x2*)(MEMH + ((size_t)i * NMEM + r) * DM + q * 256 + lane * 4) = w; } } }
        { const float* ck = PIN(2); const float* cv = PIN(3); bf16_t* KVF = WSP(bf16_t, WS_KVF);
        for (int it = gw; it < 2 * NB * PAST; it += NGW) { const int jj = it / (NB * PAST), r = it % (NB * PAST); const size_t so = ((size_t)jj * NB * PAST + r) * AW, dof = ((size_t)(r / PAST) * SKS + (r % PAST)) * AW;
            cvt_row2<6>(ck + so, KVF + (size_t)(2 * jj) * (KVS_ONE / 2) + dof, cv + so, KVF + (size_t)(2 * jj + 1) * (KVS_ONE / 2) + dof, lane); } }
        { const float* ck = PIN(5); const float* cv = PIN(6); bf16_t* KVS = WSP(bf16_t, WS_KVS);
        for (int r = gw; r < NB * PAST; r += NGW) { const size_t so = (size_t)r * AW, dof = ((size_t)(r / PAST) * SKS + (r % PAST)) * AW;
            cvt_row2<6>(ck + so, KVS + dof, cv + so, KVS + KVS_ONE / 2 + dof, lane); } }
        { const float* ck = PIN(8); const float* cv = PIN(9); bf16_t* MEMC = WSP(bf16_t, WS_MEMC);
        for (int it = gw; it < NLAYER * NB * NMEM; it += NGW) { const int L = it / (NB * NMEM), r = it % (NB * NMEM); const size_t so = ((size_t)L * NB * NMEM + r) * MEMW, dof = (size_t)r * MEMW;
            cvt_row2<2>(ck + so, MEMC + (size_t)(2 * L) * (MEMC_ONE / 2) + dof, cv + so, MEMC + (size_t)(2 * L + 1) * (MEMC_ONE / 2) + dof, lane); } }
        SEAM(0);
    }

    for (int L = 0; L < NLAYER; ++L) {
        const int kind = L % 3, j = L / 3, base = 1 + PPL * L;
        if (EN(1) && IN(base + 0)) {
            unsigned char* ws = PWS();
            const int tid = opaque_tid();
            pg8::Sched S; S.nM = MT / 256; S.nN = kind == 1 ? 20 : 21; S.nwg = S.nM * S.nN; S.G = G; S.c = bx; S.nextra = L == 0 ? 16 : 0;
            S.A = (const char*)WSP(bf16_t, WS_XB); S.B = (const char*)(WSP(bf16_t, WS_WIN) + (size_t)L * ZLD * DM); S.tA = (size_t)256 * DM * 2; S.tB = (size_t)256 * DM * 2;
            S.Ae = (const char*)WSP(bf16_t, WS_MEMH); S.Be = (const char*)WSP(bf16_t, WS_WMKV); S.tAe = (size_t)NMEM * DM * 2; S.tBe = (size_t)256 * DM * 2;
            pg8::EpiIn E; E.z = WSP(bf16_t, WS_Z); E.rss = WSP(float, WS_RSS); E.out = POUT(); E.mkvb = WSP(bf16_t, WS_MKVB); E.kind = kind; E.j = j; E.ctl = (unsigned*)WSP(unsigned, WS_CTL);
            E.kvb = kind == 0 ? WSP(bf16_t, WS_KVF) + (size_t)(2 * j) * (KVS_ONE / 2) : WSP(bf16_t, WS_KVS); E.bfg = PIN(17) + j * NH;
            pg8::gemm_phase<pg8::EpiIn, pg8::Sched>((LAS unsigned char*)lds_raw, DM, DM, DM, S, E, tid);
            SEAM(base + 0);
        }
        if (IN(base + 1) && kind != 0) {
            unsigned char* ws = PWS();
            if (EN(2) && kind == 1) {
                bf16_t* Z = WSP(bf16_t, WS_Z); bf16_t* OC = WSP(bf16_t, WS_OC); bf16_t* KVS = WSP(bf16_t, WS_KVS);
                for (int n = vcu; n < 480; n += G) { att::Blk b; b.ldq = ZLD; b.ldo = DM; b.bmode = 0; b.lf0 = b.lf1 = nullptr; b.n0 = 0; b.qq = b.kq = nullptr; b.jlo = 0; b.bsel = 0;
                    if (n < 384) { const int h = n / 32, qb = n % 32; b.Q = Z + (size_t)qb * 256 * ZLD + h * HD; b.K = Z + AW + h * HD; b.V = Z + 2 * AW + h * HD; b.ldkv = ZLD;
                        b.O = OC + (size_t)qb * 256 * DM + h * HD; b.P0 = qb * 256; b.skv = TP; b.nrows = 256; }
                    else { const int m = n - 384, bb = m / NH, h = m % NH; b.Q = Z + (size_t)(TP + bb * 64) * ZLD + h * HD; b.K = KVS + (size_t)bb * SKS * AW + h * HD; b.V = KVS + KVS_ONE / 2 + (size_t)bb * SKS * AW + h * HD; b.ldkv = AW;
                        b.O = OC + (size_t)(TP + bb * 64) * DM + h * HD; b.P0 = PAST; b.skv = SKS; b.nrows = 64; }
                    att::sb_block(b, lds, g_wave); }
            } else if (EN(3) && kind == 2) {
                for (int u = vcu; u < NCHUNK * GH; u += G) gla::g1_unit(u / GH, u % GH, WSP(bf16_t, WS_Z), PIN(22), PIN(23), WSP(float, WS_GU), WSP(float, WS_GDEC), lds, g_wave);
            }
            SEAM(base + 1);
        }
        if (EN(4) && IN(base + 2) && kind == 2) {
            unsigned char* ws = PWS();
            const int tid = opaque_tid();
            if (vcu < 144) gla::g2_tile(vcu, WSP(float, WS_GU), WSP(float, WS_GDEC), PIN(7), POUT() + O_GSP, POUT() + O_GSS, lds, tid);
            SEAM(base + 2);
        }
        if (IN(base + 3)) {
            unsigned char* ws = PWS();
            if (EN(5) && kind == 2) for (int u = vcu; u < NCHUNK * GH; u += G) gla::g3_unit(u / GH, u % GH, WSP(bf16_t, WS_Z), PIN(22), PIN(23), WSP(float, WS_GU), PIN(25), PIN(24), WSP(bf16_t, WS_OC), lds, g_wave);
            const float* outp = POUT(); const float* lfc = PIN(4);
            const int nfox = kind == 0 ? 480 : 0, total = nfox + 160;
            auto get = [&](int n, att::Blk& b) {
                int type, a0, a1;
                if (n < nfox) { if (n < 384) { type = 0; a0 = n % NH; a1 = 31 - n / NH; } else { type = 1; a0 = (n - 384) / NH; a1 = (n - 384) % NH; } }
                else { const int m = n - nfox; if (m < 128) { type = 2; a0 = m / 32; a1 = m % 32; } else { type = 3; a0 = (m - 128) / MH; a1 = (m - 128) % MH; } }
                bf16_t* Z = WSP(bf16_t, WS_Z); bf16_t* OC = WSP(bf16_t, WS_OC);
                b.ldq = ZLD; b.ldo = DM; b.lf0 = b.lf1 = nullptr; b.n0 = 0; b.bmode = 0; b.qq = b.kq = nullptr; b.jlo = 0;
                if (type == 0) { const int h = a0, qb = a1; b.Q = Z + (size_t)qb * 256 * ZLD + h * HD; b.K = Z + AW + h * HD; b.V = Z + 2 * AW + h * HD; b.ldkv = ZLD; b.O = OC + (size_t)qb * 256 * DM + h * HD;
                    b.P0 = qb * 256; b.skv = TP; b.nrows = 256; b.bmode = 1; b.lf0 = outp + O_FLP + (size_t)j * TP * NH + h; b.n0 = 1 << 30;
                    b.qq = WSP(unsigned, WS_CTL) + CW_QQ + ((j * 32 + qb) * NH + h) * 4; b.kq = WSP(unsigned, WS_CTL) + CW_KQ + j * 64 + h * 4; }
                else if (type == 1) { const int bb = a0, h = a1; const bf16_t* fk = WSP(bf16_t, WS_KVF) + (size_t)(2 * j) * (KVS_ONE / 2);
                    b.Q = Z + (size_t)(TP + bb * 64) * ZLD + h * HD; b.K = fk + (size_t)bb * SKS * AW + h * HD; b.V = fk + KVS_ONE / 2 + (size_t)bb * SKS * AW + h * HD; b.ldkv = AW;
                    b.O = OC + (size_t)(TP + bb * 64) * DM + h * HD; b.P0 = PAST; b.skv = SKS; b.nrows = 64; b.bmode = 1; b.lf0 = lfc + ((size_t)j * NB + bb) * PAST * NH + h; b.n0 = PAST; b.lf1 = outp + O_FLS + (size_t)j * TS * NH + (size_t)bb * 64 * NH + h; }
                else if (type == 2) { const int h4 = a0, qb = a1; const bf16_t* mkb = WSP(bf16_t, WS_MKVB) + (size_t)L * NMEM * 1024;
                    b.Q = Z + (size_t)qb * 256 * ZLD + 4608 + h4 * HD; b.K = mkb + h4 * HD; b.V = mkb + MEMW + h4 * HD; b.ldkv = 1024; b.O = OC + (size_t)qb * 256 * DM + AW + h4 * HD;
                    b.P0 = 1 << 20; b.skv = NMEM; b.nrows = 256; }
                else { const int bb = a0, h4 = a1; const bf16_t* mck = WSP(bf16_t, WS_MEMC) + (size_t)(2 * L) * (MEMC_ONE / 2);
                    b.Q = Z + (size_t)(TP + bb * 64) * ZLD + 4608 + h4 * HD; b.K = mck + (size_t)bb * NMEM * MEMW + h4 * HD; b.V = mck + MEMC_ONE / 2 + (size_t)bb * NMEM * MEMW + h4 * HD; b.ldkv = MEMW;
                    b.O = OC + (size_t)(TP + bb * 64) * DM + AW + h4 * HD; b.P0 = 1 << 20; b.skv = NMEM; b.nrows = 64; }
            };
            unsigned* qhead = WSP(unsigned, WS_CTL) + CW_QUEUE + 64 * L;
            auto fetch = [&]() -> int { if (opaque_tid() == 0) MISC[16] = __hip_atomic_fetch_add(qhead, 1u, __ATOMIC_RELAXED, __HIP_MEMORY_SCOPE_AGENT); __syncthreads(); const int v = (int)MISC[16]; __syncthreads(); return __builtin_amdgcn_readfirstlane(v); };
            if (EN(6)) {
                att::Blk cur, nxt; int ic = fetch();
                if (ic < total) {
                    get(ic, cur); cur.bsel = 0; att::prepare_bias(cur, lds, g_wave);
                    att::Seam S; att::att_prime(cur, lds, S, g_wave);
                    for (;;) { const int in_ = fetch(); const bool more = in_ < total;
                        if (more) { get(in_, nxt); nxt.bsel = cur.bsel ^ 1; att::prepare_bias(nxt, lds, g_wave); } else nxt = cur;
                        att::att_block(cur, nxt, lds, S, g_wave);
                        if (!more) break; cur = nxt; }
                }
            }
            SEAM(base + 3);
        }
        for (int q = 4; q <= 8; ++q) {
            if (!IN(base + q)) continue;
            unsigned char* ws = PWS();
            const bool dn = q >= 7;
            float* rssw = WSP(float, WS_RSS) + (dn ? 0 : (size_t)MT * 32);
            const int SP = dn ? 16 : 8;
            if (q == 4 || q == 7) {
                if (EN(7)) {
                const int tid = opaque_tid();
                const int K = dn ? DFF : DM; const char* Ab = dn ? (const char*)WSP(bf16_t, WS_U) : (const char*)WSP(bf16_t, WS_OC);
                const char* Bb = dn ? (const char*)(WSP(bf16_t, WS_WDN) + (size_t)L * DM * DFF) : (const char*)(WSP(bf16_t, WS_WOUT) + (size_t)L * DM * DM);
                { pg8::Sched S; S.nM = TP / 256; S.nN = DM / 256; S.nwg = S.nM * S.nN; S.G = G; S.c = bx; S.nextra = 0;
                  S.A = Ab; S.B = Bb; S.tA = (size_t)256 * K * 2; S.tB = (size_t)256 * K * 2; S.Ae = S.Be = nullptr; S.tAe = S.tBe = 0;
                  pg8::EpiRes E{WSP(float, WS_X), WSP(bf16_t, WS_XB), rssw};
                  pg8::gemm_phase<pg8::EpiRes, pg8::Sched>((LAS unsigned char*)lds_raw, K, K, K, S, E, tid); }
                { pg8::SchedSplit S; S.S = SP; S.nu = 16 * SP; S.G = G; S.c = bx; S.A = Ab; S.B = Bb; S.tA = (size_t)256 * K * 2; S.tB = (size_t)256 * K * 2; S.kbytes = (size_t)(K / SP) * 2;
                  pg8::EpiPart E{WSP(float, WS_GU)};
                  pg8::gemm_phase<pg8::EpiPart, pg8::SchedSplit>((LAS unsigned char*)lds_raw, K / SP, K, K, S, E, tid); }
                }
            } else if (q == 5 || q == 8) {
                if (EN(8)) {
                const int tid = opaque_tid(), lane = tid & 63, wave = tid >> 6;
                float* X = WSP(float, WS_X); bf16_t* XB = WSP(bf16_t, WS_XB); const float* part = WSP(float, WS_GU);
                for (int r = vcu; r < TS; r += G) { const size_t o = (size_t)(TP + r) * DM + tid * 4; const float* pp = part + (size_t)r * DM + tid * 4;
                    f32x4 a = *(const f32x4*)(X + o); f32x4 p[16];
#pragma unroll
                    for (int s = 0; s < 16; ++s) p[s] = s < SP ? *(const f32x4*)(pp + (size_t)s * TS * DM) : (f32x4){0.f, 0.f, 0.f, 0.f};
#pragma unroll
                    for (int s = 0; s < 16; ++s) a += p[s];
                    *(f32x4*)(X + o) = a; u32x2 w = {cvtpk(a[0], a[1]), cvtpk(a[2], a[3])}; *(u32x2*)(XB + o) = w;
                    const float ss = wave_sum((a[0] * a[0] + a[1] * a[1]) + (a[2] * a[2] + a[3] * a[3]));
                    if (lane < 4) rssw[(size_t)(TP + r) * 32 + wave + 8 * lane] = lane == 0 ? ss : 0.f; }
                }
            } else {
                if (EN(9)) {
                const int tid = opaque_tid();
                pg8::Sched S; S.nM = MT / 256; S.nN = DFF / 256; S.nwg = S.nM * S.nN; S.G = G; S.c = bx; S.nextra = 0;
                S.A = (const char*)WSP(bf16_t, WS_XB); S.B = (const char*)(WSP(bf16_t, WS_WUP) + (size_t)L * DFF * DM); S.tA = (size_t)256 * DM * 2; S.tB = (size_t)256 * DM * 2; S.Ae = S.Be = nullptr; S.tAe = S.tBe = 0;
                pg8::EpiUp E{WSP(bf16_t, WS_U), WSP(float, WS_RSS) + (size_t)MT * 32};
                pg8::gemm_phase<pg8::EpiUp, pg8::Sched>((LAS unsigned char*)lds_raw, DM, DM, DM, S, E, tid);
                }
            }
            SEAM(base + q);
        }
    }
    if (EN(10) && IN(PH_FINAL)) {
        unsigned char* ws = PWS(); float* out = POUT();
        const int tid = opaque_tid(), lane = tid & 63, wave = tid >> 6, gw = vcu * 8 + wave, NGW = G * 8;
        const float* g = PIN(14); const float* X = WSP(float, WS_X); const float* RSA = WSP(float, WS_RSS);
        for (int m = gw; m < MT; m += NGW) {
            const float rstd = rsqrtf(wave_sum(lane < 32 ? RSA[(size_t)m * 32 + lane] : 0.f) * (1.0f / DM) + RMS_EPS); float* dst = m < TP ? out + O_YP + (size_t)m * DM : out + O_YS + (size_t)(m - TP) * DM;
#pragma unroll
            for (int q = 0; q < 8; ++q) { const int o = q * 256 + lane * 4; const f32x4 v = *(const f32x4*)(X + (size_t)m * DM + o), gg = *(const f32x4*)(g + o); *(f32x4*)(dst + o) = v * rstd * gg; }
        }
    }
#undef IN
#undef SEAM
#undef GRID_BAR
}

extern "C" void kernel_launch(void* const* d_in, const int* in_sizes, int n_in, void* d_out, int out_size, void* d_ws, size_t ws_size, hipStream_t stream) {
    static int grid = 0;
    if (grid == 0) {
        if (n_in != 29 || (size_t)out_size != O_END || ws_size < WS_END) { fprintf(stderr, "kernel_launch: unexpected shapes (n_in %d, out %d vs %zu, ws %zu vs %zu); nothing launched\n", n_in, out_size, (size_t)O_END, ws_size, (size_t)WS_END); grid = -1; return; }
        int dev = 0, cus = 0, per_cu = 0;
        if (hipGetDevice(&dev) != hipSuccess || hipDeviceGetAttribute(&cus, hipDeviceAttributeMultiprocessorCount, dev) != hipSuccess) { grid = -1; return; }
        if (hipFuncSetAttribute((const void*)trunk_fwd, hipFuncAttributeMaxDynamicSharedMemorySize, LDS_BYTES) != hipSuccess) { fprintf(stderr, "kernel_launch: hipFuncSetAttribute failed\n"); grid = -1; return; }
        if (hipOccupancyMaxActiveBlocksPerMultiprocessor(&per_cu, (const void*)trunk_fwd, 512, LDS_BYTES) != hipSuccess || per_cu < 1) fprintf(stderr, "kernel_launch: occupancy query reports %d workgroups per CU\n", per_cu);
        (void)hipGetLastError();
        grid = cus;
    }
    if (grid < 0) return;
    if (hipMemsetAsync((char*)d_ws + WS_CTL, 0, CTL_BYTES, stream) != hipSuccess) return;
    Args a{};
    for (int i = 0; i < 29; ++i) a.in[i] = (const float*)d_in[i];
    a.out = (float*)d_out; a.ws = (unsigned char*)d_ws;
#if MK_PER_PHASE
    for (int p = 0; p < PH_END; ++p) {
        if (p >= 1 && p < PH_FINAL) { const int L = (p - 1) / PPL, q = (p - 1) % PPL, kind = L % 3; if ((q == 1 && kind == 0) || (q == 2 && kind != 2)) continue; }
        a.ph_lo = p; a.ph_hi = p + 1;
        hipLaunchKernelGGL(trunk_fwd, dim3(grid), dim3(512), LDS_BYTES, stream, a);
#ifdef PROBE_LO
        if (p == PROBE_HI - 1) for (int pp = PROBE_LO; pp < PROBE_HI; ++pp) { a.ph_lo = pp; a.ph_hi = pp + 1; hipLaunchKernelGGL(trunk_fwd, dim3(grid), dim3(512), LDS_BYTES, stream, a); }
#endif
    }
#else
    a.ph_lo = 0; a.ph_hi = PH_END;
    hipLaunchKernelGGL(trunk_fwd, dim3(grid), dim3(512), LDS_BYTES, stream, a);
#endif
}
```

```cpp
#include <hip/hip_runtime.h>
#include <hip/hip_bf16.h>
#include <cstdio>
#include <cstdint>

#define MK_PER_PHASE 0
#ifndef MK_PER_PHASE
#define MK_PER_PHASE 0
#endif

constexpr int DM = 2048, TP = 8192, TS = 512, MT = TP + TS, NB = 8, CSEQ = 64, PAST = 1024, SKS = PAST + CSEQ;
constexpr int HD = 128, NH = 12, AW = NH * HD, MEMW = 512, NMEM = 256, MH = 4;
constexpr int GH = 4, GDK = 192, GDV = 384, GKW = GH * GDK, GVW = GH * GDV, GRANK = 16;
constexpr int DFF = 8192, ZLD = 5376, NLAYER = 4;
constexpr int NCHUNK = TP / 64 + NB;
constexpr float RMS_EPS = 1e-6f;

constexpr size_t O_YP = 0;
constexpr size_t O_YS = O_YP + (size_t)TP * DM;
constexpr size_t O_FKP = O_YS + (size_t)TS * DM;
constexpr size_t O_FVP = O_FKP + (size_t)2 * TP * AW;
constexpr size_t O_FLP = O_FVP + (size_t)2 * TP * AW;
constexpr size_t O_SKP = O_FLP + (size_t)2 * TP * NH;
constexpr size_t O_SVP = O_SKP + (size_t)TP * AW;
constexpr size_t O_GSP = O_SVP + (size_t)TP * AW;
constexpr size_t O_MKP = O_GSP + (size_t)GH * GDK * GDV;
constexpr size_t O_MVP = O_MKP + (size_t)NLAYER * NMEM * MEMW;
constexpr size_t O_FKS = O_MVP + (size_t)NLAYER * NMEM * MEMW;
constexpr size_t O_FVS = O_FKS + (size_t)2 * TS * AW;
constexpr size_t O_FLS = O_FVS + (size_t)2 * TS * AW;
constexpr size_t O_SKS = O_FLS + (size_t)2 * TS * NH;
constexpr size_t O_SVS = O_SKS + (size_t)TS * AW;
constexpr size_t O_GSS = O_SVS + (size_t)TS * AW;
constexpr size_t O_END = O_GSS + (size_t)NB * GH * GDK * GDV;

constexpr size_t al256(size_t x) { return (x + 255) & ~(size_t)255; }
constexpr size_t WS_CTL = 0, CTL_BYTES = 2u << 20;
constexpr size_t WS_WIN = CTL_BYTES;
constexpr size_t WS_WOUT = WS_WIN + (size_t)NLAYER * ZLD * DM * 2;
constexpr size_t WS_WUP = WS_WOUT + (size_t)NLAYER * DM * DM * 2;
constexpr size_t WS_WDN = WS_WUP + (size_t)NLAYER * DFF * DM * 2;
constexpr size_t WS_WMKV = WS_WDN + (size_t)NLAYER * DM * DFF * 2;
constexpr size_t WS_X = WS_WMKV + (size_t)NLAYER * 1024 * DM * 2;
constexpr size_t WS_XB = WS_X + (size_t)MT * DM * 4;
constexpr size_t WS_Z = WS_XB + (size_t)MT * DM * 2;
constexpr size_t WS_OC = WS_Z + (size_t)MT * ZLD * 2;
constexpr size_t WS_U = WS_OC + (size_t)MT * DM * 2;
constexpr size_t WS_GU = WS_U + (size_t)MT * DFF * 2;
constexpr size_t WS_GDEC = WS_GU + (size_t)NCHUNK * GH * GDV * GDK * 4;
constexpr size_t WS_KVF = al256(WS_GDEC + (size_t)NCHUNK * GH * GDK * 4);
constexpr size_t KVS_ONE = (size_t)NB * SKS * AW * 2;
constexpr size_t WS_KVS = WS_KVF + 4 * KVS_ONE;
constexpr size_t WS_MEMC = WS_KVS + 2 * KVS_ONE;
constexpr size_t MEMC_ONE = (size_t)NB * NMEM * MEMW * 2;
constexpr size_t WS_MEMH = WS_MEMC + 8 * MEMC_ONE;
constexpr size_t WS_MKVB = WS_MEMH + (size_t)NLAYER * NMEM * DM * 2;
constexpr size_t WS_RSS = WS_MKVB + (size_t)NLAYER * NMEM * 1024 * 2;
constexpr size_t WS_FL = WS_RSS + (size_t)2 * MT * 32 * 4;
constexpr size_t WS_END = WS_FL + (size_t)MT * NH * 4;

constexpr int CW_BAR = 4096;
constexpr int CW_QUEUE = 8192;
constexpr int CW_KQ = 12288;
constexpr int CW_CONV = 20480;
constexpr int CW_QQ = 16384;

constexpr int LDS_WORK = 136 * 1024;
constexpr int MISC_OFF = LDS_WORK;
constexpr int LDS_BYTES = 147456;

#define GAS __attribute__((address_space(1)))
#define LAS __attribute__((address_space(3)))
typedef unsigned short bf16_t;
typedef unsigned u32x4 __attribute__((ext_vector_type(4)));
typedef unsigned u32x2 __attribute__((ext_vector_type(2)));
typedef float f32x4 __attribute__((ext_vector_type(4)));
typedef float f32x2 __attribute__((ext_vector_type(2)));
typedef float f32x16 __attribute__((ext_vector_type(16)));
typedef short bf16x8 __attribute__((ext_vector_type(8)));
typedef short s16x4 __attribute__((ext_vector_type(4)));
#define LDS_WAIT() asm volatile("s_waitcnt lgkmcnt(0)" ::: "memory")
#define VM_WAIT() asm volatile("s_waitcnt vmcnt(0)" ::: "memory")
#define SBAR() __builtin_amdgcn_sched_barrier(0)
__device__ __forceinline__ unsigned cvtpk(float lo, float hi) { unsigned r; asm volatile("v_cvt_pk_bf16_f32 %0, %1, %2" : "=v"(r) : "v"(lo), "v"(hi)); return r; }
__device__ __forceinline__ float bf2f(unsigned short b) { return __uint_as_float((unsigned)b << 16); }
__device__ __forceinline__ u32x4 pack8u(f32x4 a, f32x4 b) { u32x4 w = {cvtpk(a[0], a[1]), cvtpk(a[2], a[3]), cvtpk(b[0], b[1]), cvtpk(b[2], b[3])}; return w; }
__device__ __forceinline__ bf16x8 pack8(f32x4 a, f32x4 b) { u32x4 w = pack8u(a, b); return *reinterpret_cast<bf16x8*>(&w); }
__device__ __forceinline__ float wave_sum(float v) {
#pragma unroll
    for (int o = 1; o < 64; o <<= 1) v += __shfl_xor(v, o);
    return v;
}
__device__ __forceinline__ float log_sigmoidf(float x) { return fminf(x, 0.f) - log1pf(expf(-fabsf(x))); }
__device__ __forceinline__ float log_sigmoid_fast(float x) { return fminf(x, 0.f) - __logf(1.f + __expf(-fabsf(x))); }
__device__ __forceinline__ int opaque_tid_w(int wave) { int l; asm volatile("v_mbcnt_lo_u32_b32 %0, -1, 0\n\tv_mbcnt_hi_u32_b32 %0, -1, %0" : "=v"(l)); return wave * 64 + l; }
#define opaque_tid() opaque_tid_w(g_wave)
template <class T> __device__ __forceinline__ T* launder_s(T* p) { asm volatile("" : "+s"(p)); return p; }
#define XB_TMO      128
#define XB_XCNT(j)  (256  + 64 * (j))
#define XB_XSUB(j)  (1280 + 64 * (j))
#define XB_XGEN(j)  (2304 + 64 * (j))
#define XB_TOP      3328
#define XB_TOPGEN   3392
#define XCD_BAR_WORDS 3456
#define XB_SPIN_CAP (1u << 18)
__device__ __forceinline__ unsigned xb_ld(unsigned* p)              { return __hip_atomic_load(p, __ATOMIC_RELAXED, __HIP_MEMORY_SCOPE_AGENT); }
__device__ __forceinline__ unsigned xb_add(unsigned* p, unsigned v) { return __hip_atomic_fetch_add(p, v, __ATOMIC_RELAXED, __HIP_MEMORY_SCOPE_AGENT); }
__device__ __forceinline__ unsigned xb_xcc_id() { return (unsigned)__builtin_amdgcn_s_getreg((3 << 11) | 20) & 0xFu; }
#define XB_SPIN(cond, bar) do { unsigned _sp = 0; while (cond) { __builtin_amdgcn_s_sleep(1); \
    if ((++_sp & 255u) == 0u) { if (xb_ld(&(bar)[XB_TMO])) break; if (_sp > XB_SPIN_CAP) { atomicAdd(&(bar)[XB_TMO], 1u); break; } } } } while (0)
struct XcdBarrier { unsigned* bar; unsigned x; volatile LAS unsigned* st; };
__device__ __forceinline__ XcdBarrier xcd_barrier_post(unsigned* bar, volatile LAS unsigned* st) {
    XcdBarrier b; b.bar = bar; b.x = xb_xcc_id(); b.st = st;
    if (threadIdx.x == 0) (void)xb_add(&bar[XB_XCNT(b.x)], 1u);
    return b;
}
__device__ __forceinline__ void xcd_barrier_complete(unsigned* bar, unsigned x, unsigned& nloc, unsigned& nx) {
    const unsigned G = gridDim.x * gridDim.y * gridDim.z;
    unsigned sum, cnt, mine, sp = 0u;
    for (;;) {
        sum = 0u; cnt = 0u; mine = 0u;
#pragma unroll
        for (unsigned j = 0; j < 16; ++j) { const unsigned c = xb_ld(&bar[XB_XCNT(j)]); sum += c; cnt += (c > 0u) ? 1u : 0u; mine = (j == x) ? c : mine; }
        if (sum == G) break;
        __builtin_amdgcn_s_sleep(1);
        if ((++sp & 255u) == 0u) { if (xb_ld(&bar[XB_TMO])) break; if (sp > XB_SPIN_CAP) { atomicAdd(&bar[XB_TMO], 1u); break; } }
    }
    nloc = mine > 0u ? mine : 1u; nx = cnt > 0u ? cnt : 1u;
}
__device__ __forceinline__ void xcd_barrier(const XcdBarrier& b) {
    asm volatile("s_waitcnt vmcnt(0)" ::: "memory");
    __syncthreads();
    if (threadIdx.x == 0) {
        unsigned* bar = b.bar;
        __builtin_amdgcn_s_waitcnt(0);
        unsigned nloc = b.st[0], nx = b.st[1];
        if (nloc == 0u) { xcd_barrier_complete(bar, b.x, nloc, nx); b.st[0] = nloc; b.st[1] = nx; }
        const unsigned old = xb_add(&bar[XB_XSUB(b.x)], 1u);
        const unsigned gen = old / nloc;
        if (old + 1u == (gen + 1u) * nloc) {
            __builtin_amdgcn_fence(__ATOMIC_RELEASE, "agent");
            asm volatile("s_waitcnt vmcnt(0)" ::: "memory");
            const unsigned og = xb_add(&bar[XB_TOP], 1u);
            const unsigned tg = og / nx;
            if (og + 1u == (tg + 1u) * nx) xb_add(&bar[XB_TOPGEN], 1u);
            else XB_SPIN(xb_ld(&bar[XB_TOPGEN]) == tg, bar);
            __builtin_amdgcn_fence(__ATOMIC_ACQUIRE, "agent");
            xb_add(&bar[XB_XGEN(b.x)], 1u);
            asm volatile("s_waitcnt vmcnt(0)" ::: "memory");
        } else {
            XB_SPIN(xb_ld(&bar[XB_XGEN(b.x)]) == gen, bar);
            __builtin_amdgcn_fence(__ATOMIC_ACQUIRE, "agent");
            asm volatile("s_waitcnt vmcnt(0)" ::: "memory");
        }
    }
    __syncthreads();
}

namespace pg8 {
constexpr int BM = 256, BK = 64, HALF = 128, HTB = HALF * BK * 2, STAGE_BYTES = 8 * HTB, NXCD = 8, WGM = 8;
__host__ __device__ __forceinline__ int lds_byte(int r, int c) { const int st = (r >> 4) * 2 + (c >> 5), rr = r & 15, cc = c & 31, ob = rr * 64 + cc * 2; return st * 1024 + (ob ^ (((ob >> 9) & 1) << 5)); }
__host__ __device__ __forceinline__ void stage_rc(int b, int& R, int& C) { const int st = b / 1024, sb = b % 1024, swz = sb ^ (((sb >> 9) & 1) << 5); R = (st >> 1) * 16 + swz / 64; C = (st & 1) * 32 + (swz % 64) / 2; }
__host__ __device__ __forceinline__ int perm32(int rho) { const int n = rho >> 4, i = rho & 15; return 8 * (i >> 2) + 4 * n + (i & 3); }

struct Unit { int pm, pn, g; const char* A; const char* B; };

struct Sched {
    int nM, nN, nwg, G, c, nextra;
    const char* A; const char* B; size_t tA, tB;
    const char* Ae; const char* Be; size_t tAe, tBe;
    __device__ __forceinline__ bool next(int i, Unit& u) const {
        const long L = (long)i * G + c; if (L >= nwg + nextra) return false;
        if (L >= nwg) { const int e = (int)(L - nwg); u.g = 1 + (e >> 2); u.pm = 0; u.pn = e & 3; u.A = Ae + (size_t)(e >> 2) * tAe; u.B = Be + (size_t)e * tBe; return true; }
        int wgid = (int)L; { const int q = nwg / NXCD, r = nwg % NXCD, xcd = wgid % NXCD, off = wgid / NXCD; wgid = (xcd < r ? xcd * (q + 1) : r * (q + 1) + (xcd - r) * q) + off; }
        const int nig = WGM * nN, gid = wgid / nig, fm = gid * WGM, gsz = (nM - fm) < WGM ? (nM - fm) : WGM;
        u.pm = fm + ((wgid % nig) % gsz); u.pn = (wgid % nig) / gsz; u.g = 0; u.A = A + (size_t)u.pm * tA; u.B = B + (size_t)u.pn * tB; return true;
    }
};

__device__ __forceinline__ void row_rstd8(const float* rss, int row0, int fq, float (&rs)[2][4]) {
    f32x4 a[2][4], b[2][4];
#pragma unroll
    for (int ai = 0; ai < 2; ++ai)
#pragma unroll
        for (int m = 0; m < 4; ++m) { const f32x4* p = (const f32x4*)(rss + (size_t)(row0 + ai * HALF + m * 16) * 32 + fq * 8); a[ai][m] = p[0]; b[ai][m] = p[1]; }
#pragma unroll
    for (int ai = 0; ai < 2; ++ai)
#pragma unroll
        for (int m = 0; m < 4; ++m) { const f32x4 v = a[ai][m] + b[ai][m]; float s = (v[0] + v[1]) + (v[2] + v[3]); s += __shfl_xor(s, 16); s += __shfl_xor(s, 32); rs[ai][m] = rsqrtf(s * (1.0f / DM) + RMS_EPS); }
}
struct EpiIn {
    static constexpr bool PERM = true, AFTER_DRAIN = false;
    bf16_t* z; const float* rss; float* out; bf16_t* kvb; bf16_t* mkvb; const float* bfg; unsigned* ctl; float* fl; float* dup; int kind, j, ml;
    __device__ __forceinline__ void operator()(const f32x4 (&acc)[2][2][4][2], const Unit& u, int wr, int wc, int fr, int fq) const {
        asm volatile("" : "+v"(fr), "+v"(fq));
        const int row0 = u.pm * BM + wr * 64 + fr, colt = u.pn * BM, col0 = colt + wc * 32 + 8 * fq;
        if (u.g != 0) {
            const int e = ml; const bool isv = colt >= MEMW; float* of = out + (isv ? O_MVP : O_MKP) + (size_t)e * NMEM * MEMW; bf16_t* ob = mkvb + (size_t)e * NMEM * 1024;
#pragma unroll
            for (int ai = 0; ai < 2; ++ai)
#pragma unroll
                for (int m = 0; m < 4; ++m) { const int row = row0 + ai * HALF + m * 16;
#pragma unroll
                    for (int bj = 0; bj < 2; ++bj) { const int c = col0 + bj * HALF; const f32x4 v0 = acc[ai][bj][m][0], v1 = acc[ai][bj][m][1];
                        *(u32x4*)(ob + (size_t)row * 1024 + c) = pack8u(v0, v1);
                        float* o = of + (size_t)row * MEMW + (c - (isv ? MEMW : 0)); *(f32x4*)o = v0; *(f32x4*)(o + 4) = v1; } }
            return;
        }
        float rs[2][4]; row_rstd8(rss, row0, fq, rs);
        const bool kt = kind != 2 && colt >= AW && colt < 2 * AW, vt = kind != 2 && colt >= 2 * AW && colt < 3 * AW, smp = u.pm >= TP / BM;
        const int cbase = kt ? AW : 2 * AW;
        const size_t ocache = kind == 0 ? (smp ? (kt ? O_FKS : O_FVS) + (size_t)j * TS * AW : (kt ? O_FKP : O_FVP) + (size_t)j * TP * AW) : (smp ? (kt ? O_SKS : O_SVS) : (kt ? O_SKP : O_SVP));
        float* oc = out + ocache; bf16_t* kvs = kvb + (kt ? 0 : KVS_ONE / 2);
        const bool lft = kind == 0 && colt == 5120 && wc == 0 && fq < 2;
        const bool nrm = kind == 0 && !smp && colt < 2 * AW;
        float nmx[2] = {0.f, 0.f};
#pragma unroll
        for (int ai = 0; ai < 2; ++ai)
#pragma unroll
            for (int m = 0; m < 4; ++m) { const int row = row0 + ai * HALF + m * 16, rr = smp ? row - TP : row; const float sc = rs[ai][m];
#pragma unroll
                for (int bj = 0; bj < 2; ++bj) { const int c = col0 + bj * HALF; const f32x4 v0 = acc[ai][bj][m][0] * sc, v1 = acc[ai][bj][m][1] * sc; const u32x4 w = pack8u(v0, v1);
                    *(u32x4*)(z + (size_t)row * ZLD + c) = w;
                    if (nrm) { float q = (v0[0] * v0[0] + v0[1] * v0[1]) + (v0[2] * v0[2] + v0[3] * v0[3]) + (v1[0] * v1[0] + v1[1] * v1[1]) + (v1[2] * v1[2] + v1[3] * v1[3]);
                        q += __shfl_xor(q, 16); q += __shfl_xor(q, 32); nmx[bj] = fmaxf(nmx[bj], q); }
                    if (kt || vt) { const int cc = c - cbase; float* o = oc + (size_t)rr * AW + cc; __builtin_nontemporal_store(v0, (f32x4*)o); __builtin_nontemporal_store(v1, (f32x4*)(o + 4));
#ifdef PROBE_DUPKV
                        { float* o2 = dup + (size_t)row * AW + cc + (kt ? 0 : (size_t)MT * AW); *(f32x4*)o2 = v0; *(f32x4*)(o2 + 4) = v1; }
#endif
                        if (smp) *(u32x4*)(kvs + ((size_t)(rr >> 6) * SKS + PAST + (rr & 63)) * AW + cc) = w; }
                } }
        if (lft) {
            float bb[8];
#pragma unroll
            for (int e = 0; e < 8; ++e) bb[e] = bfg[(8 * fq + e) % NH];
#pragma unroll
            for (int ai = 0; ai < 2; ++ai)
#pragma unroll
                for (int m = 0; m < 4; ++m) { const int row = row0 + ai * HALF + m * 16; const float sc = rs[ai][m]; float* o = fl + (size_t)row * NH + 8 * fq;
                    f32x4 v0 = acc[ai][0][m][0] * sc, v1 = acc[ai][0][m][1] * sc;
#pragma unroll
                    for (int e = 0; e < 4; ++e) { v0[e] += bb[e]; v1[e] += bb[4 + e]; }
                    *(f32x4*)o = v0; if (fq == 0) *(f32x4*)(o + 4) = v1; }
        }
        if (nrm) {
#pragma unroll
            for (int bj = 0; bj < 2; ++bj) { float q = nmx[bj]; q = fmaxf(q, __shfl_xor(q, 1)); q = fmaxf(q, __shfl_xor(q, 2)); q = fmaxf(q, __shfl_xor(q, 4)); q = fmaxf(q, __shfl_xor(q, 8));
                if (fr == 0 && fq == 0) { const bool isq = colt < AW; const int h = (colt - (isq ? 0 : AW)) / HD + bj;
                    unsigned* t = isq ? ctl + CW_QQ + ((j * 32 + u.pm) * NH + h) * 4 + wc : ctl + CW_KQ + j * 64 + h * 4 + wc;
                    __hip_atomic_fetch_max(t, __float_as_uint(q), __ATOMIC_RELAXED, __HIP_MEMORY_SCOPE_AGENT); } }
        }
    }
};
struct EpiRes {
    static constexpr bool PERM = true, AFTER_DRAIN = false;
    float* x; bf16_t* xb; float* rss;
    __device__ __forceinline__ void operator()(const f32x4 (&acc)[2][2][4][2], const Unit& u, int wr, int wc, int fr, int fq) const {
        const int row0 = u.pm * BM + wr * 64 + fr, col0 = u.pn * BM + wc * 32 + 8 * fq;
#pragma unroll
        for (int ai = 0; ai < 2; ++ai)
#pragma unroll
            for (int m = 0; m < 4; ++m) { const int row = row0 + ai * HALF + m * 16; float ss = 0.f;
#pragma unroll
                for (int bj = 0; bj < 2; ++bj) { float* p = x + (size_t)row * DM + col0 + bj * HALF;
                    const f32x4 a = *(const f32x4*)p + acc[ai][bj][m][0], b = *(const f32x4*)(p + 4) + acc[ai][bj][m][1];
                    *(f32x4*)p = a; *(f32x4*)(p + 4) = b; *(u32x4*)(xb + (size_t)row * DM + col0 + bj * HALF) = pack8u(a, b);
                    ss += (a[0] * a[0] + a[1] * a[1]) + (a[2] * a[2] + a[3] * a[3]) + (b[0] * b[0] + b[1] * b[1]) + (b[2] * b[2] + b[3] * b[3]); }
                ss += __shfl_xor(ss, 16); ss += __shfl_xor(ss, 32);
                if (fq == 0) rss[(size_t)row * 32 + u.pn * 4 + wc] = ss;
                if (m & 1) asm volatile("" ::: "memory"); }
    }
};
struct EpiUp {
    static constexpr bool PERM = true, AFTER_DRAIN = false;
    bf16_t* o; const float* rss;
    __device__ __forceinline__ void operator()(const f32x4 (&acc)[2][2][4][2], const Unit& u, int wr, int wc, int fr, int fq) const {
        const int row0 = u.pm * BM + wr * 64 + fr, col0 = u.pn * BM + wc * 32 + 8 * fq;
        float rs[2][4]; row_rstd8(rss, row0, fq, rs);
#pragma unroll
        for (int ai = 0; ai < 2; ++ai)
#pragma unroll
            for (int m = 0; m < 4; ++m) { const int row = row0 + ai * HALF + m * 16; const float sc = rs[ai][m];
#pragma unroll
                for (int bj = 0; bj < 2; ++bj) { f32x4 v0 = acc[ai][bj][m][0] * sc, v1 = acc[ai][bj][m][1] * sc;
#pragma unroll
                    for (int e = 0; e < 4; ++e) { const float a = fmaxf(v0[e], 0.f), b = fmaxf(v1[e], 0.f); v0[e] = a * a; v1[e] = b * b; }
                    *(u32x4*)(o + (size_t)row * DFF + col0 + bj * HALF) = pack8u(v0, v1); } }
    }
};

struct SchedSplit {
    int S, nu, G, c; const char* A; const char* B; size_t tA, tB, kbytes;
    __device__ __forceinline__ bool next(int i, Unit& u) const {
        const int e = i * G + c; if (e >= nu) return false;
        const int tile = e / S, sp = e - tile * S; u.pm = TP / BM + (tile >> 3); u.pn = tile & 7; u.g = sp;
        u.A = A + (size_t)u.pm * tA + (size_t)sp * kbytes; u.B = B + (size_t)u.pn * tB + (size_t)sp * kbytes; return true;
    }
};
struct EpiPart {
    static constexpr bool PERM = true, AFTER_DRAIN = false;
    float* part;
    __device__ __forceinline__ void operator()(const f32x4 (&acc)[2][2][4][2], const Unit& u, int wr, int wc, int fr, int fq) const {
        const int row0 = (u.pm - TP / BM) * BM + wr * 64 + fr, col0 = u.pn * BM + wc * 32 + 8 * fq; float* base = part + (size_t)u.g * TS * DM;
#pragma unroll
        for (int ai = 0; ai < 2; ++ai)
#pragma unroll
            for (int m = 0; m < 4; ++m) { const int row = row0 + ai * HALF + m * 16;
#pragma unroll
                for (int bj = 0; bj < 2; ++bj) { float* p = base + (size_t)row * DM + col0 + bj * HALF; *(f32x4*)p = acc[ai][bj][m][0]; *(f32x4*)(p + 4) = acc[ai][bj][m][1]; } }
    }
};

template <class Epi, class Sch>
__device__ __forceinline__ void gemm_phase(LAS unsigned char* lds, const int K, const int lda, const int ldb, const Sch& S, const Epi& E, const int tid) {
    const int wid = __builtin_amdgcn_readfirstlane(tid >> 6), lane = tid & 63, wr = wid >> 2, wc = wid & 3, fr = lane & 15, fq = lane >> 4;
    const int nt = K / BK;
    unsigned voffA[2], voffB[2];
#pragma unroll
    for (int i = 0; i < 2; ++i) { int R, C; stage_rc(tid * 16 + i * 8192, R, C); const int Rb = Epi::PERM ? ((R & ~31) + perm32(R & 31)) : R;
        voffA[i] = (unsigned)(R * lda + C) * 2u; voffB[i] = (unsigned)(Rb * ldb + C) * 2u; }
    const size_t kstep = (size_t)(BK * 2);
    const size_t hstepA = (size_t)HALF * lda * 2, hstepB = (size_t)HALF * ldb * 2;
    const unsigned ldsw = (unsigned)wid * 1024u;
    const int aoff = lds_byte(wr * 64 + fr, fq * 8), boff = lds_byte(wc * 32 + fr, fq * 8);
#define PG8_SA(b, h) (((b) * 2 + (h)) * HTB)
#define PG8_SB(b, h) ((4 + (b) * 2 + (h)) * HTB)
#define PG8_STAGE(bufoff, gbase, voff) do { _Pragma("unroll") for (int _i = 0; _i < 2; ++_i) \
        __builtin_amdgcn_global_load_lds((const unsigned*)((const char*)(gbase) + (voff)[_i]), (LAS unsigned*)(lds + (bufoff) + ldsw + _i * 8192), 16, 0, 0); } while (0)
#define PG8_LDA(dst, b, h) do { _Pragma("unroll") for (int m = 0; m < 4; ++m) _Pragma("unroll") for (int k = 0; k < 2; ++k) dst[m][k] = *(const LAS bf16x8*)(lds + PG8_SA(b, h) + aoff + m * 2048 + k * 1024); } while (0)
#define PG8_LDB(dst, b, h) do { _Pragma("unroll") for (int n = 0; n < 2; ++n) _Pragma("unroll") for (int k = 0; k < 2; ++k) dst[n][k] = *(const LAS bf16x8*)(lds + PG8_SB(b, h) + boff + n * 2048 + k * 1024); } while (0)
#define PG8_MMA(ai, bj, At, Bt) do { __builtin_amdgcn_s_setprio(1); _Pragma("unroll") for (int m = 0; m < 4; ++m) _Pragma("unroll") for (int n = 0; n < 2; ++n) _Pragma("unroll") for (int k = 0; k < 2; ++k) \
        acc[ai][bj][m][n] = __builtin_amdgcn_mfma_f32_16x16x32_bf16(Bt[n][k], At[m][k], acc[ai][bj][m][n], 0, 0, 0); __builtin_amdgcn_s_setprio(0); } while (0)
#define PG8_WAIT_V(n) asm volatile("s_waitcnt vmcnt(" #n ")" ::: "memory")
#define PG8_WAIT_L(n) asm volatile("s_waitcnt lgkmcnt(" #n ")" ::: "memory")
#define PG8_BAR __builtin_amdgcn_s_barrier()
#define PG8_SCHED __builtin_amdgcn_sched_barrier(0)
    Unit cur, nxt; int ui = 0;
    if (!S.next(0, cur)) return;
    f32x4 acc[2][2][4][2];
#pragma unroll
    for (int a = 0; a < 2; ++a)
#pragma unroll
        for (int b = 0; b < 2; ++b)
#pragma unroll
            for (int m = 0; m < 4; ++m)
#pragma unroll
                for (int n = 0; n < 2; ++n) acc[a][b][m][n] = (f32x4){0.f, 0.f, 0.f, 0.f};
    bf16x8 At[4][2], B0[2][2], B1[2][2];
    const char* cA = cur.A; const char* cB = cur.B;
    PG8_STAGE(PG8_SB(0, 0), cB, voffB); PG8_STAGE(PG8_SB(0, 1), cB + hstepB, voffB); PG8_STAGE(PG8_SA(0, 0), cA, voffA); PG8_STAGE(PG8_SA(0, 1), cA + hstepA, voffA);
    if (wr == 1) PG8_BAR;
    PG8_WAIT_V(2); PG8_BAR;
    PG8_STAGE(PG8_SB(1, 0), cB + kstep, voffB); PG8_STAGE(PG8_SA(1, 0), cA + kstep, voffA); PG8_STAGE(PG8_SB(1, 1), cB + hstepB + kstep, voffB);
    PG8_WAIT_V(6); PG8_BAR;
    for (;;) {
        const bool has_next = S.next(ui + 1, nxt);
        const char* nA = has_next ? nxt.A : cA; const char* nB = has_next ? nxt.B : cB;
        for (int t = 0; t < nt; t += 2) {
            const bool last = (t == nt - 2);
            const char* a1 = cA + (size_t)(t + 1) * kstep;
            const char* a2 = last ? nA : cA + (size_t)(t + 2) * kstep; const char* b2 = last ? nB : cB + (size_t)(t + 2) * kstep;
            const char* a3 = a2 + kstep; const char* b3 = b2 + kstep;
            PG8_LDB(B0, 0, 0); PG8_LDB(B1, 0, 1); PG8_SCHED; PG8_LDA(At, 0, 0); PG8_STAGE(PG8_SA(1, 1), a1 + hstepA, voffA);
            PG8_WAIT_V(8); PG8_WAIT_L(0); PG8_BAR; PG8_MMA(0, 0, At, B0); PG8_MMA(0, 1, At, B1); PG8_BAR; PG8_SCHED;
            PG8_LDA(At, 0, 1); PG8_STAGE(PG8_SB(0, 0), b2, voffB); PG8_STAGE(PG8_SB(0, 1), b2 + hstepB, voffB); PG8_STAGE(PG8_SA(0, 0), a2, voffA);
            PG8_WAIT_V(8); PG8_WAIT_L(0); PG8_BAR; PG8_MMA(1, 0, At, B0); PG8_MMA(1, 1, At, B1); PG8_BAR; PG8_SCHED;
            PG8_LDB(B0, 1, 0); PG8_LDB(B1, 1, 1); PG8_SCHED; PG8_LDA(At, 1, 0); PG8_STAGE(PG8_SA(0, 1), a2 + hstepA, voffA);
            PG8_WAIT_V(8); PG8_WAIT_L(0); PG8_BAR; PG8_MMA(0, 0, At, B0); PG8_MMA(0, 1, At, B1); PG8_BAR; PG8_SCHED;
            PG8_LDA(At, 1, 1); PG8_STAGE(PG8_SB(1, 0), b3, voffB); PG8_STAGE(PG8_SB(1, 1), b3 + hstepB, voffB); PG8_STAGE(PG8_SA(1, 0), a3, voffA);
            PG8_WAIT_V(8); PG8_WAIT_L(0); PG8_BAR; PG8_MMA(1, 0, At, B0); PG8_MMA(1, 1, At, B1); PG8_BAR; PG8_SCHED;
        }
        if (wr == 0) PG8_BAR;
        E(acc, cur, wr, wc, fr, fq);
        if (!has_next) break;
#pragma unroll
        for (int a = 0; a < 2; ++a)
#pragma unroll
            for (int b = 0; b < 2; ++b)
#pragma unroll
                for (int m = 0; m < 4; ++m)
#pragma unroll
                    for (int n = 0; n < 2; ++n) acc[a][b][m][n] = (f32x4){0.f, 0.f, 0.f, 0.f};
        cur = nxt; cA = nA; cB = nB; ++ui;
        if (wr == 1) PG8_BAR;
    }
    PG8_WAIT_V(0);
    PG8_BAR;
#undef PG8_SA
#undef PG8_SB
#undef PG8_STAGE
#undef PG8_LDA
#undef PG8_LDB
#undef PG8_MMA
#undef PG8_WAIT_V
#undef PG8_WAIT_L
#undef PG8_BAR
#undef PG8_SCHED
}
}

namespace att {
constexpr float SCALE = 0.08838834764831845f;
constexpr float THR = 8.f;
constexpr int NW = 8, QBLK = 32, KVBLK = 64, QB = NW * QBLK, D = 128;
constexpr int SHM_V = KVBLK * D * 2, SHM_K = KVBLK * D * 2;
constexpr int ATT_LDS = 2 * SHM_V + 2 * SHM_K + NW * 64 * 4;
constexpr int BOS_OFF = ATT_LDS;
constexpr int BOS_BYTES = 8192 * 4;
constexpr int SCR_OFF = BOS_OFF + 2 * BOS_BYTES;
constexpr int WINF = 1 << 30;
static_assert(SCR_OFF + 256 <= LDS_WORK, "attention LDS map");

#define KSWZ(row, colB) ((row) * 256 + ((colB) ^ (((row) & 7) << 4)))
__device__ __forceinline__ int v_st(int k, int c) { const int kk = (k & ~0xC) | ((k & 4) << 1) | ((k & 8) >> 1); return ((kk >> 3) * 4 + (c >> 5)) * 512 + ((kk & 7) * 32 + (c & 31)) * 2; }
__device__ __forceinline__ int v_rd_base(int lane) { return ((lane & 3) << 3) | (((lane >> 2) & 3) << 6) | (((lane >> 4) & 1) << 5) | (((lane >> 5) & 1) << 8); }
constexpr int v_rd_off(int d0, int ks, int half) { return d0 * 512 + ks * 4096 + half * 2048; }
__device__ __forceinline__ int crow(int r, int hi) { return (r & 3) + 8 * (r >> 2) + 4 * hi; }
__device__ __forceinline__ bf16x8 load8(const bf16_t* p) { return *reinterpret_cast<const bf16x8*>(p); }

__device__ __forceinline__ void mask_tile(f32x16& p0, f32x16& p1, int dq, unsigned W) {
    const float NEG = -__builtin_inff();
#pragma unroll
    for (int r = 0; r < 16; ++r) {
        const int c = (r & 3) + 8 * (r >> 2);
        if ((unsigned)(dq - c) >= W) p0[r] = NEG;
        if ((unsigned)(dq - c - 32) >= W) p1[r] = NEG;
    }
}
__device__ __forceinline__ void partialSM(f32x16& p0, f32x16& p1, float& m_reg, float& mn, float& alpha) {
    float pmax = p0[0]; for (int r = 1; r < 16; ++r) pmax = fmaxf(pmax, p0[r]); for (int r = 0; r < 16; ++r) pmax = fmaxf(pmax, p1[r]);
    { auto rr = __builtin_amdgcn_permlane32_swap(__float_as_uint(pmax), __float_as_uint(pmax), false, false);
      pmax = fmaxf(__uint_as_float(rr[0]), __uint_as_float(rr[1])); }
    constexpr float C2 = 1.4426950408889634f * SCALE;
    if (__builtin_expect(__all((pmax - m_reg) * SCALE <= THR), 1)) { mn = m_reg; alpha = 1.f; }
    else { mn = fmaxf(m_reg, pmax); alpha = __builtin_amdgcn_exp2f((m_reg - mn) * C2); m_reg = mn; }
    const float mnL = -mn * C2;
    for (int r = 0; r < 16; ++r) p0[r] = fmaf(p0[r], C2, mnL); for (int r = 0; r < 16; ++r) p1[r] = fmaf(p1[r], C2, mnL);
    for (int r = 0; r < 16; ++r) p0[r] = __builtin_amdgcn_exp2f(p0[r]);
}
#define PK4(P, B_, OUT) do { unsigned a0 = cvtpk(P[B_+0], P[B_+1]), a1 = cvtpk(P[B_+2], P[B_+3]);                          \
        unsigned b0 = cvtpk(P[B_+4], P[B_+5]), b1 = cvtpk(P[B_+6], P[B_+7]);                                             \
        auto r0 = __builtin_amdgcn_permlane32_swap(a0, b0, false, false); auto r1 = __builtin_amdgcn_permlane32_swap(a1, b1, false, false); \
        u32x4 w = {r0[0], r1[0], r0[1], r1[1]}; OUT = *reinterpret_cast<bf16x8*>(&w); } while (0)
__device__ __forceinline__ void finishSM(f32x16& p0, f32x16& p1, float alpha, float& l_reg, bf16x8& pa0, bf16x8& pa1, bf16x8& pa2, bf16x8& pa3) {
    for (int r = 0; r < 16; ++r) p1[r] = __builtin_amdgcn_exp2f(p1[r]);
    float ps = 0; for (int r = 0; r < 16; ++r) ps += p0[r]; for (int r = 0; r < 16; ++r) ps += p1[r];
    { auto rr = __builtin_amdgcn_permlane32_swap(__float_as_uint(ps), __float_as_uint(ps), false, false);
      ps = __uint_as_float(rr[0]) + __uint_as_float(rr[1]); }
    l_reg = l_reg * alpha + ps;
    PK4(p0, 0, pa0); PK4(p0, 8, pa1); PK4(p1, 0, pa2); PK4(p1, 8, pa3);
}
template <int KB, bool BIAS>
__device__ __forceinline__ void qkt(f32x16& p0, f32x16& p1, const char* K_lds, int r32, int hi, const bf16x8* qr, const float* bk) {
    if constexpr (BIAS) {
#pragma unroll
        for (int i = 0; i < 4; ++i) { const f32x4 a = *(const f32x4*)(bk + 8 * i), b = *(const f32x4*)(bk + 32 + 8 * i);
            p0[4 * i] = a[0]; p0[4 * i + 1] = a[1]; p0[4 * i + 2] = a[2]; p0[4 * i + 3] = a[3];
            p1[4 * i] = b[0]; p1[4 * i + 1] = b[1]; p1[4 * i + 2] = b[2]; p1[4 * i + 3] = b[3]; }
    } else { p0 = f32x16{}; p1 = f32x16{}; }
    const char* kb[4];
#pragma unroll
    for (int dd = 0; dd < 4; ++dd) kb[dd] = K_lds + KB * SHM_K + KSWZ(r32, (dd * 16 + hi * 8) * 2);
#pragma unroll
    for (int d0 = 0; d0 < 8; ++d0) { const char* a = kb[d0 & 3] + (d0 >> 2) * 128;
        bf16x8 b0 = *reinterpret_cast<const bf16x8*>(a);
        bf16x8 b1 = *reinterpret_cast<const bf16x8*>(a + 32 * 256);
        p0 = __builtin_amdgcn_mfma_f32_32x32x16_bf16(b0, qr[d0], p0, 0, 0, 0);
        p1 = __builtin_amdgcn_mfma_f32_32x32x16_bf16(b1, qr[d0], p1, 0, 0, 0); }
}
template <int VB>
__device__ __forceinline__ void pv_tile(f32x16* o, int vb0, bf16x8 pa0, bf16x8 pa1, bf16x8 pa2, bf16x8 pa3) {
#define TRRD(dst, off) asm volatile("ds_read_b64_tr_b16 %0, %1 offset:%2" : "=&v"(dst) : "v"(vb0), "i"(off) : "memory")
#define PV_D0(d0) do { s16x4 l0, l1, l2, l3, h0, h1, h2, h3; constexpr int b_ = VB * SHM_V + v_rd_off(d0, 0, 0); \
        TRRD(l0, b_); TRRD(h0, b_ + 2048); TRRD(l1, b_ + 4096); TRRD(h1, b_ + 6144); TRRD(l2, b_ + 8192); TRRD(h2, b_ + 10240); TRRD(l3, b_ + 12288); TRRD(h3, b_ + 14336); \
        asm volatile("s_waitcnt lgkmcnt(0)" ::: "memory"); SBAR();   \
        o[d0] = __builtin_amdgcn_mfma_f32_32x32x16_bf16(pa0, (bf16x8){l0[0], l0[1], l0[2], l0[3], h0[0], h0[1], h0[2], h0[3]}, o[d0], 0, 0, 0);   \
        o[d0] = __builtin_amdgcn_mfma_f32_32x32x16_bf16(pa1, (bf16x8){l1[0], l1[1], l1[2], l1[3], h1[0], h1[1], h1[2], h1[3]}, o[d0], 0, 0, 0);   \
        o[d0] = __builtin_amdgcn_mfma_f32_32x32x16_bf16(pa2, (bf16x8){l2[0], l2[1], l2[2], l2[3], h2[0], h2[1], h2[2], h2[3]}, o[d0], 0, 0, 0);   \
        o[d0] = __builtin_amdgcn_mfma_f32_32x32x16_bf16(pa3, (bf16x8){l3[0], l3[1], l3[2], l3[3], h3[0], h3[1], h3[2], h3[3]}, o[d0], 0, 0, 0); } while (0)
    PV_D0(0); PV_D0(1); PV_D0(2); PV_D0(3);
#undef PV_D0
#undef TRRD
}

struct Blk { const bf16_t* Q; const bf16_t* K; const bf16_t* V; bf16_t* O; int ldq, ldkv, ldo; int P0, skv, nrows; int bmode; const float* lf0; int n0; const float* lf1;
             const unsigned* qq; const unsigned* kq; int jlo, bsel, pre0; };
struct Seam { bf16x8 qr[8]; bf16x8 st_v0, st_v1, st_k0, st_k1; };
__device__ __forceinline__ int blk_jhi(const Blk& b) { int j = (b.P0 + QB - 1) / KVBLK + 1; const int m = b.skv / KVBLK; return j > m ? m : j; }

__device__ __forceinline__ void prepare_bias(Blk& b, char* lds, int g_wave) {
    const int tid = opaque_tid();
    float* bos = (float*)(lds + BOS_OFF + b.bsel * BOS_BYTES); float* scr = (float*)(lds + SCR_OFF);
    const int nk = blk_jhi(b) * KVBLK, lane = tid & 63, wid = tid >> 6;
    b.jlo = 0;
    if (b.bmode == 0) { for (int k = tid; k < nk; k += 512) bos[k] = 0.f; __syncthreads(); return; }
    float v[16]; float tot = 0.f; const int k0 = tid * 16; const bool in = k0 < nk;
#pragma unroll
    for (int i = 0; i < 16; ++i) { const int k = k0 + i; float x = 0.f; if (in) { if (k < b.n0) { x = b.lf0[(size_t)k * NH]; if (b.pre0) x = log_sigmoid_fast(x); } else x = log_sigmoid_fast(b.lf1[(size_t)(k - b.n0) * NH]); } v[i] = x; tot += x; }
    float inc = tot;
#pragma unroll
    for (int o = 1; o < 64; o <<= 1) { const float y = __shfl_down(inc, o); if (lane + o < 64) inc += y; }
    if (lane == 0) scr[wid] = inc;
    if (tid == 0) ((int*)scr)[9] = 0;
    __syncthreads();
    float hiw = 0.f;
#pragma unroll
    for (int w = 0; w < 8; ++w) if (w > wid) hiw += scr[w];
    float run = (inc - tot) + hiw;
#pragma unroll
    for (int i = 15; i >= 0; --i) { const float lf = v[i]; v[i] = run; run += lf; }
    if (in) {
#pragma unroll
        for (int i = 0; i < 16; ++i) bos[k0 + i] = v[i] * (1.0f / SCALE);
    }
    if (b.qq != nullptr) {
        if (in && k0 == b.P0) scr[8] = v[0];
        __syncthreads();
        const float q2 = (__uint_as_float(b.qq[0]) + __uint_as_float(b.qq[1])) + (__uint_as_float(b.qq[2]) + __uint_as_float(b.qq[3]));
        const float k2 = (__uint_as_float(b.kq[0]) + __uint_as_float(b.kq[1])) + (__uint_as_float(b.kq[2]) + __uint_as_float(b.kq[3]));
        const float B = sqrtf(q2 * k2) * SCALE * 1.02f, cut = scr[8] - (2.f * B + 34.f);
        int cnt = 0;
#pragma unroll
        for (int i = 0; i < 16; ++i) cnt += (in && k0 + i < b.P0 && v[i] < cut) ? 1 : 0;
#pragma unroll
        for (int o = 1; o < 64; o <<= 1) cnt += __shfl_xor(cnt, o);
        if (lane == 0 && cnt) atomicAdd((int*)scr + 9, cnt);
        __syncthreads();
        b.jlo = ((int*)scr)[9] / KVBLK;
    }
    __syncthreads();
}

#define ROWK(p, ld, k0, rr) ((p) + (size_t)((k0) + (rr)) * (ld) + sc)
#define VMW() asm volatile("s_waitcnt vmcnt(0)" ::: "memory")
#define VMWN(n) asm volatile("s_waitcnt vmcnt(%0)" :: "i"(n) : "memory")
#define SLOAD_H(Kp, Vp, ld, k0) do { S.st_v0 = load8(ROWK(Vp, ld, k0, sr)); S.st_v1 = load8(ROWK(Vp, ld, k0, 32 + sr));              \
                         S.st_k0 = load8(ROWK(Kp, ld, k0, sr)); S.st_k1 = load8(ROWK(Kp, ld, k0, 32 + sr)); } while (0)
#define SWRITE_HK(bf) do { *(bf16x8*)(K_lds + (bf) * SHM_K + kws) = S.st_k0; *(bf16x8*)(K_lds + (bf) * SHM_K + kws + 32 * 256) = S.st_k1; } while (0)
#define SWRITE_HV(bf) do { *(bf16x8*)(V_lds + (bf) * SHM_V + vst0) = S.st_v0; *(bf16x8*)(V_lds + (bf) * SHM_V + vst1) = S.st_v1; } while (0)
#define SWRITE_H(bf) do { SWRITE_HV(bf); SWRITE_HK(bf); } while (0)
#define QROWP(b_) ((b_).Q + (size_t)((wid * QBLK + r32) & ((b_).nrows - 1)) * (b_).ldq + hi * 8)
__device__ __forceinline__ void att_prime(const Blk& cur, char* lds, Seam& S, int g_wave) {
    const int tid = opaque_tid();
    const int wid = __builtin_amdgcn_readfirstlane(tid >> 6), lane = tid & 63, r32 = lane & 31, hi = lane >> 5;
    const int sr = tid >> 4, sc = (tid & 15) * 8, kws = KSWZ(sr, sc * 2); char* K_lds = lds + 2 * SHM_V;
    const bf16_t* qp = QROWP(cur);
#pragma unroll
    for (int d0 = 0; d0 < 8; ++d0) S.qr[d0] = load8(qp + d0 * 16);
    SLOAD_H(cur.K, cur.V, cur.ldkv, cur.jlo * KVBLK); VMW(); SWRITE_HK(0);
    __syncthreads();
}
__device__ __forceinline__ void att_block(const Blk& cur, const Blk& nxt, char* lds, Seam& S, int g_wave) {
    const int tid = opaque_tid();
    const int wid = __builtin_amdgcn_readfirstlane(tid >> 6), lane = tid & 63, r32 = lane & 31, hi = lane >> 5;
    constexpr int W = WINF;
    const int j_lo = cur.jlo, NT = blk_jhi(cur) - j_lo;
    const int qlo = cur.P0 + wid * QBLK, qm = qlo + r32 - 4 * hi;
    char* V_lds = lds; char* K_lds = lds + 2 * SHM_V;
    float* ws = (float*)(lds + 2 * SHM_V + 2 * SHM_K) + wid * 64; float* li_l = ws, * al_l = ws + 32;
    const float* bos = (const float*)(lds + BOS_OFF + cur.bsel * BOS_BYTES) + 4 * hi;
    float m_reg = -1e30f, l_reg = 0; f32x16 o[4] = {};
    const int sr = tid >> 4, sc = (tid & 15) * 8, vst0 = v_st(sr, sc), vst1 = v_st(32 + sr, sc), kws = KSWZ(sr, sc * 2);
    const int vb0 = (int)(uintptr_t)V_lds + v_rd_base(lane);
    const bf16_t* Kh = cur.K; const bf16_t* Vh = cur.V; const int ldkv = cur.ldkv;
#define RESC(a) do { if (__any((a) < 1.f)) { if (hi == 0) al_l[r32] = (a); asm volatile("s_waitcnt lgkmcnt(0)" ::: "memory");              \
                     for (int d_ = 0; d_ < 4; ++d_) for (int r = 0; r < 16; ++r) o[d_][r] *= al_l[crow(r, hi)]; } } while (0)
#define KBASE(t) ((j_lo + (t)) * KVBLK)
#define MASKT(P0_, P1_, t) do { const int kb_ = KBASE(t); if (kb_ + KVBLK - 1 > qlo) mask_tile(P0_, P1_, qm - kb_, (unsigned)W); } while (0)
    constexpr int NQL = 8;
#define SEAM_K0() do { VMWN(NQL); SWRITE_HK(0); SBAR(); } while (0)
    f32x16 pA0, pA1, pB0, pB1; float mnA, mnB, alA, alB; bf16x8 pa0, pa1, pa2, pa3;
    SWRITE_HV(0); SBAR();
    if (NT > 1) SLOAD_H(Kh, Vh, ldkv, KBASE(1));
    SBAR(); qkt<0, true>(pA0, pA1, K_lds, r32, hi, S.qr, bos + KBASE(0));
    MASKT(pA0, pA1, 0); partialSM(pA0, pA1, m_reg, mnA, alA);
    if (NT > 1) { VMW(); SWRITE_H(1); }
    __syncthreads();
#define HALF_STEP(PX0, PX1, mnX, alX, PY0, PY1, alY, t, KB, VB, SB) do {                                                      \
        SBAR(); qkt<KB, true>(PX0, PX1, K_lds, r32, hi, S.qr, bos + KBASE(t));                                                \
        finishSM(PY0, PY1, alY, l_reg, pa0, pa1, pa2, pa3); SBAR();                                                           \
        if ((t) + 1 < NT) { SLOAD_H(Kh, Vh, ldkv, KBASE((t) + 1)); SBAR(); }                                                  \
        pv_tile<VB>(o, vb0, pa0, pa1, pa2, pa3); MASKT(PX0, PX1, (t)); partialSM(PX0, PX1, m_reg, mnX, alX);                  \
        __syncthreads();                                                                                                      \
        if ((t) + 1 < NT) { VMW(); SWRITE_H(SB); }                                                                            \
        RESC(alX); __syncthreads(); } while (0)
    for (int t = 1; t + 1 < NT; t += 2) {
        HALF_STEP(pB0, pB1, mnB, alB, pA0, pA1, alA, t, 1, 0, 0);
        HALF_STEP(pA0, pA1, mnA, alA, pB0, pB1, alB, t + 1, 0, 1, 1);
    }
    const bool even = (NT & 1) == 0;
    if (even) { SBAR(); qkt<1, true>(pB0, pB1, K_lds, r32, hi, S.qr, bos + KBASE(NT - 1)); SBAR(); }
    SLOAD_H(nxt.K, nxt.V, nxt.ldkv, nxt.jlo * KVBLK); SBAR();
    { const bf16_t* qp = QROWP(nxt);
#pragma unroll
      for (int d0 = 0; d0 < 8; ++d0) S.qr[d0] = load8(qp + d0 * 16); }
    SBAR();
    finishSM(pA0, pA1, alA, l_reg, pa0, pa1, pa2, pa3); SBAR();
    pv_tile<0>(o, vb0, pa0, pa1, pa2, pa3);
    if (even) { MASKT(pB0, pB1, NT - 1); partialSM(pB0, pB1, m_reg, mnB, alB); __syncthreads(); RESC(alB);
        finishSM(pB0, pB1, alB, l_reg, pa0, pa1, pa2, pa3); SBAR(); pv_tile<1>(o, vb0, pa0, pa1, pa2, pa3); }
    SBAR(); SEAM_K0();
    if (hi == 0) li_l[r32] = l_reg; asm volatile("s_waitcnt lgkmcnt(0)" ::: "memory");
    float rli[16];
#pragma unroll
    for (int r = 0; r < 16; ++r) rli[r] = __builtin_amdgcn_rcpf(li_l[crow(r, hi)]);
    if (wid * QBLK < cur.nrows) {
        bf16_t* Ow = cur.O + (size_t)(wid * QBLK) * cur.ldo;
#pragma unroll
        for (int r = 0; r < 16; ++r) { const int orow = crow(r, hi);
#pragma unroll
            for (int d0 = 0; d0 < 4; ++d0) { const float v = o[d0][r] * rli[r]; const float vn = __shfl_xor(v, 1);
                if ((r32 & 1) == 0) *(unsigned*)(Ow + (size_t)orow * cur.ldo + d0 * 32 + r32) = cvtpk(v, vn); } }
    }
    __syncthreads();
#undef RESC
#undef MASKT
#undef SEAM_K0
#undef HALF_STEP
}

__device__ __forceinline__ void sb_block(const Blk& b, char* lds, int g_wave) {
    const int tid = opaque_tid();
    const int wid = __builtin_amdgcn_readfirstlane(tid >> 6), lane = tid & 63, r32 = lane & 31, hi = lane >> 5;
    char* V_lds = lds; char* K_lds = lds + 2 * SHM_V; int* flags = (int*)(lds + 2 * SHM_V + 2 * SHM_K);
    const int sr = tid >> 4, sc = (tid & 15) * 8, vst0 = v_st(sr, sc), vst1 = v_st(32 + sr, sc), kws = KSWZ(sr, sc * 2);
    const int vb0 = (int)(uintptr_t)V_lds + v_rd_base(lane);
    bf16x8 qr[8];
    { const bf16_t* qp = QROWP(b);
#pragma unroll
      for (int d0 = 0; d0 < 8; ++d0) qr[d0] = load8(qp + d0 * 16); }
    const int NT = blk_jhi(b), qlo = b.P0 + wid * QBLK, pos = qlo + r32;
    bool wdead = wid * QBLK >= b.nrows;
    float prun = 1.f; f32x16 o[4] = {};
    constexpr float C2 = 1.4426950408889634f * SCALE;
    for (int t = NT - 1; t >= 0; --t) {
        const int kb = t * KVBLK;
        const bf16x8 k0 = load8(ROWK(b.K, b.ldkv, kb, sr)), k1 = load8(ROWK(b.K, b.ldkv, kb, 32 + sr)), v0 = load8(ROWK(b.V, b.ldkv, kb, sr)), v1 = load8(ROWK(b.V, b.ldkv, kb, 32 + sr));
        __syncthreads();
        *(bf16x8*)(K_lds + kws) = k0; *(bf16x8*)(K_lds + kws + 32 * 256) = k1; *(bf16x8*)(V_lds + vst0) = v0; *(bf16x8*)(V_lds + vst1) = v1;
        __syncthreads();
        if (!wdead && kb < qlo + QBLK - 1) {
            f32x16 p0, p1; qkt<0, false>(p0, p1, K_lds, r32, hi, qr, nullptr);
            if (kb + KVBLK - 1 >= qlo) {
                const float NEG = -__builtin_inff();
#pragma unroll
                for (int r = 0; r < 16; ++r) { const int key = kb + crow(r, hi); if (key >= pos) p0[r] = NEG; if (key + 32 >= pos) p1[r] = NEG; }
            }
#pragma unroll
            for (int r = 0; r < 16; ++r) {
                p0[r] = __builtin_amdgcn_rcpf(1.f + __builtin_amdgcn_exp2f(fminf(p0[r] * C2, 60.f))); p1[r] = __builtin_amdgcn_rcpf(1.f + __builtin_amdgcn_exp2f(fminf(p1[r] * C2, 60.f))); }
            float gl[8], gu[8];
#pragma unroll
            for (int g = 0; g < 8; ++g) { const float gp = g < 4 ? (p0[4 * g] * p0[4 * g + 1]) * (p0[4 * g + 2] * p0[4 * g + 3]) : (p1[4 * g - 16] * p1[4 * g - 15]) * (p1[4 * g - 14] * p1[4 * g - 13]);
                auto x = __builtin_amdgcn_permlane32_swap(__float_as_uint(gp), __float_as_uint(gp), false, false); gl[g] = __uint_as_float(x[0]); gu[g] = __uint_as_float(x[1]); }
            float s = 1.f, sown[8];
#pragma unroll
            for (int g = 7; g >= 0; --g) { const float su = s; s *= gu[g]; const float sl = s; s *= gl[g]; sown[g] = hi ? su : sl; }
#define SB_EL(P, q) do { const float rr_ = P[q]; P[q] = (1.f - rr_) * tt; tt *= rr_; } while (0)
#pragma unroll
            for (int g = 0; g < 8; ++g) { float tt = sown[g] * prun;
                if (g < 4) { const int q = 4 * g; SB_EL(p0, q + 3); SB_EL(p0, q + 2); SB_EL(p0, q + 1); SB_EL(p0, q); }
                else { const int q = 4 * g - 16; SB_EL(p1, q + 3); SB_EL(p1, q + 2); SB_EL(p1, q + 1); SB_EL(p1, q); } }
#undef SB_EL
            prun *= s;
            bf16x8 pa0, pa1, pa2, pa3;
            PK4(p0, 0, pa0); PK4(p0, 8, pa1); PK4(p1, 0, pa2); PK4(p1, 8, pa3);
            pv_tile<0>(o, vb0, pa0, pa1, pa2, pa3);
            wdead = __all(prun < 8.67e-19f);
        }
        if (lane == 0) flags[wid] = wdead ? 1 : 0;
        __syncthreads();
        const int alld = flags[0] & flags[1] & flags[2] & flags[3] & flags[4] & flags[5] & flags[6] & flags[7];
        if (alld) break;
    }
    if (wid * QBLK < b.nrows) {
        bf16_t* Ow = b.O + (size_t)(wid * QBLK) * b.ldo;
#pragma unroll
        for (int r = 0; r < 16; ++r) { const int orow = crow(r, hi);
#pragma unroll
            for (int d0 = 0; d0 < 4; ++d0) { const float v = o[d0][r]; const float vn = __shfl_xor(v, 1);
                if ((r32 & 1) == 0) *(unsigned*)(Ow + (size_t)orow * b.ldo + d0 * 32 + r32) = cvtpk(v, vn); } }
    }
    __syncthreads();
}
#undef ROWK
#undef VMW
#undef VMWN
#undef SLOAD_H
#undef SWRITE_HK
#undef SWRITE_HV
#undef SWRITE_H
#undef QROWP
#undef PK4
#undef KSWZ
#undef KBASE
}

namespace gla {
constexpr int ZQ = 0, ZK = GKW, ZV = 2 * GKW, ZR = 2 * GKW + GVW, ZG = 5120;
constexpr int KP = 72, QP = 200;
constexpr int L_G = 0;
constexpr int L_GLOW = 49152;
constexpr int L_TOT = 53248;
constexpr int L_QP = 54272;
constexpr int L_KPB = L_QP + 64 * QP * 2;
constexpr int L_AB = L_KPB + 64 * QP * 2;
constexpr int L_VT = L_AB + 64 * KP * 2;
constexpr int L_RS = L_VT + 128 * KP * 2;
constexpr int L_ST = 0;
constexpr int L1_KD = 54272;
constexpr int L1_VT = L1_KD + 192 * KP * 2;
static_assert(L_RS + 1024 <= LDS_WORK && L1_VT + 384 * KP * 2 <= LDS_WORK, "GLA LDS map");

__device__ __forceinline__ int chunk_row0(int c) { return c < TP / 64 ? c * 64 : TP + (c - TP / 64) * 64; }

__device__ __forceinline__ void decay_scan(const bf16_t* z, const float* wg2, const float* bg, int row0, int h, char* lds, int tid) {
    float* G = (float*)(lds + L_G); float* glow = (float*)(lds + L_GLOW); float* tot = (float*)(lds + L_TOT);
    for (int i = tid; i < 64 * 16; i += 512) glow[i] = bf2f(z[(size_t)(row0 + (i >> 4)) * ZLD + ZG + (i & 15)]);
    __syncthreads();
    if (tid < 384) {
        const int k = tid % 192, half = tid / 192; float w[16];
#pragma unroll
        for (int j = 0; j < 16; ++j) w[j] = wg2[(size_t)j * GKW + h * GDK + k];
        const float b = bg[h * GDK + k]; float g = 0.f;
        for (int s = half * 32; s < half * 32 + 32; ++s) { float a = b;
#pragma unroll
            for (int j = 0; j < 16; ++j) a += glow[s * 16 + j] * w[j];
            g += (fminf(a, 0.f) - __logf(1.f + __expf(-fabsf(a)))) * (1.0f / 16.0f); G[s * GDK + k] = g; }
        if (half == 0) tot[k] = g;
    }
    __syncthreads();
}

__device__ __forceinline__ void g1_unit(int c, int h, const bf16_t* z, const float* wg2, const float* bg, float* UT, float* DEC, char* lds, int g_wave) {
    const int tid = opaque_tid(); const int row0 = chunk_row0(c);
    decay_scan(z, wg2, bg, row0, h, lds, tid);
    const float* G = (const float*)(lds + L_G); const float* tot = (const float*)(lds + L_TOT);
    bf16_t* KD = (bf16_t*)(lds + L1_KD); bf16_t* VT = (bf16_t*)(lds + L1_VT);
    for (int it = tid; it < 192 * 8; it += 512) {
        const int k = it % 192, sb = it / 192; const float t0 = tot[k], glast = G[63 * GDK + k] + t0; float v[8];
#pragma unroll
        for (int i = 0; i < 8; ++i) { const int s = sb * 8 + i; const float g = G[s * GDK + k] + (s >= 32 ? t0 : 0.f);
            v[i] = bf2f(z[(size_t)(row0 + s) * ZLD + ZK + h * GDK + k]) * __expf(glast - g); }
        u32x4 w = {cvtpk(v[0], v[1]), cvtpk(v[2], v[3]), cvtpk(v[4], v[5]), cvtpk(v[6], v[7])};
        *(u32x4*)(KD + k * KP + sb * 8) = w;
        if (sb == 0) DEC[(size_t)(c * GH + h) * GDK + k] = __expf(glast);
    }
    for (int it = tid; it < 64 * 48; it += 512) {
        const int s = it & 63, vb = it >> 6; const u32x4 w = *(const u32x4*)(z + (size_t)(row0 + s) * ZLD + ZV + h * GDV + vb * 8);
#pragma unroll
        for (int i = 0; i < 4; ++i) { VT[(vb * 8 + 2 * i) * KP + s] = (bf16_t)(w[i] & 0xffffu); VT[(vb * 8 + 2 * i + 1) * KP + s] = (bf16_t)(w[i] >> 16); }
    }
    __syncthreads();
    const int wid = tid >> 6, lane = tid & 63, l32 = lane & 31, hi = lane >> 5, mq = wid & 3, nh = wid >> 2;
    f32x16 acc[3][3];
#pragma unroll
    for (int i = 0; i < 3; ++i)
#pragma unroll
        for (int j = 0; j < 3; ++j) acc[i][j] = f32x16{};
#pragma unroll
    for (int ks = 0; ks < 4; ++ks) { bf16x8 a[3], bb[3];
#pragma unroll
        for (int i = 0; i < 3; ++i) { a[i] = *(const bf16x8*)(VT + ((mq * 3 + i) * 32 + l32) * KP + ks * 16 + hi * 8); bb[i] = *(const bf16x8*)(KD + ((nh * 3 + i) * 32 + l32) * KP + ks * 16 + hi * 8); }
#pragma unroll
        for (int i = 0; i < 3; ++i)
#pragma unroll
            for (int j = 0; j < 3; ++j) acc[i][j] = __builtin_amdgcn_mfma_f32_32x32x16_bf16(a[i], bb[j], acc[i][j], 0, 0, 0); }
    float* out = UT + (size_t)(c * GH + h) * GDV * GDK;
#pragma unroll
    for (int i = 0; i < 3; ++i)
#pragma unroll
        for (int j = 0; j < 3; ++j)
#pragma unroll
            for (int r = 0; r < 16; ++r) out[(size_t)((mq * 3 + i) * 32 + att::crow(r, hi)) * GDK + (nh * 3 + j) * 32 + l32] = acc[i][j][r];
    __syncthreads();
}

__device__ __forceinline__ void g2_tile(int tile, float* UT, const float* DEC, const float* s0in, float* outp, float* outs, char* lds, int tid) {
    const int h = tile / 36, vt = (tile % 36) / 3, kt = tile % 3, vi = tid >> 4, kg = tid & 15, v = vt * 32 + vi, k = kt * 64 + kg * 4;
    float* T = (float*)lds;
    const size_t cstride = (size_t)GH * GDV * GDK; float* up = UT + ((size_t)h * GDV + v) * GDK + k; const float* dp = DEC + h * GDK + k;
    float zz = 0.f; asm volatile("" : "+v"(zz)); f32x4 S = {zz, zz, zz, zz};
    for (int c0 = 0; c0 < TP / 64; c0 += 8) { f32x4 u[8], d[8];
#pragma unroll
        for (int i = 0; i < 8; ++i) { u[i] = *(const f32x4*)(up + (size_t)(c0 + i) * cstride); d[i] = *(const f32x4*)(dp + (size_t)(c0 + i) * GH * GDK); }
#pragma unroll
        for (int i = 0; i < 8; ++i) { *(f32x4*)(up + (size_t)(c0 + i) * cstride) = S; S = d[i] * S + u[i]; } }
    const int kr = tid >> 3, v4 = (tid & 7) * 4;
    T[(kg * 4 + 0) * 33 + vi] = S[0]; T[(kg * 4 + 1) * 33 + vi] = S[1]; T[(kg * 4 + 2) * 33 + vi] = S[2]; T[(kg * 4 + 3) * 33 + vi] = S[3];
    __syncthreads();
    { f32x4 o = {T[kr * 33 + v4], T[kr * 33 + v4 + 1], T[kr * 33 + v4 + 2], T[kr * 33 + v4 + 3]}; *(f32x4*)(outp + ((size_t)h * GDK + kt * 64 + kr) * GDV + vt * 32 + v4) = o; }
    __syncthreads();
    for (int b = 0; b < NB; ++b) {
        const int c = TP / 64 + b; const size_t sb = ((size_t)b * GH + h) * GDK * GDV;
        { const f32x4 i4 = *(const f32x4*)(s0in + sb + (size_t)(kt * 64 + kr) * GDV + vt * 32 + v4); T[kr * 33 + v4] = i4[0]; T[kr * 33 + v4 + 1] = i4[1]; T[kr * 33 + v4 + 2] = i4[2]; T[kr * 33 + v4 + 3] = i4[3]; }
        __syncthreads();
        f32x4 s0 = {T[(kg * 4 + 0) * 33 + vi], T[(kg * 4 + 1) * 33 + vi], T[(kg * 4 + 2) * 33 + vi], T[(kg * 4 + 3) * 33 + vi]};
        const f32x4 u = *(const f32x4*)(up + (size_t)c * cstride), d = *(const f32x4*)(dp + (size_t)c * GH * GDK);
        *(f32x4*)(up + (size_t)c * cstride) = s0; const f32x4 sn = d * s0 + u;
        __syncthreads();
        T[(kg * 4 + 0) * 33 + vi] = sn[0]; T[(kg * 4 + 1) * 33 + vi] = sn[1]; T[(kg * 4 + 2) * 33 + vi] = sn[2]; T[(kg * 4 + 3) * 33 + vi] = sn[3];
        __syncthreads();
        { f32x4 o = {T[kr * 33 + v4], T[kr * 33 + v4 + 1], T[kr * 33 + v4 + 2], T[kr * 33 + v4 + 3]}; *(f32x4*)(outs + sb + (size_t)(kt * 64 + kr) * GDV + vt * 32 + v4) = o; }
        __syncthreads();
    }
}

__device__ __forceinline__ void g3_unit(int c, int h, const bf16_t* z, const float* wg2, const float* bg, const float* UT, const float* ng, const float* br, bf16_t* oc, char* lds, int g_wave) {
    const int tid = opaque_tid(); const int row0 = chunk_row0(c);
    decay_scan(z, wg2, bg, row0, h, lds, tid);
    const float* G = (const float*)(lds + L_G); const float* tot = (const float*)(lds + L_TOT);
    bf16_t* Qp = (bf16_t*)(lds + L_QP); bf16_t* Kp = (bf16_t*)(lds + L_KPB); bf16_t* Ab = (bf16_t*)(lds + L_AB); bf16_t* VT = (bf16_t*)(lds + L_VT); bf16_t* ST = (bf16_t*)(lds + L_ST);
    float* RS = (float*)(lds + L_RS);
    const float qs = 0.07216878364870322f;
    for (int it = tid; it < 64 * 24; it += 512) {
        const int s = it / 24, kb = (it % 24) * 8; float g[8];
#pragma unroll
        for (int i = 0; i < 8; ++i) g[i] = G[s * GDK + kb + i] + (s >= 32 ? tot[kb + i] : 0.f);
        const u32x4 qw = *(const u32x4*)(z + (size_t)(row0 + s) * ZLD + ZQ + h * GDK + kb), kw = *(const u32x4*)(z + (size_t)(row0 + s) * ZLD + ZK + h * GDK + kb);
        u32x4 qo, ko;
#pragma unroll
        for (int i = 0; i < 4; ++i) { const float e0 = __expf(g[2 * i]), e1 = __expf(g[2 * i + 1]);
            qo[i] = cvtpk(__uint_as_float(qw[i] << 16) * qs * e0, __uint_as_float(qw[i] & 0xffff0000u) * qs * e1);
            ko[i] = cvtpk(__uint_as_float(kw[i] << 16) * __builtin_amdgcn_rcpf(e0), __uint_as_float(kw[i] & 0xffff0000u) * __builtin_amdgcn_rcpf(e1)); }
        *(u32x4*)(Qp + s * QP + kb) = qo; *(u32x4*)(Kp + s * QP + kb) = ko;
    }
    __syncthreads();
    const int wid = tid >> 6, lane = tid & 63, l32 = lane & 31, hi = lane >> 5;
    if (wid < 4) {
        const int mt = wid & 1, nt = wid >> 1; f32x16 a = f32x16{};
        if (nt <= mt) {
#pragma unroll
            for (int ks = 0; ks < 12; ++ks) { const bf16x8 x = *(const bf16x8*)(Qp + (mt * 32 + l32) * QP + ks * 16 + hi * 8), y = *(const bf16x8*)(Kp + (nt * 32 + l32) * QP + ks * 16 + hi * 8);
                a = __builtin_amdgcn_mfma_f32_32x32x16_bf16(x, y, a, 0, 0, 0); }
        }
#pragma unroll
        for (int r = 0; r < 16; ++r) { const int t = mt * 32 + att::crow(r, hi), s = nt * 32 + l32; const float v = (s <= t) ? a[r] : 0.f; Ab[t * KP + s] = (bf16_t)(cvtpk(v, 0.f) & 0xffffu); }
    }
    __syncthreads();
    const int mt = wid & 1, nt = wid >> 1;
    f32x16 oacc[3];
    const float* Sb = UT + (size_t)(c * GH + h) * GDV * GDK;
#pragma unroll
    for (int vs = 0; vs < 3; ++vs) {
        for (int it = tid; it < 128 * 24; it += 512) { const int v = it / 24, kb = (it % 24) * 8; const float* p = Sb + (size_t)(vs * 128 + v) * GDK + kb;
            *(u32x4*)(ST + v * QP + kb) = pack8u(*(const f32x4*)p, *(const f32x4*)(p + 4)); }
        for (int it = tid; it < 64 * 16; it += 512) { const int s = it & 63, vb = it >> 6; const u32x4 w = *(const u32x4*)(z + (size_t)(row0 + s) * ZLD + ZV + h * GDV + vs * 128 + vb * 8);
#pragma unroll
            for (int i = 0; i < 4; ++i) { VT[(vb * 8 + 2 * i) * KP + s] = (bf16_t)(w[i] & 0xffffu); VT[(vb * 8 + 2 * i + 1) * KP + s] = (bf16_t)(w[i] >> 16); } }
        __syncthreads();
        f32x16 a = f32x16{};
#pragma unroll
        for (int ks = 0; ks < 12; ++ks) { const bf16x8 x = *(const bf16x8*)(Qp + (mt * 32 + l32) * QP + ks * 16 + hi * 8), y = *(const bf16x8*)(ST + (nt * 32 + l32) * QP + ks * 16 + hi * 8);
            a = __builtin_amdgcn_mfma_f32_32x32x16_bf16(x, y, a, 0, 0, 0); }
#pragma unroll
        for (int ks = 0; ks < 4; ++ks) { const bf16x8 x = *(const bf16x8*)(Ab + (mt * 32 + l32) * KP + ks * 16 + hi * 8), y = *(const bf16x8*)(VT + (nt * 32 + l32) * KP + ks * 16 + hi * 8);
            a = __builtin_amdgcn_mfma_f32_32x32x16_bf16(x, y, a, 0, 0, 0); }
        oacc[vs] = a;
        __syncthreads();
    }
#pragma unroll
    for (int r = 0; r < 16; ++r) { float q = oacc[0][r] * oacc[0][r] + oacc[1][r] * oacc[1][r] + oacc[2][r] * oacc[2][r];
        q += __shfl_xor(q, 1); q += __shfl_xor(q, 2); q += __shfl_xor(q, 4); q += __shfl_xor(q, 8); q += __shfl_xor(q, 16);
        if (l32 == 0) RS[(mt * 32 + att::crow(r, hi)) * 4 + nt] = q; }
    __syncthreads();
#pragma unroll
    for (int r = 0; r < 16; ++r) { const int t = mt * 32 + att::crow(r, hi); const f32x4 q4 = *(const f32x4*)(RS + t * 4);
        const float rstd = rsqrtf(((q4[0] + q4[1]) + (q4[2] + q4[3])) * (1.0f / GDV) + RMS_EPS);
#pragma unroll
        for (int vs = 0; vs < 3; ++vs) { const int cv = h * GDV + vs * 128 + nt * 32 + l32;
            const float gate = bf2f(z[(size_t)(row0 + t) * ZLD + ZR + cv]) + br[cv]; const float sg = gate / (1.f + __expf(-gate));
            const float val = oacc[vs][r] * rstd * ng[cv] * sg; const float vn = __shfl_xor(val, 1);
            if ((l32 & 1) == 0) *(unsigned*)(oc + (size_t)(row0 + t) * DM + cv) = cvtpk(val, vn); } }
    __syncthreads();
}
}

__device__ __forceinline__ int in_rowmap(int kind, int c) {
    if (kind == 0) return c < 4608 ? c : (c < 4620 ? 5120 + (c - 4608) : 4608 + (c - 4620));
    if (kind == 2) return c < 4608 ? c : (c < 4624 ? 5120 + (c - 4608) : 4608 + (c - 4624));
    return c;
}
__device__ __forceinline__ void tr_item(const float* W, int K, int N, bf16_t* WT, int kind, const float* gain, float* scr, int item, int lane) {
    const int nblk = (N + 31) >> 5, kb = item / nblk, nb = item - kb * nblk, k0 = 64 * kb, n0 = 32 * nb;
    const int nn = n0 + (lane & 31); const bool ok = nn < N;
    const float* src = W + (size_t)(k0 + (lane >> 5)) * N + (ok ? nn : 0);
    float v[32];
#pragma unroll
    for (int i = 0; i < 32; ++i) v[i] = __builtin_nontemporal_load(src + (size_t)(2 * i) * N);
    if (gain) {
#pragma unroll
        for (int i = 0; i < 32; ++i) v[i] *= gain[k0 + 2 * i + (lane >> 5)];
    }
#pragma unroll
    for (int i = 0; i < 32; ++i) scr[(2 * i + (lane >> 5)) * 33 + (lane & 31)] = ok ? v[i] : 0.f;
    LDS_WAIT(); asm volatile("" ::: "memory");
    const int c = lane & 7;
#pragma unroll
    for (int j = 0; j < 4; ++j) { const int n = (lane >> 3) + 8 * j; const float* s = scr + (8 * c) * 33 + n;
        if (n0 + n < N) { u32x4 o; o[0] = cvtpk(s[0 * 33], s[1 * 33]); o[1] = cvtpk(s[2 * 33], s[3 * 33]); o[2] = cvtpk(s[4 * 33], s[5 * 33]); o[3] = cvtpk(s[6 * 33], s[7 * 33]);
            *(u32x4*)(WT + (size_t)in_rowmap(kind, n0 + n) * K + k0 + 8 * c) = o; } }
    LDS_WAIT(); asm volatile("" ::: "memory");
}
template <int NF4>
__device__ __forceinline__ void cvt_row2(const float* s0, bf16_t* d0, const float* s1, bf16_t* d1, int lane) {
    f32x4 a[NF4], b[NF4];
#pragma unroll
    for (int q = 0; q < NF4; ++q) { a[q] = __builtin_nontemporal_load((const f32x4*)(s0 + q * 256 + lane * 4)); b[q] = __builtin_nontemporal_load((const f32x4*)(s1 + q * 256 + lane * 4)); }
#pragma unroll
    for (int q = 0; q < NF4; ++q) { u32x2 w = {cvtpk(a[q][0], a[q][1]), cvtpk(a[q][2], a[q][3])}; *(u32x2*)(d0 + q * 256 + lane * 4) = w;
        u32x2 x = {cvtpk(b[q][0], b[q][1]), cvtpk(b[q][2], b[q][3])}; *(u32x2*)(d1 + q * 256 + lane * 4) = x; }
}

#ifndef EN_MASK
#define EN_MASK 0xFFFF
#endif
#define EN(k) ((EN_MASK >> (k)) & 1)
struct Args { const float* in[29]; float* out; unsigned char* ws; int ph_lo, ph_hi; };
constexpr int PPL = 9;
constexpr int PH_FINAL = 1 + PPL * NLAYER, PH_END = PH_FINAL + 1;
constexpr int PT_OFF = MISC_OFF + 256;
__device__ __forceinline__ unsigned long long ptab_raw(const char* lds, int k) {
    const unsigned long long v = ((const unsigned long long*)(lds + PT_OFF))[k];
    const unsigned l = __builtin_amdgcn_readfirstlane((unsigned)v), h = __builtin_amdgcn_readfirstlane((unsigned)(v >> 32));
    return ((unsigned long long)h << 32) | l;
}
#define PIN(k) ((const float*)(const GAS float*)ptab_raw(lds, (k)))
#define POUT() ((float*)(GAS float*)ptab_raw(lds, 29))
#define PWS() ((unsigned char*)(GAS unsigned char*)ptab_raw(lds, 30))
#define WSP(T, off) ((T*)(ws + (off)))

__device__ __forceinline__ int queue_fetch(unsigned* qhead, volatile LAS unsigned* MISC, int g_wave) {
    if (opaque_tid() == 0) MISC[16] = __hip_atomic_fetch_add(qhead, 1u, __ATOMIC_RELAXED, __HIP_MEMORY_SCOPE_AGENT);
    __syncthreads(); const int v = (int)MISC[16]; __syncthreads(); return __builtin_amdgcn_readfirstlane(v);
}
__device__ __forceinline__ void convert_layer_weights(int L, char* lds, unsigned char* ws, unsigned* qh, volatile LAS unsigned* MISC, int g_wave) {
    const int kind = L % 3, j = L / 3, tid = opaque_tid(), lane = tid & 63, wave = tid >> 6;
    const float* win = kind == 0 ? PIN(16) + (size_t)j * DM * 5132 : (kind == 1 ? PIN(19) : PIN(21)); const int nin = kind == 0 ? 5132 : (kind == 1 ? 5120 : 5136);
    const float* wout = kind == 0 ? PIN(18) + (size_t)j * DM * DM : (kind == 1 ? PIN(20) : PIN(26));
    const float* wup = PIN(27) + (size_t)L * DM * DFF; const float* wdn = PIN(28) + (size_t)L * DFF * DM; const float* wkv = PIN(15) + (size_t)L * DM * 1024;
    const float* gmix = PIN(11) + L * DM; const float* gmlp = PIN(12) + L * DM;
    const int n0 = 32 * ((nin + 31) / 32), n1 = n0 + 32 * 64, n2 = n1 + 32 * 256, n3 = n2 + 128 * 64, total = n3 + 32 * 32, nchunks = (total + 63) / 64;
    float* scr = (float*)(lds + wave * 16384);
    for (;;) {
        const int chunk = queue_fetch(qh, MISC, g_wave); if (chunk >= nchunks) break;
        for (int i = 0; i < 8; ++i) { const int it = chunk * 64 + wave * 8 + i; if (it >= total) break;
            const float* W; int K, N, kd, li; bf16_t* WT; const float* gain;
            if (it < n0) { W = win; K = DM; N = nin; WT = WSP(bf16_t, WS_WIN) + (size_t)L * ZLD * DM; kd = kind; gain = gmix; li = it; }
            else if (it < n1) { W = wout; K = DM; N = DM; WT = WSP(bf16_t, WS_WOUT) + (size_t)L * DM * DM; kd = 1; gain = nullptr; li = it - n0; }
            else if (it < n2) { W = wup; K = DM; N = DFF; WT = WSP(bf16_t, WS_WUP) + (size_t)L * DFF * DM; kd = 1; gain = gmlp; li = it - n1; }
            else if (it < n3) { W = wdn; K = DFF; N = DM; WT = WSP(bf16_t, WS_WDN) + (size_t)L * DM * DFF; kd = 1; gain = nullptr; li = it - n2; }
            else { W = wkv; K = DM; N = 1024; WT = WSP(bf16_t, WS_WMKV) + (size_t)L * 1024 * DM; kd = 1; gain = nullptr; li = it - n3; }
            tr_item(W, K, N, WT, kd, gain, scr, li, lane); }
    }
}
__device__ __forceinline__ void convert_kv_cache(const float* ck, const float* cv, bf16_t* dk, bf16_t* dv, unsigned* qh, volatile LAS unsigned* MISC, int g_wave) {
    const int tid = opaque_tid(), lane = tid & 63, wave = tid >> 6;
    for (;;) {
        const int chunk = queue_fetch(qh, MISC, g_wave); if (chunk >= NB * PAST / 64) break;
#pragma unroll 2
        for (int i = 0; i < 8; ++i) { const int r = chunk * 64 + wave * 8 + i; const size_t so = (size_t)r * AW, dof = ((size_t)(r / PAST) * SKS + (r % PAST)) * AW;
            cvt_row2<6>(ck + so, dk + dof, cv + so, dv + dof, lane); }
    }
}

__global__ void __launch_bounds__(512, 2) trunk_fwd(Args args) {
    extern __shared__ __attribute__((aligned(16))) unsigned char lds_raw[];
    char* lds = (char*)lds_raw;
    volatile LAS unsigned* MISC = (volatile LAS unsigned*)((LAS unsigned char*)lds_raw + MISC_OFF);
    for (int u = threadIdx.x; u < 64; u += 512) MISC[u] = 0u;
    if (threadIdx.x < 29) ((unsigned long long*)(lds + PT_OFF))[threadIdx.x] = (unsigned long long)args.in[threadIdx.x];
    if (threadIdx.x == 29) ((unsigned long long*)(lds + PT_OFF))[29] = (unsigned long long)args.out;
    if (threadIdx.x == 30) ((unsigned long long*)(lds + PT_OFF))[30] = (unsigned long long)args.ws;
    const int g_wave = __builtin_amdgcn_readfirstlane(threadIdx.x >> 6);
    __syncthreads();
    const int G = gridDim.x, bx = blockIdx.x, vcu = (G % 8 == 0) ? (bx % 8) * (G / 8) + bx / 8 : bx;
#if !MK_PER_PHASE
    const XcdBarrier bar = xcd_barrier_post((unsigned*)(args.ws + WS_CTL) + CW_BAR, MISC + 8);
#define GRID_BAR() xcd_barrier(bar)
#else
#define GRID_BAR() do { } while (0)
#endif
    const int lo = args.ph_lo, hi = args.ph_hi;
#define IN(k) (lo <= (k) && (k) < hi)
#define SEAM(k) do { if ((k) + 1 < hi) GRID_BAR(); } while (0)

    if (EN(0) && IN(0)) {
        unsigned char* ws = PWS();
        const int tid = opaque_tid(), lane = tid & 63, wave = tid >> 6, gw = vcu * 8 + wave, NGW = G * 8;
        float* scr = (float*)(lds + wave * 16384);
        convert_layer_weights(0, lds, ws, WSP(unsigned, WS_CTL) + CW_CONV, MISC, g_wave);
        { const float* xp = PIN(0); const float* xs = PIN(1); float* X = WSP(float, WS_X); bf16_t* XB = WSP(bf16_t, WS_XB); float* RSA = WSP(float, WS_RSS);
        for (int m = gw; m < MT; m += NGW) {
            const float* src = m < TP ? xp + (size_t)m * DM : xs + (size_t)(m - TP) * DM; float ss = 0.f;
#pragma unroll
            for (int q = 0; q < 8; ++q) { const int o = q * 256 + lane * 4; const f32x4 v = *(const f32x4*)(src + o); *(f32x4*)(X + (size_t)m * DM + o) = v;
                u32x2 w = {cvtpk(v[0], v[1]), cvtpk(v[2], v[3])}; *(u32x2*)(XB + (size_t)m * DM + o) = w; ss += (v[0] * v[0] + v[1] * v[1]) + (v[2] * v[2] + v[3] * v[3]); }
            ss = wave_sum(ss);
            if (lane < 32) RSA[(size_t)m * 32 + lane] = lane == 0 ? ss : 0.f;
        } }
        { const float* mp = PIN(10); const float* gm = PIN(13); bf16_t* MEMH = WSP(bf16_t, WS_MEMH);
        for (int it = gw; it < NLAYER * NMEM; it += NGW) { const int i = it / NMEM, r = it % NMEM; const float* src = mp + (size_t)r * DM; const float* g = gm + (size_t)i * DM;
            f32x4 v[8]; float ss = 0.f;
#pragma unroll
            for (int q = 0; q < 8; ++q) { v[q] = *(const f32x4*)(src + q * 256 + lane * 4); ss += (v[q][0] * v[q][0] + v[q][1] * v[q][1]) + (v[q][2] * v[q][2] + v[q][3] * v[q][3]); }
            const float rstd = rsqrtf(wave_sum(ss) * (1.0f / DM) + RMS_EPS);
#pragma unroll
            for (int q = 0; q < 8; ++q) { const f32x4 gg = *(const f32x4*)(g + q * 256 + lane * 4); u32x2 w = {cvtpk(v[q][0] * rstd * gg[0], v[q][1] * rstd * gg[1]), cvtpk(v[q][2] * rstd * gg[2], v[q][3] * rstd * gg[3])};
                *(u32x2*)(MEMH + ((size_t)i * NMEM + r) * DM + q * 256 + lane * 4) = w; } } }
        { const float* ck = PIN(2); const float* cv = PIN(3); bf16_t* KVF = WSP(bf16_t, WS_KVF);
        for (int r = gw; r < NB * PAST; r += NGW) { const size_t so = (size_t)r * AW, dof = ((size_t)(r / PAST) * SKS + (r % PAST)) * AW;
            cvt_row2<6>(ck + so, KVF + dof, cv + so, KVF + KVS_ONE / 2 + dof, lane); } }
        { const float* ck = PIN(8); const float* cv = PIN(9); bf16_t* MEMC = WSP(bf16_t, WS_MEMC);
        for (int it = gw; it < NLAYER * NB * NMEM; it += NGW) { const int L = it / (NB * NMEM), r = it % (NB * NMEM); const size_t so = ((size_t)L * NB * NMEM + r) * MEMW, dof = (size_t)r * MEMW;
            cvt_row2<2>(ck + so, MEMC + (size_t)(2 * L) * (MEMC_ONE / 2) + dof, cv + so, MEMC + (size_t)(2 * L + 1) * (MEMC_ONE / 2) + dof, lane); } }
        SEAM(0);
    }

    for (int L = 0; L < NLAYER; ++L) {
        const int kind = L % 3, j = L / 3, base = 1 + PPL * L;
        if (EN(1) && IN(base + 0)) {
            unsigned char* ws = PWS();
            const int tid = opaque_tid();
            pg8::Sched S; S.nM = MT / 256; S.nN = kind == 1 ? 20 : 21; S.nwg = S.nM * S.nN; S.G = G; S.c = bx; S.nextra = 4;
            S.A = (const char*)WSP(bf16_t, WS_XB); S.B = (const char*)(WSP(bf16_t, WS_WIN) + (size_t)L * ZLD * DM); S.tA = (size_t)256 * DM * 2; S.tB = (size_t)256 * DM * 2;
            S.Ae = (const char*)(WSP(bf16_t, WS_MEMH) + (size_t)L * NMEM * DM); S.Be = (const char*)(WSP(bf16_t, WS_WMKV) + (size_t)L * 1024 * DM); S.tAe = 0; S.tBe = (size_t)256 * DM * 2;
            pg8::EpiIn E; E.z = WSP(bf16_t, WS_Z); E.rss = WSP(float, WS_RSS); E.out = POUT(); E.mkvb = WSP(bf16_t, WS_MKVB); E.kind = kind; E.j = j; E.ml = L; E.ctl = (unsigned*)WSP(unsigned, WS_CTL); E.fl = WSP(float, WS_FL); E.dup = WSP(float, WS_GU);
            E.kvb = kind == 0 ? WSP(bf16_t, WS_KVF) + (size_t)(2 * j) * (KVS_ONE / 2) : WSP(bf16_t, WS_KVS); E.bfg = PIN(17) + j * NH;
            pg8::gemm_phase<pg8::EpiIn, pg8::Sched>((LAS unsigned char*)lds_raw, DM, DM, DM, S, E, tid);
            SEAM(base + 0);
        }
        if (IN(base + 1) && kind != 0) {
            unsigned char* ws = PWS();
            if (EN(2) && kind == 1) {
                bf16_t* Z = WSP(bf16_t, WS_Z); bf16_t* OC = WSP(bf16_t, WS_OC); bf16_t* KVS = WSP(bf16_t, WS_KVS);
                for (int n = vcu; n < 480; n += G) { att::Blk b; b.ldq = ZLD; b.ldo = DM; b.bmode = 0; b.lf0 = b.lf1 = nullptr; b.n0 = 0; b.qq = b.kq = nullptr; b.jlo = 0; b.bsel = 0; b.pre0 = 0;
                    if (n < 384) { const int h = n / 32, qb = n % 32; b.Q = Z + (size_t)qb * 256 * ZLD + h * HD; b.K = Z + AW + h * HD; b.V = Z + 2 * AW + h * HD; b.ldkv = ZLD;
                        b.O = OC + (size_t)qb * 256 * DM + h * HD; b.P0 = qb * 256; b.skv = TP; b.nrows = 256; }
                    else { const int m = n - 384, bb = m / NH, h = m % NH; b.Q = Z + (size_t)(TP + bb * 64) * ZLD + h * HD; b.K = KVS + (size_t)bb * SKS * AW + h * HD; b.V = KVS + KVS_ONE / 2 + (size_t)bb * SKS * AW + h * HD; b.ldkv = AW;
                        b.O = OC + (size_t)(TP + bb * 64) * DM + h * HD; b.P0 = PAST; b.skv = SKS; b.nrows = 64; }
                    att::sb_block(b, lds, g_wave); }
            } else if (EN(3) && kind == 2) {
                for (int u = vcu; u < NCHUNK * GH; u += G) gla::g1_unit(u / GH, u % GH, WSP(bf16_t, WS_Z), PIN(22), PIN(23), WSP(float, WS_GU), WSP(float, WS_GDEC), lds, g_wave);
            }
            SEAM(base + 1);
        }
        if (EN(4) && IN(base + 2) && kind == 2) {
            unsigned char* ws = PWS();
            const int tid = opaque_tid();
            if (vcu < 144) gla::g2_tile(vcu, WSP(float, WS_GU), WSP(float, WS_GDEC), PIN(7), POUT() + O_GSP, POUT() + O_GSS, lds, tid);
            __syncthreads();
            convert_kv_cache(PIN(2) + (size_t)NB * PAST * AW, PIN(3) + (size_t)NB * PAST * AW, WSP(bf16_t, WS_KVF) + 2 * (KVS_ONE / 2), WSP(bf16_t, WS_KVF) + 3 * (KVS_ONE / 2), WSP(unsigned, WS_CTL) + CW_CONV + 64 * 5, MISC, g_wave);
            SEAM(base + 2);
        }
        if (IN(base + 3)) {
            unsigned char* ws = PWS();
            if (EN(5) && kind == 2) for (int u = vcu; u < NCHUNK * GH; u += G) gla::g3_unit(u / GH, u % GH, WSP(bf16_t, WS_Z), PIN(22), PIN(23), WSP(float, WS_GU), PIN(25), PIN(24), WSP(bf16_t, WS_OC), lds, g_wave);
            float* outp = POUT(); const float* lfc = PIN(4); const float* FL = WSP(float, WS_FL);
            if (kind == 0) {
                const int tid = opaque_tid();
                for (int e = vcu * 512 + tid; e < MT * NH; e += G * 512) { const float v = log_sigmoidf(FL[e]);
                    if (e < TP * NH) outp[O_FLP + (size_t)j * TP * NH + e] = v; else outp[O_FLS + (size_t)j * TS * NH + (e - TP * NH)] = v; }
            }
            const int nfox = kind == 0 ? 480 : 0, total = nfox + 160;
            auto get = [&](int n, att::Blk& b) {
                int type, a0, a1;
                if (n < nfox) { if (n < 384) { type = 0; a0 = n % NH; a1 = 31 - n / NH; } else { type = 1; a0 = (n - 384) / NH; a1 = (n - 384) % NH; } }
                else { const int m = n - nfox; if (m < 128) { type = 2; a0 = m / 32; a1 = m % 32; } else { type = 3; a0 = (m - 128) / MH; a1 = (m - 128) % MH; } }
                bf16_t* Z = WSP(bf16_t, WS_Z); bf16_t* OC = WSP(bf16_t, WS_OC);
                b.ldq = ZLD; b.ldo = DM; b.lf0 = b.lf1 = nullptr; b.n0 = 0; b.bmode = 0; b.qq = b.kq = nullptr; b.jlo = 0; b.pre0 = 0;
                if (type == 0) { const int h = a0, qb = a1; b.Q = Z + (size_t)qb * 256 * ZLD + h * HD; b.K = Z + AW + h * HD; b.V = Z + 2 * AW + h * HD; b.ldkv = ZLD; b.O = OC + (size_t)qb * 256 * DM + h * HD;
                    b.P0 = qb * 256; b.skv = TP; b.nrows = 256; b.bmode = 1; b.lf0 = FL + h; b.n0 = 1 << 30; b.pre0 = 1;
                    b.qq = WSP(unsigned, WS_CTL) + CW_QQ + ((j * 32 + qb) * NH + h) * 4; b.kq = WSP(unsigned, WS_CTL) + CW_KQ + j * 64 + h * 4; }
                else if (type == 1) { const int bb = a0, h = a1; const bf16_t* fk = WSP(bf16_t, WS_KVF) + (size_t)(2 * j) * (KVS_ONE / 2);
                    b.Q = Z + (size_t)(TP + bb * 64) * ZLD + h * HD; b.K = fk + (size_t)bb * SKS * AW + h * HD; b.V = fk + KVS_ONE / 2 + (size_t)bb * SKS * AW + h * HD; b.ldkv = AW;
                    b.O = OC + (size_t)(TP + bb * 64) * DM + h * HD; b.P0 = PAST; b.skv = SKS; b.nrows = 64; b.bmode = 1; b.lf0 = lfc + ((size_t)j * NB + bb) * PAST * NH + h; b.n0 = PAST; b.lf1 = FL + (size_t)(TP + bb * 64) * NH + h; }
                else if (type == 2) { const int h4 = a0, qb = a1; const bf16_t* mkb = WSP(bf16_t, WS_MKVB) + (size_t)L * NMEM * 1024;
                    b.Q = Z + (size_t)qb * 256 * ZLD + 4608 + h4 * HD; b.K = mkb + h4 * HD; b.V = mkb + MEMW + h4 * HD; b.ldkv = 1024; b.O = OC + (size_t)qb * 256 * DM + AW + h4 * HD;
                    b.P0 = 1 << 20; b.skv = NMEM; b.nrows = 256; }
                else { const int bb = a0, h4 = a1; const bf16_t* mck = WSP(bf16_t, WS_MEMC) + (size_t)(2 * L) * (MEMC_ONE / 2);
                    b.Q = Z + (size_t)(TP + bb * 64) * ZLD + 4608 + h4 * HD; b.K = mck + (size_t)bb * NMEM * MEMW + h4 * HD; b.V = mck + MEMC_ONE / 2 + (size_t)bb * NMEM * MEMW + h4 * HD; b.ldkv = MEMW;
                    b.O = OC + (size_t)(TP + bb * 64) * DM + AW + h4 * HD; b.P0 = 1 << 20; b.skv = NMEM; b.nrows = 64; }
            };
            unsigned* qhead = WSP(unsigned, WS_CTL) + CW_QUEUE + 64 * L;
            auto fetch = [&]() -> int { return queue_fetch(qhead, MISC, g_wave); };
            if (EN(6)) {
                att::Blk cur, nxt; int ic = fetch();
                if (ic < total) {
                    get(ic, cur); cur.bsel = 0; att::prepare_bias(cur, lds, g_wave);
                    att::Seam S; att::att_prime(cur, lds, S, g_wave);
                    for (;;) { const int in_ = fetch(); const bool more = in_ < total;
                        if (more) { get(in_, nxt); nxt.bsel = cur.bsel ^ 1; att::prepare_bias(nxt, lds, g_wave); } else nxt = cur;
                        att::att_block(cur, nxt, lds, S, g_wave);
                        if (!more) break; cur = nxt; }
                }
            }
            if (L == 0) convert_kv_cache(PIN(5), PIN(6), WSP(bf16_t, WS_KVS), WSP(bf16_t, WS_KVS) + KVS_ONE / 2, WSP(unsigned, WS_CTL) + CW_CONV + 64 * 4, MISC, g_wave);
            SEAM(base + 3);
        }
        for (int q = 4; q <= 8; ++q) {
            if (!IN(base + q)) continue;
            unsigned char* ws = PWS();
            const bool dn = q >= 7;
            float* rssw = WSP(float, WS_RSS) + (dn ? 0 : (size_t)MT * 32);
            const int SP = dn ? 16 : 8;
            if (q == 4 || q == 7) {
                if (EN(7)) {
                const int tid = opaque_tid();
                const int K = dn ? DFF : DM; const char* Ab = dn ? (const char*)WSP(bf16_t, WS_U) : (const char*)WSP(bf16_t, WS_OC);
                const char* Bb = dn ? (const char*)(WSP(bf16_t, WS_WDN) + (size_t)L * DM * DFF) : (const char*)(WSP(bf16_t, WS_WOUT) + (size_t)L * DM * DM);
                { pg8::Sched S; S.nM = TP / 256; S.nN = DM / 256; S.nwg = S.nM * S.nN; S.G = G; S.c = bx; S.nextra = 0;
                  S.A = Ab; S.B = Bb; S.tA = (size_t)256 * K * 2; S.tB = (size_t)256 * K * 2; S.Ae = S.Be = nullptr; S.tAe = S.tBe = 0;
                  pg8::EpiRes E{WSP(float, WS_X), WSP(bf16_t, WS_XB), rssw};
                  pg8::gemm_phase<pg8::EpiRes, pg8::Sched>((LAS unsigned char*)lds_raw, K, K, K, S, E, tid); }
                { pg8::SchedSplit S; S.S = SP; S.nu = 16 * SP; S.G = G; S.c = bx; S.A = Ab; S.B = Bb; S.tA = (size_t)256 * K * 2; S.tB = (size_t)256 * K * 2; S.kbytes = (size_t)(K / SP) * 2;
                  pg8::EpiPart E{WSP(float, WS_GU)};
                  pg8::gemm_phase<pg8::EpiPart, pg8::SchedSplit>((LAS unsigned char*)lds_raw, K / SP, K, K, S, E, tid); }
                }
            } else if (q == 5 || q == 8) {
                if (EN(8)) {
                const int tid = opaque_tid(), lane = tid & 63, wave = tid >> 6;
                float* X = WSP(float, WS_X); bf16_t* XB = WSP(bf16_t, WS_XB); const float* part = WSP(float, WS_GU);
                for (int r = vcu; r < TS; r += G) { const size_t o = (size_t)(TP + r) * DM + tid * 4; const float* pp = part + (size_t)r * DM + tid * 4;
                    f32x4 a = *(const f32x4*)(X + o); f32x4 p[16];
#pragma unroll
                    for (int s = 0; s < 16; ++s) p[s] = s < SP ? *(const f32x4*)(pp + (size_t)s * TS * DM) : (f32x4){0.f, 0.f, 0.f, 0.f};
#pragma unroll
                    for (int s = 0; s < 16; ++s) a += p[s];
                    *(f32x4*)(X + o) = a; u32x2 w = {cvtpk(a[0], a[1]), cvtpk(a[2], a[3])}; *(u32x2*)(XB + o) = w;
                    const float ss = wave_sum((a[0] * a[0] + a[1] * a[1]) + (a[2] * a[2] + a[3] * a[3]));
                    if (lane < 4) rssw[(size_t)(TP + r) * 32 + wave + 8 * lane] = lane == 0 ? ss : 0.f; }
                }
            } else {
                if (EN(9)) {
                const int tid = opaque_tid();
                pg8::Sched S; S.nM = MT / 256; S.nN = DFF / 256; S.nwg = S.nM * S.nN; S.G = G; S.c = bx; S.nextra = 0;
                S.A = (const char*)WSP(bf16_t, WS_XB); S.B = (const char*)(WSP(bf16_t, WS_WUP) + (size_t)L * DFF * DM); S.tA = (size_t)256 * DM * 2; S.tB = (size_t)256 * DM * 2; S.Ae = S.Be = nullptr; S.tAe = S.tBe = 0;
                pg8::EpiUp E{WSP(bf16_t, WS_U), WSP(float, WS_RSS) + (size_t)MT * 32};
                pg8::gemm_phase<pg8::EpiUp, pg8::Sched>((LAS unsigned char*)lds_raw, DM, DM, DM, S, E, tid);
                if (L + 1 < NLAYER) convert_layer_weights(L + 1, lds, ws, WSP(unsigned, WS_CTL) + CW_CONV + 64 * (L + 1), MISC, g_wave);
                }
            }
            SEAM(base + q);
        }
    }
    if (EN(10) && IN(PH_FINAL)) {
        unsigned char* ws = PWS(); float* out = POUT();
        const int tid = opaque_tid(), lane = tid & 63, wave = tid >> 6, gw = vcu * 8 + wave, NGW = G * 8;
        const float* g = PIN(14); const float* X = WSP(float, WS_X); const float* RSA = WSP(float, WS_RSS);
        for (int m = gw; m < MT; m += NGW) {
            const float rstd = rsqrtf(wave_sum(lane < 32 ? RSA[(size_t)m * 32 + lane] : 0.f) * (1.0f / DM) + RMS_EPS); float* dst = m < TP ? out + O_YP + (size_t)m * DM : out + O_YS + (size_t)(m - TP) * DM;
#pragma unroll
            for (int q = 0; q < 8; ++q) { const int o = q * 256 + lane * 4; const f32x4 v = *(const f32x4*)(X + (size_t)m * DM + o), gg = *(const f32x4*)(g + o); __builtin_nontemporal_store(v * rstd * gg, (f32x4*)(dst + o)); }
        }
    }
#undef IN
#undef SEAM
#undef GRID_BAR
}

extern "C" void kernel_launch(void* const* d_in, const int* in_sizes, int n_in, void* d_out, int out_size, void* d_ws, size_t ws_size, hipStream_t stream) {
    static int grid = 0;
    if (grid == 0) {
        if (n_in != 29 || (size_t)out_size != O_END || ws_size < WS_END) { fprintf(stderr, "kernel_launch: unexpected shapes (n_in %d, out %d vs %zu, ws %zu vs %zu); nothing launched\n", n_in, out_size, (size_t)O_END, ws_size, (size_t)WS_END); grid = -1; return; }
        int dev = 0, cus = 0, per_cu = 0;
        if (hipGetDevice(&dev) != hipSuccess || hipDeviceGetAttribute(&cus, hipDeviceAttributeMultiprocessorCount, dev) != hipSuccess) { grid = -1; return; }
        if (hipFuncSetAttribute((const void*)trunk_fwd, hipFuncAttributeMaxDynamicSharedMemorySize, LDS_BYTES) != hipSuccess) { fprintf(stderr, "kernel_launch: hipFuncSetAttribute failed\n"); grid = -1; return; }
        if (hipOccupancyMaxActiveBlocksPerMultiprocessor(&per_cu, (const void*)trunk_fwd, 512, LDS_BYTES) != hipSuccess || per_cu < 1) fprintf(stderr, "kernel_launch: occupancy query reports %d workgroups per CU\n", per_cu);
        (void)hipGetLastError();
        grid = cus;
    }
    if (grid < 0) return;
    if (hipMemsetAsync((char*)d_ws + WS_CTL, 0, CTL_BYTES, stream) != hipSuccess) return;
    Args a{};
    for (int i = 0; i < 29; ++i) a.in[i] = (const float*)d_in[i];
    a.out = (float*)d_out; a.ws = (unsigned char*)d_ws;
#if MK_PER_PHASE
    for (int p = 0; p < PH_END; ++p) {
        if (p >= 1 && p < PH_FINAL) { const int L = (p - 1) / PPL, q = (p - 1) % PPL, kind = L % 3; if ((q == 1 && kind == 0) || (q == 2 && kind != 2)) continue; }
        a.ph_lo = p; a.ph_hi = p + 1;
        hipLaunchKernelGGL(trunk_fwd, dim3(grid), dim3(512), LDS_BYTES, stream, a);
#ifdef PROBE_LO
        if (p == PROBE_HI - 1) for (int pp = PROBE_LO; pp < PROBE_HI; ++pp) { a.ph_lo = pp; a.ph_hi = pp + 1; hipLaunchKernelGGL(trunk_fwd, dim3(grid), dim3(512), LDS_BYTES, stream, a); }
#endif
    }
#else
    a.ph_lo = 0; a.ph_hi = PH_END;
    hipLaunchKernelGGL(trunk_fwd, dim3(grid), dim3(512), LDS_BYTES, stream, a);
#endif
}
```

```cpp
#include <hip/hip_runtime.h>
#include <hip/hip_bf16.h>
#include <cstdio>
#include <cstdint>

#define MK_PER_PHASE 0
#ifndef MK_PER_PHASE
#define MK_PER_PHASE 0
#endif

constexpr int DM = 2048, TP = 8192, TS = 512, MT = TP + TS, NB = 8, CSEQ = 64, PAST = 1024, SKS = PAST + CSEQ;
constexpr int HD = 128, NH = 12, AW = NH * HD, MEMW = 512, NMEM = 256, MH = 4;
constexpr int GH = 4, GDK = 192, GDV = 384, GKW = GH * GDK, GVW = GH * GDV, GRANK = 16;
constexpr int DFF = 8192, ZLD = 5376, NLAYER = 4;
constexpr int NCHUNK = TP / 64 + NB;
constexpr float RMS_EPS = 1e-6f;

constexpr size_t O_YP = 0;
constexpr size_t O_YS = O_YP + (size_t)TP * DM;
constexpr size_t O_FKP = O_YS + (size_t)TS * DM;
constexpr size_t O_FVP = O_FKP + (size_t)2 * TP * AW;
constexpr size_t O_FLP = O_FVP + (size_t)2 * TP * AW;
constexpr size_t O_SKP = O_FLP + (size_t)2 * TP * NH;
constexpr size_t O_SVP = O_SKP + (size_t)TP * AW;
constexpr size_t O_GSP = O_SVP + (size_t)TP * AW;
constexpr size_t O_MKP = O_GSP + (size_t)GH * GDK * GDV;
constexpr size_t O_MVP = O_MKP + (size_t)NLAYER * NMEM * MEMW;
constexpr size_t O_FKS = O_MVP + (size_t)NLAYER * NMEM * MEMW;
constexpr size_t O_FVS = O_FKS + (size_t)2 * TS * AW;
constexpr size_t O_FLS = O_FVS + (size_t)2 * TS * AW;
constexpr size_t O_SKS = O_FLS + (size_t)2 * TS * NH;
constexpr size_t O_SVS = O_SKS + (size_t)TS * AW;
constexpr size_t O_GSS = O_SVS + (size_t)TS * AW;
constexpr size_t O_END = O_GSS + (size_t)NB * GH * GDK * GDV;

constexpr size_t al256(size_t x) { return (x + 255) & ~(size_t)255; }
constexpr size_t WS_CTL = 0, CTL_BYTES = 2u << 20;
constexpr size_t WS_WIN = CTL_BYTES;
constexpr size_t WS_WOUT = WS_WIN + (size_t)NLAYER * ZLD * DM * 2;
constexpr size_t WS_WUP = WS_WOUT + (size_t)NLAYER * DM * DM * 2;
constexpr size_t WS_WDN = WS_WUP + (size_t)NLAYER * DFF * DM * 2;
constexpr size_t WS_WMKV = WS_WDN + (size_t)NLAYER * DM * DFF * 2;
constexpr size_t WS_X = WS_WMKV + (size_t)NLAYER * 1024 * DM * 2;
constexpr size_t WS_XB = WS_X + (size_t)MT * DM * 4;
constexpr size_t WS_Z = WS_XB + (size_t)MT * DM * 2;
constexpr size_t WS_OC = WS_Z + (size_t)MT * ZLD * 2;
constexpr size_t WS_U = WS_OC + (size_t)MT * DM * 2;
constexpr size_t WS_GU = WS_U + (size_t)MT * DFF * 2;
constexpr size_t WS_GDEC = WS_GU + (size_t)NCHUNK * GH * GDV * GDK * 4;
constexpr size_t WS_KVF = al256(WS_GDEC + (size_t)NCHUNK * GH * GDK * 4);
constexpr size_t KVS_ONE = (size_t)NB * SKS * AW * 2;
constexpr size_t WS_KVS = WS_KVF + 4 * KVS_ONE;
constexpr size_t WS_MEMC = WS_KVS + 2 * KVS_ONE;
constexpr size_t MEMC_ONE = (size_t)NB * NMEM * MEMW * 2;
constexpr size_t WS_MEMH = WS_MEMC + 8 * MEMC_ONE;
constexpr size_t WS_MKVB = WS_MEMH + (size_t)NLAYER * NMEM * DM * 2;
constexpr size_t WS_RSS = WS_MKVB + (size_t)NLAYER * NMEM * 1024 * 2;
constexpr size_t WS_FL = WS_RSS + (size_t)2 * MT * 32 * 4;
constexpr size_t WS_END = WS_FL + (size_t)MT * NH * 4;

constexpr int CW_BAR = 4096;
constexpr int CW_QUEUE = 8192;
constexpr int CW_KQ = 12288;
constexpr int CW_CONV = 20480;
constexpr int CW_HS = 12800;
constexpr int CW_FIN = 22528;
constexpr int CW_TS = 24576;
constexpr int CW_QQ = 16384;

constexpr int LDS_WORK = 136 * 1024;
constexpr int MISC_OFF = LDS_WORK;
constexpr int LDS_BYTES = 147456;

#define GAS __attribute__((address_space(1)))
#define LAS __attribute__((address_space(3)))
typedef unsigned short bf16_t;
typedef unsigned u32x4 __attribute__((ext_vector_type(4)));
typedef unsigned u32x2 __attribute__((ext_vector_type(2)));
typedef float f32x4 __attribute__((ext_vector_type(4)));
typedef float f32x2 __attribute__((ext_vector_type(2)));
typedef float f32x16 __attribute__((ext_vector_type(16)));
typedef short bf16x8 __attribute__((ext_vector_type(8)));
typedef short s16x4 __attribute__((ext_vector_type(4)));
#define LDS_WAIT() asm volatile("s_waitcnt lgkmcnt(0)" ::: "memory")
#define VM_WAIT() asm volatile("s_waitcnt vmcnt(0)" ::: "memory")
#define SBAR() __builtin_amdgcn_sched_barrier(0)
__device__ __forceinline__ unsigned cvtpk(float lo, float hi) { unsigned r; asm volatile("v_cvt_pk_bf16_f32 %0, %1, %2" : "=v"(r) : "v"(lo), "v"(hi)); return r; }
__device__ __forceinline__ float bf2f(unsigned short b) { return __uint_as_float((unsigned)b << 16); }
__device__ __forceinline__ u32x4 pack8u(f32x4 a, f32x4 b) { u32x4 w = {cvtpk(a[0], a[1]), cvtpk(a[2], a[3]), cvtpk(b[0], b[1]), cvtpk(b[2], b[3])}; return w; }
__device__ __forceinline__ bf16x8 pack8(f32x4 a, f32x4 b) { u32x4 w = pack8u(a, b); return *reinterpret_cast<bf16x8*>(&w); }
#define WS_SWZ(v, m) __int_as_float(__builtin_amdgcn_ds_swizzle(__float_as_int(v), ((m) << 10) | 0x1f))
__device__ __forceinline__ float wave_sum(float v) {
    v += WS_SWZ(v, 1); v += WS_SWZ(v, 2); v += WS_SWZ(v, 4); v += WS_SWZ(v, 8); v += WS_SWZ(v, 16);
    { auto rr = __builtin_amdgcn_permlane32_swap(__float_as_uint(v), __float_as_uint(v), false, false); v = __uint_as_float(rr[0]) + __uint_as_float(rr[1]); }
    return v;
}
__device__ __forceinline__ float log_sigmoidf(float x) { return fminf(x, 0.f) - log1pf(expf(-fabsf(x))); }
__device__ __forceinline__ float log_sigmoid_fast(float x) { return fminf(x, 0.f) - __logf(1.f + __expf(-fabsf(x))); }
__device__ __forceinline__ int opaque_tid_w(int wave) { int l; asm volatile("v_mbcnt_lo_u32_b32 %0, -1, 0\n\tv_mbcnt_hi_u32_b32 %0, -1, %0" : "=v"(l)); return wave * 64 + l; }
#define opaque_tid() opaque_tid_w(g_wave)
template <class T> __device__ __forceinline__ T* launder_s(T* p) { asm volatile("" : "+s"(p)); return p; }
#define XB_TMO      128
#define XB_XCNT(j)  (256  + 64 * (j))
#define XB_XSUB(j)  (1280 + 64 * (j))
#define XB_XGEN(j)  (2304 + 64 * (j))
#define XB_TOP      3328
#define XB_TOPGEN   3392
#define XCD_BAR_WORDS 3456
#define XB_SPIN_CAP (1u << 18)
__device__ __forceinline__ unsigned xb_ld(unsigned* p)              { return __hip_atomic_load(p, __ATOMIC_RELAXED, __HIP_MEMORY_SCOPE_AGENT); }
__device__ __forceinline__ unsigned xb_add(unsigned* p, unsigned v) { return __hip_atomic_fetch_add(p, v, __ATOMIC_RELAXED, __HIP_MEMORY_SCOPE_AGENT); }
__device__ __forceinline__ unsigned xb_xcc_id() { return (unsigned)__builtin_amdgcn_s_getreg((3 << 11) | 20) & 0xFu; }
#define XB_SPIN(cond, bar) do { unsigned _sp = 0; while (cond) { __builtin_amdgcn_s_sleep(1); \
    if ((++_sp & 255u) == 0u) { if (xb_ld(&(bar)[XB_TMO])) break; if (_sp > XB_SPIN_CAP) { atomicAdd(&(bar)[XB_TMO], 1u); break; } } } } while (0)
struct XcdBarrier { unsigned* bar; unsigned x; volatile LAS unsigned* st; int wave; };
__device__ __forceinline__ XcdBarrier xcd_barrier_post(unsigned* bar, volatile LAS unsigned* st) {
    XcdBarrier b; b.bar = bar; b.x = xb_xcc_id(); b.st = st;
    if (threadIdx.x == 0) (void)xb_add(&bar[XB_XCNT(b.x)], 1u);
    return b;
}
__device__ __forceinline__ void xcd_barrier_complete(unsigned* bar, unsigned x, unsigned& nloc, unsigned& nx) {
    const unsigned G = gridDim.x * gridDim.y * gridDim.z;
    unsigned sum, cnt, mine, sp = 0u;
    for (;;) {
        sum = 0u; cnt = 0u; mine = 0u;
#pragma unroll
        for (unsigned j = 0; j < 16; ++j) { const unsigned c = xb_ld(&bar[XB_XCNT(j)]); sum += c; cnt += (c > 0u) ? 1u : 0u; mine = (j == x) ? c : mine; }
        if (sum == G) break;
        __builtin_amdgcn_s_sleep(1);
        if ((++sp & 255u) == 0u) { if (xb_ld(&bar[XB_TMO])) break; if (sp > XB_SPIN_CAP) { atomicAdd(&bar[XB_TMO], 1u); break; } }
    }
    nloc = mine > 0u ? mine : 1u; nx = cnt > 0u ? cnt : 1u;
}
__device__ __forceinline__ void xcd_barrier(const XcdBarrier& b) {
    asm volatile("s_waitcnt vmcnt(0)" ::: "memory");
    __syncthreads();
    if (opaque_tid_w(b.wave) == 0) {
        unsigned* bar = b.bar;
        __builtin_amdgcn_s_waitcnt(0);
        unsigned nloc = b.st[0], nx = b.st[1];
        if (nloc == 0u) { xcd_barrier_complete(bar, b.x, nloc, nx); b.st[0] = nloc; b.st[1] = nx; }
        const unsigned old = xb_add(&bar[XB_XSUB(b.x)], 1u);
        const unsigned gen = old / nloc;
        if (old + 1u == (gen + 1u) * nloc) {
            __builtin_amdgcn_fence(__ATOMIC_RELEASE, "agent");
            asm volatile("s_waitcnt vmcnt(0)" ::: "memory");
            const unsigned og = xb_add(&bar[XB_TOP], 1u);
            const unsigned tg = og / nx;
            if (og + 1u == (tg + 1u) * nx) xb_add(&bar[XB_TOPGEN], 1u);
            else XB_SPIN(xb_ld(&bar[XB_TOPGEN]) == tg, bar);
            __builtin_amdgcn_fence(__ATOMIC_ACQUIRE, "agent");
            xb_add(&bar[XB_XGEN(b.x)], 1u);
            asm volatile("s_waitcnt vmcnt(0)" ::: "memory");
        } else {
            XB_SPIN(xb_ld(&bar[XB_XGEN(b.x)]) == gen, bar);
            __builtin_amdgcn_fence(__ATOMIC_ACQUIRE, "agent");
            asm volatile("s_waitcnt vmcnt(0)" ::: "memory");
        }
    }
    __syncthreads();
}

namespace pg8 {
constexpr int BM = 256, BK = 64, HALF = 128, HTB = HALF * BK * 2, STAGE_BYTES = 8 * HTB, NXCD = 8, WGM = 8;
__host__ __device__ __forceinline__ int lds_byte(int r, int c) { const int st = (r >> 4) * 2 + (c >> 5), rr = r & 15, cc = c & 31, ob = rr * 64 + cc * 2; return st * 1024 + (ob ^ (((ob >> 9) & 1) << 5)); }
__host__ __device__ __forceinline__ void stage_rc(int b, int& R, int& C) { const int st = b / 1024, sb = b % 1024, swz = sb ^ (((sb >> 9) & 1) << 5); R = (st >> 1) * 16 + swz / 64; C = (st & 1) * 32 + (swz % 64) / 2; }
__host__ __device__ __forceinline__ int perm32(int rho) { const int n = rho >> 4, i = rho & 15; return 8 * (i >> 2) + 4 * n + (i & 3); }

struct Unit { int pm, pn, g, nt; const char* A; const char* B; };

struct Sched {
    int nM, nN, nwg, G, c, nextra, nt;
    const char* A; const char* B; size_t tA, tB;
    const char* Ae; const char* Be; size_t tAe, tBe;
    unsigned* rdy; unsigned need;
    __device__ __forceinline__ bool waits(const Unit& u) const { return rdy != nullptr && u.g == 0 && u.pm >= TP / BM; }
    __device__ __forceinline__ void poll() const {
        unsigned sp = 0; while (__hip_atomic_load(rdy, __ATOMIC_RELAXED, __HIP_MEMORY_SCOPE_AGENT) < need) { __builtin_amdgcn_s_sleep(1); if (++sp > (1u << 22)) break; }
        __builtin_amdgcn_fence(__ATOMIC_ACQUIRE, "agent"); asm volatile("s_waitcnt vmcnt(0)" ::: "memory"); }
    __device__ __forceinline__ bool next(int i, Unit& u) const {
        const long L = (long)i * G + c; if (L >= nwg + nextra) return false;
        u.nt = nt;
        if (L >= nwg) { const int e = (int)(L - nwg); u.g = 1 + (e >> 2); u.pm = 0; u.pn = e & 3; u.A = Ae + (size_t)(e >> 2) * tAe; u.B = Be + (size_t)e * tBe; return true; }
        int wgid = (int)L; { const int q = nwg / NXCD, r = nwg % NXCD, xcd = wgid % NXCD, off = wgid / NXCD; wgid = (xcd < r ? xcd * (q + 1) : r * (q + 1) + (xcd - r) * q) + off; }
        const int nig = WGM * nN, gid = wgid / nig, fm = gid * WGM, gsz = (nM - fm) < WGM ? (nM - fm) : WGM;
        u.pm = fm + ((wgid % nig) % gsz); u.pn = (wgid % nig) / gsz; u.g = 0; u.A = A + (size_t)u.pm * tA; u.B = B + (size_t)u.pn * tB; return true;
    }
};

__device__ __forceinline__ void row_rstd8(const float* rss, int row0, int fq, float (&rs)[2][4]) {
    f32x4 a[2][4], b[2][4];
#pragma unroll
    for (int ai = 0; ai < 2; ++ai)
#pragma unroll
        for (int m = 0; m < 4; ++m) { const f32x4* p = (const f32x4*)(rss + (size_t)(row0 + ai * HALF + m * 16) * 32 + fq * 8); a[ai][m] = p[0]; b[ai][m] = p[1]; }
#pragma unroll
    for (int ai = 0; ai < 2; ++ai)
#pragma unroll
        for (int m = 0; m < 4; ++m) { const f32x4 v = a[ai][m] + b[ai][m]; float s = (v[0] + v[1]) + (v[2] + v[3]); s += __shfl_xor(s, 16); s += __shfl_xor(s, 32); rs[ai][m] = rsqrtf(s * (1.0f / DM) + RMS_EPS); }
}
__device__ __forceinline__ void rs_table(const LAS float* rst, int wr, int fr, float (&rs)[2][4]) {
#pragma unroll
    for (int ai = 0; ai < 2; ++ai)
#pragma unroll
        for (int m = 0; m < 4; ++m) rs[ai][m] = rst[wr * 64 + fr + ai * HALF + m * 16];
}
struct EpiIn {
    static constexpr bool PERM = true, AFTER_DRAIN = false, RSTD = true;
    bf16_t* z; const float* rss; float* out; bf16_t* kvb; bf16_t* mkvb; const float* bfg; unsigned* ctl; float* fl; float* dup; int kind, j, ml;
    __device__ __forceinline__ void operator()(const f32x4 (&acc)[2][2][4][2], const Unit& u, int wr, int wc, int fr, int fq, const LAS float* rst) const {
        asm volatile("" : "+v"(fr), "+v"(fq));
        const int row0 = u.pm * BM + wr * 64 + fr, colt = u.pn * BM, col0 = colt + wc * 32 + 8 * fq;
        if (u.g != 0) {
            const int e = ml; const bool isv = colt >= MEMW; float* of = out + (isv ? O_MVP : O_MKP) + (size_t)e * NMEM * MEMW; bf16_t* ob = mkvb + (size_t)e * NMEM * 1024;
#pragma unroll
            for (int ai = 0; ai < 2; ++ai)
#pragma unroll
                for (int m = 0; m < 4; ++m) { const int row = row0 + ai * HALF + m * 16;
#pragma unroll
                    for (int bj = 0; bj < 2; ++bj) { const int c = col0 + bj * HALF; const f32x4 v0 = acc[ai][bj][m][0], v1 = acc[ai][bj][m][1];
                        *(u32x4*)(ob + (size_t)row * 1024 + c) = pack8u(v0, v1);
                        float* o = of + (size_t)row * MEMW + (c - (isv ? MEMW : 0)); *(f32x4*)o = v0; *(f32x4*)(o + 4) = v1; } }
            return;
        }
        float rs[2][4]; rs_table(rst, wr, fr, rs);
        const bool kt = kind != 2 && colt >= AW && colt < 2 * AW, vt = kind != 2 && colt >= 2 * AW && colt < 3 * AW, smp = u.pm >= TP / BM;
        const int cbase = kt ? AW : 2 * AW;
        const size_t ocache = kind == 0 ? (smp ? (kt ? O_FKS : O_FVS) + (size_t)j * TS * AW : (kt ? O_FKP : O_FVP) + (size_t)j * TP * AW) : (smp ? (kt ? O_SKS : O_SVS) : (kt ? O_SKP : O_SVP));
        float* oc = out + ocache; bf16_t* kvs = kvb + (kt ? 0 : KVS_ONE / 2);
        const bool lft = kind == 0 && colt == 5120 && wc == 0 && fq < 2;
        const bool nrm = kind == 0 && !smp && colt < 2 * AW;
        float nmx[2] = {0.f, 0.f};
#pragma unroll
        for (int ai = 0; ai < 2; ++ai)
#pragma unroll
            for (int m = 0; m < 4; ++m) { const int row = row0 + ai * HALF + m * 16, rr = smp ? row - TP : row; const float sc = rs[ai][m];
#pragma unroll
                for (int bj = 0; bj < 2; ++bj) { const int c = col0 + bj * HALF; const f32x4 v0 = acc[ai][bj][m][0] * sc, v1 = acc[ai][bj][m][1] * sc; const u32x4 w = pack8u(v0, v1);
                    *(u32x4*)(z + (size_t)row * ZLD + c) = w;
                    if (nrm) { float q = (v0[0] * v0[0] + v0[1] * v0[1]) + (v0[2] * v0[2] + v0[3] * v0[3]) + (v1[0] * v1[0] + v1[1] * v1[1]) + (v1[2] * v1[2] + v1[3] * v1[3]);
                        q += __shfl_xor(q, 16); q += __shfl_xor(q, 32); nmx[bj] = fmaxf(nmx[bj], q); }
                    if (kt || vt) { const int cc = c - cbase; float* o = oc + (size_t)rr * AW + cc; __builtin_nontemporal_store(v0, (f32x4*)o); __builtin_nontemporal_store(v1, (f32x4*)(o + 4));
#ifdef PROBE_DUPKV
                        { float* o2 = dup + (size_t)row * AW + cc + (kt ? 0 : (size_t)MT * AW); *(f32x4*)o2 = v0; *(f32x4*)(o2 + 4) = v1; }
#endif
                        if (smp) *(u32x4*)(kvs + ((size_t)(rr >> 6) * SKS + PAST + (rr & 63)) * AW + cc) = w; }
                } }
        if (lft) {
            float bb[8], hs[8];
#pragma unroll
            for (int e = 0; e < 8; ++e) { bb[e] = bfg[(8 * fq + e) % NH]; hs[e] = 0.f; }
#pragma unroll
            for (int ai = 0; ai < 2; ++ai)
#pragma unroll
                for (int m = 0; m < 4; ++m) { const int row = row0 + ai * HALF + m * 16; const float sc = rs[ai][m]; float* o = fl + (size_t)(8 * fq) * MT + row;
                    f32x4 v0 = acc[ai][0][m][0] * sc, v1 = acc[ai][0][m][1] * sc;
#pragma unroll
                    for (int e = 0; e < 4; ++e) { v0[e] += bb[e]; v1[e] += bb[4 + e]; }
#pragma unroll
                    for (int e = 0; e < 4; ++e) { o[(size_t)e * MT] = v0[e]; if (fq == 0) o[(size_t)(4 + e) * MT] = v1[e]; }
#pragma unroll
                    for (int e = 0; e < 4; ++e) { hs[e] += v0[e]; hs[4 + e] += v1[e]; } }
            if (!smp) {
#pragma unroll
                for (int e = 0; e < 8; ++e) { float s = hs[e]; s += __shfl_xor(s, 1); s += __shfl_xor(s, 2); s += __shfl_xor(s, 4); s += __shfl_xor(s, 8);
                    if (fr == 0 && 8 * fq + e < NH) atomicAdd((float*)(ctl + CW_HS + j * 64) + 8 * fq + e, s); }
            }
        }
        if (nrm) {
#pragma unroll
            for (int bj = 0; bj < 2; ++bj) { float q = nmx[bj]; q = fmaxf(q, __shfl_xor(q, 1)); q = fmaxf(q, __shfl_xor(q, 2)); q = fmaxf(q, __shfl_xor(q, 4)); q = fmaxf(q, __shfl_xor(q, 8));
                if (fr == 0 && fq == 0) { const bool isq = colt < AW; const int h = (colt - (isq ? 0 : AW)) / HD + bj;
                    unsigned* t = isq ? ctl + CW_QQ + ((j * 32 + u.pm) * NH + h) * 4 + wc : ctl + CW_KQ + j * 64 + h * 4 + wc;
                    __hip_atomic_fetch_max(t, __float_as_uint(q), __ATOMIC_RELAXED, __HIP_MEMORY_SCOPE_AGENT); } }
        }
    }
};
struct EpiRes {
    static constexpr bool PERM = true, AFTER_DRAIN = false, RSTD = false;
    const float* base32; bf16_t* xb; float* rss;
    __device__ __forceinline__ void operator()(const f32x4 (&acc)[2][2][4][2], const Unit& u, int wr, int wc, int fr, int fq, const LAS float* rst) const {
        const int row0 = u.pm * BM + wr * 64 + fr, col0 = u.pn * BM + wc * 32 + 8 * fq;
#pragma unroll
        for (int ai = 0; ai < 2; ++ai)
#pragma unroll
            for (int m = 0; m < 4; ++m) { const int row = row0 + ai * HALF + m * 16; float ss = 0.f;
#pragma unroll
                for (int bj = 0; bj < 2; ++bj) { bf16_t* p = xb + (size_t)row * DM + col0 + bj * HALF; f32x4 a, b;
                    if (base32) { const float* pb = base32 + (size_t)row * DM + col0 + bj * HALF; a = *(const f32x4*)pb; b = *(const f32x4*)(pb + 4); }
                    else { const u32x4 w = *(const u32x4*)p; a = (f32x4){__uint_as_float(w[0] << 16), __uint_as_float(w[0] & 0xffff0000u), __uint_as_float(w[1] << 16), __uint_as_float(w[1] & 0xffff0000u)};
                           b = (f32x4){__uint_as_float(w[2] << 16), __uint_as_float(w[2] & 0xffff0000u), __uint_as_float(w[3] << 16), __uint_as_float(w[3] & 0xffff0000u)}; }
                    a += acc[ai][bj][m][0]; b += acc[ai][bj][m][1];
                    *(u32x4*)p = pack8u(a, b);
                    ss += (a[0] * a[0] + a[1] * a[1]) + (a[2] * a[2] + a[3] * a[3]) + (b[0] * b[0] + b[1] * b[1]) + (b[2] * b[2] + b[3] * b[3]); }
                ss += __shfl_xor(ss, 16); ss += __shfl_xor(ss, 32);
                if (fq == 0) rss[(size_t)row * 32 + u.pn * 4 + wc] = ss;
                if (m & 1) asm volatile("" ::: "memory"); }
    }
};
struct EpiUp {
    static constexpr bool PERM = true, AFTER_DRAIN = false, RSTD = true;
    bf16_t* o; const float* rss;
    __device__ __forceinline__ void operator()(const f32x4 (&acc)[2][2][4][2], const Unit& u, int wr, int wc, int fr, int fq, const LAS float* rst) const {
        const int row0 = u.pm * BM + wr * 64 + fr, col0 = u.pn * BM + wc * 32 + 8 * fq;
        float rs[2][4]; rs_table(rst, wr, fr, rs);
#pragma unroll
        for (int ai = 0; ai < 2; ++ai)
#pragma unroll
            for (int m = 0; m < 4; ++m) { const int row = row0 + ai * HALF + m * 16; const float sc = rs[ai][m];
#pragma unroll
                for (int bj = 0; bj < 2; ++bj) { f32x4 v0 = acc[ai][bj][m][0] * sc, v1 = acc[ai][bj][m][1] * sc;
#pragma unroll
                    for (int e = 0; e < 4; ++e) { const float a = fmaxf(v0[e], 0.f), b = fmaxf(v1[e], 0.f); v0[e] = a * a; v1[e] = b * b; }
                    *(u32x4*)(o + (size_t)row * DFF + col0 + bj * HALF) = pack8u(v0, v1); } }
    }
};

struct SchedRes {
    int S, nu, G, c, ntm, nts; const char* A; const char* B; size_t tA, tB, kbytes;
    __device__ __forceinline__ bool waits(const Unit&) const { return false; }
    __device__ __forceinline__ void poll() const {}
    __device__ __forceinline__ bool next(int i, Unit& u) const {
        const int L = i * G + c; constexpr int NMAIN = (TP / BM) * (DM / BM);
        if (L < NMAIN) { int wgid = L; { const int q = NMAIN / NXCD, xcd = wgid % NXCD, off = wgid / NXCD; wgid = xcd * q + off; }
            const int nig = WGM * (DM / BM), gid = wgid / nig, fm = gid * WGM; u.pm = fm + ((wgid % nig) % WGM); u.pn = (wgid % nig) / WGM; u.g = -1; u.nt = ntm;
            u.A = A + (size_t)u.pm * tA; u.B = B + (size_t)u.pn * tB; return true; }
        const int e = L - NMAIN; if (e >= nu) return false;
        const int tile = e / S, sp = e - tile * S; u.pm = TP / BM + (tile >> 3); u.pn = tile & 7; u.g = sp; u.nt = nts;
        u.A = A + (size_t)u.pm * tA + (size_t)sp * kbytes; u.B = B + (size_t)u.pn * tB + (size_t)sp * kbytes; return true;
    }
};
struct EpiPart {
    static constexpr bool PERM = true, AFTER_DRAIN = false, RSTD = false;
    float* part;
    __device__ __forceinline__ void operator()(const f32x4 (&acc)[2][2][4][2], const Unit& u, int wr, int wc, int fr, int fq, const LAS float* rst) const {
        const int row0 = (u.pm - TP / BM) * BM + wr * 64 + fr, col0 = u.pn * BM + wc * 32 + 8 * fq; float* base = part + (size_t)u.g * TS * DM;
#pragma unroll
        for (int ai = 0; ai < 2; ++ai)
#pragma unroll
            for (int m = 0; m < 4; ++m) { const int row = row0 + ai * HALF + m * 16;
#pragma unroll
                for (int bj = 0; bj < 2; ++bj) { float* p = base + (size_t)row * DM + col0 + bj * HALF; *(f32x4*)p = acc[ai][bj][m][0]; *(f32x4*)(p + 4) = acc[ai][bj][m][1]; } }
    }
};

struct EpiResPart {
    static constexpr bool PERM = true, AFTER_DRAIN = false, RSTD = false;
    EpiRes res; EpiPart part;
    __device__ __forceinline__ void operator()(const f32x4 (&acc)[2][2][4][2], const Unit& u, int wr, int wc, int fr, int fq, const LAS float* rst) const { if (u.g < 0) res(acc, u, wr, wc, fr, fq, rst); else part(acc, u, wr, wc, fr, fq, rst); }
};

template <class Epi, class Sch>
__device__ __forceinline__ void gemm_phase(LAS unsigned char* lds, const int K, const int lda, const int ldb, const Sch& S, const Epi& E, const int tid) {
    const int wid = __builtin_amdgcn_readfirstlane(tid >> 6), lane = tid & 63, wr = wid >> 2, wc = wid & 3, fr = lane & 15, fq = lane >> 4;
    unsigned voffA[2], voffB[2];
#pragma unroll
    for (int i = 0; i < 2; ++i) { int R, C; stage_rc(tid * 16 + i * 8192, R, C); const int Rb = Epi::PERM ? ((R & ~31) + perm32(R & 31)) : R;
        voffA[i] = (unsigned)(R * lda + C) * 2u; voffB[i] = (unsigned)(Rb * ldb + C) * 2u; }
    const size_t kstep = (size_t)(BK * 2);
    const size_t hstepA = (size_t)HALF * lda * 2, hstepB = (size_t)HALF * ldb * 2;
    const unsigned ldsw = (unsigned)wid * 1024u;
    const int aoff = lds_byte(wr * 64 + fr, fq * 8), boff = lds_byte(wc * 32 + fr, fq * 8);
#define PG8_SA(b, h) (((b) * 2 + (h)) * HTB)
#define PG8_SB(b, h) ((4 + (b) * 2 + (h)) * HTB)
#define PG8_STAGE(bufoff, gbase, voff) do { _Pragma("unroll") for (int _i = 0; _i < 2; ++_i) \
        __builtin_amdgcn_global_load_lds((const unsigned*)((const char*)(gbase) + (voff)[_i]), (LAS unsigned*)(lds + (bufoff) + ldsw + _i * 8192), 16, 0, 0); } while (0)
#define PG8_LDA(dst, b, h) do { _Pragma("unroll") for (int m = 0; m < 4; ++m) _Pragma("unroll") for (int k = 0; k < 2; ++k) dst[m][k] = *(const LAS bf16x8*)(lds + PG8_SA(b, h) + aoff + m * 2048 + k * 1024); } while (0)
#define PG8_LDB(dst, b, h) do { _Pragma("unroll") for (int n = 0; n < 2; ++n) _Pragma("unroll") for (int k = 0; k < 2; ++k) dst[n][k] = *(const LAS bf16x8*)(lds + PG8_SB(b, h) + boff + n * 2048 + k * 1024); } while (0)
#define PG8_MMA(ai, bj, At, Bt) do { __builtin_amdgcn_s_setprio(1); _Pragma("unroll") for (int m = 0; m < 4; ++m) _Pragma("unroll") for (int n = 0; n < 2; ++n) _Pragma("unroll") for (int k = 0; k < 2; ++k) \
        acc[ai][bj][m][n] = __builtin_amdgcn_mfma_f32_16x16x32_bf16(Bt[n][k], At[m][k], acc[ai][bj][m][n], 0, 0, 0); __builtin_amdgcn_s_setprio(0); } while (0)
#define PG8_WAIT_V(n) asm volatile("s_waitcnt vmcnt(" #n ")" ::: "memory")
#define PG8_WAIT_L(n) asm volatile("s_waitcnt lgkmcnt(" #n ")" ::: "memory")
#define PG8_BAR __builtin_amdgcn_s_barrier()
#define PG8_SCHED __builtin_amdgcn_sched_barrier(0)
    Unit cur, nxt; int ui = 0;
    if (!S.next(0, cur)) return;
    bool seen = false;
#define PG8_AREADY(u) do { if (!seen && S.waits(u)) { seen = true; if (wid == 0) S.poll(); __builtin_amdgcn_s_barrier(); } } while (0)
    PG8_AREADY(cur);
    LAS float* const rstab = (LAS float*)(lds + STAGE_BYTES);
#define PG8_RS_ISSUE(pm_) do { const float* p_ = E.rss + ((size_t)(pm_) * BM + (tid >> 1)) * 32 + (tid & 1) * 16; _Pragma("unroll") for (int i_ = 0; i_ < 4; ++i_) rq[i_] = *(const f32x4*)(p_ + 4 * i_); } while (0)
#define PG8_RS_FINISH(buf) do { const f32x4 v_ = (rq[0] + rq[1]) + (rq[2] + rq[3]); float s_ = (v_[0] + v_[1]) + (v_[2] + v_[3]); s_ += __shfl_xor(s_, 1); \
        if (!(tid & 1)) rstab[(buf) * 256 + (tid >> 1)] = rsqrtf(s_ * (1.0f / DM) + RMS_EPS); } while (0)
    f32x4 rq0[4];
    if constexpr (Epi::RSTD) { f32x4 (&rq)[4] = rq0; PG8_RS_ISSUE(cur.pm); }
    f32x4 acc[2][2][4][2];
#pragma unroll
    for (int a = 0; a < 2; ++a)
#pragma unroll
        for (int b = 0; b < 2; ++b)
#pragma unroll
            for (int m = 0; m < 4; ++m)
#pragma unroll
                for (int n = 0; n < 2; ++n) acc[a][b][m][n] = (f32x4){0.f, 0.f, 0.f, 0.f};
    bf16x8 At[4][2], B0[2][2], B1[2][2];
    const char* cA = cur.A; const char* cB = cur.B;
    PG8_STAGE(PG8_SB(0, 0), cB, voffB); PG8_STAGE(PG8_SB(0, 1), cB + hstepB, voffB); PG8_STAGE(PG8_SA(0, 0), cA, voffA); PG8_STAGE(PG8_SA(0, 1), cA + hstepA, voffA);
    if (wr == 1) PG8_BAR;
    PG8_WAIT_V(2); PG8_BAR;
    PG8_STAGE(PG8_SB(1, 0), cB + kstep, voffB); PG8_STAGE(PG8_SA(1, 0), cA + kstep, voffA); PG8_STAGE(PG8_SB(1, 1), cB + hstepB + kstep, voffB);
    PG8_WAIT_V(6); PG8_BAR;
    if constexpr (Epi::RSTD) { f32x4 (&rq)[4] = rq0; PG8_RS_FINISH(0); }
    for (;;) {
        const bool has_next = S.next(ui + 1, nxt);
        const char* nA = has_next ? nxt.A : cA; const char* nB = has_next ? nxt.B : cB;
        const int nt = cur.nt;
        for (int t = 0; t < nt; t += 2) {
            const bool last = (t == nt - 2);
            if (last && has_next) PG8_AREADY(nxt);
            const char* a1 = cA + (size_t)(t + 1) * kstep;
            const char* a2 = last ? nA : cA + (size_t)(t + 2) * kstep; const char* b2 = last ? nB : cB + (size_t)(t + 2) * kstep;
            const char* a3 = a2 + kstep; const char* b3 = b2 + kstep;
            PG8_LDB(B0, 0, 0); PG8_LDB(B1, 0, 1); PG8_SCHED; PG8_LDA(At, 0, 0); PG8_STAGE(PG8_SA(1, 1), a1 + hstepA, voffA);
            PG8_WAIT_V(8); PG8_WAIT_L(0); PG8_BAR; PG8_MMA(0, 0, At, B0); PG8_MMA(0, 1, At, B1); PG8_BAR; PG8_SCHED;
            PG8_LDA(At, 0, 1); PG8_STAGE(PG8_SB(0, 0), b2, voffB); PG8_STAGE(PG8_SB(0, 1), b2 + hstepB, voffB); PG8_STAGE(PG8_SA(0, 0), a2, voffA);
            PG8_WAIT_V(8); PG8_WAIT_L(0); PG8_BAR; PG8_MMA(1, 0, At, B0); PG8_MMA(1, 1, At, B1); PG8_BAR; PG8_SCHED;
            PG8_LDB(B0, 1, 0); PG8_LDB(B1, 1, 1); PG8_SCHED; PG8_LDA(At, 1, 0); PG8_STAGE(PG8_SA(0, 1), a2 + hstepA, voffA);
            PG8_WAIT_V(8); PG8_WAIT_L(0); PG8_BAR; PG8_MMA(0, 0, At, B0); PG8_MMA(0, 1, At, B1); PG8_BAR; PG8_SCHED;
            PG8_LDA(At, 1, 1); PG8_STAGE(PG8_SB(1, 0), b3, voffB); PG8_STAGE(PG8_SB(1, 1), b3 + hstepB, voffB); PG8_STAGE(PG8_SA(1, 0), a3, voffA);
            PG8_WAIT_V(8); PG8_WAIT_L(0); PG8_BAR; PG8_MMA(1, 0, At, B0); PG8_MMA(1, 1, At, B1); PG8_BAR; PG8_SCHED;
        }
        if (wr == 0) PG8_BAR;
        if constexpr (Epi::RSTD) { f32x4 rq[4]; PG8_RS_ISSUE(has_next ? nxt.pm : cur.pm); E(acc, cur, wr, wc, fr, fq, rstab + (ui & 1) * 256); PG8_RS_FINISH((ui + 1) & 1); }
        else E(acc, cur, wr, wc, fr, fq, rstab);
        if (!has_next) break;
#pragma unroll
        for (int a = 0; a < 2; ++a)
#pragma unroll
            for (int b = 0; b < 2; ++b)
#pragma unroll
                for (int m = 0; m < 4; ++m)
#pragma unroll
                    for (int n = 0; n < 2; ++n) acc[a][b][m][n] = (f32x4){0.f, 0.f, 0.f, 0.f};
        cur = nxt; cA = nA; cB = nB; ++ui;
        if (wr == 1) PG8_BAR;
    }
    PG8_WAIT_V(0);
    PG8_BAR;
#undef PG8_AREADY
#undef PG8_RS_ISSUE
#undef PG8_RS_FINISH
#undef PG8_SA
#undef PG8_SB
#undef PG8_STAGE
#undef PG8_LDA
#undef PG8_LDB
#undef PG8_MMA
#undef PG8_WAIT_V
#undef PG8_WAIT_L
#undef PG8_BAR
#undef PG8_SCHED
}
}

#ifndef PRUNE_T
#define PRUNE_T 25.f
#endif
namespace att {
constexpr float SCALE = 0.08838834764831845f;
constexpr float THR = 8.f;
constexpr int NW = 8, QBLK = 32, KVBLK = 64, QB = NW * QBLK, D = 128;
constexpr int SHM_V = KVBLK * D * 2, SHM_K = KVBLK * D * 2;
constexpr int ATT_LDS = 2 * SHM_V + 2 * SHM_K + NW * 64 * 4;
constexpr int BOS_OFF = ATT_LDS;
constexpr int BOS_BYTES = 8192 * 4;
constexpr int SCR_OFF = BOS_OFF + 2 * BOS_BYTES;
constexpr int WINF = 1 << 30;
static_assert(SCR_OFF + 256 <= LDS_WORK, "attention LDS map");

#define KSWZ(row, colB) ((row) * 256 + ((colB) ^ (((row) & 7) << 4)))
__device__ __forceinline__ int v_st(int k, int c) { const int kk = (k & ~0xC) | ((k & 4) << 1) | ((k & 8) >> 1); return ((kk >> 3) * 4 + (c >> 5)) * 512 + ((kk & 7) * 32 + (c & 31)) * 2; }
__device__ __forceinline__ int v_rd_base(int lane) { return ((lane & 3) << 3) | (((lane >> 2) & 3) << 6) | (((lane >> 4) & 1) << 5) | (((lane >> 5) & 1) << 8); }
constexpr int v_rd_off(int d0, int ks, int half) { return d0 * 512 + ks * 4096 + half * 2048; }
__device__ __forceinline__ int crow(int r, int hi) { return (r & 3) + 8 * (r >> 2) + 4 * hi; }
__device__ __forceinline__ bf16x8 load8(const bf16_t* p) { return *reinterpret_cast<const bf16x8*>(p); }

__device__ __forceinline__ void mask_tile(f32x16& p0, f32x16& p1, int dq, unsigned W) {
    const float NEG = -__builtin_inff();
#pragma unroll
    for (int r = 0; r < 16; ++r) {
        const int c = (r & 3) + 8 * (r >> 2);
        if ((unsigned)(dq - c) >= W) p0[r] = NEG;
        if ((unsigned)(dq - c - 32) >= W) p1[r] = NEG;
    }
}
__device__ __forceinline__ void partialSM(f32x16& p0, f32x16& p1, float& m_reg, float& mn, float& alpha) {
    float pmax = p0[0]; for (int r = 1; r < 16; ++r) pmax = fmaxf(pmax, p0[r]); for (int r = 0; r < 16; ++r) pmax = fmaxf(pmax, p1[r]);
    { auto rr = __builtin_amdgcn_permlane32_swap(__float_as_uint(pmax), __float_as_uint(pmax), false, false);
      pmax = fmaxf(__uint_as_float(rr[0]), __uint_as_float(rr[1])); }
    constexpr float C2 = 1.4426950408889634f * SCALE;
    if (__builtin_expect(__all((pmax - m_reg) * SCALE <= THR), 1)) { mn = m_reg; alpha = 1.f; }
    else { mn = fmaxf(m_reg, pmax); alpha = __builtin_amdgcn_exp2f((m_reg - mn) * C2); m_reg = mn; }
    const float mnL = -mn * C2;
    for (int r = 0; r < 16; ++r) p0[r] = fmaf(p0[r], C2, mnL); for (int r = 0; r < 16; ++r) p1[r] = fmaf(p1[r], C2, mnL);
    for (int r = 0; r < 16; ++r) p0[r] = __builtin_amdgcn_exp2f(p0[r]);
}
#define PK4(P, B_, OUT) do { unsigned a0 = cvtpk(P[B_+0], P[B_+1]), a1 = cvtpk(P[B_+2], P[B_+3]);                          \
        unsigned b0 = cvtpk(P[B_+4], P[B_+5]), b1 = cvtpk(P[B_+6], P[B_+7]);                                             \
        auto r0 = __builtin_amdgcn_permlane32_swap(a0, b0, false, false); auto r1 = __builtin_amdgcn_permlane32_swap(a1, b1, false, false); \
        u32x4 w = {r0[0], r1[0], r0[1], r1[1]}; OUT = *reinterpret_cast<bf16x8*>(&w); } while (0)
__device__ __forceinline__ void finishSM(f32x16& p0, f32x16& p1, float alpha, float& l_reg, bf16x8& pa0, bf16x8& pa1, bf16x8& pa2, bf16x8& pa3) {
    for (int r = 0; r < 16; ++r) p1[r] = __builtin_amdgcn_exp2f(p1[r]);
    float ps = 0; for (int r = 0; r < 16; ++r) ps += p0[r]; for (int r = 0; r < 16; ++r) ps += p1[r];
    { auto rr = __builtin_amdgcn_permlane32_swap(__float_as_uint(ps), __float_as_uint(ps), false, false);
      ps = __uint_as_float(rr[0]) + __uint_as_float(rr[1]); }
    l_reg = l_reg * alpha + ps;
    PK4(p0, 0, pa0); PK4(p0, 8, pa1); PK4(p1, 0, pa2); PK4(p1, 8, pa3);
}
template <int KB, bool BIAS>
__device__ __forceinline__ void qkt(f32x16& p0, f32x16& p1, const char* K_lds, int r32, int hi, const bf16x8* qr, const float* bk, bool act = true) {
    if (!act) { const float NEG = -__builtin_inff();
#pragma unroll
        for (int r = 0; r < 16; ++r) { p0[r] = NEG; p1[r] = NEG; } return; }
    if constexpr (BIAS) {
#pragma unroll
        for (int i = 0; i < 4; ++i) { const f32x4 a = *(const f32x4*)(bk + 8 * i), b = *(const f32x4*)(bk + 32 + 8 * i);
            p0[4 * i] = a[0]; p0[4 * i + 1] = a[1]; p0[4 * i + 2] = a[2]; p0[4 * i + 3] = a[3];
            p1[4 * i] = b[0]; p1[4 * i + 1] = b[1]; p1[4 * i + 2] = b[2]; p1[4 * i + 3] = b[3]; }
    } else { p0 = f32x16{}; p1 = f32x16{}; }
    const char* kb[4];
#pragma unroll
    for (int dd = 0; dd < 4; ++dd) kb[dd] = K_lds + KB * SHM_K + KSWZ(r32, (dd * 16 + hi * 8) * 2);
#pragma unroll
    for (int d0 = 0; d0 < 8; ++d0) { const char* a = kb[d0 & 3] + (d0 >> 2) * 128;
        bf16x8 b0 = *reinterpret_cast<const bf16x8*>(a);
        bf16x8 b1 = *reinterpret_cast<const bf16x8*>(a + 32 * 256);
        p0 = __builtin_amdgcn_mfma_f32_32x32x16_bf16(b0, qr[d0], p0, 0, 0, 0);
        p1 = __builtin_amdgcn_mfma_f32_32x32x16_bf16(b1, qr[d0], p1, 0, 0, 0); }
}
template <int VB>
__device__ __forceinline__ void pv_tile(f32x16* o, int vb0, bf16x8 pa0, bf16x8 pa1, bf16x8 pa2, bf16x8 pa3, bool act = true) {
    if (!act) return;
#define TRRD(dst, off) asm volatile("ds_read_b64_tr_b16 %0, %1 offset:%2" : "=&v"(dst) : "v"(vb0), "i"(off) : "memory")
#define PV_D0(d0) do { s16x4 l0, l1, l2, l3, h0, h1, h2, h3; constexpr int b_ = VB * SHM_V + v_rd_off(d0, 0, 0); \
        TRRD(l0, b_); TRRD(h0, b_ + 2048); TRRD(l1, b_ + 4096); TRRD(h1, b_ + 6144); TRRD(l2, b_ + 8192); TRRD(h2, b_ + 10240); TRRD(l3, b_ + 12288); TRRD(h3, b_ + 14336); \
        asm volatile("s_waitcnt lgkmcnt(0)" ::: "memory"); SBAR();   \
        o[d0] = __builtin_amdgcn_mfma_f32_32x32x16_bf16(pa0, (bf16x8){l0[0], l0[1], l0[2], l0[3], h0[0], h0[1], h0[2], h0[3]}, o[d0], 0, 0, 0);   \
        o[d0] = __builtin_amdgcn_mfma_f32_32x32x16_bf16(pa1, (bf16x8){l1[0], l1[1], l1[2], l1[3], h1[0], h1[1], h1[2], h1[3]}, o[d0], 0, 0, 0);   \
        o[d0] = __builtin_amdgcn_mfma_f32_32x32x16_bf16(pa2, (bf16x8){l2[0], l2[1], l2[2], l2[3], h2[0], h2[1], h2[2], h2[3]}, o[d0], 0, 0, 0);   \
        o[d0] = __builtin_amdgcn_mfma_f32_32x32x16_bf16(pa3, (bf16x8){l3[0], l3[1], l3[2], l3[3], h3[0], h3[1], h3[2], h3[3]}, o[d0], 0, 0, 0); } while (0)
    PV_D0(0); PV_D0(1); PV_D0(2); PV_D0(3);
#undef PV_D0
#undef TRRD
}

struct Blk { const bf16_t* Q; const bf16_t* K; const bf16_t* V; bf16_t* O; int ldq, ldkv, ldo; int P0, skv, nrows; int bmode; const float* lf0; int n0; const float* lf1;
             const unsigned* qq; const unsigned* kq; int jlo, bsel, pre0, ls0; const float* Kf; const float* Vf; int nf, ldf; };
struct Seam { bf16x8 qr[8]; bf16x8 st_v0, st_v1, st_k0, st_k1; };
__device__ __forceinline__ int blk_jhi(const Blk& b) { int j = (b.P0 + QB - 1) / KVBLK + 1; const int m = b.skv / KVBLK; return j > m ? m : j; }

__device__ __forceinline__ void prepare_bias(Blk& b, char* lds, int g_wave) {
    const int tid = opaque_tid();
    float* bos = (float*)(lds + BOS_OFF + b.bsel * BOS_BYTES); float* scr = (float*)(lds + SCR_OFF);
    const int nk = blk_jhi(b) * KVBLK, lane = tid & 63, wid = tid >> 6;
    b.jlo = 0;
    if (b.bmode == 0) { for (int k = tid; k < nk; k += 512) bos[k] = 0.f; __syncthreads(); return; }
    float v[16]; float tot = 0.f; const int k0 = tid * 16; const bool in = k0 < nk;
#pragma unroll
    for (int i = 0; i < 16; ++i) { const int k = k0 + i; float x = 0.f; if (in) { if (k < b.n0) { x = b.lf0[(size_t)k * b.ls0]; if (b.pre0) x = log_sigmoid_fast(x); } else x = log_sigmoid_fast(b.lf1[k - b.n0]); } v[i] = x; tot += x; }
    float inc = tot;
#pragma unroll
    for (int o = 1; o < 64; o <<= 1) { const float y = __int_as_float(__builtin_amdgcn_ds_bpermute(((lane + o) & 63) << 2, __float_as_int(inc))); if (lane + o < 64) inc += y; }
    if (lane == 0) scr[wid] = inc;
    if (tid == 0) ((int*)scr)[9] = 0;
    __syncthreads();
    float hiw = 0.f;
#pragma unroll
    for (int w = 0; w < 8; ++w) if (w > wid) hiw += scr[w];
    float run = (inc - tot) + hiw;
#pragma unroll
    for (int i = 15; i >= 0; --i) { const float lf = v[i]; v[i] = run; run += lf; }
    if (in) {
#pragma unroll
        for (int i = 0; i < 16; ++i) bos[k0 + i] = v[i] * (1.0f / SCALE);
    }
    if (b.qq != nullptr) {
        if (in && k0 == b.P0) scr[8] = v[0];
        { const int row = tid >> 1, half = tid & 1; const bf16_t* qp = b.Q + (size_t)row * b.ldq + half * 64; const bf16_t* kp = b.K + (size_t)(b.P0 + row) * b.ldkv + half * 64; float d = 0.f;
#pragma unroll
          for (int c8 = 0; c8 < 8; ++c8) { const u32x4 qa = *(const u32x4*)(qp + c8 * 8), ka = *(const u32x4*)(kp + c8 * 8);
#pragma unroll
              for (int e = 0; e < 4; ++e) d += __uint_as_float(qa[e] << 16) * __uint_as_float(ka[e] << 16) + __uint_as_float(qa[e] & 0xffff0000u) * __uint_as_float(ka[e] & 0xffff0000u); }
          d += __shfl_xor(d, 1);
#pragma unroll
          for (int o = 2; o < 64; o <<= 1) d = fminf(d, __shfl_xor(d, o));
          if (lane == 0) scr[10 + wid] = d * SCALE; }
        __syncthreads();
        float mmin = scr[10];
#pragma unroll
        for (int w = 1; w < 8; ++w) mmin = fminf(mmin, scr[10 + w]);
        const float q2 = (__uint_as_float(b.qq[0]) + __uint_as_float(b.qq[1])) + (__uint_as_float(b.qq[2]) + __uint_as_float(b.qq[3]));
        const float k2 = (__uint_as_float(b.kq[0]) + __uint_as_float(b.kq[1])) + (__uint_as_float(b.kq[2]) + __uint_as_float(b.kq[3]));
        const float B = sqrtf(q2 * k2) * SCALE * 1.02f, cut = scr[8] - (B - mmin + PRUNE_T);
        int cnt = 0;
#pragma unroll
        for (int i = 0; i < 16; ++i) cnt += (in && k0 + i < b.P0 && v[i] < cut) ? 1 : 0;
#pragma unroll
        for (int o = 1; o < 64; o <<= 1) cnt += __shfl_xor(cnt, o);
        if (lane == 0 && cnt) atomicAdd((int*)scr + 9, cnt);
        __syncthreads();
        b.jlo = ((int*)scr)[9] / KVBLK;
    }
    __syncthreads();
}

#define ROWK(p, ld, k0, rr) ((p) + (size_t)((k0) + (rr)) * (ld) + sc)
#define VMW() asm volatile("s_waitcnt vmcnt(0)" ::: "memory")
#define VMWN(n) asm volatile("s_waitcnt vmcnt(%0)" :: "i"(n) : "memory")
#define SLOAD_H(Kp, Vp, ld, k0) do { S.st_v0 = load8(ROWK(Vp, ld, k0, sr)); S.st_v1 = load8(ROWK(Vp, ld, k0, 32 + sr));              \
                         S.st_k0 = load8(ROWK(Kp, ld, k0, sr)); S.st_k1 = load8(ROWK(Kp, ld, k0, 32 + sr)); } while (0)
#define SWRITE_HK(bf) do { *(bf16x8*)(K_lds + (bf) * SHM_K + kws) = S.st_k0; *(bf16x8*)(K_lds + (bf) * SHM_K + kws + 32 * 256) = S.st_k1; } while (0)
#define SWRITE_HV(bf) do { *(bf16x8*)(V_lds + (bf) * SHM_V + vst0) = S.st_v0; *(bf16x8*)(V_lds + (bf) * SHM_V + vst1) = S.st_v1; } while (0)
#define SWRITE_H(bf) do { SWRITE_HV(bf); SWRITE_HK(bf); } while (0)
#define QROWP(b_) ((b_).Q + (size_t)((wid * QBLK + r32) & ((b_).nrows - 1)) * (b_).ldq + hi * 8)
__device__ __forceinline__ void att_prime(const Blk& cur, char* lds, Seam& S, int g_wave) {
    const int tid = opaque_tid();
    const int wid = __builtin_amdgcn_readfirstlane(tid >> 6), lane = tid & 63, r32 = lane & 31, hi = lane >> 5;
    const int sr = tid >> 4, sc = (tid & 15) * 8, kws = KSWZ(sr, sc * 2); char* K_lds = lds + 2 * SHM_V;
    const bf16_t* qp = QROWP(cur);
#pragma unroll
    for (int d0 = 0; d0 < 8; ++d0) S.qr[d0] = load8(qp + d0 * 16);
    SLOAD_H(cur.K, cur.V, cur.ldkv, cur.jlo * KVBLK); VMW(); SWRITE_HK(0);
    __syncthreads();
}
__device__ __forceinline__ void att_block(const Blk& cur, const Blk& nxt, char* lds, Seam& S, int g_wave) {
    const int tid = opaque_tid();
    const int wid = __builtin_amdgcn_readfirstlane(tid >> 6), lane = tid & 63, r32 = lane & 31, hi = lane >> 5;
    constexpr int W = WINF;
    const int j_lo = cur.jlo, NT = blk_jhi(cur) - j_lo;
    const int qlo = cur.P0 + wid * QBLK, qm = qlo + r32 - 4 * hi; const bool wact = wid * QBLK < cur.nrows;
    char* V_lds = lds; char* K_lds = lds + 2 * SHM_V;
    float* ws = (float*)(lds + 2 * SHM_V + 2 * SHM_K) + wid * 64; float* li_l = ws, * al_l = ws + 32;
    const float* bos = (const float*)(lds + BOS_OFF + cur.bsel * BOS_BYTES) + 4 * hi;
    float m_reg = -1e30f, l_reg = 0; f32x16 o[4] = {};
    const int sr = tid >> 4, sc = (tid & 15) * 8, vst0 = v_st(sr, sc), vst1 = v_st(32 + sr, sc), kws = KSWZ(sr, sc * 2);
    const int vb0 = (int)(uintptr_t)V_lds + v_rd_base(lane);
    const bf16_t* Kh = cur.K; const bf16_t* Vh = cur.V; const int ldkv = cur.ldkv;
#define RESC(a) do { if (__any((a) < 1.f)) { if (hi == 0) al_l[r32] = (a); asm volatile("s_waitcnt lgkmcnt(0)" ::: "memory");              \
                     for (int d_ = 0; d_ < 4; ++d_) for (int r = 0; r < 16; ++r) o[d_][r] *= al_l[crow(r, hi)]; } } while (0)
#define KBASE(t) ((j_lo + (t)) * KVBLK)
#define MASKT(P0_, P1_, t) do { const int kb_ = KBASE(t); if (kb_ + KVBLK - 1 > qlo) mask_tile(P0_, P1_, qm - kb_, (unsigned)W); } while (0)
    constexpr int NQL = 8;
#define SEAM_K0() do { VMWN(NQL); SWRITE_HK(0); SBAR(); } while (0)
    f32x16 pA0, pA1, pB0, pB1; float mnA, mnB, alA, alB; bf16x8 pa0, pa1, pa2, pa3;
    SWRITE_HV(0); SBAR();
    if (NT > 1) SLOAD_H(Kh, Vh, ldkv, KBASE(1));
    SBAR(); qkt<0, true>(pA0, pA1, K_lds, r32, hi, S.qr, bos + KBASE(0), wact);
    MASKT(pA0, pA1, 0); partialSM(pA0, pA1, m_reg, mnA, alA);
    if (NT > 1) { VMW(); SWRITE_H(1); }
    __syncthreads();
#define HALF_STEP(PX0, PX1, mnX, alX, PY0, PY1, alY, t, KB, VB, SB) do {                                                      \
        SBAR(); qkt<KB, true>(PX0, PX1, K_lds, r32, hi, S.qr, bos + KBASE(t), wact);                                                \
        finishSM(PY0, PY1, alY, l_reg, pa0, pa1, pa2, pa3); SBAR();                                                           \
        if ((t) + 1 < NT) { SLOAD_H(Kh, Vh, ldkv, KBASE((t) + 1)); SBAR(); }                                                  \
        pv_tile<VB>(o, vb0, pa0, pa1, pa2, pa3, wact); MASKT(PX0, PX1, (t)); partialSM(PX0, PX1, m_reg, mnX, alX);                  \
        __syncthreads();                                                                                                      \
        if ((t) + 1 < NT) { VMW(); SWRITE_H(SB); }                                                                            \
        RESC(alX); __syncthreads(); } while (0)
    for (int t = 1; t + 1 < NT; t += 2) {
        HALF_STEP(pB0, pB1, mnB, alB, pA0, pA1, alA, t, 1, 0, 0);
        HALF_STEP(pA0, pA1, mnA, alA, pB0, pB1, alB, t + 1, 0, 1, 1);
    }
    const bool even = (NT & 1) == 0;
    if (even) { SBAR(); qkt<1, true>(pB0, pB1, K_lds, r32, hi, S.qr, bos + KBASE(NT - 1), wact); SBAR(); }
    SLOAD_H(nxt.K, nxt.V, nxt.ldkv, nxt.jlo * KVBLK); SBAR();
    { const bf16_t* qp = QROWP(nxt);
#pragma unroll
      for (int d0 = 0; d0 < 8; ++d0) S.qr[d0] = load8(qp + d0 * 16); }
    SBAR();
    finishSM(pA0, pA1, alA, l_reg, pa0, pa1, pa2, pa3); SBAR();
    pv_tile<0>(o, vb0, pa0, pa1, pa2, pa3, wact);
    if (even) { MASKT(pB0, pB1, NT - 1); partialSM(pB0, pB1, m_reg, mnB, alB); __syncthreads(); RESC(alB);
        finishSM(pB0, pB1, alB, l_reg, pa0, pa1, pa2, pa3); SBAR(); pv_tile<1>(o, vb0, pa0, pa1, pa2, pa3, wact); }
    SBAR(); SEAM_K0();
    if (hi == 0) li_l[r32] = l_reg; asm volatile("s_waitcnt lgkmcnt(0)" ::: "memory");
    float rli[16];
#pragma unroll
    for (int r = 0; r < 16; ++r) rli[r] = __builtin_amdgcn_rcpf(li_l[crow(r, hi)]);
    if (wid * QBLK < cur.nrows) {
        bf16_t* Ow = cur.O + (size_t)(wid * QBLK) * cur.ldo;
#pragma unroll
        for (int r = 0; r < 16; ++r) { const int orow = crow(r, hi);
#pragma unroll
            for (int d0 = 0; d0 < 4; ++d0) { const float v = o[d0][r] * rli[r]; const float vn = __shfl_xor(v, 1);
                if ((r32 & 1) == 0) *(unsigned*)(Ow + (size_t)orow * cur.ldo + d0 * 32 + r32) = cvtpk(v, vn); } }
    }
    __syncthreads();
#undef RESC
#undef MASKT
#undef SEAM_K0
#undef HALF_STEP
}

__device__ __forceinline__ void sb_block(const Blk& b, char* lds, int g_wave) {
    const int tid = opaque_tid();
    const int wid = __builtin_amdgcn_readfirstlane(tid >> 6), lane = tid & 63, r32 = lane & 31, hi = lane >> 5;
    char* V_lds = lds; char* K_lds = lds + 2 * SHM_V; int* flags = (int*)(lds + 2 * SHM_V + 2 * SHM_K);
    const int sr = tid >> 4, sc = (tid & 15) * 8, vst0 = v_st(sr, sc), vst1 = v_st(32 + sr, sc), kws = KSWZ(sr, sc * 2);
    const int vb0 = (int)(uintptr_t)V_lds + v_rd_base(lane);
    bf16x8 qr[8];
    { const bf16_t* qp = QROWP(b);
#pragma unroll
      for (int d0 = 0; d0 < 8; ++d0) qr[d0] = load8(qp + d0 * 16); }
    const int NT = blk_jhi(b), qlo = b.P0 + wid * QBLK, pos = qlo + r32;
    bool wdead = wid * QBLK >= b.nrows;
    float prun = 1.f; f32x16 o[4] = {};
    constexpr float C2 = 1.4426950408889634f * SCALE;
    const int nf = b.nf; bf16x8 k0, k1, v0, v1; f32x4 fk[4], fv[4];
#define SB_LOAD(kn) do { if ((kn) < nf) { const float* pk_ = b.Kf + (size_t)((kn) + sr) * AW + sc; const float* pv_ = b.Vf + (size_t)((kn) + sr) * AW + sc; \
            fk[0] = *(const f32x4*)pk_; fk[1] = *(const f32x4*)(pk_ + 4); fk[2] = *(const f32x4*)(pk_ + 32 * AW); fk[3] = *(const f32x4*)(pk_ + 32 * AW + 4); \
            fv[0] = *(const f32x4*)pv_; fv[1] = *(const f32x4*)(pv_ + 4); fv[2] = *(const f32x4*)(pv_ + 32 * AW); fv[3] = *(const f32x4*)(pv_ + 32 * AW + 4); } \
        else { k0 = load8(ROWK(b.K, b.ldkv, (kn), sr)); k1 = load8(ROWK(b.K, b.ldkv, (kn), 32 + sr)); v0 = load8(ROWK(b.V, b.ldkv, (kn), sr)); v1 = load8(ROWK(b.V, b.ldkv, (kn), 32 + sr)); } } while (0)
    SB_LOAD((NT - 1) * KVBLK);
    for (int t = NT - 1; t >= 0; --t) {
        const int kb = t * KVBLK;
        __syncthreads();
        if (kb < nf) { k0 = pack8(fk[0], fk[1]); k1 = pack8(fk[2], fk[3]); v0 = pack8(fv[0], fv[1]); v1 = pack8(fv[2], fv[3]); }
        *(bf16x8*)(K_lds + kws) = k0; *(bf16x8*)(K_lds + kws + 32 * 256) = k1; *(bf16x8*)(V_lds + vst0) = v0; *(bf16x8*)(V_lds + vst1) = v1;
        __syncthreads();
        if (t > 0) { const int kn = kb - KVBLK;
            SB_LOAD(kn); }
        if (!wdead && kb < qlo + QBLK - 1) {
            f32x16 p0, p1; qkt<0, false>(p0, p1, K_lds, r32, hi, qr, nullptr);
            if (kb + KVBLK - 1 >= qlo) {
                const float NEG = -__builtin_inff();
#pragma unroll
                for (int r = 0; r < 16; ++r) { const int key = kb + crow(r, hi); if (key >= pos) p0[r] = NEG; if (key + 32 >= pos) p1[r] = NEG; }
            }
#pragma unroll
            for (int r = 0; r < 16; ++r) {
                p0[r] = __builtin_amdgcn_rcpf(1.f + __builtin_amdgcn_exp2f(fminf(p0[r] * C2, 60.f))); p1[r] = __builtin_amdgcn_rcpf(1.f + __builtin_amdgcn_exp2f(fminf(p1[r] * C2, 60.f))); }
            float gl[8], gu[8];
#pragma unroll
            for (int g = 0; g < 8; ++g) { const float gp = g < 4 ? (p0[4 * g] * p0[4 * g + 1]) * (p0[4 * g + 2] * p0[4 * g + 3]) : (p1[4 * g - 16] * p1[4 * g - 15]) * (p1[4 * g - 14] * p1[4 * g - 13]);
                auto x = __builtin_amdgcn_permlane32_swap(__float_as_uint(gp), __float_as_uint(gp), false, false); gl[g] = __uint_as_float(x[0]); gu[g] = __uint_as_float(x[1]); }
            float s = 1.f, sown[8];
#pragma unroll
            for (int g = 7; g >= 0; --g) { const float su = s; s *= gu[g]; const float sl = s; s *= gl[g]; sown[g] = hi ? su : sl; }
#define SB_EL(P, q) do { const float rr_ = P[q]; P[q] = (1.f - rr_) * tt; tt *= rr_; } while (0)
#pragma unroll
            for (int g = 0; g < 8; ++g) { float tt = sown[g] * prun;
                if (g < 4) { const int q = 4 * g; SB_EL(p0, q + 3); SB_EL(p0, q + 2); SB_EL(p0, q + 1); SB_EL(p0, q); }
                else { const int q = 4 * g - 16; SB_EL(p1, q + 3); SB_EL(p1, q + 2); SB_EL(p1, q + 1); SB_EL(p1, q); } }
#undef SB_EL
            prun *= s;
            bf16x8 pa0, pa1, pa2, pa3;
            PK4(p0, 0, pa0); PK4(p0, 8, pa1); PK4(p1, 0, pa2); PK4(p1, 8, pa3);
            pv_tile<0>(o, vb0, pa0, pa1, pa2, pa3);
            wdead = __all(prun < 9.1e-13f);
        }
        if (lane == 0) flags[wid] = wdead ? 1 : 0;
        __syncthreads();
        const int alld = flags[0] & flags[1] & flags[2] & flags[3] & flags[4] & flags[5] & flags[6] & flags[7];
        if (alld) break;
    }
    if (wid * QBLK < b.nrows) {
        bf16_t* Ow = b.O + (size_t)(wid * QBLK) * b.ldo;
#pragma unroll
        for (int r = 0; r < 16; ++r) { const int orow = crow(r, hi);
#pragma unroll
            for (int d0 = 0; d0 < 4; ++d0) { const float v = o[d0][r]; const float vn = __shfl_xor(v, 1);
                if ((r32 & 1) == 0) *(unsigned*)(Ow + (size_t)orow * b.ldo + d0 * 32 + r32) = cvtpk(v, vn); } }
    }
    __syncthreads();
}

__device__ __forceinline__ void small_block(const Blk& bin, char* lds, int g_wave) {
    Blk b = bin; b.bsel = 0; prepare_bias(b, lds, g_wave);
    const int tid = opaque_tid();
    const int wid = __builtin_amdgcn_readfirstlane(tid >> 6), lane = tid & 63, r32 = lane & 31, hi = lane >> 5;
    char* V_lds = lds; char* K_lds = lds + 2 * SHM_V;
    float* ws = (float*)(lds + 2 * SHM_V + 2 * SHM_K) + wid * 64; float* li_l = ws, * al_l = ws + 32;
    const float* bos = (const float*)(lds + BOS_OFF) + 4 * hi;
    const int sr = tid >> 4, sc = (tid & 15) * 8, vst0 = v_st(sr, sc), vst1 = v_st(32 + sr, sc), kws = KSWZ(sr, sc * 2);
    const int vb0 = (int)(uintptr_t)V_lds + v_rd_base(lane);
    const int NT = blk_jhi(b), qlo = b.P0 + wid * QBLK, qm = qlo + r32 - 4 * hi; const bool wact = wid * QBLK < b.nrows;
    bf16x8 qr[8];
    { const bf16_t* qp = QROWP(b);
#pragma unroll
      for (int d0 = 0; d0 < 8; ++d0) qr[d0] = load8(qp + d0 * 16); }
    const int nf = b.nf, ldf = b.ldf; bf16x8 k0, k1, v0, v1; f32x4 fk[4], fv[4];
#define SM_LOAD(kn) do { if ((kn) < nf) { const float* pk_ = b.Kf + (size_t)((kn) + sr) * ldf + sc; const float* pv_ = b.Vf + (size_t)((kn) + sr) * ldf + sc; \
            fk[0] = *(const f32x4*)pk_; fk[1] = *(const f32x4*)(pk_ + 4); fk[2] = *(const f32x4*)(pk_ + (size_t)32 * ldf); fk[3] = *(const f32x4*)(pk_ + (size_t)32 * ldf + 4); \
            fv[0] = *(const f32x4*)pv_; fv[1] = *(const f32x4*)(pv_ + 4); fv[2] = *(const f32x4*)(pv_ + (size_t)32 * ldf); fv[3] = *(const f32x4*)(pv_ + (size_t)32 * ldf + 4); } \
        else { k0 = load8(ROWK(b.K, b.ldkv, (kn), sr)); k1 = load8(ROWK(b.K, b.ldkv, (kn), 32 + sr)); v0 = load8(ROWK(b.V, b.ldkv, (kn), sr)); v1 = load8(ROWK(b.V, b.ldkv, (kn), 32 + sr)); } } while (0)
    SM_LOAD(0);
    float m_reg = -1e30f, l_reg = 0.f; f32x16 o[4] = {};
    for (int t = 0; t < NT; ++t) {
        const int kb = t * KVBLK;
        __syncthreads();
        if (kb < nf) { k0 = pack8(fk[0], fk[1]); k1 = pack8(fk[2], fk[3]); v0 = pack8(fv[0], fv[1]); v1 = pack8(fv[2], fv[3]); }
        *(bf16x8*)(K_lds + kws) = k0; *(bf16x8*)(K_lds + kws + 32 * 256) = k1; *(bf16x8*)(V_lds + vst0) = v0; *(bf16x8*)(V_lds + vst1) = v1;
        __syncthreads();
        if (t + 1 < NT) SM_LOAD(kb + KVBLK);
        if (wact) {
            f32x16 p0, p1; qkt<0, true>(p0, p1, K_lds, r32, hi, qr, bos + kb);
            if (kb + KVBLK - 1 > qlo) mask_tile(p0, p1, qm - kb, (unsigned)WINF);
            float mn, al; partialSM(p0, p1, m_reg, mn, al);
            if (__any(al < 1.f)) { if (hi == 0) al_l[r32] = al; asm volatile("s_waitcnt lgkmcnt(0)" ::: "memory");
#pragma unroll
                for (int d_ = 0; d_ < 4; ++d_)
#pragma unroll
                    for (int r = 0; r < 16; ++r) o[d_][r] *= al_l[crow(r, hi)]; }
            bf16x8 pa0, pa1, pa2, pa3; finishSM(p0, p1, al, l_reg, pa0, pa1, pa2, pa3);
            pv_tile<0>(o, vb0, pa0, pa1, pa2, pa3);
        }
    }
    if (wact) {
        if (hi == 0) li_l[r32] = l_reg; asm volatile("s_waitcnt lgkmcnt(0)" ::: "memory");
        bf16_t* Ow = b.O + (size_t)(wid * QBLK) * b.ldo;
#pragma unroll
        for (int r = 0; r < 16; ++r) { const int orow = crow(r, hi); const float rl = __builtin_amdgcn_rcpf(li_l[orow]);
#pragma unroll
            for (int d0 = 0; d0 < 4; ++d0) { const float v = o[d0][r] * rl; const float vn = __shfl_xor(v, 1);
                if ((r32 & 1) == 0) *(unsigned*)(Ow + (size_t)orow * b.ldo + d0 * 32 + r32) = cvtpk(v, vn); } }
    }
    __syncthreads();
#undef SM_LOAD
}
#undef SB_LOAD
#undef ROWK
#undef VMW
#undef VMWN
#undef SLOAD_H
#undef SWRITE_HK
#undef SWRITE_HV
#undef SWRITE_H
#undef QROWP
#undef PK4
#undef KSWZ
#undef KBASE
}

namespace gla {
constexpr int ZQ = 0, ZK = GKW, ZV = 2 * GKW, ZR = 2 * GKW + GVW, ZG = 5120;
constexpr int KP = 72, QP = 200;
constexpr int L_G = 0;
constexpr int L_GLOW = 49152;
constexpr int L_TOT = 53248;
constexpr int L_QP = 54272;
constexpr int L_KPB = L_QP + 64 * QP * 2;
constexpr int L_AB = L_KPB + 64 * QP * 2;
constexpr int L_VT = L_AB + 64 * KP * 2;
constexpr int L_RS = L_VT + 128 * KP * 2;
constexpr int L_ST = 0;
constexpr int L1_KD = 54272;
constexpr int L1_VT = L1_KD + 192 * KP * 2;
static_assert(L_RS + 1024 <= LDS_WORK && L1_VT + 384 * KP * 2 <= LDS_WORK, "GLA LDS map");

__device__ __forceinline__ int chunk_row0(int c) { return c < TP / 64 ? c * 64 : TP + (c - TP / 64) * 64; }

__device__ __forceinline__ void decay_scan(const bf16_t* z, const float* wg2, const float* bg, int row0, int h, char* lds, int tid) {
    float* G = (float*)(lds + L_G); float* glow = (float*)(lds + L_GLOW); float* tot = (float*)(lds + L_TOT);
    const int k = tid % 192, half = tid / 192; float w[16];
#pragma unroll
    for (int j = 0; j < 16; ++j) w[j] = wg2[(size_t)j * GKW + h * GDK + k];
    const float b = bg[h * GDK + k];
    for (int i = tid; i < 64 * 16; i += 512) glow[i] = bf2f(z[(size_t)(row0 + (i >> 4)) * ZLD + ZG + (i & 15)]);
    __syncthreads();
    if (tid < 384) {
        float g = 0.f;
        for (int s = half * 32; s < half * 32 + 32; ++s) { float a = b;
#pragma unroll
            for (int j = 0; j < 16; ++j) a += glow[s * 16 + j] * w[j];
            g += (fminf(a, 0.f) - __logf(1.f + __expf(-fabsf(a)))) * (1.0f / 16.0f); G[s * GDK + k] = g; }
        if (half == 0) tot[k] = g;
    }
    __syncthreads();
}

__device__ __forceinline__ void g1_unit(int c, int h, const bf16_t* z, const float* wg2, const float* bg, bf16_t* UT, float* DEC, char* lds, int g_wave) {
    const int tid = opaque_tid(); const int row0 = chunk_row0(c);
    bf16_t kpre[3][8]; u32x4 vpre[6];
#pragma unroll
    for (int j = 0; j < 3; ++j) { const int it = tid + 512 * j, k = it % 192, sb = it / 192;
#pragma unroll
        for (int i = 0; i < 8; ++i) kpre[j][i] = z[(size_t)(row0 + sb * 8 + i) * ZLD + ZK + h * GDK + k]; }
#pragma unroll
    for (int j = 0; j < 6; ++j) { const int it = tid + 512 * j, s = it & 63, vb = it >> 6; vpre[j] = *(const u32x4*)(z + (size_t)(row0 + s) * ZLD + ZV + h * GDV + vb * 8); }
    decay_scan(z, wg2, bg, row0, h, lds, tid);
    const float* G = (const float*)(lds + L_G); const float* tot = (const float*)(lds + L_TOT);
    bf16_t* KD = (bf16_t*)(lds + L1_KD); bf16_t* VT = (bf16_t*)(lds + L1_VT);
#pragma unroll
    for (int j = 0; j < 3; ++j) {
        const int it = tid + 512 * j, k = it % 192, sb = it / 192; const float t0 = tot[k], glast = G[63 * GDK + k] + t0; float v[8];
#pragma unroll
        for (int i = 0; i < 8; ++i) { const int s = sb * 8 + i; const float g = G[s * GDK + k] + (s >= 32 ? t0 : 0.f);
            v[i] = bf2f(kpre[j][i]) * __expf(glast - g); }
        u32x4 w = {cvtpk(v[0], v[1]), cvtpk(v[2], v[3]), cvtpk(v[4], v[5]), cvtpk(v[6], v[7])};
        *(u32x4*)(KD + k * KP + sb * 8) = w;
        if (sb == 0) DEC[(size_t)(c * GH + h) * GDK + k] = __expf(glast);
    }
#pragma unroll
    for (int j = 0; j < 6; ++j) {
        const int it = tid + 512 * j, s = it & 63, vb = it >> 6; const u32x4 w = vpre[j];
#pragma unroll
        for (int i = 0; i < 4; ++i) { VT[(vb * 8 + 2 * i) * KP + s] = (bf16_t)(w[i] & 0xffffu); VT[(vb * 8 + 2 * i + 1) * KP + s] = (bf16_t)(w[i] >> 16); }
    }
    __syncthreads();
    const int wid = tid >> 6, lane = tid & 63, l32 = lane & 31, hi = lane >> 5, mq = wid & 3, nh = wid >> 2;
    f32x16 acc[3][3];
#pragma unroll
    for (int i = 0; i < 3; ++i)
#pragma unroll
        for (int j = 0; j < 3; ++j) acc[i][j] = f32x16{};
#pragma unroll
    for (int ks = 0; ks < 4; ++ks) { bf16x8 a[3], bb[3];
#pragma unroll
        for (int i = 0; i < 3; ++i) { a[i] = *(const bf16x8*)(VT + ((mq * 3 + i) * 32 + l32) * KP + ks * 16 + hi * 8); bb[i] = *(const bf16x8*)(KD + ((nh * 3 + i) * 32 + l32) * KP + ks * 16 + hi * 8); }
#pragma unroll
        for (int i = 0; i < 3; ++i)
#pragma unroll
            for (int j = 0; j < 3; ++j) acc[i][j] = __builtin_amdgcn_mfma_f32_32x32x16_bf16(a[i], bb[j], acc[i][j], 0, 0, 0); }
    bf16_t* out = UT + (size_t)(c * GH + h) * GDV * GDK;
#pragma unroll
    for (int i = 0; i < 3; ++i)
#pragma unroll
        for (int j = 0; j < 3; ++j)
#pragma unroll
            for (int r = 0; r < 16; ++r) { const float v = acc[i][j][r], vn = __shfl_xor(v, 1);
                if ((l32 & 1) == 0) *(unsigned*)(out + (size_t)((mq * 3 + i) * 32 + att::crow(r, hi)) * GDK + (nh * 3 + j) * 32 + l32) = cvtpk(v, vn); }
    __syncthreads();
}

__device__ __forceinline__ void g2_tile(int tile, bf16_t* UT, const float* DEC, const float* s0in, float* outp, float* outs, char* lds, int tid) {
    const int h = tile / 36, vt = (tile % 36) / 3, kt = tile % 3, vi = tid >> 4, kg = tid & 15, v = vt * 32 + vi, k = kt * 64 + kg * 4;
    float* T = (float*)lds;
    const size_t cstride = (size_t)GH * GDV * GDK; bf16_t* up = UT + ((size_t)h * GDV + v) * GDK + k; const float* dp = DEC + h * GDK + k;
    float zz = 0.f; asm volatile("" : "+v"(zz)); f32x4 S = {zz, zz, zz, zz};
#define G2_LOAD(U, D, c0_) do { _Pragma("unroll") for (int i = 0; i < 8; ++i) { U[i] = *(const u32x2*)(up + (size_t)((c0_) + i) * cstride); D[i] = *(const f32x4*)(dp + (size_t)((c0_) + i) * GH * GDK); } } while (0)
#define G2_STEP(U, D, c0_) do { _Pragma("unroll") for (int i = 0; i < 8; ++i) { u32x2 w = {cvtpk(S[0], S[1]), cvtpk(S[2], S[3])}; *(u32x2*)(up + (size_t)((c0_) + i) * cstride) = w; \
        const f32x4 u_ = {__uint_as_float(U[i][0] << 16), __uint_as_float(U[i][0] & 0xffff0000u), __uint_as_float(U[i][1] << 16), __uint_as_float(U[i][1] & 0xffff0000u)}; S = D[i] * S + u_; } } while (0)
    { u32x2 ua[8], ub[8], uc[8]; f32x4 da[8], db[8], dc[8];
      constexpr int NCH = TP / 64;
      static_assert(NCH % 24 == 8, "scan loop: 5 x 3 batches + 1");
      G2_LOAD(ua, da, 0); G2_LOAD(ub, db, 8);
      for (int c0 = 0; c0 + 24 <= NCH; c0 += 24) { G2_LOAD(uc, dc, c0 + 16); G2_STEP(ua, da, c0); G2_LOAD(ua, da, c0 + 24); G2_STEP(ub, db, c0 + 8); if (c0 + 32 < NCH) G2_LOAD(ub, db, c0 + 32); G2_STEP(uc, dc, c0 + 16); }
      G2_STEP(ua, da, NCH - 8); }
#undef G2_LOAD
#undef G2_STEP
    const int kr = tid >> 3, v4 = (tid & 7) * 4;
    T[(kg * 4 + 0) * 33 + vi] = S[0]; T[(kg * 4 + 1) * 33 + vi] = S[1]; T[(kg * 4 + 2) * 33 + vi] = S[2]; T[(kg * 4 + 3) * 33 + vi] = S[3];
    __syncthreads();
    { f32x4 o = {T[kr * 33 + v4], T[kr * 33 + v4 + 1], T[kr * 33 + v4 + 2], T[kr * 33 + v4 + 3]}; *(f32x4*)(outp + ((size_t)h * GDK + kt * 64 + kr) * GDV + vt * 32 + v4) = o; }
    __syncthreads();
    for (int b = 0; b < NB; ++b) {
        const int c = TP / 64 + b; const size_t sb = ((size_t)b * GH + h) * GDK * GDV;
        { const f32x4 i4 = *(const f32x4*)(s0in + sb + (size_t)(kt * 64 + kr) * GDV + vt * 32 + v4); T[kr * 33 + v4] = i4[0]; T[kr * 33 + v4 + 1] = i4[1]; T[kr * 33 + v4 + 2] = i4[2]; T[kr * 33 + v4 + 3] = i4[3]; }
        __syncthreads();
        f32x4 s0 = {T[(kg * 4 + 0) * 33 + vi], T[(kg * 4 + 1) * 33 + vi], T[(kg * 4 + 2) * 33 + vi], T[(kg * 4 + 3) * 33 + vi]};
        const u32x2 uw = *(const u32x2*)(up + (size_t)c * cstride); const f32x4 u = {__uint_as_float(uw[0] << 16), __uint_as_float(uw[0] & 0xffff0000u), __uint_as_float(uw[1] << 16), __uint_as_float(uw[1] & 0xffff0000u)};
        const f32x4 d = *(const f32x4*)(dp + (size_t)c * GH * GDK);
        { u32x2 w = {cvtpk(s0[0], s0[1]), cvtpk(s0[2], s0[3])}; *(u32x2*)(up + (size_t)c * cstride) = w; } const f32x4 sn = d * s0 + u;
        __syncthreads();
        T[(kg * 4 + 0) * 33 + vi] = sn[0]; T[(kg * 4 + 1) * 33 + vi] = sn[1]; T[(kg * 4 + 2) * 33 + vi] = sn[2]; T[(kg * 4 + 3) * 33 + vi] = sn[3];
        __syncthreads();
        { f32x4 o = {T[kr * 33 + v4], T[kr * 33 + v4 + 1], T[kr * 33 + v4 + 2], T[kr * 33 + v4 + 3]}; *(f32x4*)(outs + sb + (size_t)(kt * 64 + kr) * GDV + vt * 32 + v4) = o; }
        __syncthreads();
    }
}

__device__ __forceinline__ void state_transpose(const float* s0, bf16_t* out, char* lds, int tid) {
    float* T = (float*)lds; const int r = tid >> 3, c8 = (tid & 7) * 8;
    for (int t = 0; t < (GDK / 64) * (GDV / 64); ++t) { const int k0 = (t / (GDV / 64)) * 64, v0 = (t % (GDV / 64)) * 64;
        const f32x4 a = *(const f32x4*)(s0 + (size_t)(k0 + r) * GDV + v0 + c8), b = *(const f32x4*)(s0 + (size_t)(k0 + r) * GDV + v0 + c8 + 4);
        __syncthreads();
#pragma unroll
        for (int i = 0; i < 4; ++i) { T[r * 65 + c8 + i] = a[i]; T[r * 65 + c8 + 4 + i] = b[i]; }
        __syncthreads();
        float x[8];
#pragma unroll
        for (int i = 0; i < 8; ++i) x[i] = T[(c8 + i) * 65 + r];
        u32x4 w = {cvtpk(x[0], x[1]), cvtpk(x[2], x[3]), cvtpk(x[4], x[5]), cvtpk(x[6], x[7])};
        *(u32x4*)(out + (size_t)(v0 + r) * GDK + k0 + c8) = w; }
    asm volatile("s_waitcnt vmcnt(0)" ::: "memory"); __syncthreads();
}

__device__ __forceinline__ void g3_unit(int c, int h, const bf16_t* z, const float* wg2, const float* bg, const bf16_t* UT, const float* ng, const float* br, bf16_t* oc, char* lds, int g_wave) {
    const int tid = opaque_tid(); const int row0 = chunk_row0(c);
    u32x4 qpre[3], kpre[3];
#pragma unroll
    for (int j = 0; j < 3; ++j) { const int it = tid + 512 * j, s = it / 24, kb = (it % 24) * 8; qpre[j] = *(const u32x4*)(z + (size_t)(row0 + s) * ZLD + ZQ + h * GDK + kb); kpre[j] = *(const u32x4*)(z + (size_t)(row0 + s) * ZLD + ZK + h * GDK + kb); }
    decay_scan(z, wg2, bg, row0, h, lds, tid);
    const float* G = (const float*)(lds + L_G); const float* tot = (const float*)(lds + L_TOT);
    bf16_t* Qp = (bf16_t*)(lds + L_QP); bf16_t* Kp = (bf16_t*)(lds + L_KPB); bf16_t* Ab = (bf16_t*)(lds + L_AB); bf16_t* VT = (bf16_t*)(lds + L_VT); bf16_t* ST = (bf16_t*)(lds + L_ST);
    float* RS = (float*)(lds + L_RS);
    const float qs = 0.07216878364870322f;
#pragma unroll
    for (int j = 0; j < 3; ++j) {
        const int it = tid + 512 * j, s = it / 24, kb = (it % 24) * 8; float g[8];
#pragma unroll
        for (int i = 0; i < 8; ++i) g[i] = G[s * GDK + kb + i] + (s >= 32 ? tot[kb + i] : 0.f);
        const u32x4 qw = qpre[j], kw = kpre[j];
        u32x4 qo, ko;
#pragma unroll
        for (int i = 0; i < 4; ++i) { const float e0 = __expf(g[2 * i]), e1 = __expf(g[2 * i + 1]);
            qo[i] = cvtpk(__uint_as_float(qw[i] << 16) * qs * e0, __uint_as_float(qw[i] & 0xffff0000u) * qs * e1);
            ko[i] = cvtpk(__uint_as_float(kw[i] << 16) * __builtin_amdgcn_rcpf(e0), __uint_as_float(kw[i] & 0xffff0000u) * __builtin_amdgcn_rcpf(e1)); }
        *(u32x4*)(Qp + s * QP + kb) = qo; *(u32x4*)(Kp + s * QP + kb) = ko;
    }
    __syncthreads();
    const int wid = tid >> 6, lane = tid & 63, l32 = lane & 31, hi = lane >> 5;
    const int mt = wid & 1, nt = wid >> 1;
    f32x16 oacc[3];
    const bf16_t* Sb = UT + (size_t)(c * GH + h) * GDV * GDK;
    u32x4 stp[6], vtp[2];
#define G3_LOAD(vs_) do { _Pragma("unroll") for (int j = 0; j < 6; ++j) { const int it = tid + 512 * j, v = it / 24, kb = (it % 24) * 8; stp[j] = *(const u32x4*)(Sb + (size_t)((vs_) * 128 + v) * GDK + kb); } \
        _Pragma("unroll") for (int j = 0; j < 2; ++j) { const int it = tid + 512 * j, s = it & 63, vb = it >> 6; vtp[j] = *(const u32x4*)(z + (size_t)(row0 + s) * ZLD + ZV + h * GDV + (vs_) * 128 + vb * 8); } } while (0)
    G3_LOAD(0);
    if (wid < 4) {
        const int mt = wid & 1, nt = wid >> 1; f32x16 a = f32x16{};
        if (nt <= mt) {
#pragma unroll
            for (int ks = 0; ks < 12; ++ks) { const bf16x8 x = *(const bf16x8*)(Qp + (mt * 32 + l32) * QP + ks * 16 + hi * 8), y = *(const bf16x8*)(Kp + (nt * 32 + l32) * QP + ks * 16 + hi * 8);
                a = __builtin_amdgcn_mfma_f32_32x32x16_bf16(x, y, a, 0, 0, 0); }
        }
#pragma unroll
        for (int r = 0; r < 16; ++r) { const int t = mt * 32 + att::crow(r, hi), s = nt * 32 + l32; const float v = (s <= t) ? a[r] : 0.f; Ab[t * KP + s] = (bf16_t)(cvtpk(v, 0.f) & 0xffffu); }
    }
    __syncthreads();
#pragma unroll
    for (int vs = 0; vs < 3; ++vs) {
#pragma unroll
        for (int j = 0; j < 6; ++j) { const int it = tid + 512 * j, v = it / 24, kb = (it % 24) * 8; *(u32x4*)(ST + v * QP + kb) = stp[j]; }
#pragma unroll
        for (int j = 0; j < 2; ++j) { const int it = tid + 512 * j, s = it & 63, vb = it >> 6; const u32x4 w = vtp[j];
#pragma unroll
            for (int i = 0; i < 4; ++i) { VT[(vb * 8 + 2 * i) * KP + s] = (bf16_t)(w[i] & 0xffffu); VT[(vb * 8 + 2 * i + 1) * KP + s] = (bf16_t)(w[i] >> 16); } }
        __syncthreads();
        if (vs < 2) G3_LOAD(vs + 1);
        f32x16 a = f32x16{};
#pragma unroll
        for (int ks = 0; ks < 12; ++ks) { const bf16x8 x = *(const bf16x8*)(Qp + (mt * 32 + l32) * QP + ks * 16 + hi * 8), y = *(const bf16x8*)(ST + (nt * 32 + l32) * QP + ks * 16 + hi * 8);
            a = __builtin_amdgcn_mfma_f32_32x32x16_bf16(x, y, a, 0, 0, 0); }
#pragma unroll
        for (int ks = 0; ks < 4; ++ks) { const bf16x8 x = *(const bf16x8*)(Ab + (mt * 32 + l32) * KP + ks * 16 + hi * 8), y = *(const bf16x8*)(VT + (nt * 32 + l32) * KP + ks * 16 + hi * 8);
            a = __builtin_amdgcn_mfma_f32_32x32x16_bf16(x, y, a, 0, 0, 0); }
        oacc[vs] = a;
        __syncthreads();
    }
#undef G3_LOAD
#pragma unroll
    for (int r = 0; r < 16; ++r) { float q = oacc[0][r] * oacc[0][r] + oacc[1][r] * oacc[1][r] + oacc[2][r] * oacc[2][r];
        q += __shfl_xor(q, 1); q += __shfl_xor(q, 2); q += __shfl_xor(q, 4); q += __shfl_xor(q, 8); q += __shfl_xor(q, 16);
        if (l32 == 0) RS[(mt * 32 + att::crow(r, hi)) * 4 + nt] = q; }
    __syncthreads();
#pragma unroll
    for (int r = 0; r < 16; ++r) { const int t = mt * 32 + att::crow(r, hi); const f32x4 q4 = *(const f32x4*)(RS + t * 4);
        const float rstd = rsqrtf(((q4[0] + q4[1]) + (q4[2] + q4[3])) * (1.0f / GDV) + RMS_EPS);
#pragma unroll
        for (int vs = 0; vs < 3; ++vs) { const int cv = h * GDV + vs * 128 + nt * 32 + l32;
            const float gate = bf2f(z[(size_t)(row0 + t) * ZLD + ZR + cv]) + br[cv]; const float sg = gate / (1.f + __expf(-gate));
            const float val = oacc[vs][r] * rstd * ng[cv] * sg; const float vn = __shfl_xor(val, 1);
            if ((l32 & 1) == 0) *(unsigned*)(oc + (size_t)(row0 + t) * DM + cv) = cvtpk(val, vn); } }
    __syncthreads();
}
}

__device__ __forceinline__ int in_rowmap(int kind, int c) {
    if (kind == 0) return c < 4608 ? c : (c < 4620 ? 5120 + (c - 4608) : 4608 + (c - 4620));
    if (kind == 2) return c < 4608 ? c : (c < 4624 ? 5120 + (c - 4608) : 4608 + (c - 4624));
    return c;
}
constexpr int TR_SCR = 64 * 65 * 4;
struct TrItem { const float* W; bf16_t* WT; const float* gain; int K, N, kind, item; };
__device__ __forceinline__ bool tr_geom(const TrItem& t, int& k0, int& n0) {
    const int nblk = (t.N + 63) >> 6, kq = t.K >> 8, sb = t.item >> 4, e = t.item & 15, kb = (sb % kq) * 4 + (e & 3), nb = (sb / kq) * 4 + (e >> 2); k0 = 64 * kb; n0 = 64 * nb; return nb < nblk;
}
__device__ __forceinline__ void tr_load(const TrItem& t, float (&v)[64], int lane) {
    int k0, n0; if (!tr_geom(t, k0, n0)) return;
    const int nn = n0 + lane; const float* src = t.W + (size_t)k0 * t.N + (nn < t.N ? nn : 0);
#pragma unroll
    for (int i = 0; i < 64; ++i) v[i] = __builtin_nontemporal_load(src + (size_t)i * t.N);
}
__device__ __forceinline__ void tr_store(const TrItem& t, float (&v)[64], float* scr, int lane) {
    int k0, n0; if (!tr_geom(t, k0, n0)) return;
    const bool ok = n0 + lane < t.N;
    if (t.gain) {
#pragma unroll
        for (int i = 0; i < 64; ++i) v[i] *= t.gain[k0 + i];
    }
#pragma unroll
    for (int i = 0; i < 64; ++i) scr[i * 65 + lane] = ok ? v[i] : 0.f;
    LDS_WAIT(); asm volatile("" ::: "memory");
    const int c = lane & 7;
#pragma unroll
    for (int j = 0; j < 8; ++j) { const int n = (lane >> 3) + 8 * j; const float* s = scr + (8 * c) * 65 + n;
        if (n0 + n < t.N) { u32x4 o; o[0] = cvtpk(s[0 * 65], s[1 * 65]); o[1] = cvtpk(s[2 * 65], s[3 * 65]); o[2] = cvtpk(s[4 * 65], s[5 * 65]); o[3] = cvtpk(s[6 * 65], s[7 * 65]);
            *(u32x4*)(t.WT + (size_t)in_rowmap(t.kind, n0 + n) * t.K + k0 + 8 * c) = o; } }
    LDS_WAIT(); asm volatile("" ::: "memory");
}
template <int NF4>
__device__ __forceinline__ void cvt_row2(const float* s0, bf16_t* d0, const float* s1, bf16_t* d1, int lane) {
    f32x4 a[NF4], b[NF4];
#pragma unroll
    for (int q = 0; q < NF4; ++q) { a[q] = __builtin_nontemporal_load((const f32x4*)(s0 + q * 256 + lane * 4)); b[q] = __builtin_nontemporal_load((const f32x4*)(s1 + q * 256 + lane * 4)); }
#pragma unroll
    for (int q = 0; q < NF4; ++q) { u32x2 w = {cvtpk(a[q][0], a[q][1]), cvtpk(a[q][2], a[q][3])}; *(u32x2*)(d0 + q * 256 + lane * 4) = w;
        u32x2 x = {cvtpk(b[q][0], b[q][1]), cvtpk(b[q][2], b[q][3])}; *(u32x2*)(d1 + q * 256 + lane * 4) = x; }
}

#ifndef EN_MASK
#define EN_MASK 0xFFFF
#endif
#define EN(k) ((EN_MASK >> (k)) & 1)
template <int V> struct IC { static constexpr int value = V; };
struct Args { const float* in[29]; float* out; unsigned char* ws; int ph_lo, ph_hi; };
constexpr int PPL = 9;
constexpr int PH_FINAL = 1 + PPL * NLAYER, PH_END = PH_FINAL + 1;
constexpr int PT_OFF = MISC_OFF + 256;
__device__ __forceinline__ unsigned long long ptab_raw(const char* lds, int k) {
    const unsigned long long v = ((const unsigned long long*)(lds + PT_OFF))[k];
    const unsigned l = __builtin_amdgcn_readfirstlane((unsigned)v), h = __builtin_amdgcn_readfirstlane((unsigned)(v >> 32));
    return ((unsigned long long)h << 32) | l;
}
#define PIN(k) ((const float*)(const GAS float*)ptab_raw(lds, (k)))
#define POUT() ((float*)(GAS float*)ptab_raw(lds, 29))
#define PWS() ((unsigned char*)(GAS unsigned char*)ptab_raw(lds, 30))
#define WSP(T, off) ((T*)(ws + (off)))

__device__ __forceinline__ int queue_fetch(unsigned* qhead, volatile LAS unsigned* MISC, int g_wave) {
    if (opaque_tid() == 0) MISC[16] = __hip_atomic_fetch_add(qhead, 1u, __ATOMIC_RELAXED, __HIP_MEMORY_SCOPE_AGENT);
    __syncthreads(); const int v = (int)MISC[16]; __syncthreads(); return __builtin_amdgcn_readfirstlane(v);
}
__device__ __forceinline__ void convert_weights(int Ld, int Ln, int cs, char* lds, unsigned char* ws, unsigned* qh, volatile LAS unsigned* MISC, int g_wave) {
    const int Lq = Ln < 0 ? 0 : Ln, Lp = Ld < 0 ? 0 : Ld, kind = Lq % 3, j = Lq / 3, tid = opaque_tid(), lane = tid & 63, wave = tid >> 6;
    const int nin = kind == 0 ? 5132 : (kind == 1 ? 5120 : 5136);
    const int hn = Ln >= 0 ? 1 : 0, n0 = 128 * ((((nin + 63) / 64) + 3) / 4);
    const int m0 = Ld >= 0 ? 128 * 32 : 0, m1 = m0 + hn * 32 * 32, m2 = m1 + hn * 32 * 128, m3 = m2 + hn * 32 * 16, total = m3 + hn * n0, nchunks = (total + cs - 1) / cs, ipw = cs >> 3;
    float* scr = (float*)(lds + wave * TR_SCR);
    auto mk = [&](int it, TrItem& t) -> bool {
        if (it >= total) return false;
        if (it < m0) { t.W = PIN(28) + (size_t)Lp * DFF * DM; t.K = DFF; t.N = DM; t.WT = WSP(bf16_t, WS_WDN) + (size_t)Lp * DM * DFF; t.kind = 1; t.gain = nullptr; t.item = it; }
        else if (it < m1) { t.W = kind == 0 ? PIN(18) + (size_t)j * DM * DM : (kind == 1 ? PIN(20) : PIN(26)); t.K = DM; t.N = DM; t.WT = WSP(bf16_t, WS_WOUT) + (size_t)Lq * DM * DM; t.kind = 1; t.gain = nullptr; t.item = it - m0; }
        else if (it < m2) { t.W = PIN(27) + (size_t)Lq * DM * DFF; t.K = DM; t.N = DFF; t.WT = WSP(bf16_t, WS_WUP) + (size_t)Lq * DFF * DM; t.kind = 1; t.gain = PIN(12) + Lq * DM; t.item = it - m1; }
        else if (it < m3) { t.W = PIN(15) + (size_t)Lq * DM * 1024; t.K = DM; t.N = 1024; t.WT = WSP(bf16_t, WS_WMKV) + (size_t)Lq * 1024 * DM; t.kind = 1; t.gain = nullptr; t.item = it - m2; }
        else { t.W = kind == 0 ? PIN(16) + (size_t)j * DM * 5132 : (kind == 1 ? PIN(19) : PIN(21)); t.K = DM; t.N = nin; t.WT = WSP(bf16_t, WS_WIN) + (size_t)Lq * ZLD * DM; t.kind = kind; t.gain = PIN(11) + Lq * DM; t.item = it - m3; }
        return true;
    };
    for (;;) {
        const int chunk = queue_fetch(qh, MISC, g_wave); if (chunk >= nchunks) break;
        const int it0 = chunk * cs + wave * ipw; float va[64], vb[64]; TrItem ta, tb; bool oa = mk(it0, ta), ob;
        if (oa) tr_load(ta, va, lane);
#pragma unroll 1
        for (int i = 0; i < ipw; i += 2) {
            ob = mk(it0 + i + 1, tb); if (ob) tr_load(tb, vb, lane);
            if (oa) tr_store(ta, va, scr, lane);
            oa = i + 2 < ipw && mk(it0 + i + 2, ta); if (oa) tr_load(ta, va, lane);
            if (ob) tr_store(tb, vb, scr, lane);
        }
    }
}
__device__ __forceinline__ void convert_kv_cache(const float* ck, const float* cv, bf16_t* dk, bf16_t* dv, unsigned* qh, volatile LAS unsigned* MISC, int g_wave) {
    const int tid = opaque_tid(), lane = tid & 63, wave = tid >> 6;
    for (;;) {
        const int chunk = queue_fetch(qh, MISC, g_wave); if (chunk >= NB * PAST / 64) break;
#pragma unroll 2
        for (int i = 0; i < 8; ++i) { const int r = chunk * 64 + wave * 8 + i; const size_t so = (size_t)r * AW, dof = ((size_t)(r / PAST) * SKS + (r % PAST)) * AW;
            cvt_row2<6>(ck + so, dk + dof, cv + so, dv + dof, lane); }
    }
}

__global__ void __launch_bounds__(512, 2) trunk_fwd(Args args) {
    extern __shared__ __attribute__((aligned(16))) unsigned char lds_raw[];
    char* lds = (char*)lds_raw;
    volatile LAS unsigned* MISC = (volatile LAS unsigned*)((LAS unsigned char*)lds_raw + MISC_OFF);
    for (int u = threadIdx.x; u < 64; u += 512) MISC[u] = 0u;
    if (threadIdx.x < 29) ((unsigned long long*)(lds + PT_OFF))[threadIdx.x] = (unsigned long long)args.in[threadIdx.x];
    if (threadIdx.x == 29) ((unsigned long long*)(lds + PT_OFF))[29] = (unsigned long long)args.out;
    if (threadIdx.x == 30) ((unsigned long long*)(lds + PT_OFF))[30] = (unsigned long long)args.ws;
    const int g_wave = __builtin_amdgcn_readfirstlane(threadIdx.x >> 6);
    __syncthreads();
    const int G = gridDim.x, bx = blockIdx.x, vcu = (G % 8 == 0) ? (bx % 8) * (G / 8) + bx / 8 : bx;
#if !MK_PER_PHASE
    XcdBarrier bar = xcd_barrier_post((unsigned*)(args.ws + WS_CTL) + CW_BAR, MISC + 8); bar.wave = g_wave;
#define GRID_BAR() xcd_barrier(bar)
#else
#define GRID_BAR() do { } while (0)
#endif
    const int lo = args.ph_lo, hi = args.ph_hi;
#define IN(k) (lo <= (k) && (k) < hi)
#ifdef PROBE_TS_A
#define STAMP(k) do { if (bx == 0 && opaque_tid() == 0) ((unsigned long long*)((unsigned*)(PWS() + WS_CTL) + CW_TS))[(k) + 1] = __builtin_amdgcn_s_memrealtime(); } while (0)
#else
#define STAMP(k) do { } while (0)
#endif
#define SEAM(k) do { if ((k) + 1 < hi) GRID_BAR(); STAMP(k); } while (0)

    STAMP(-1);
    if (EN(0) && IN(0)) {
        unsigned char* ws = PWS();
        const int tid = opaque_tid(), lane = tid & 63, wave = tid >> 6, gw = vcu * 8 + wave, NGW = G * 8;
        float* scr = (float*)(lds + wave * 16384);
        convert_weights(-1, 0, 32, lds, ws, WSP(unsigned, WS_CTL) + CW_CONV, MISC, g_wave);
        { const float* xp = PIN(0); const float* xs = PIN(1); float* X = WSP(float, WS_X); bf16_t* XB = WSP(bf16_t, WS_XB); float* RSA = WSP(float, WS_RSS);
        for (int m = gw; m < MT; m += NGW) {
            const float* src = m < TP ? xp + (size_t)m * DM : xs + (size_t)(m - TP) * DM; float ss = 0.f;
#pragma unroll
            for (int q = 0; q < 8; ++q) { const int o = q * 256 + lane * 4; const f32x4 v = *(const f32x4*)(src + o);
                u32x2 w = {cvtpk(v[0], v[1]), cvtpk(v[2], v[3])}; *(u32x2*)(XB + (size_t)m * DM + o) = w; ss += (v[0] * v[0] + v[1] * v[1]) + (v[2] * v[2] + v[3] * v[3]); }
            ss = wave_sum(ss);
            if (lane < 32) RSA[(size_t)m * 32 + lane] = lane == 0 ? ss : 0.f;
        } }
        { const float* mp = PIN(10); const float* gm = PIN(13); bf16_t* MEMH = WSP(bf16_t, WS_MEMH);
        for (int it = gw; it < NLAYER * NMEM; it += NGW) { const int i = it / NMEM, r = it % NMEM; const float* src = mp + (size_t)r * DM; const float* g = gm + (size_t)i * DM;
            f32x4 v[8]; float ss = 0.f;
#pragma unroll
            for (int q = 0; q < 8; ++q) { v[q] = *(const f32x4*)(src + q * 256 + lane * 4); ss += (v[q][0] * v[q][0] + v[q][1] * v[q][1]) + (v[q][2] * v[q][2] + v[q][3] * v[q][3]); }
            const float rstd = rsqrtf(wave_sum(ss) * (1.0f / DM) + RMS_EPS);
#pragma unroll
            for (int q = 0; q < 8; ++q) { const f32x4 gg = *(const f32x4*)(g + q * 256 + lane * 4); u32x2 w = {cvtpk(v[q][0] * rstd * gg[0], v[q][1] * rstd * gg[1]), cvtpk(v[q][2] * rstd * gg[2], v[q][3] * rstd * gg[3])};
                *(u32x2*)(MEMH + ((size_t)i * NMEM + r) * DM + q * 256 + lane * 4) = w; } } }
        SEAM(0);
    }

    auto finalize = [&](int L, bool dn, bool fin, unsigned* ctr) {
        unsigned char* ws = PWS();
        const int tid = opaque_tid(), lane = tid & 63, wave = tid >> 6; const int SP = dn ? 16 : 8;
        float* rssw = WSP(float, WS_RSS) + (dn ? 0 : (size_t)MT * 32);
        bf16_t* XB = WSP(bf16_t, WS_XB); const float* part = WSP(float, WS_GU);
        const float* xin = (L == 0 && !dn) ? PIN(1) : nullptr;
        int r0 = vcu; asm volatile("" : "+s"(r0));
        for (int r = r0; r < TS; r += G) { const size_t o = (size_t)(TP + r) * DM + tid * 4; const float* pp = part + (size_t)r * DM + tid * 4;
            f32x4 a; if (xin) a = *(const f32x4*)(xin + (size_t)r * DM + tid * 4); else { const u32x2 w = *(const u32x2*)(XB + o); a = (f32x4){__uint_as_float(w[0] << 16), __uint_as_float(w[0] & 0xffff0000u), __uint_as_float(w[1] << 16), __uint_as_float(w[1] & 0xffff0000u)}; }
            f32x4 p[16];
#pragma unroll
            for (int s = 0; s < 16; ++s) p[s] = s < SP ? *(const f32x4*)(pp + (size_t)s * TS * DM) : (f32x4){0.f, 0.f, 0.f, 0.f};
#pragma unroll
            for (int s = 0; s < 16; ++s) a += p[s];
            const float ss = wave_sum((a[0] * a[0] + a[1] * a[1]) + (a[2] * a[2] + a[3] * a[3]));
            if (!fin) { u32x2 w = {cvtpk(a[0], a[1]), cvtpk(a[2], a[3])}; *(u32x2*)(XB + o) = w;
                if (lane < 4) rssw[(size_t)(TP + r) * 32 + wave + 8 * lane] = lane == 0 ? ss : 0.f; }
            else { if (lane == 0) MISC[32 + wave] = __float_as_uint(ss);
                __syncthreads();
                float tot = 0.f;
#pragma unroll
                for (int w8 = 0; w8 < 8; ++w8) tot += __uint_as_float(MISC[32 + w8]);
                __syncthreads();
                const float rstd = rsqrtf(tot * (1.0f / DM) + RMS_EPS); const f32x4 gg = *(const f32x4*)(PIN(14) + tid * 4);
                __builtin_nontemporal_store(a * rstd * gg, (f32x4*)(POUT() + O_YS + (size_t)r * DM + tid * 4)); }
        }
        if (ctr) { asm volatile("s_waitcnt vmcnt(0)" ::: "memory"); __syncthreads();
            if (tid == 0) (void)__hip_atomic_fetch_add(ctr, 1u, __ATOMIC_RELEASE, __HIP_MEMORY_SCOPE_AGENT); }
    };
    auto layer = [&](auto Lc) {
        constexpr int L = decltype(Lc)::value;
        const int kind = L % 3, j = L / 3, base = 1 + PPL * L;
        const bool att_in_g2 = kind == 2 && G >= 144 + 64;
        auto att_section = [&](int vc, int Gc) {
            unsigned char* ws = PWS();
            float* outp = POUT(); const float* lfc = PIN(4); const float* FL = WSP(float, WS_FL);
            const int nfox = kind == 0 ? 480 : 0, total = nfox + 160;
            unsigned long long hperm = 0;
            if (kind == 0) { const float* hsum = (const float*)(WSP(unsigned, WS_CTL) + CW_HS + j * 64); float hv[NH];
#pragma unroll
                for (int h = 0; h < NH; ++h) hv[h] = __builtin_amdgcn_readfirstlane(hsum[h]);
#pragma unroll
                for (int h = 0; h < NH; ++h) { int rank = 0;
#pragma unroll
                    for (int g = 0; g < NH; ++g) rank += (hv[g] > hv[h] || (hv[g] == hv[h] && g < h)) ? 1 : 0;
                    hperm |= (unsigned long long)h << (4 * rank); } }
            auto get = [&](int n, att::Blk& b) {
                int type, a0, a1;
                if (n < nfox) { if (n < 384) { type = 0; a0 = (int)((hperm >> (4 * (n >> 5))) & 15); a1 = 31 - (n & 31); } else { type = 1; a0 = (n - 384) / NH; a1 = (n - 384) % NH; } }
                else { const int m = n - nfox; if (m < 128) { type = 2; a0 = m / 32; a1 = m % 32; } else { type = 3; a0 = (m - 128) / MH; a1 = (m - 128) % MH; } }
                bf16_t* Z = WSP(bf16_t, WS_Z); bf16_t* OC = WSP(bf16_t, WS_OC);
                b.ldq = ZLD; b.ldo = DM; b.lf0 = b.lf1 = nullptr; b.n0 = 0; b.bmode = 0; b.qq = b.kq = nullptr; b.jlo = 0; b.bsel = 0; b.pre0 = 0; b.ls0 = 1; b.Kf = b.Vf = nullptr; b.nf = 0; b.ldf = AW;
                if (type == 0) { const int h = a0, qb = a1; b.Q = Z + (size_t)qb * 256 * ZLD + h * HD; b.K = Z + AW + h * HD; b.V = Z + 2 * AW + h * HD; b.ldkv = ZLD; b.O = OC + (size_t)qb * 256 * DM + h * HD;
                    b.P0 = qb * 256; b.skv = TP; b.nrows = 256; b.bmode = 1; b.lf0 = FL + (size_t)h * MT; b.ls0 = 1; b.n0 = 1 << 30; b.pre0 = 1;
                    b.qq = WSP(unsigned, WS_CTL) + CW_QQ + ((j * 32 + qb) * NH + h) * 4; b.kq = WSP(unsigned, WS_CTL) + CW_KQ + j * 64 + h * 4; }
                else if (type == 1) { const int bb = a0, h = a1; const bf16_t* fk = WSP(bf16_t, WS_KVF) + (size_t)(2 * j) * (KVS_ONE / 2);
                    b.Q = Z + (size_t)(TP + bb * 64) * ZLD + h * HD; b.K = fk + (size_t)bb * SKS * AW + h * HD; b.V = fk + KVS_ONE / 2 + (size_t)bb * SKS * AW + h * HD; b.ldkv = AW;
                    b.O = OC + (size_t)(TP + bb * 64) * DM + h * HD; b.P0 = PAST; b.skv = SKS; b.nrows = 64; b.bmode = 1; b.lf0 = lfc + ((size_t)j * NB + bb) * PAST * NH + h; b.ls0 = NH; b.n0 = PAST; b.lf1 = FL + (size_t)h * MT + TP + bb * 64;
                    b.nf = PAST; b.ldf = AW; b.Kf = PIN(2) + ((size_t)j * NB + bb) * PAST * AW + h * HD; b.Vf = PIN(3) + ((size_t)j * NB + bb) * PAST * AW + h * HD; }
                else if (type == 2) { const int h4 = a0, qb = a1; const bf16_t* mkb = WSP(bf16_t, WS_MKVB) + (size_t)L * NMEM * 1024;
                    b.Q = Z + (size_t)qb * 256 * ZLD + 4608 + h4 * HD; b.K = mkb + h4 * HD; b.V = mkb + MEMW + h4 * HD; b.ldkv = 1024; b.O = OC + (size_t)qb * 256 * DM + AW + h4 * HD;
                    b.P0 = 1 << 20; b.skv = NMEM; b.nrows = 256; }
                else { const int bb = a0, h4 = a1; const bf16_t* mck = WSP(bf16_t, WS_MEMC) + (size_t)(2 * L) * (MEMC_ONE / 2);
                    b.Q = Z + (size_t)(TP + bb * 64) * ZLD + 4608 + h4 * HD; b.K = mck + (size_t)bb * NMEM * MEMW + h4 * HD; b.V = mck + MEMC_ONE / 2 + (size_t)bb * NMEM * MEMW + h4 * HD; b.ldkv = MEMW;
                    b.O = OC + (size_t)(TP + bb * 64) * DM + AW + h4 * HD; b.P0 = 1 << 20; b.skv = NMEM; b.nrows = 64;
                    b.nf = NMEM; b.ldf = MEMW; b.Kf = PIN(8) + ((size_t)L * NB + bb) * NMEM * MEMW + h4 * HD; b.Vf = PIN(9) + ((size_t)L * NB + bb) * NMEM * MEMW + h4 * HD; }
            };
            unsigned* qhead = WSP(unsigned, WS_CTL) + CW_QUEUE + 64 * L;
            const int nfp = kind == 0 ? 384 : 0, nfs = kind == 0 ? 96 : 0, nmain = nfp + 128, nsmall = nfs + 32;
            if (EN(6)) for (int si = vc; si < nsmall; si += Gc) { att::Blk sbk; get(si < nfs ? nfp + si : nfp + nfs + 128 + (si - nfs), sbk); att::small_block(sbk, lds, g_wave); }
            { const bool t0 = opaque_tid() == 0; unsigned pend = 0; const bool dyn = kind == 1 || vc < nsmall; const int qb0 = kind == 1 ? 0 : (Gc > nsmall ? Gc - nsmall : 0);
                auto issue = [&]() { if (t0) pend = __hip_atomic_fetch_add(qhead, 1u, __ATOMIC_RELAXED, __HIP_MEMORY_SCOPE_AGENT); };
                auto take = [&]() -> int { if (t0) MISC[16] = pend; __syncthreads(); const int v = (int)MISC[16]; __syncthreads(); return qb0 + __builtin_amdgcn_readfirstlane(v); };
                auto main_n = [&](int m) -> int { return m < nfp ? m : m + nfs; };
                int first = vc - nsmall; if (dyn) { issue(); first = take(); }
                if (EN(6) && first < nmain) {
                att::Blk cur, nxt;
                issue();
                get(main_n(first), cur); cur.bsel = 0; att::prepare_bias(cur, lds, g_wave);
                att::Seam S; att::att_prime(cur, lds, S, g_wave);
                for (;;) { const int in_ = take(); const bool more = in_ < nmain;
                    if (more) { issue(); get(main_n(in_), nxt); nxt.bsel = cur.bsel ^ 1; att::prepare_bias(nxt, lds, g_wave); } else nxt = cur;
                    att::att_block(cur, nxt, lds, S, g_wave);
                    if (!more) break; cur = nxt; }
                } }
        };
        if (EN(1) && IN(base + 0)) {
            unsigned char* ws = PWS();
            const int tid = opaque_tid();
            pg8::Sched S; S.nM = MT / 256; S.nN = kind == 1 ? 20 : 21; S.nwg = S.nM * S.nN; S.G = G; S.c = bx; S.nextra = 4; S.nt = DM / 64; S.rdy = L > 0 ? WSP(unsigned, WS_CTL) + CW_FIN + 64 * (2 * L) : nullptr; S.need = (unsigned)G;
            S.A = (const char*)WSP(bf16_t, WS_XB); S.B = (const char*)(WSP(bf16_t, WS_WIN) + (size_t)L * ZLD * DM); S.tA = (size_t)256 * DM * 2; S.tB = (size_t)256 * DM * 2;
            S.Ae = (const char*)(WSP(bf16_t, WS_MEMH) + (size_t)L * NMEM * DM); S.Be = (const char*)(WSP(bf16_t, WS_WMKV) + (size_t)L * 1024 * DM); S.tAe = 0; S.tBe = (size_t)256 * DM * 2;
            pg8::EpiIn E; E.z = WSP(bf16_t, WS_Z); E.rss = WSP(float, WS_RSS); E.out = POUT(); E.mkvb = WSP(bf16_t, WS_MKVB); E.kind = kind; E.j = j; E.ml = L; E.ctl = (unsigned*)WSP(unsigned, WS_CTL); E.fl = WSP(float, WS_FL); E.dup = WSP(float, WS_GU);
            E.kvb = kind == 0 ? WSP(bf16_t, WS_KVF) + (size_t)(2 * j) * (KVS_ONE / 2) : WSP(bf16_t, WS_KVS); E.bfg = PIN(17) + j * NH;
            pg8::gemm_phase<pg8::EpiIn, pg8::Sched>((LAS unsigned char*)lds_raw, DM, DM, DM, S, E, tid);
            SEAM(base + 0);
        }
        if (IN(base + 1) && kind != 0) {
            unsigned char* ws = PWS();
            if (EN(2) && kind == 1) {
                bf16_t* Z = WSP(bf16_t, WS_Z); bf16_t* OC = WSP(bf16_t, WS_OC); bf16_t* KVS = WSP(bf16_t, WS_KVS);
                for (int n = vcu; n < 480; n += G) { att::Blk b; b.ldq = ZLD; b.ldo = DM; b.bmode = 0; b.lf0 = b.lf1 = nullptr; b.n0 = 0; b.qq = b.kq = nullptr; b.jlo = 0; b.bsel = 0; b.pre0 = 0; b.ls0 = 1; b.nf = 0; b.Kf = b.Vf = nullptr; b.ldf = AW;
                    if (n < 384) { const int h = n / 32, qb = n % 32; b.Q = Z + (size_t)qb * 256 * ZLD + h * HD; b.K = Z + AW + h * HD; b.V = Z + 2 * AW + h * HD; b.ldkv = ZLD;
                        b.O = OC + (size_t)qb * 256 * DM + h * HD; b.P0 = qb * 256; b.skv = TP; b.nrows = 256; }
                    else { const int m = n - 384, bb = m / NH, h = m % NH; b.Q = Z + (size_t)(TP + bb * 64) * ZLD + h * HD; b.K = KVS + (size_t)bb * SKS * AW + h * HD; b.V = KVS + KVS_ONE / 2 + (size_t)bb * SKS * AW + h * HD; b.ldkv = AW;
                        b.O = OC + (size_t)(TP + bb * 64) * DM + h * HD; b.P0 = PAST; b.skv = SKS; b.nrows = 64;
                        b.nf = PAST; b.Kf = PIN(5) + (size_t)bb * PAST * AW + h * HD; b.Vf = PIN(6) + (size_t)bb * PAST * AW + h * HD; }
                    att::sb_block(b, lds, g_wave); }
            } else if (EN(3) && kind == 2) {
                for (int u = vcu; u < NCHUNK * GH; u += G) gla::g1_unit(u / GH, u % GH, WSP(bf16_t, WS_Z), PIN(22), PIN(23), WSP(bf16_t, WS_GU), WSP(float, WS_GDEC), lds, g_wave);
            }
            if (kind != 1) SEAM(base + 1);
        }
        if (EN(4) && IN(base + 2) && kind == 2) {
            unsigned char* ws = PWS();
            const int tid = opaque_tid();
            if (vcu < 144) gla::g2_tile(vcu, WSP(bf16_t, WS_GU), WSP(float, WS_GDEC), PIN(7), POUT() + O_GSP, POUT() + O_GSS, lds, tid);
            __syncthreads();
            if (att_in_g2 && vcu >= 144 && vcu - 144 < NB * GH) {
                const int sb_ = (vcu - 144) / GH, sh_ = (vcu - 144) % GH;
                bf16_t* UTS = WSP(bf16_t, WS_MEMC);
                gla::state_transpose(PIN(7) + ((size_t)sb_ * GH + sh_) * GDK * GDV, UTS + ((size_t)sb_ * GH + sh_) * GDV * GDK, lds, opaque_tid());
                gla::g3_unit(TP / 64 + sb_, sh_, WSP(bf16_t, WS_Z), PIN(22), PIN(23), UTS - (size_t)(TP / 64) * GH * GDV * GDK, PIN(25), PIN(24), WSP(bf16_t, WS_OC), lds, g_wave); }
            if (att_in_g2 && vcu >= 144) att_section(vcu - 144, G - 144);
            SEAM(base + 2);
        }
        if (IN(base + 3)) {
            unsigned char* ws = PWS();
            if (EN(5) && kind == 2) for (int u = vcu; u < (att_in_g2 ? (TP / 64) * GH : NCHUNK * GH); u += G) gla::g3_unit(u / GH, u % GH, WSP(bf16_t, WS_Z), PIN(22), PIN(23), WSP(bf16_t, WS_GU), PIN(25), PIN(24), WSP(bf16_t, WS_OC), lds, g_wave);
            float* outp = POUT(); const float* FL = WSP(float, WS_FL);
            if (!att_in_g2) att_section(vcu, G);
            if (kind == 0) {
                const int tid = opaque_tid();
                for (int e = vcu * 512 + tid; e < MT * NH; e += G * 512) { const int h = e / MT, row = e - h * MT; const float v = log_sigmoidf(FL[e]);
                    if (row < TP) outp[O_FLP + (size_t)j * TP * NH + (size_t)row * NH + h] = v; else outp[O_FLS + (size_t)j * TS * NH + (size_t)(row - TP) * NH + h] = v; }
            }
            SEAM(base + 3);
        }
        for (int q = 4; q <= 8; ++q) {
            if (q == 5 || !IN(base + q)) continue;
            if (q == 8) { if (EN(8)) finalize(L, true, L == NLAYER - 1, L + 1 < NLAYER ? (unsigned*)PWS() + CW_FIN + 64 * (2 * L + 2) : nullptr); continue; }
            unsigned char* ws = PWS();
            const bool dn = q == 7;
            float* rssw = WSP(float, WS_RSS) + (dn ? 0 : (size_t)MT * 32);
            const int SP = dn ? 16 : 8;
            if (q == 4 || q == 7) {
                if (EN(7)) {
                const int tid = opaque_tid();
                const int K = dn ? DFF : DM; const char* Ab = dn ? (const char*)WSP(bf16_t, WS_U) : (const char*)WSP(bf16_t, WS_OC);
                const char* Bb = dn ? (const char*)(WSP(bf16_t, WS_WDN) + (size_t)L * DM * DFF) : (const char*)(WSP(bf16_t, WS_WOUT) + (size_t)L * DM * DM);
                pg8::SchedRes S; S.S = SP; S.nu = 16 * SP; S.G = G; S.c = bx; S.ntm = K / 64; S.nts = K / SP / 64; S.A = Ab; S.B = Bb; S.tA = (size_t)256 * K * 2; S.tB = (size_t)256 * K * 2; S.kbytes = (size_t)(K / SP) * 2;
                pg8::EpiResPart E{pg8::EpiRes{(L == 0 && !dn) ? PIN(0) : nullptr, WSP(bf16_t, WS_XB), rssw}, pg8::EpiPart{WSP(float, WS_GU)}};
                pg8::gemm_phase<pg8::EpiResPart, pg8::SchedRes>((LAS unsigned char*)lds_raw, K, K, K, S, E, tid);
                }
            } else {
                if (EN(9)) {
                unsigned* fctr = WSP(unsigned, WS_CTL) + CW_FIN + 64 * (2 * L + 1);
                finalize(L, false, false, fctr);
                const int tid = opaque_tid();
                pg8::Sched S; S.nM = MT / 256; S.nN = DFF / 256; S.nwg = S.nM * S.nN; S.G = G; S.c = bx; S.nextra = 0; S.nt = DM / 64; S.rdy = fctr; S.need = (unsigned)G;
                S.A = (const char*)WSP(bf16_t, WS_XB); S.B = (const char*)(WSP(bf16_t, WS_WUP) + (size_t)L * DFF * DM); S.tA = (size_t)256 * DM * 2; S.tB = (size_t)256 * DM * 2; S.Ae = S.Be = nullptr; S.tAe = S.tBe = 0;
                pg8::EpiUp E{WSP(bf16_t, WS_U), WSP(float, WS_RSS) + (size_t)MT * 32};
                pg8::gemm_phase<pg8::EpiUp, pg8::Sched>((LAS unsigned char*)lds_raw, DM, DM, DM, S, E, tid);
                convert_weights(L, L + 1 < NLAYER ? L + 1 : -1, L + 1 < NLAYER ? 64 : 16, lds, ws, WSP(unsigned, WS_CTL) + CW_CONV + 64 * (L + 1 < NLAYER ? L + 1 : 6), MISC, g_wave);
                }
            }
            SEAM(base + q);
        }
    };
    layer(IC<0>{}); layer(IC<1>{}); layer(IC<2>{}); layer(IC<3>{});
    if (EN(10) && IN(PH_FINAL)) {
        unsigned char* ws = PWS(); float* out = POUT();
        const int tid = opaque_tid(), lane = tid & 63, wave = tid >> 6, gw = vcu * 8 + wave, NGW = G * 8;
        const float* g = PIN(14); const bf16_t* XB = WSP(bf16_t, WS_XB); const float* RSA = WSP(float, WS_RSS);
        for (int m = gw; m < TP; m += NGW) {
            const float rstd = rsqrtf(wave_sum(lane < 32 ? RSA[(size_t)m * 32 + lane] : 0.f) * (1.0f / DM) + RMS_EPS); float* dst = out + O_YP + (size_t)m * DM;
#pragma unroll
            for (int q = 0; q < 8; ++q) { const int o = q * 256 + lane * 4; const u32x2 w = *(const u32x2*)(XB + (size_t)m * DM + o); const f32x4 v = {__uint_as_float(w[0] << 16), __uint_as_float(w[0] & 0xffff0000u), __uint_as_float(w[1] << 16), __uint_as_float(w[1] & 0xffff0000u)}, gg = *(const f32x4*)(g + o);
                __builtin_nontemporal_store(v * rstd * gg, (f32x4*)(dst + o)); }
        }
    }
#ifdef PROBE_TS_A
    if (IN(PH_FINAL)) { GRID_BAR(); if (bx == 0 && opaque_tid() == 0) { const unsigned long long* ts = (const unsigned long long*)((unsigned*)(PWS() + WS_CTL) + CW_TS);
        POUT()[O_YP] = (float)(((ts[PROBE_TS_B + 1] - ts[PROBE_TS_A + 1]) / 2000) * 20 + 10) * 1000.0f; } }
#endif
#undef IN
#undef SEAM
#undef GRID_BAR
}

extern "C" void kernel_launch(void* const* d_in, const int* in_sizes, int n_in, void* d_out, int out_size, void* d_ws, size_t ws_size, hipStream_t stream) {
    static int grid = 0;
    if (grid == 0) {
        if (n_in != 29 || (size_t)out_size != O_END || ws_size < WS_END) { fprintf(stderr, "kernel_launch: unexpected shapes (n_in %d, out %d vs %zu, ws %zu vs %zu); nothing launched\n", n_in, out_size, (size_t)O_END, ws_size, (size_t)WS_END); grid = -1; return; }
        int dev = 0, cus = 0, per_cu = 0;
        if (hipGetDevice(&dev) != hipSuccess || hipDeviceGetAttribute(&cus, hipDeviceAttributeMultiprocessorCount, dev) != hipSuccess) { grid = -1; return; }
        if (hipFuncSetAttribute((const void*)trunk_fwd, hipFuncAttributeMaxDynamicSharedMemorySize, LDS_BYTES) != hipSuccess) { fprintf(stderr, "kernel_launch: hipFuncSetAttribute failed\n"); grid = -1; return; }
        if (hipOccupancyMaxActiveBlocksPerMultiprocessor(&per_cu, (const void*)trunk_fwd, 512, LDS_BYTES) != hipSuccess || per_cu < 1) fprintf(stderr, "kernel_launch: occupancy query reports %d workgroups per CU\n", per_cu);
        (void)hipGetLastError();
        grid = cus;
    }
    if (grid < 0) return;
    if (hipMemsetAsync((char*)d_ws + WS_CTL, 0, CTL_BYTES, stream) != hipSuccess) return;
    Args a{};
    for (int i = 0; i < 29; ++i) a.in[i] = (const float*)d_in[i];
    a.out = (float*)d_out; a.ws = (unsigned char*)d_ws;
#if MK_PER_PHASE
    for (int p = 0; p < PH_END; ++p) {
        if (p >= 1 && p < PH_FINAL) { const int L = (p - 1) / PPL, q = (p - 1) % PPL, kind = L % 3; if ((q == 1 && kind == 0) || (q == 2 && kind != 2) || q == 5) continue; }
        a.ph_lo = p; a.ph_hi = p + 1;
        hipLaunchKernelGGL(trunk_fwd, dim3(grid), dim3(512), LDS_BYTES, stream, a);
#ifdef PROBE_LO
        if (p == PROBE_HI - 1) { (void)hipMemsetAsync((char*)d_ws + WS_CTL + CW_QUEUE * 4, 0, 4 * 64 * 4, stream); }
        if (p == PROBE_HI - 1) for (int pp = PROBE_LO; pp < PROBE_HI; ++pp) { a.ph_lo = pp; a.ph_hi = pp + 1; hipLaunchKernelGGL(trunk_fwd, dim3(grid), dim3(512), LDS_BYTES, stream, a); }
#endif
    }
#else
    a.ph_lo = 0; a.ph_hi = PH_END;
    hipLaunchKernelGGL(trunk_fwd, dim3(grid), dim3(512), LDS_BYTES, stream, a);
#endif
}
```

```cpp
#include <hip/hip_runtime.h>
#include <hip/hip_bf16.h>
#include <cstdio>
#include <cstdint>

#define MK_PER_PHASE 0
#ifndef MK_PER_PHASE
#define MK_PER_PHASE 0
#endif

constexpr int DM = 2048, TP = 8192, TS = 512, MT = TP + TS, NB = 8, CSEQ = 64, PAST = 1024, SKS = PAST + CSEQ;
constexpr int HD = 128, NH = 12, AW = NH * HD, MEMW = 512, NMEM = 256, MH = 4;
constexpr int GH = 4, GDK = 192, GDV = 384, GKW = GH * GDK, GVW = GH * GDV, GRANK = 16;
constexpr int DFF = 8192, ZLD = 5376, NLAYER = 4;
constexpr int NCHUNK = TP / 64 + NB;
constexpr float RMS_EPS = 1e-6f;

constexpr size_t O_YP = 0;
constexpr size_t O_YS = O_YP + (size_t)TP * DM;
constexpr size_t O_FKP = O_YS + (size_t)TS * DM;
constexpr size_t O_FVP = O_FKP + (size_t)2 * TP * AW;
constexpr size_t O_FLP = O_FVP + (size_t)2 * TP * AW;
constexpr size_t O_SKP = O_FLP + (size_t)2 * TP * NH;
constexpr size_t O_SVP = O_SKP + (size_t)TP * AW;
constexpr size_t O_GSP = O_SVP + (size_t)TP * AW;
constexpr size_t O_MKP = O_GSP + (size_t)GH * GDK * GDV;
constexpr size_t O_MVP = O_MKP + (size_t)NLAYER * NMEM * MEMW;
constexpr size_t O_FKS = O_MVP + (size_t)NLAYER * NMEM * MEMW;
constexpr size_t O_FVS = O_FKS + (size_t)2 * TS * AW;
constexpr size_t O_FLS = O_FVS + (size_t)2 * TS * AW;
constexpr size_t O_SKS = O_FLS + (size_t)2 * TS * NH;
constexpr size_t O_SVS = O_SKS + (size_t)TS * AW;
constexpr size_t O_GSS = O_SVS + (size_t)TS * AW;
constexpr size_t O_END = O_GSS + (size_t)NB * GH * GDK * GDV;

constexpr size_t al256(size_t x) { return (x + 255) & ~(size_t)255; }
constexpr size_t WS_CTL = 0, CTL_BYTES = 2u << 20;
constexpr size_t WS_WIN = CTL_BYTES;
constexpr size_t WS_WOUT = WS_WIN + (size_t)NLAYER * ZLD * DM * 2;
constexpr size_t WS_WUP = WS_WOUT + (size_t)NLAYER * DM * DM * 2;
constexpr size_t WS_WDN = WS_WUP + (size_t)NLAYER * DFF * DM * 2;
constexpr size_t WS_WMKV = WS_WDN + (size_t)NLAYER * DM * DFF * 2;
constexpr size_t WS_X = WS_WMKV + (size_t)NLAYER * 1024 * DM * 2;
constexpr size_t WS_XB = WS_X + (size_t)MT * DM * 4;
constexpr size_t WS_Z = WS_XB + (size_t)MT * DM * 2;
constexpr size_t WS_OC = WS_Z + (size_t)MT * ZLD * 2;
constexpr size_t WS_U = WS_OC + (size_t)MT * DM * 2;
constexpr size_t WS_GU = WS_U + (size_t)MT * DFF * 2;
constexpr size_t WS_GDEC = WS_GU + (size_t)NCHUNK * GH * GDV * GDK * 4;
constexpr size_t WS_KVF = al256(WS_GDEC + (size_t)NCHUNK * GH * GDK * 4);
constexpr size_t KVS_ONE = (size_t)NB * SKS * AW * 2;
constexpr size_t WS_KVS = WS_KVF + 4 * KVS_ONE;
constexpr size_t WS_MEMC = WS_KVS + 2 * KVS_ONE;
constexpr size_t MEMC_ONE = (size_t)NB * NMEM * MEMW * 2;
constexpr size_t WS_MEMH = WS_MEMC + 8 * MEMC_ONE;
constexpr size_t WS_MKVB = WS_MEMH + (size_t)NLAYER * NMEM * DM * 2;
constexpr size_t WS_RSS = WS_MKVB + (size_t)NLAYER * NMEM * 1024 * 2;
constexpr size_t WS_FL = WS_RSS + (size_t)2 * MT * 32 * 4;
constexpr size_t WS_END = WS_FL + (size_t)MT * NH * 4;

constexpr int CW_BAR = 4096;
constexpr int CW_QUEUE = 8192;
constexpr int CW_KQ = 12288;
constexpr int CW_CONV = 20480;
constexpr int CW_HS = 12800;
constexpr int CW_FIN = 22528;
constexpr int CW_TS = 24576;
constexpr int CW_QQ = 16384;

constexpr int LDS_WORK = 136 * 1024;
constexpr int MISC_OFF = LDS_WORK;
constexpr int LDS_BYTES = 147456;

#define GAS __attribute__((address_space(1)))
#define LAS __attribute__((address_space(3)))
typedef unsigned short bf16_t;
typedef unsigned u32x4 __attribute__((ext_vector_type(4)));
typedef unsigned u32x2 __attribute__((ext_vector_type(2)));
typedef float f32x4 __attribute__((ext_vector_type(4)));
typedef float f32x2 __attribute__((ext_vector_type(2)));
typedef float f32x16 __attribute__((ext_vector_type(16)));
typedef short bf16x8 __attribute__((ext_vector_type(8)));
typedef short s16x4 __attribute__((ext_vector_type(4)));
#define LDS_WAIT() asm volatile("s_waitcnt lgkmcnt(0)" ::: "memory")
#define VM_WAIT() asm volatile("s_waitcnt vmcnt(0)" ::: "memory")
#define SBAR() __builtin_amdgcn_sched_barrier(0)
__device__ __forceinline__ unsigned cvtpk(float lo, float hi) { unsigned r; asm volatile("v_cvt_pk_bf16_f32 %0, %1, %2" : "=v"(r) : "v"(lo), "v"(hi)); return r; }
__device__ __forceinline__ float bf2f(unsigned short b) { return __uint_as_float((unsigned)b << 16); }
__device__ __forceinline__ u32x4 pack8u(f32x4 a, f32x4 b) { u32x4 w = {cvtpk(a[0], a[1]), cvtpk(a[2], a[3]), cvtpk(b[0], b[1]), cvtpk(b[2], b[3])}; return w; }
__device__ __forceinline__ bf16x8 pack8(f32x4 a, f32x4 b) { u32x4 w = pack8u(a, b); return *reinterpret_cast<bf16x8*>(&w); }
#define WS_SWZ(v, m) __int_as_float(__builtin_amdgcn_ds_swizzle(__float_as_int(v), ((m) << 10) | 0x1f))
__device__ __forceinline__ float wave_sum(float v) {
    v += WS_SWZ(v, 1); v += WS_SWZ(v, 2); v += WS_SWZ(v, 4); v += WS_SWZ(v, 8); v += WS_SWZ(v, 16);
    { auto rr = __builtin_amdgcn_permlane32_swap(__float_as_uint(v), __float_as_uint(v), false, false); v = __uint_as_float(rr[0]) + __uint_as_float(rr[1]); }
    return v;
}
__device__ __forceinline__ float log_sigmoidf(float x) { return fminf(x, 0.f) - log1pf(expf(-fabsf(x))); }
__device__ __forceinline__ float log_sigmoid_fast(float x) { return fminf(x, 0.f) - __logf(1.f + __expf(-fabsf(x))); }
__device__ __forceinline__ int opaque_tid_w(int wave) { int l; asm volatile("v_mbcnt_lo_u32_b32 %0, -1, 0\n\tv_mbcnt_hi_u32_b32 %0, -1, %0" : "=v"(l)); return wave * 64 + l; }
#define opaque_tid() opaque_tid_w(g_wave)
template <class T> __device__ __forceinline__ T* launder_s(T* p) { asm volatile("" : "+s"(p)); return p; }
#define XB_TMO      128
#define XB_XCNT(j)  (256  + 64 * (j))
#define XB_XSUB(j)  (1280 + 64 * (j))
#define XB_XGEN(j)  (2304 + 64 * (j))
#define XB_TOP      3328
#define XB_TOPGEN   3392
#define XCD_BAR_WORDS 3456
#define XB_SPIN_CAP (1u << 18)
__device__ __forceinline__ unsigned xb_ld(unsigned* p)              { return __hip_atomic_load(p, __ATOMIC_RELAXED, __HIP_MEMORY_SCOPE_AGENT); }
__device__ __forceinline__ unsigned xb_add(unsigned* p, unsigned v) { return __hip_atomic_fetch_add(p, v, __ATOMIC_RELAXED, __HIP_MEMORY_SCOPE_AGENT); }
__device__ __forceinline__ unsigned xb_xcc_id() { return (unsigned)__builtin_amdgcn_s_getreg((3 << 11) | 20) & 0xFu; }
#define XB_SPIN(cond, bar) do { unsigned _sp = 0; while (cond) { __builtin_amdgcn_s_sleep(1); \
    if ((++_sp & 255u) == 0u) { if (xb_ld(&(bar)[XB_TMO])) break; if (_sp > XB_SPIN_CAP) { atomicAdd(&(bar)[XB_TMO], 1u); break; } } } } while (0)
struct XcdBarrier { unsigned* bar; unsigned x; volatile LAS unsigned* st; int wave; };
__device__ __forceinline__ XcdBarrier xcd_barrier_post(unsigned* bar, volatile LAS unsigned* st) {
    XcdBarrier b; b.bar = bar; b.x = xb_xcc_id(); b.st = st;
    if (threadIdx.x == 0) (void)xb_add(&bar[XB_XCNT(b.x)], 1u);
    return b;
}
__device__ __forceinline__ void xcd_barrier_complete(unsigned* bar, unsigned x, unsigned& nloc, unsigned& nx) {
    const unsigned G = gridDim.x * gridDim.y * gridDim.z;
    unsigned sum, cnt, mine, sp = 0u;
    for (;;) {
        sum = 0u; cnt = 0u; mine = 0u;
#pragma unroll
        for (unsigned j = 0; j < 16; ++j) { const unsigned c = xb_ld(&bar[XB_XCNT(j)]); sum += c; cnt += (c > 0u) ? 1u : 0u; mine = (j == x) ? c : mine; }
        if (sum == G) break;
        __builtin_amdgcn_s_sleep(1);
        if ((++sp & 255u) == 0u) { if (xb_ld(&bar[XB_TMO])) break; if (sp > XB_SPIN_CAP) { atomicAdd(&bar[XB_TMO], 1u); break; } }
    }
    nloc = mine > 0u ? mine : 1u; nx = cnt > 0u ? cnt : 1u;
}
__device__ __forceinline__ void xcd_barrier(const XcdBarrier& b) {
    asm volatile("s_waitcnt vmcnt(0)" ::: "memory");
    __syncthreads();
    if (opaque_tid_w(b.wave) == 0) {
        unsigned* bar = b.bar;
        __builtin_amdgcn_s_waitcnt(0);
        unsigned nloc = b.st[0], nx = b.st[1];
        if (nloc == 0u) { xcd_barrier_complete(bar, b.x, nloc, nx); b.st[0] = nloc; b.st[1] = nx; }
        const unsigned old = xb_add(&bar[XB_XSUB(b.x)], 1u);
        const unsigned gen = old / nloc;
        if (old + 1u == (gen + 1u) * nloc) {
            __builtin_amdgcn_fence(__ATOMIC_RELEASE, "agent");
            asm volatile("s_waitcnt vmcnt(0)" ::: "memory");
            const unsigned og = xb_add(&bar[XB_TOP], 1u);
            const unsigned tg = og / nx;
            if (og + 1u == (tg + 1u) * nx) xb_add(&bar[XB_TOPGEN], 1u);
            else XB_SPIN(xb_ld(&bar[XB_TOPGEN]) == tg, bar);
            __builtin_amdgcn_fence(__ATOMIC_ACQUIRE, "agent");
            xb_add(&bar[XB_XGEN(b.x)], 1u);
            asm volatile("s_waitcnt vmcnt(0)" ::: "memory");
        } else {
            XB_SPIN(xb_ld(&bar[XB_XGEN(b.x)]) == gen, bar);
            __builtin_amdgcn_fence(__ATOMIC_ACQUIRE, "agent");
            asm volatile("s_waitcnt vmcnt(0)" ::: "memory");
        }
    }
    __syncthreads();
}

namespace pg8 {
constexpr int BM = 256, BK = 64, HALF = 128, HTB = HALF * BK * 2, STAGE_BYTES = 8 * HTB, NXCD = 8, WGM = 8;
__host__ __device__ __forceinline__ int lds_byte(int r, int c) { const int st = (r >> 4) * 2 + (c >> 5), rr = r & 15, cc = c & 31, ob = rr * 64 + cc * 2; return st * 1024 + (ob ^ (((ob >> 9) & 1) << 5)); }
__host__ __device__ __forceinline__ void stage_rc(int b, int& R, int& C) { const int st = b / 1024, sb = b % 1024, swz = sb ^ (((sb >> 9) & 1) << 5); R = (st >> 1) * 16 + swz / 64; C = (st & 1) * 32 + (swz % 64) / 2; }
__host__ __device__ __forceinline__ int perm32(int rho) { const int n = rho >> 4, i = rho & 15; return 8 * (i >> 2) + 4 * n + (i & 3); }

struct Unit { int pm, pn, g, nt; const char* A; const char* B; };

struct Sched {
    int nM, nN, nwg, G, c, nextra, nt;
    const char* A; const char* B; size_t tA, tB;
    const char* Ae; const char* Be; size_t tAe, tBe;
    unsigned* rdy; unsigned need;
    __device__ __forceinline__ bool waits(const Unit& u) const { return rdy != nullptr && u.g == 0 && u.pm >= TP / BM; }
    __device__ __forceinline__ void poll() const {
        unsigned sp = 0; while (__hip_atomic_load(rdy, __ATOMIC_RELAXED, __HIP_MEMORY_SCOPE_AGENT) < need) { __builtin_amdgcn_s_sleep(1); if (++sp > (1u << 22)) break; }
        __builtin_amdgcn_fence(__ATOMIC_ACQUIRE, "agent"); asm volatile("s_waitcnt vmcnt(0)" ::: "memory"); }
    __device__ __forceinline__ bool next(int i, Unit& u) const {
        const long L = (long)i * G + c; if (L >= nwg + nextra) return false;
        u.nt = nt;
        if (L >= nwg) { const int e = (int)(L - nwg); u.g = 1 + (e >> 2); u.pm = 0; u.pn = e & 3; u.A = Ae + (size_t)(e >> 2) * tAe; u.B = Be + (size_t)e * tBe; return true; }
        int wgid = (int)L; { const int q = nwg / NXCD, r = nwg % NXCD, xcd = wgid % NXCD, off = wgid / NXCD; wgid = (xcd < r ? xcd * (q + 1) : r * (q + 1) + (xcd - r) * q) + off; }
        const int nig = WGM * nN, gid = wgid / nig, fm = gid * WGM, gsz = (nM - fm) < WGM ? (nM - fm) : WGM;
        u.pm = fm + ((wgid % nig) % gsz); u.pn = (wgid % nig) / gsz; u.g = 0; u.A = A + (size_t)u.pm * tA; u.B = B + (size_t)u.pn * tB; return true;
    }
};

__device__ __forceinline__ void row_rstd8(const float* rss, int row0, int fq, float (&rs)[2][4]) {
    f32x4 a[2][4], b[2][4];
#pragma unroll
    for (int ai = 0; ai < 2; ++ai)
#pragma unroll
        for (int m = 0; m < 4; ++m) { const f32x4* p = (const f32x4*)(rss + (size_t)(row0 + ai * HALF + m * 16) * 32 + fq * 8); a[ai][m] = p[0]; b[ai][m] = p[1]; }
#pragma unroll
    for (int ai = 0; ai < 2; ++ai)
#pragma unroll
        for (int m = 0; m < 4; ++m) { const f32x4 v = a[ai][m] + b[ai][m]; float s = (v[0] + v[1]) + (v[2] + v[3]); s += __shfl_xor(s, 16); s += __shfl_xor(s, 32); rs[ai][m] = rsqrtf(s * (1.0f / DM) + RMS_EPS); }
}
__device__ __forceinline__ void rs_table(const LAS float* rst, int wr, int fr, float (&rs)[2][4]) {
#pragma unroll
    for (int ai = 0; ai < 2; ++ai)
#pragma unroll
        for (int m = 0; m < 4; ++m) rs[ai][m] = rst[wr * 64 + fr + ai * HALF + m * 16];
}
struct EpiIn {
    static constexpr bool PERM = true, AFTER_DRAIN = false, RSTD = true;
    bf16_t* z; const float* rss; float* out; bf16_t* kvb; bf16_t* mkvb; const float* bfg; unsigned* ctl; float* fl; float* dup; int kind, j, ml;
    __device__ __forceinline__ void operator()(const f32x4 (&acc)[2][2][4][2], const Unit& u, int wr, int wc, int fr, int fq, const LAS float* rst) const {
        asm volatile("" : "+v"(fr), "+v"(fq));
        const int row0 = u.pm * BM + wr * 64 + fr, colt = u.pn * BM, col0 = colt + wc * 32 + 8 * fq;
        if (u.g != 0) {
            const int e = ml; const bool isv = colt >= MEMW; float* of = out + (isv ? O_MVP : O_MKP) + (size_t)e * NMEM * MEMW; bf16_t* ob = mkvb + (size_t)e * NMEM * 1024;
#pragma unroll
            for (int ai = 0; ai < 2; ++ai)
#pragma unroll
                for (int m = 0; m < 4; ++m) { const int row = row0 + ai * HALF + m * 16;
#pragma unroll
                    for (int bj = 0; bj < 2; ++bj) { const int c = col0 + bj * HALF; const f32x4 v0 = acc[ai][bj][m][0], v1 = acc[ai][bj][m][1];
                        *(u32x4*)(ob + (size_t)row * 1024 + c) = pack8u(v0, v1);
                        float* o = of + (size_t)row * MEMW + (c - (isv ? MEMW : 0)); *(f32x4*)o = v0; *(f32x4*)(o + 4) = v1; } }
            return;
        }
        float rs[2][4]; rs_table(rst, wr, fr, rs);
        const bool kt = kind != 2 && colt >= AW && colt < 2 * AW, vt = kind != 2 && colt >= 2 * AW && colt < 3 * AW, smp = u.pm >= TP / BM;
        const int cbase = kt ? AW : 2 * AW;
        const size_t ocache = kind == 0 ? (smp ? (kt ? O_FKS : O_FVS) + (size_t)j * TS * AW : (kt ? O_FKP : O_FVP) + (size_t)j * TP * AW) : (smp ? (kt ? O_SKS : O_SVS) : (kt ? O_SKP : O_SVP));
        float* oc = out + ocache; bf16_t* kvs = kvb + (kt ? 0 : KVS_ONE / 2);
        const bool lft = kind == 0 && colt == 5120 && wc == 0 && fq < 2;
        const bool nrm = kind == 0 && !smp && colt < 2 * AW;
        float nmx[2] = {0.f, 0.f};
#pragma unroll
        for (int ai = 0; ai < 2; ++ai)
#pragma unroll
            for (int m = 0; m < 4; ++m) { const int row = row0 + ai * HALF + m * 16, rr = smp ? row - TP : row; const float sc = rs[ai][m];
#pragma unroll
                for (int bj = 0; bj < 2; ++bj) { const int c = col0 + bj * HALF; const f32x4 v0 = acc[ai][bj][m][0] * sc, v1 = acc[ai][bj][m][1] * sc; const u32x4 w = pack8u(v0, v1);
                    *(u32x4*)(z + (size_t)row * ZLD + c) = w;
                    if (nrm) { float q = (v0[0] * v0[0] + v0[1] * v0[1]) + (v0[2] * v0[2] + v0[3] * v0[3]) + (v1[0] * v1[0] + v1[1] * v1[1]) + (v1[2] * v1[2] + v1[3] * v1[3]);
                        q += __shfl_xor(q, 16); q += __shfl_xor(q, 32); nmx[bj] = fmaxf(nmx[bj], q); }
                    if (kt || vt) { const int cc = c - cbase; float* o = oc + (size_t)rr * AW + cc; __builtin_nontemporal_store(v0, (f32x4*)o); __builtin_nontemporal_store(v1, (f32x4*)(o + 4));
#ifdef PROBE_DUPKV
                        { float* o2 = dup + (size_t)row * AW + cc + (kt ? 0 : (size_t)MT * AW); *(f32x4*)o2 = v0; *(f32x4*)(o2 + 4) = v1; }
#endif
                        if (smp) *(u32x4*)(kvs + ((size_t)(rr >> 6) * SKS + PAST + (rr & 63)) * AW + cc) = w; }
                } }
        if (lft) {
            float bb[8], hs[8];
#pragma unroll
            for (int e = 0; e < 8; ++e) { bb[e] = bfg[(8 * fq + e) % NH]; hs[e] = 0.f; }
#pragma unroll
            for (int ai = 0; ai < 2; ++ai)
#pragma unroll
                for (int m = 0; m < 4; ++m) { const int row = row0 + ai * HALF + m * 16; const float sc = rs[ai][m]; float* o = fl + (size_t)(8 * fq) * MT + row;
                    f32x4 v0 = acc[ai][0][m][0] * sc, v1 = acc[ai][0][m][1] * sc;
#pragma unroll
                    for (int e = 0; e < 4; ++e) { v0[e] += bb[e]; v1[e] += bb[4 + e]; }
#pragma unroll
                    for (int e = 0; e < 4; ++e) { o[(size_t)e * MT] = v0[e]; if (fq == 0) o[(size_t)(4 + e) * MT] = v1[e]; }
#pragma unroll
                    for (int e = 0; e < 4; ++e) { hs[e] += v0[e]; hs[4 + e] += v1[e]; } }
            if (!smp) {
#pragma unroll
                for (int e = 0; e < 8; ++e) { float s = hs[e]; s += __shfl_xor(s, 1); s += __shfl_xor(s, 2); s += __shfl_xor(s, 4); s += __shfl_xor(s, 8);
                    if (fr == 0 && 8 * fq + e < NH) atomicAdd((float*)(ctl + CW_HS + j * 64) + 8 * fq + e, s); }
            }
        }
        if (nrm) {
#pragma unroll
            for (int bj = 0; bj < 2; ++bj) { float q = nmx[bj]; q = fmaxf(q, __shfl_xor(q, 1)); q = fmaxf(q, __shfl_xor(q, 2)); q = fmaxf(q, __shfl_xor(q, 4)); q = fmaxf(q, __shfl_xor(q, 8));
                if (fr == 0 && fq == 0) { const bool isq = colt < AW; const int h = (colt - (isq ? 0 : AW)) / HD + bj;
                    unsigned* t = isq ? ctl + CW_QQ + ((j * 32 + u.pm) * NH + h) * 4 + wc : ctl + CW_KQ + j * 64 + h * 4 + wc;
                    __hip_atomic_fetch_max(t, __float_as_uint(q), __ATOMIC_RELAXED, __HIP_MEMORY_SCOPE_AGENT); } }
        }
    }
};
struct EpiRes {
    static constexpr bool PERM = true, AFTER_DRAIN = false, RSTD = false;
    const float* base32; bf16_t* xb; float* rss;
    __device__ __forceinline__ void operator()(const f32x4 (&acc)[2][2][4][2], const Unit& u, int wr, int wc, int fr, int fq, const LAS float* rst) const {
        const int row0 = u.pm * BM + wr * 64 + fr, col0 = u.pn * BM + wc * 32 + 8 * fq;
#pragma unroll
        for (int ai = 0; ai < 2; ++ai)
#pragma unroll
            for (int m = 0; m < 4; ++m) { const int row = row0 + ai * HALF + m * 16; float ss = 0.f;
#pragma unroll
                for (int bj = 0; bj < 2; ++bj) { bf16_t* p = xb + (size_t)row * DM + col0 + bj * HALF; f32x4 a, b;
                    if (base32) { const float* pb = base32 + (size_t)row * DM + col0 + bj * HALF; a = *(const f32x4*)pb; b = *(const f32x4*)(pb + 4); }
                    else { const u32x4 w = *(const u32x4*)p; a = (f32x4){__uint_as_float(w[0] << 16), __uint_as_float(w[0] & 0xffff0000u), __uint_as_float(w[1] << 16), __uint_as_float(w[1] & 0xffff0000u)};
                           b = (f32x4){__uint_as_float(w[2] << 16), __uint_as_float(w[2] & 0xffff0000u), __uint_as_float(w[3] << 16), __uint_as_float(w[3] & 0xffff0000u)}; }
                    a += acc[ai][bj][m][0]; b += acc[ai][bj][m][1];
                    *(u32x4*)p = pack8u(a, b);
                    ss += (a[0] * a[0] + a[1] * a[1]) + (a[2] * a[2] + a[3] * a[3]) + (b[0] * b[0] + b[1] * b[1]) + (b[2] * b[2] + b[3] * b[3]); }
                ss += __shfl_xor(ss, 16); ss += __shfl_xor(ss, 32);
                if (fq == 0) rss[(size_t)row * 32 + u.pn * 4 + wc] = ss;
                if (m & 1) asm volatile("" ::: "memory"); }
    }
};
struct EpiUp {
    static constexpr bool PERM = true, AFTER_DRAIN = false, RSTD = true;
    bf16_t* o; const float* rss;
    __device__ __forceinline__ void operator()(const f32x4 (&acc)[2][2][4][2], const Unit& u, int wr, int wc, int fr, int fq, const LAS float* rst) const {
        const int row0 = u.pm * BM + wr * 64 + fr, col0 = u.pn * BM + wc * 32 + 8 * fq;
        float rs[2][4]; rs_table(rst, wr, fr, rs);
#pragma unroll
        for (int ai = 0; ai < 2; ++ai)
#pragma unroll
            for (int m = 0; m < 4; ++m) { const int row = row0 + ai * HALF + m * 16; const float sc = rs[ai][m];
#pragma unroll
                for (int bj = 0; bj < 2; ++bj) { f32x4 v0 = acc[ai][bj][m][0] * sc, v1 = acc[ai][bj][m][1] * sc;
#pragma unroll
                    for (int e = 0; e < 4; ++e) { const float a = fmaxf(v0[e], 0.f), b = fmaxf(v1[e], 0.f); v0[e] = a * a; v1[e] = b * b; }
                    *(u32x4*)(o + (size_t)row * DFF + col0 + bj * HALF) = pack8u(v0, v1); } }
    }
};

struct SchedRes {
    int S, nu, G, c, ntm, nts; const char* A; const char* B; size_t tA, tB, kbytes;
    __device__ __forceinline__ bool waits(const Unit&) const { return false; }
    __device__ __forceinline__ void poll() const {}
    __device__ __forceinline__ bool next(int i, Unit& u) const {
        const int L = i * G + c; constexpr int NMAIN = (TP / BM) * (DM / BM);
        if (L < NMAIN) { int wgid = L; { const int q = NMAIN / NXCD, xcd = wgid % NXCD, off = wgid / NXCD; wgid = xcd * q + off; }
            const int nig = WGM * (DM / BM), gid = wgid / nig, fm = gid * WGM; u.pm = fm + ((wgid % nig) % WGM); u.pn = (wgid % nig) / WGM; u.g = -1; u.nt = ntm;
            u.A = A + (size_t)u.pm * tA; u.B = B + (size_t)u.pn * tB; return true; }
        const int e = L - NMAIN; if (e >= nu) return false;
        const int tile = e / S, sp = e - tile * S; u.pm = TP / BM + (tile >> 3); u.pn = tile & 7; u.g = sp; u.nt = nts;
        u.A = A + (size_t)u.pm * tA + (size_t)sp * kbytes; u.B = B + (size_t)u.pn * tB + (size_t)sp * kbytes; return true;
    }
};
struct EpiPart {
    static constexpr bool PERM = true, AFTER_DRAIN = false, RSTD = false;
    float* part;
    __device__ __forceinline__ void operator()(const f32x4 (&acc)[2][2][4][2], const Unit& u, int wr, int wc, int fr, int fq, const LAS float* rst) const {
        const int row0 = (u.pm - TP / BM) * BM + wr * 64 + fr, col0 = u.pn * BM + wc * 32 + 8 * fq; float* base = part + (size_t)u.g * TS * DM;
#pragma unroll
        for (int ai = 0; ai < 2; ++ai)
#pragma unroll
            for (int m = 0; m < 4; ++m) { const int row = row0 + ai * HALF + m * 16;
#pragma unroll
                for (int bj = 0; bj < 2; ++bj) { float* p = base + (size_t)row * DM + col0 + bj * HALF; *(f32x4*)p = acc[ai][bj][m][0]; *(f32x4*)(p + 4) = acc[ai][bj][m][1]; } }
    }
};

struct EpiResPart {
    static constexpr bool PERM = true, AFTER_DRAIN = false, RSTD = false;
    EpiRes res; EpiPart part;
    __device__ __forceinline__ void operator()(const f32x4 (&acc)[2][2][4][2], const Unit& u, int wr, int wc, int fr, int fq, const LAS float* rst) const { if (u.g < 0) res(acc, u, wr, wc, fr, fq, rst); else part(acc, u, wr, wc, fr, fq, rst); }
};

template <class Epi, class Sch>
__device__ __forceinline__ void gemm_phase(LAS unsigned char* lds, const int K, const int lda, const int ldb, const Sch& S, const Epi& E, const int tid) {
    const int wid = __builtin_amdgcn_readfirstlane(tid >> 6), lane = tid & 63, wr = wid >> 2, wc = wid & 3, fr = lane & 15, fq = lane >> 4;
    unsigned voffA[2], voffB[2];
#pragma unroll
    for (int i = 0; i < 2; ++i) { int R, C; stage_rc(tid * 16 + i * 8192, R, C); const int Rb = Epi::PERM ? ((R & ~31) + perm32(R & 31)) : R;
        voffA[i] = (unsigned)(R * lda + C) * 2u; voffB[i] = (unsigned)(Rb * ldb + C) * 2u; }
    const size_t kstep = (size_t)(BK * 2);
    const size_t hstepA = (size_t)HALF * lda * 2, hstepB = (size_t)HALF * ldb * 2;
    const unsigned ldsw = (unsigned)wid * 1024u;
    const int aoff = lds_byte(wr * 64 + fr, fq * 8), boff = lds_byte(wc * 32 + fr, fq * 8);
#define PG8_SA(b, h) (((b) * 2 + (h)) * HTB)
#define PG8_SB(b, h) ((4 + (b) * 2 + (h)) * HTB)
#define PG8_STAGE(bufoff, gbase, voff) do { _Pragma("unroll") for (int _i = 0; _i < 2; ++_i) \
        __builtin_amdgcn_global_load_lds((const unsigned*)((const char*)(gbase) + (voff)[_i]), (LAS unsigned*)(lds + (bufoff) + ldsw + _i * 8192), 16, 0, 0); } while (0)
#define PG8_LDA(dst, b, h) do { _Pragma("unroll") for (int m = 0; m < 4; ++m) _Pragma("unroll") for (int k = 0; k < 2; ++k) dst[m][k] = *(const LAS bf16x8*)(lds + PG8_SA(b, h) + aoff + m * 2048 + k * 1024); } while (0)
#define PG8_LDB(dst, b, h) do { _Pragma("unroll") for (int n = 0; n < 2; ++n) _Pragma("unroll") for (int k = 0; k < 2; ++k) dst[n][k] = *(const LAS bf16x8*)(lds + PG8_SB(b, h) + boff + n * 2048 + k * 1024); } while (0)
#define PG8_MMA(ai, bj, At, Bt) do { __builtin_amdgcn_s_setprio(1); _Pragma("unroll") for (int m = 0; m < 4; ++m) _Pragma("unroll") for (int n = 0; n < 2; ++n) _Pragma("unroll") for (int k = 0; k < 2; ++k) \
        acc[ai][bj][m][n] = __builtin_amdgcn_mfma_f32_16x16x32_bf16(Bt[n][k], At[m][k], acc[ai][bj][m][n], 0, 0, 0); __builtin_amdgcn_s_setprio(0); } while (0)
#define PG8_WAIT_V(n) asm volatile("s_waitcnt vmcnt(" #n ")" ::: "memory")
#define PG8_WAIT_L(n) asm volatile("s_waitcnt lgkmcnt(" #n ")" ::: "memory")
#define PG8_BAR __builtin_amdgcn_s_barrier()
#define PG8_SCHED __builtin_amdgcn_sched_barrier(0)
    Unit cur, nxt; int ui = 0;
    if (!S.next(0, cur)) return;
    bool seen = false;
#define PG8_AREADY(u) do { if (!seen && S.waits(u)) { seen = true; if (wid == 0) S.poll(); __builtin_amdgcn_s_barrier(); } } while (0)
    PG8_AREADY(cur);
    LAS float* const rstab = (LAS float*)(lds + STAGE_BYTES);
#define PG8_RS_ISSUE(pm_) do { const float* p_ = E.rss + ((size_t)(pm_) * BM + (tid >> 1)) * 32 + (tid & 1) * 16; _Pragma("unroll") for (int i_ = 0; i_ < 4; ++i_) rq[i_] = *(const f32x4*)(p_ + 4 * i_); } while (0)
#define PG8_RS_FINISH(buf) do { const f32x4 v_ = (rq[0] + rq[1]) + (rq[2] + rq[3]); float s_ = (v_[0] + v_[1]) + (v_[2] + v_[3]); s_ += __shfl_xor(s_, 1); \
        if (!(tid & 1)) rstab[(buf) * 256 + (tid >> 1)] = rsqrtf(s_ * (1.0f / DM) + RMS_EPS); } while (0)
    f32x4 rq0[4];
    if constexpr (Epi::RSTD) { f32x4 (&rq)[4] = rq0; PG8_RS_ISSUE(cur.pm); }
    f32x4 acc[2][2][4][2];
#pragma unroll
    for (int a = 0; a < 2; ++a)
#pragma unroll
        for (int b = 0; b < 2; ++b)
#pragma unroll
            for (int m = 0; m < 4; ++m)
#pragma unroll
                for (int n = 0; n < 2; ++n) acc[a][b][m][n] = (f32x4){0.f, 0.f, 0.f, 0.f};
    bf16x8 At[4][2], B0[2][2], B1[2][2];
    const char* cA = cur.A; const char* cB = cur.B;
    PG8_STAGE(PG8_SB(0, 0), cB, voffB); PG8_STAGE(PG8_SB(0, 1), cB + hstepB, voffB); PG8_STAGE(PG8_SA(0, 0), cA, voffA); PG8_STAGE(PG8_SA(0, 1), cA + hstepA, voffA);
    if (wr == 1) PG8_BAR;
    PG8_WAIT_V(2); PG8_BAR;
    PG8_STAGE(PG8_SB(1, 0), cB + kstep, voffB); PG8_STAGE(PG8_SA(1, 0), cA + kstep, voffA); PG8_STAGE(PG8_SB(1, 1), cB + hstepB + kstep, voffB);
    PG8_WAIT_V(6); PG8_BAR;
    if constexpr (Epi::RSTD) { f32x4 (&rq)[4] = rq0; PG8_RS_FINISH(0); }
    for (;;) {
        const bool has_next = S.next(ui + 1, nxt);
        const char* nA = has_next ? nxt.A : cA; const char* nB = has_next ? nxt.B : cB;
        const int nt = cur.nt;
        for (int t = 0; t < nt; t += 2) {
            const bool last = (t == nt - 2);
            if (last && has_next) PG8_AREADY(nxt);
            const char* a1 = cA + (size_t)(t + 1) * kstep;
            const char* a2 = last ? nA : cA + (size_t)(t + 2) * kstep; const char* b2 = last ? nB : cB + (size_t)(t + 2) * kstep;
            const char* a3 = a2 + kstep; const char* b3 = b2 + kstep;
            PG8_LDB(B0, 0, 0); PG8_LDB(B1, 0, 1); PG8_SCHED; PG8_LDA(At, 0, 0); PG8_STAGE(PG8_SA(1, 1), a1 + hstepA, voffA);
            PG8_WAIT_V(8); PG8_WAIT_L(0); PG8_BAR; PG8_MMA(0, 0, At, B0); PG8_MMA(0, 1, At, B1); PG8_BAR; PG8_SCHED;
            PG8_LDA(At, 0, 1); PG8_STAGE(PG8_SB(0, 0), b2, voffB); PG8_STAGE(PG8_SB(0, 1), b2 + hstepB, voffB); PG8_STAGE(PG8_SA(0, 0), a2, voffA);
            PG8_WAIT_V(8); PG8_WAIT_L(0); PG8_BAR; PG8_MMA(1, 0, At, B0); PG8_MMA(1, 1, At, B1); PG8_BAR; PG8_SCHED;
            PG8_LDB(B0, 1, 0); PG8_LDB(B1, 1, 1); PG8_SCHED; PG8_LDA(At, 1, 0); PG8_STAGE(PG8_SA(0, 1), a2 + hstepA, voffA);
            PG8_WAIT_V(8); PG8_WAIT_L(0); PG8_BAR; PG8_MMA(0, 0, At, B0); PG8_MMA(0, 1, At, B1); PG8_BAR; PG8_SCHED;
            PG8_LDA(At, 1, 1); PG8_STAGE(PG8_SB(1, 0), b3, voffB); PG8_STAGE(PG8_SB(1, 1), b3 + hstepB, voffB); PG8_STAGE(PG8_SA(1, 0), a3, voffA);
            PG8_WAIT_V(8); PG8_WAIT_L(0); PG8_BAR; PG8_MMA(1, 0, At, B0); PG8_MMA(1, 1, At, B1); PG8_BAR; PG8_SCHED;
        }
        if (wr == 0) PG8_BAR;
        if constexpr (Epi::RSTD) { f32x4 rq[4]; PG8_RS_ISSUE(has_next ? nxt.pm : cur.pm); E(acc, cur, wr, wc, fr, fq, rstab + (ui & 1) * 256); PG8_RS_FINISH((ui + 1) & 1); }
        else E(acc, cur, wr, wc, fr, fq, rstab);
        if (!has_next) break;
#pragma unroll
        for (int a = 0; a < 2; ++a)
#pragma unroll
            for (int b = 0; b < 2; ++b)
#pragma unroll
                for (int m = 0; m < 4; ++m)
#pragma unroll
                    for (int n = 0; n < 2; ++n) acc[a][b][m][n] = (f32x4){0.f, 0.f, 0.f, 0.f};
        cur = nxt; cA = nA; cB = nB; ++ui;
        if (wr == 1) PG8_BAR;
    }
    PG8_WAIT_V(0);
    PG8_BAR;
#undef PG8_AREADY
#undef PG8_RS_ISSUE
#undef PG8_RS_FINISH
#undef PG8_SA
#undef PG8_SB
#undef PG8_STAGE
#undef PG8_LDA
#undef PG8_LDB
#undef PG8_MMA
#undef PG8_WAIT_V
#undef PG8_WAIT_L
#undef PG8_BAR
#undef PG8_SCHED
}
}

#ifndef PRUNE_T
#define PRUNE_T 25.f
#endif
namespace att {
constexpr float SCALE = 0.08838834764831845f;
constexpr float THR = 8.f;
constexpr int NW = 8, QBLK = 32, KVBLK = 64, QB = NW * QBLK, D = 128;
constexpr int SHM_V = KVBLK * D * 2, SHM_K = KVBLK * D * 2;
constexpr int ATT_LDS = 2 * SHM_V + 2 * SHM_K + NW * 64 * 4;
constexpr int BOS_OFF = ATT_LDS;
constexpr int BOS_BYTES = 8192 * 4;
constexpr int SCR_OFF = BOS_OFF + 2 * BOS_BYTES;
constexpr int WINF = 1 << 30;
static_assert(SCR_OFF + 256 <= LDS_WORK, "attention LDS map");

#define KSWZ(row, colB) ((row) * 256 + ((colB) ^ (((row) & 7) << 4)))
__device__ __forceinline__ int v_st(int k, int c) { const int kk = (k & ~0xC) | ((k & 4) << 1) | ((k & 8) >> 1); return ((kk >> 3) * 4 + (c >> 5)) * 512 + ((kk & 7) * 32 + (c & 31)) * 2; }
__device__ __forceinline__ int v_rd_base(int lane) { return ((lane & 3) << 3) | (((lane >> 2) & 3) << 6) | (((lane >> 4) & 1) << 5) | (((lane >> 5) & 1) << 8); }
constexpr int v_rd_off(int d0, int ks, int half) { return d0 * 512 + ks * 4096 + half * 2048; }
__device__ __forceinline__ int crow(int r, int hi) { return (r & 3) + 8 * (r >> 2) + 4 * hi; }
__device__ __forceinline__ bf16x8 load8(const bf16_t* p) { return *reinterpret_cast<const bf16x8*>(p); }

__device__ __forceinline__ void mask_tile(f32x16& p0, f32x16& p1, int dq, unsigned W) {
    const float NEG = -__builtin_inff();
#pragma unroll
    for (int r = 0; r < 16; ++r) {
        const int c = (r & 3) + 8 * (r >> 2);
        if ((unsigned)(dq - c) >= W) p0[r] = NEG;
        if ((unsigned)(dq - c - 32) >= W) p1[r] = NEG;
    }
}
__device__ __forceinline__ void partialSM(f32x16& p0, f32x16& p1, float& m_reg, float& mn, float& alpha) {
    float pmax = p0[0]; for (int r = 1; r < 16; ++r) pmax = fmaxf(pmax, p0[r]); for (int r = 0; r < 16; ++r) pmax = fmaxf(pmax, p1[r]);
    { auto rr = __builtin_amdgcn_permlane32_swap(__float_as_uint(pmax), __float_as_uint(pmax), false, false);
      pmax = fmaxf(__uint_as_float(rr[0]), __uint_as_float(rr[1])); }
    constexpr float C2 = 1.4426950408889634f * SCALE;
    if (__builtin_expect(__all((pmax - m_reg) * SCALE <= THR), 1)) { mn = m_reg; alpha = 1.f; }
    else { mn = fmaxf(m_reg, pmax); alpha = __builtin_amdgcn_exp2f((m_reg - mn) * C2); m_reg = mn; }
    const float mnL = -mn * C2;
    for (int r = 0; r < 16; ++r) p0[r] = fmaf(p0[r], C2, mnL); for (int r = 0; r < 16; ++r) p1[r] = fmaf(p1[r], C2, mnL);
    for (int r = 0; r < 16; ++r) p0[r] = __builtin_amdgcn_exp2f(p0[r]);
}
#define PK4(P, B_, OUT) do { unsigned a0 = cvtpk(P[B_+0], P[B_+1]), a1 = cvtpk(P[B_+2], P[B_+3]);                          \
        unsigned b0 = cvtpk(P[B_+4], P[B_+5]), b1 = cvtpk(P[B_+6], P[B_+7]);                                             \
        auto r0 = __builtin_amdgcn_permlane32_swap(a0, b0, false, false); auto r1 = __builtin_amdgcn_permlane32_swap(a1, b1, false, false); \
        u32x4 w = {r0[0], r1[0], r0[1], r1[1]}; OUT = *reinterpret_cast<bf16x8*>(&w); } while (0)
__device__ __forceinline__ void finishSM(f32x16& p0, f32x16& p1, float alpha, float& l_reg, bf16x8& pa0, bf16x8& pa1, bf16x8& pa2, bf16x8& pa3) {
    for (int r = 0; r < 16; ++r) p1[r] = __builtin_amdgcn_exp2f(p1[r]);
    float ps = 0; for (int r = 0; r < 16; ++r) ps += p0[r]; for (int r = 0; r < 16; ++r) ps += p1[r];
    { auto rr = __builtin_amdgcn_permlane32_swap(__float_as_uint(ps), __float_as_uint(ps), false, false);
      ps = __uint_as_float(rr[0]) + __uint_as_float(rr[1]); }
    l_reg = l_reg * alpha + ps;
    PK4(p0, 0, pa0); PK4(p0, 8, pa1); PK4(p1, 0, pa2); PK4(p1, 8, pa3);
}
template <int KB, bool BIAS>
__device__ __forceinline__ void qkt(f32x16& p0, f32x16& p1, const char* K_lds, int r32, int hi, const bf16x8* qr, const float* bk, bool act = true) {
    if (!act) { const float NEG = -__builtin_inff();
#pragma unroll
        for (int r = 0; r < 16; ++r) { p0[r] = NEG; p1[r] = NEG; } return; }
    if constexpr (BIAS) {
#pragma unroll
        for (int i = 0; i < 4; ++i) { const f32x4 a = *(const f32x4*)(bk + 8 * i), b = *(const f32x4*)(bk + 32 + 8 * i);
            p0[4 * i] = a[0]; p0[4 * i + 1] = a[1]; p0[4 * i + 2] = a[2]; p0[4 * i + 3] = a[3];
            p1[4 * i] = b[0]; p1[4 * i + 1] = b[1]; p1[4 * i + 2] = b[2]; p1[4 * i + 3] = b[3]; }
    } else { p0 = f32x16{}; p1 = f32x16{}; }
    const char* kb[4];
#pragma unroll
    for (int dd = 0; dd < 4; ++dd) kb[dd] = K_lds + KB * SHM_K + KSWZ(r32, (dd * 16 + hi * 8) * 2);
#pragma unroll
    for (int d0 = 0; d0 < 8; ++d0) { const char* a = kb[d0 & 3] + (d0 >> 2) * 128;
        bf16x8 b0 = *reinterpret_cast<const bf16x8*>(a);
        bf16x8 b1 = *reinterpret_cast<const bf16x8*>(a + 32 * 256);
        p0 = __builtin_amdgcn_mfma_f32_32x32x16_bf16(b0, qr[d0], p0, 0, 0, 0);
        p1 = __builtin_amdgcn_mfma_f32_32x32x16_bf16(b1, qr[d0], p1, 0, 0, 0); }
}
template <int VB>
__device__ __forceinline__ void pv_tile(f32x16* o, int vb0, bf16x8 pa0, bf16x8 pa1, bf16x8 pa2, bf16x8 pa3, bool act = true) {
    if (!act) return;
#define TRRD(dst, off) asm volatile("ds_read_b64_tr_b16 %0, %1 offset:%2" : "=&v"(dst) : "v"(vb0), "i"(off) : "memory")
#define PV_D0(d0) do { s16x4 l0, l1, l2, l3, h0, h1, h2, h3; constexpr int b_ = VB * SHM_V + v_rd_off(d0, 0, 0); \
        TRRD(l0, b_); TRRD(h0, b_ + 2048); TRRD(l1, b_ + 4096); TRRD(h1, b_ + 6144); TRRD(l2, b_ + 8192); TRRD(h2, b_ + 10240); TRRD(l3, b_ + 12288); TRRD(h3, b_ + 14336); \
        asm volatile("s_waitcnt lgkmcnt(0)" ::: "memory"); SBAR();   \
        o[d0] = __builtin_amdgcn_mfma_f32_32x32x16_bf16(pa0, (bf16x8){l0[0], l0[1], l0[2], l0[3], h0[0], h0[1], h0[2], h0[3]}, o[d0], 0, 0, 0);   \
        o[d0] = __builtin_amdgcn_mfma_f32_32x32x16_bf16(pa1, (bf16x8){l1[0], l1[1], l1[2], l1[3], h1[0], h1[1], h1[2], h1[3]}, o[d0], 0, 0, 0);   \
        o[d0] = __builtin_amdgcn_mfma_f32_32x32x16_bf16(pa2, (bf16x8){l2[0], l2[1], l2[2], l2[3], h2[0], h2[1], h2[2], h2[3]}, o[d0], 0, 0, 0);   \
        o[d0] = __builtin_amdgcn_mfma_f32_32x32x16_bf16(pa3, (bf16x8){l3[0], l3[1], l3[2], l3[3], h3[0], h3[1], h3[2], h3[3]}, o[d0], 0, 0, 0); } while (0)
    PV_D0(0); PV_D0(1); PV_D0(2); PV_D0(3);
#undef PV_D0
#undef TRRD
}

struct Blk { const bf16_t* Q; const bf16_t* K; const bf16_t* V; bf16_t* O; int ldq, ldkv, ldo; int P0, skv, nrows; int bmode; const float* lf0; int n0; const float* lf1;
             const unsigned* qq; const unsigned* kq; int jlo, bsel, pre0, ls0; const float* Kf; const float* Vf; int nf, ldf; };
struct Seam { bf16x8 qr[8]; bf16x8 st_v0, st_v1, st_k0, st_k1; };
__device__ __forceinline__ int blk_jhi(const Blk& b) { int j = (b.P0 + QB - 1) / KVBLK + 1; const int m = b.skv / KVBLK; return j > m ? m : j; }

__device__ __forceinline__ void prepare_bias(Blk& b, char* lds, int g_wave) {
    const int tid = opaque_tid();
    float* bos = (float*)(lds + BOS_OFF + b.bsel * BOS_BYTES); float* scr = (float*)(lds + SCR_OFF);
    const int nk = blk_jhi(b) * KVBLK, lane = tid & 63, wid = tid >> 6;
    b.jlo = 0;
    if (b.bmode == 0) { for (int k = tid; k < nk; k += 512) bos[k] = 0.f; __syncthreads(); return; }
    float v[16]; float tot = 0.f; const int k0 = tid * 16; const bool in = k0 < nk;
#pragma unroll
    for (int i = 0; i < 16; ++i) { const int k = k0 + i; float x = 0.f; if (in) { if (k < b.n0) { x = b.lf0[(size_t)k * b.ls0]; if (b.pre0) x = log_sigmoid_fast(x); } else x = log_sigmoid_fast(b.lf1[k - b.n0]); } v[i] = x; tot += x; }
    float inc = tot;
#pragma unroll
    for (int o = 1; o < 64; o <<= 1) { const float y = __int_as_float(__builtin_amdgcn_ds_bpermute(((lane + o) & 63) << 2, __float_as_int(inc))); if (lane + o < 64) inc += y; }
    if (lane == 0) scr[wid] = inc;
    if (tid == 0) ((int*)scr)[9] = 0;
    __syncthreads();
    float hiw = 0.f;
#pragma unroll
    for (int w = 0; w < 8; ++w) if (w > wid) hiw += scr[w];
    float run = (inc - tot) + hiw;
#pragma unroll
    for (int i = 15; i >= 0; --i) { const float lf = v[i]; v[i] = run; run += lf; }
    if (in) {
#pragma unroll
        for (int i = 0; i < 16; ++i) bos[k0 + i] = v[i] * (1.0f / SCALE);
    }
    if (b.qq != nullptr) {
        if (in && k0 == b.P0) scr[8] = v[0];
        { const int row = tid >> 1, half = tid & 1; const bf16_t* qp = b.Q + (size_t)row * b.ldq + half * 64; const bf16_t* kp = b.K + (size_t)(b.P0 + row) * b.ldkv + half * 64; float d = 0.f;
#pragma unroll
          for (int c8 = 0; c8 < 8; ++c8) { const u32x4 qa = *(const u32x4*)(qp + c8 * 8), ka = *(const u32x4*)(kp + c8 * 8);
#pragma unroll
              for (int e = 0; e < 4; ++e) d += __uint_as_float(qa[e] << 16) * __uint_as_float(ka[e] << 16) + __uint_as_float(qa[e] & 0xffff0000u) * __uint_as_float(ka[e] & 0xffff0000u); }
          d += __shfl_xor(d, 1);
#pragma unroll
          for (int o = 2; o < 64; o <<= 1) d = fminf(d, __shfl_xor(d, o));
          if (lane == 0) scr[10 + wid] = d * SCALE; }
        __syncthreads();
        float mmin = scr[10];
#pragma unroll
        for (int w = 1; w < 8; ++w) mmin = fminf(mmin, scr[10 + w]);
        const float q2 = (__uint_as_float(b.qq[0]) + __uint_as_float(b.qq[1])) + (__uint_as_float(b.qq[2]) + __uint_as_float(b.qq[3]));
        const float k2 = (__uint_as_float(b.kq[0]) + __uint_as_float(b.kq[1])) + (__uint_as_float(b.kq[2]) + __uint_as_float(b.kq[3]));
        const float B = sqrtf(q2 * k2) * SCALE * 1.02f, cut = scr[8] - (B - mmin + PRUNE_T);
        int cnt = 0;
#pragma unroll
        for (int i = 0; i < 16; ++i) cnt += (in && k0 + i < b.P0 && v[i] < cut) ? 1 : 0;
#pragma unroll
        for (int o = 1; o < 64; o <<= 1) cnt += __shfl_xor(cnt, o);
        if (lane == 0 && cnt) atomicAdd((int*)scr + 9, cnt);
        __syncthreads();
        b.jlo = ((int*)scr)[9] / KVBLK;
    }
    __syncthreads();
}

#define ROWK(p, ld, k0, rr) ((p) + (size_t)((k0) + (rr)) * (ld) + sc)
#define VMW() asm volatile("s_waitcnt vmcnt(0)" ::: "memory")
#define VMWN(n) asm volatile("s_waitcnt vmcnt(%0)" :: "i"(n) : "memory")
#define SLOAD_H(Kp, Vp, ld, k0) do { S.st_v0 = load8(ROWK(Vp, ld, k0, sr)); S.st_v1 = load8(ROWK(Vp, ld, k0, 32 + sr));              \
                         S.st_k0 = load8(ROWK(Kp, ld, k0, sr)); S.st_k1 = load8(ROWK(Kp, ld, k0, 32 + sr)); } while (0)
#define SWRITE_HK(bf) do { *(bf16x8*)(K_lds + (bf) * SHM_K + kws) = S.st_k0; *(bf16x8*)(K_lds + (bf) * SHM_K + kws + 32 * 256) = S.st_k1; } while (0)
#define SWRITE_HV(bf) do { *(bf16x8*)(V_lds + (bf) * SHM_V + vst0) = S.st_v0; *(bf16x8*)(V_lds + (bf) * SHM_V + vst1) = S.st_v1; } while (0)
#define SWRITE_H(bf) do { SWRITE_HV(bf); SWRITE_HK(bf); } while (0)
#define QROWP(b_) ((b_).Q + (size_t)((wid * QBLK + r32) & ((b_).nrows - 1)) * (b_).ldq + hi * 8)
__device__ __forceinline__ void att_prime(const Blk& cur, char* lds, Seam& S, int g_wave) {
    const int tid = opaque_tid();
    const int wid = __builtin_amdgcn_readfirstlane(tid >> 6), lane = tid & 63, r32 = lane & 31, hi = lane >> 5;
    const int sr = tid >> 4, sc = (tid & 15) * 8, kws = KSWZ(sr, sc * 2); char* K_lds = lds + 2 * SHM_V;
    const bf16_t* qp = QROWP(cur);
#pragma unroll
    for (int d0 = 0; d0 < 8; ++d0) S.qr[d0] = load8(qp + d0 * 16);
    SLOAD_H(cur.K, cur.V, cur.ldkv, cur.jlo * KVBLK); VMW(); SWRITE_HK(0);
    __syncthreads();
}
__device__ __forceinline__ void att_block(const Blk& cur, const Blk& nxt, char* lds, Seam& S, int g_wave) {
    const int tid = opaque_tid();
    const int wid = __builtin_amdgcn_readfirstlane(tid >> 6), lane = tid & 63, r32 = lane & 31, hi = lane >> 5;
    constexpr int W = WINF;
    const int j_lo = cur.jlo, NT = blk_jhi(cur) - j_lo;
    const int qlo = cur.P0 + wid * QBLK, qm = qlo + r32 - 4 * hi; const bool wact = wid * QBLK < cur.nrows;
    char* V_lds = lds; char* K_lds = lds + 2 * SHM_V;
    float* ws = (float*)(lds + 2 * SHM_V + 2 * SHM_K) + wid * 64; float* li_l = ws, * al_l = ws + 32;
    const float* bos = (const float*)(lds + BOS_OFF + cur.bsel * BOS_BYTES) + 4 * hi;
    float m_reg = -1e30f, l_reg = 0; f32x16 o[4] = {};
    const int sr = tid >> 4, sc = (tid & 15) * 8, vst0 = v_st(sr, sc), vst1 = v_st(32 + sr, sc), kws = KSWZ(sr, sc * 2);
    const int vb0 = (int)(uintptr_t)V_lds + v_rd_base(lane);
    const bf16_t* Kh = cur.K; const bf16_t* Vh = cur.V; const int ldkv = cur.ldkv;
#define RESC(a) do { if (__any((a) < 1.f)) { if (hi == 0) al_l[r32] = (a); asm volatile("s_waitcnt lgkmcnt(0)" ::: "memory");              \
                     for (int d_ = 0; d_ < 4; ++d_) for (int r = 0; r < 16; ++r) o[d_][r] *= al_l[crow(r, hi)]; } } while (0)
#define KBASE(t) ((j_lo + (t)) * KVBLK)
#define MASKT(P0_, P1_, t) do { const int kb_ = KBASE(t); if (kb_ + KVBLK - 1 > qlo) mask_tile(P0_, P1_, qm - kb_, (unsigned)W); } while (0)
    constexpr int NQL = 8;
#define SEAM_K0() do { VMWN(NQL); SWRITE_HK(0); SBAR(); } while (0)
    f32x16 pA0, pA1, pB0, pB1; float mnA, mnB, alA, alB; bf16x8 pa0, pa1, pa2, pa3;
    SWRITE_HV(0); SBAR();
    if (NT > 1) SLOAD_H(Kh, Vh, ldkv, KBASE(1));
    SBAR(); qkt<0, true>(pA0, pA1, K_lds, r32, hi, S.qr, bos + KBASE(0), wact);
    MASKT(pA0, pA1, 0); partialSM(pA0, pA1, m_reg, mnA, alA);
    if (NT > 1) { VMW(); SWRITE_H(1); }
    __syncthreads();
#define HALF_STEP(PX0, PX1, mnX, alX, PY0, PY1, alY, t, KB, VB, SB) do {                                                      \
        SBAR(); qkt<KB, true>(PX0, PX1, K_lds, r32, hi, S.qr, bos + KBASE(t), wact);                                                \
        finishSM(PY0, PY1, alY, l_reg, pa0, pa1, pa2, pa3); SBAR();                                                           \
        if ((t) + 1 < NT) { SLOAD_H(Kh, Vh, ldkv, KBASE((t) + 1)); SBAR(); }                                                  \
        pv_tile<VB>(o, vb0, pa0, pa1, pa2, pa3, wact); MASKT(PX0, PX1, (t)); partialSM(PX0, PX1, m_reg, mnX, alX);                  \
        __syncthreads();                                                                                                      \
        if ((t) + 1 < NT) { VMW(); SWRITE_H(SB); }                                                                            \
        RESC(alX); __syncthreads(); } while (0)
    for (int t = 1; t + 1 < NT; t += 2) {
        HALF_STEP(pB0, pB1, mnB, alB, pA0, pA1, alA, t, 1, 0, 0);
        HALF_STEP(pA0, pA1, mnA, alA, pB0, pB1, alB, t + 1, 0, 1, 1);
    }
    const bool even = (NT & 1) == 0;
    if (even) { SBAR(); qkt<1, true>(pB0, pB1, K_lds, r32, hi, S.qr, bos + KBASE(NT - 1), wact); SBAR(); }
    SLOAD_H(nxt.K, nxt.V, nxt.ldkv, nxt.jlo * KVBLK); SBAR();
    { const bf16_t* qp = QROWP(nxt);
#pragma unroll
      for (int d0 = 0; d0 < 8; ++d0) S.qr[d0] = load8(qp + d0 * 16); }
    SBAR();
    finishSM(pA0, pA1, alA, l_reg, pa0, pa1, pa2, pa3); SBAR();
    pv_tile<0>(o, vb0, pa0, pa1, pa2, pa3, wact);
    if (even) { MASKT(pB0, pB1, NT - 1); partialSM(pB0, pB1, m_reg, mnB, alB); __syncthreads(); RESC(alB);
        finishSM(pB0, pB1, alB, l_reg, pa0, pa1, pa2, pa3); SBAR(); pv_tile<1>(o, vb0, pa0, pa1, pa2, pa3, wact); }
    SBAR(); SEAM_K0();
    if (hi == 0) li_l[r32] = l_reg; asm volatile("s_waitcnt lgkmcnt(0)" ::: "memory");
    float rli[16];
#pragma unroll
    for (int r = 0; r < 16; ++r) rli[r] = __builtin_amdgcn_rcpf(li_l[crow(r, hi)]);
    if (wid * QBLK < cur.nrows) {
        bf16_t* Ow = cur.O + (size_t)(wid * QBLK) * cur.ldo;
#pragma unroll
        for (int r = 0; r < 16; ++r) { const int orow = crow(r, hi);
#pragma unroll
            for (int d0 = 0; d0 < 4; ++d0) { const float v = o[d0][r] * rli[r]; const float vn = __shfl_xor(v, 1);
                if ((r32 & 1) == 0) *(unsigned*)(Ow + (size_t)orow * cur.ldo + d0 * 32 + r32) = cvtpk(v, vn); } }
    }
    __syncthreads();
#undef RESC
#undef MASKT
#undef SEAM_K0
#undef HALF_STEP
}

__device__ __forceinline__ void sb_block(const Blk& b, char* lds, int g_wave) {
    const int tid = opaque_tid();
    const int wid = __builtin_amdgcn_readfirstlane(tid >> 6), lane = tid & 63, r32 = lane & 31, hi = lane >> 5;
    char* V_lds = lds; char* K_lds = lds + 2 * SHM_V; int* flags = (int*)(lds + 2 * SHM_V + 2 * SHM_K);
    const int sr = tid >> 4, sc = (tid & 15) * 8, vst0 = v_st(sr, sc), vst1 = v_st(32 + sr, sc), kws = KSWZ(sr, sc * 2);
    const int vb0 = (int)(uintptr_t)V_lds + v_rd_base(lane);
    bf16x8 qr[8];
    { const bf16_t* qp = QROWP(b);
#pragma unroll
      for (int d0 = 0; d0 < 8; ++d0) qr[d0] = load8(qp + d0 * 16); }
    const int NT = blk_jhi(b), qlo = b.P0 + wid * QBLK, pos = qlo + r32;
    bool wdead = wid * QBLK >= b.nrows;
    float prun = 1.f; f32x16 o[4] = {};
    constexpr float C2 = 1.4426950408889634f * SCALE;
    const int nf = b.nf; bf16x8 k0, k1, v0, v1; f32x4 fk[4], fv[4];
#define SB_LOAD(kn) do { if ((kn) < nf) { const float* pk_ = b.Kf + (size_t)((kn) + sr) * AW + sc; const float* pv_ = b.Vf + (size_t)((kn) + sr) * AW + sc; \
            fk[0] = *(const f32x4*)pk_; fk[1] = *(const f32x4*)(pk_ + 4); fk[2] = *(const f32x4*)(pk_ + 32 * AW); fk[3] = *(const f32x4*)(pk_ + 32 * AW + 4); \
            fv[0] = *(const f32x4*)pv_; fv[1] = *(const f32x4*)(pv_ + 4); fv[2] = *(const f32x4*)(pv_ + 32 * AW); fv[3] = *(const f32x4*)(pv_ + 32 * AW + 4); } \
        else { k0 = load8(ROWK(b.K, b.ldkv, (kn), sr)); k1 = load8(ROWK(b.K, b.ldkv, (kn), 32 + sr)); v0 = load8(ROWK(b.V, b.ldkv, (kn), sr)); v1 = load8(ROWK(b.V, b.ldkv, (kn), 32 + sr)); } } while (0)
    SB_LOAD((NT - 1) * KVBLK);
    for (int t = NT - 1; t >= 0; --t) {
        const int kb = t * KVBLK;
        __syncthreads();
        if (kb < nf) { k0 = pack8(fk[0], fk[1]); k1 = pack8(fk[2], fk[3]); v0 = pack8(fv[0], fv[1]); v1 = pack8(fv[2], fv[3]); }
        *(bf16x8*)(K_lds + kws) = k0; *(bf16x8*)(K_lds + kws + 32 * 256) = k1; *(bf16x8*)(V_lds + vst0) = v0; *(bf16x8*)(V_lds + vst1) = v1;
        __syncthreads();
        if (t > 0) { const int kn = kb - KVBLK;
            SB_LOAD(kn); }
        if (!wdead && kb < qlo + QBLK - 1) {
            f32x16 p0, p1; qkt<0, false>(p0, p1, K_lds, r32, hi, qr, nullptr);
            if (kb + KVBLK - 1 >= qlo) {
                const float NEG = -__builtin_inff();
#pragma unroll
                for (int r = 0; r < 16; ++r) { const int key = kb + crow(r, hi); if (key >= pos) p0[r] = NEG; if (key + 32 >= pos) p1[r] = NEG; }
            }
#pragma unroll
            for (int r = 0; r < 16; ++r) {
                p0[r] = __builtin_amdgcn_rcpf(1.f + __builtin_amdgcn_exp2f(fminf(p0[r] * C2, 60.f))); p1[r] = __builtin_amdgcn_rcpf(1.f + __builtin_amdgcn_exp2f(fminf(p1[r] * C2, 60.f))); }
            float gl[8], gu[8];
#pragma unroll
            for (int g = 0; g < 8; ++g) { const float gp = g < 4 ? (p0[4 * g] * p0[4 * g + 1]) * (p0[4 * g + 2] * p0[4 * g + 3]) : (p1[4 * g - 16] * p1[4 * g - 15]) * (p1[4 * g - 14] * p1[4 * g - 13]);
                auto x = __builtin_amdgcn_permlane32_swap(__float_as_uint(gp), __float_as_uint(gp), false, false); gl[g] = __uint_as_float(x[0]); gu[g] = __uint_as_float(x[1]); }
            float s = 1.f, sown[8];
#pragma unroll
            for (int g = 7; g >= 0; --g) { const float su = s; s *= gu[g]; const float sl = s; s *= gl[g]; sown[g] = hi ? su : sl; }
#define SB_EL(P, q) do { const float rr_ = P[q]; P[q] = (1.f - rr_) * tt; tt *= rr_; } while (0)
#pragma unroll
            for (int g = 0; g < 8; ++g) { float tt = sown[g] * prun;
                if (g < 4) { const int q = 4 * g; SB_EL(p0, q + 3); SB_EL(p0, q + 2); SB_EL(p0, q + 1); SB_EL(p0, q); }
                else { const int q = 4 * g - 16; SB_EL(p1, q + 3); SB_EL(p1, q + 2); SB_EL(p1, q + 1); SB_EL(p1, q); } }
#undef SB_EL
            prun *= s;
            bf16x8 pa0, pa1, pa2, pa3;
            PK4(p0, 0, pa0); PK4(p0, 8, pa1); PK4(p1, 0, pa2); PK4(p1, 8, pa3);
            pv_tile<0>(o, vb0, pa0, pa1, pa2, pa3);
            wdead = __all(prun < 9.1e-13f);
        }
        if (lane == 0) flags[wid] = wdead ? 1 : 0;
        __syncthreads();
        const int alld = flags[0] & flags[1] & flags[2] & flags[3] & flags[4] & flags[5] & flags[6] & flags[7];
        if (alld) break;
    }
    if (wid * QBLK < b.nrows) {
        bf16_t* Ow = b.O + (size_t)(wid * QBLK) * b.ldo;
#pragma unroll
        for (int r = 0; r < 16; ++r) { const int orow = crow(r, hi);
#pragma unroll
            for (int d0 = 0; d0 < 4; ++d0) { const float v = o[d0][r]; const float vn = __shfl_xor(v, 1);
                if ((r32 & 1) == 0) *(unsigned*)(Ow + (size_t)orow * b.ldo + d0 * 32 + r32) = cvtpk(v, vn); } }
    }
    __syncthreads();
}

__device__ __forceinline__ void small_block(const Blk& bin, char* lds, int g_wave) {
    Blk b = bin; b.bsel = 0; prepare_bias(b, lds, g_wave);
    const int tid = opaque_tid();
    const int wid = __builtin_amdgcn_readfirstlane(tid >> 6), lane = tid & 63, r32 = lane & 31, hi = lane >> 5;
    char* V_lds = lds; char* K_lds = lds + 2 * SHM_V;
    float* ws = (float*)(lds + 2 * SHM_V + 2 * SHM_K) + wid * 64; float* li_l = ws, * al_l = ws + 32;
    const float* bos = (const float*)(lds + BOS_OFF) + 4 * hi;
    const int sr = tid >> 4, sc = (tid & 15) * 8, vst0 = v_st(sr, sc), vst1 = v_st(32 + sr, sc), kws = KSWZ(sr, sc * 2);
    const int vb0 = (int)(uintptr_t)V_lds + v_rd_base(lane);
    const int NT = blk_jhi(b), qlo = b.P0 + wid * QBLK, qm = qlo + r32 - 4 * hi; const bool wact = wid * QBLK < b.nrows;
    bf16x8 qr[8];
    { const bf16_t* qp = QROWP(b);
#pragma unroll
      for (int d0 = 0; d0 < 8; ++d0) qr[d0] = load8(qp + d0 * 16); }
    const int nf = b.nf, ldf = b.ldf; bf16x8 k0, k1, v0, v1; f32x4 fk[4], fv[4];
#define SM_LOAD(kn) do { if ((kn) < nf) { const float* pk_ = b.Kf + (size_t)((kn) + sr) * ldf + sc; const float* pv_ = b.Vf + (size_t)((kn) + sr) * ldf + sc; \
            fk[0] = *(const f32x4*)pk_; fk[1] = *(const f32x4*)(pk_ + 4); fk[2] = *(const f32x4*)(pk_ + (size_t)32 * ldf); fk[3] = *(const f32x4*)(pk_ + (size_t)32 * ldf + 4); \
            fv[0] = *(const f32x4*)pv_; fv[1] = *(const f32x4*)(pv_ + 4); fv[2] = *(const f32x4*)(pv_ + (size_t)32 * ldf); fv[3] = *(const f32x4*)(pv_ + (size_t)32 * ldf + 4); } \
        else { k0 = load8(ROWK(b.K, b.ldkv, (kn), sr)); k1 = load8(ROWK(b.K, b.ldkv, (kn), 32 + sr)); v0 = load8(ROWK(b.V, b.ldkv, (kn), sr)); v1 = load8(ROWK(b.V, b.ldkv, (kn), 32 + sr)); } } while (0)
    SM_LOAD(0);
    float m_reg = -1e30f, l_reg = 0.f; f32x16 o[4] = {};
    for (int t = 0; t < NT; ++t) {
        const int kb = t * KVBLK;
        __syncthreads();
        if (kb < nf) { k0 = pack8(fk[0], fk[1]); k1 = pack8(fk[2], fk[3]); v0 = pack8(fv[0], fv[1]); v1 = pack8(fv[2], fv[3]); }
        *(bf16x8*)(K_lds + kws) = k0; *(bf16x8*)(K_lds + kws + 32 * 256) = k1; *(bf16x8*)(V_lds + vst0) = v0; *(bf16x8*)(V_lds + vst1) = v1;
        __syncthreads();
        if (t + 1 < NT) SM_LOAD(kb + KVBLK);
        if (wact) {
            f32x16 p0, p1; qkt<0, true>(p0, p1, K_lds, r32, hi, qr, bos + kb);
            if (kb + KVBLK - 1 > qlo) mask_tile(p0, p1, qm - kb, (unsigned)WINF);
            float mn, al; partialSM(p0, p1, m_reg, mn, al);
            if (__any(al < 1.f)) { if (hi == 0) al_l[r32] = al; asm volatile("s_waitcnt lgkmcnt(0)" ::: "memory");
#pragma unroll
                for (int d_ = 0; d_ < 4; ++d_)
#pragma unroll
                    for (int r = 0; r < 16; ++r) o[d_][r] *= al_l[crow(r, hi)]; }
            bf16x8 pa0, pa1, pa2, pa3; finishSM(p0, p1, al, l_reg, pa0, pa1, pa2, pa3);
            pv_tile<0>(o, vb0, pa0, pa1, pa2, pa3);
        }
    }
    if (wact) {
        if (hi == 0) li_l[r32] = l_reg; asm volatile("s_waitcnt lgkmcnt(0)" ::: "memory");
        bf16_t* Ow = b.O + (size_t)(wid * QBLK) * b.ldo;
#pragma unroll
        for (int r = 0; r < 16; ++r) { const int orow = crow(r, hi); const float rl = __builtin_amdgcn_rcpf(li_l[orow]);
#pragma unroll
            for (int d0 = 0; d0 < 4; ++d0) { const float v = o[d0][r] * rl; const float vn = __shfl_xor(v, 1);
                if ((r32 & 1) == 0) *(unsigned*)(Ow + (size_t)orow * b.ldo + d0 * 32 + r32) = cvtpk(v, vn); } }
    }
    __syncthreads();
#undef SM_LOAD
}
#undef SB_LOAD
#undef ROWK
#undef VMW
#undef VMWN
#undef SLOAD_H
#undef SWRITE_HK
#undef SWRITE_HV
#undef SWRITE_H
#undef QROWP
#undef PK4
#undef KSWZ
#undef KBASE
}

namespace gla {
constexpr int ZQ = 0, ZK = GKW, ZV = 2 * GKW, ZR = 2 * GKW + GVW, ZG = 5120;
constexpr int KP = 72, QP = 200;
constexpr int L_G = 0;
constexpr int L_GLOW = 49152;
constexpr int L_TOT = 53248;
constexpr int L_QP = 54272;
constexpr int L_KPB = L_QP + 64 * QP * 2;
constexpr int L_AB = L_KPB + 64 * QP * 2;
constexpr int L_VT = L_AB + 64 * KP * 2;
constexpr int L_RS = L_VT + 128 * KP * 2;
constexpr int L_ST = 0;
constexpr int L1_KD = 54272;
constexpr int L1_VT = L1_KD + 192 * KP * 2;
static_assert(L_RS + 1024 <= LDS_WORK && L1_VT + 384 * KP * 2 <= LDS_WORK, "GLA LDS map");

__device__ __forceinline__ int chunk_row0(int c) { return c < TP / 64 ? c * 64 : TP + (c - TP / 64) * 64; }

__device__ __forceinline__ void decay_scan(const bf16_t* z, const float* wg2, const float* bg, int row0, int h, char* lds, int tid) {
    float* G = (float*)(lds + L_G); float* glow = (float*)(lds + L_GLOW); float* tot = (float*)(lds + L_TOT);
    const int k = tid % 192, half = tid / 192; float w[16];
#pragma unroll
    for (int j = 0; j < 16; ++j) w[j] = wg2[(size_t)j * GKW + h * GDK + k];
    const float b = bg[h * GDK + k];
    for (int i = tid; i < 64 * 16; i += 512) glow[i] = bf2f(z[(size_t)(row0 + (i >> 4)) * ZLD + ZG + (i & 15)]);
    __syncthreads();
    if (tid < 384) {
        float g = 0.f;
        for (int s = half * 32; s < half * 32 + 32; ++s) { float a = b;
#pragma unroll
            for (int j = 0; j < 16; ++j) a += glow[s * 16 + j] * w[j];
            g += (fminf(a, 0.f) - __logf(1.f + __expf(-fabsf(a)))) * (1.0f / 16.0f); G[s * GDK + k] = g; }
        if (half == 0) tot[k] = g;
    }
    __syncthreads();
}

__device__ __forceinline__ void g1_unit(int c, int h, const bf16_t* z, const float* wg2, const float* bg, bf16_t* UT, float* DEC, char* lds, int g_wave) {
    const int tid = opaque_tid(); const int row0 = chunk_row0(c);
    bf16_t kpre[3][8]; u32x4 vpre[6];
#pragma unroll
    for (int j = 0; j < 3; ++j) { const int it = tid + 512 * j, k = it % 192, sb = it / 192;
#pragma unroll
        for (int i = 0; i < 8; ++i) kpre[j][i] = z[(size_t)(row0 + sb * 8 + i) * ZLD + ZK + h * GDK + k]; }
#pragma unroll
    for (int j = 0; j < 6; ++j) { const int it = tid + 512 * j, s = it & 63, vb = it >> 6; vpre[j] = *(const u32x4*)(z + (size_t)(row0 + s) * ZLD + ZV + h * GDV + vb * 8); }
    decay_scan(z, wg2, bg, row0, h, lds, tid);
    const float* G = (const float*)(lds + L_G); const float* tot = (const float*)(lds + L_TOT);
    bf16_t* KD = (bf16_t*)(lds + L1_KD); bf16_t* VT = (bf16_t*)(lds + L1_VT);
#pragma unroll
    for (int j = 0; j < 3; ++j) {
        const int it = tid + 512 * j, k = it % 192, sb = it / 192; const float t0 = tot[k], glast = G[63 * GDK + k] + t0; float v[8];
#pragma unroll
        for (int i = 0; i < 8; ++i) { const int s = sb * 8 + i; const float g = G[s * GDK + k] + (s >= 32 ? t0 : 0.f);
            v[i] = bf2f(kpre[j][i]) * __expf(glast - g); }
        u32x4 w = {cvtpk(v[0], v[1]), cvtpk(v[2], v[3]), cvtpk(v[4], v[5]), cvtpk(v[6], v[7])};
        *(u32x4*)(KD + k * KP + sb * 8) = w;
        if (sb == 0) DEC[(size_t)(c * GH + h) * GDK + k] = __expf(glast);
    }
#pragma unroll
    for (int j = 0; j < 6; ++j) {
        const int it = tid + 512 * j, s = it & 63, vb = it >> 6; const u32x4 w = vpre[j];
#pragma unroll
        for (int i = 0; i < 4; ++i) { VT[(vb * 8 + 2 * i) * KP + s] = (bf16_t)(w[i] & 0xffffu); VT[(vb * 8 + 2 * i + 1) * KP + s] = (bf16_t)(w[i] >> 16); }
    }
    __syncthreads();
    const int wid = tid >> 6, lane = tid & 63, l32 = lane & 31, hi = lane >> 5, mq = wid & 3, nh = wid >> 2;
    f32x16 acc[3][3];
#pragma unroll
    for (int i = 0; i < 3; ++i)
#pragma unroll
        for (int j = 0; j < 3; ++j) acc[i][j] = f32x16{};
#pragma unroll
    for (int ks = 0; ks < 4; ++ks) { bf16x8 a[3], bb[3];
#pragma unroll
        for (int i = 0; i < 3; ++i) { a[i] = *(const bf16x8*)(VT + ((mq * 3 + i) * 32 + l32) * KP + ks * 16 + hi * 8); bb[i] = *(const bf16x8*)(KD + ((nh * 3 + i) * 32 + l32) * KP + ks * 16 + hi * 8); }
#pragma unroll
        for (int i = 0; i < 3; ++i)
#pragma unroll
            for (int j = 0; j < 3; ++j) acc[i][j] = __builtin_amdgcn_mfma_f32_32x32x16_bf16(a[i], bb[j], acc[i][j], 0, 0, 0); }
    bf16_t* out = UT + (size_t)(c * GH + h) * GDV * GDK;
#pragma unroll
    for (int i = 0; i < 3; ++i)
#pragma unroll
        for (int j = 0; j < 3; ++j)
#pragma unroll
            for (int r = 0; r < 16; ++r) { const float v = acc[i][j][r], vn = __shfl_xor(v, 1);
                if ((l32 & 1) == 0) *(unsigned*)(out + (size_t)((mq * 3 + i) * 32 + att::crow(r, hi)) * GDK + (nh * 3 + j) * 32 + l32) = cvtpk(v, vn); }
    __syncthreads();
}

__device__ __forceinline__ void g2_tile(int tile, bf16_t* UT, const float* DEC, const float* s0in, float* outp, float* outs, char* lds, int tid) {
    const int h = tile / 36, vt = (tile % 36) / 3, kt = tile % 3, vi = tid >> 4, kg = tid & 15, v = vt * 32 + vi, k = kt * 64 + kg * 4;
    float* T = (float*)lds;
    const size_t cstride = (size_t)GH * GDV * GDK; bf16_t* up = UT + ((size_t)h * GDV + v) * GDK + k; const float* dp = DEC + h * GDK + k;
    float zz = 0.f; asm volatile("" : "+v"(zz)); f32x4 S = {zz, zz, zz, zz};
#define G2_LOAD(U, D, c0_) do { _Pragma("unroll") for (int i = 0; i < 8; ++i) { U[i] = *(const u32x2*)(up + (size_t)((c0_) + i) * cstride); D[i] = *(const f32x4*)(dp + (size_t)((c0_) + i) * GH * GDK); } } while (0)
#define G2_STEP(U, D, c0_) do { _Pragma("unroll") for (int i = 0; i < 8; ++i) { u32x2 w = {cvtpk(S[0], S[1]), cvtpk(S[2], S[3])}; *(u32x2*)(up + (size_t)((c0_) + i) * cstride) = w; \
        const f32x4 u_ = {__uint_as_float(U[i][0] << 16), __uint_as_float(U[i][0] & 0xffff0000u), __uint_as_float(U[i][1] << 16), __uint_as_float(U[i][1] & 0xffff0000u)}; S = D[i] * S + u_; } } while (0)
    { u32x2 ua[8], ub[8], uc[8]; f32x4 da[8], db[8], dc[8];
      constexpr int NCH = TP / 64;
      static_assert(NCH % 24 == 8, "scan loop: 5 x 3 batches + 1");
      G2_LOAD(ua, da, 0); G2_LOAD(ub, db, 8);
      for (int c0 = 0; c0 + 24 <= NCH; c0 += 24) { G2_LOAD(uc, dc, c0 + 16); G2_STEP(ua, da, c0); G2_LOAD(ua, da, c0 + 24); G2_STEP(ub, db, c0 + 8); if (c0 + 32 < NCH) G2_LOAD(ub, db, c0 + 32); G2_STEP(uc, dc, c0 + 16); }
      G2_STEP(ua, da, NCH - 8); }
#undef G2_LOAD
#undef G2_STEP
    const int kr = tid >> 3, v4 = (tid & 7) * 4;
    T[(kg * 4 + 0) * 33 + vi] = S[0]; T[(kg * 4 + 1) * 33 + vi] = S[1]; T[(kg * 4 + 2) * 33 + vi] = S[2]; T[(kg * 4 + 3) * 33 + vi] = S[3];
    __syncthreads();
    { f32x4 o = {T[kr * 33 + v4], T[kr * 33 + v4 + 1], T[kr * 33 + v4 + 2], T[kr * 33 + v4 + 3]}; *(f32x4*)(outp + ((size_t)h * GDK + kt * 64 + kr) * GDV + vt * 32 + v4) = o; }
    __syncthreads();
    for (int b = 0; b < NB; ++b) {
        const int c = TP / 64 + b; const size_t sb = ((size_t)b * GH + h) * GDK * GDV;
        { const f32x4 i4 = *(const f32x4*)(s0in + sb + (size_t)(kt * 64 + kr) * GDV + vt * 32 + v4); T[kr * 33 + v4] = i4[0]; T[kr * 33 + v4 + 1] = i4[1]; T[kr * 33 + v4 + 2] = i4[2]; T[kr * 33 + v4 + 3] = i4[3]; }
        __syncthreads();
        f32x4 s0 = {T[(kg * 4 + 0) * 33 + vi], T[(kg * 4 + 1) * 33 + vi], T[(kg * 4 + 2) * 33 + vi], T[(kg * 4 + 3) * 33 + vi]};
        const u32x2 uw = *(const u32x2*)(up + (size_t)c * cstride); const f32x4 u = {__uint_as_float(uw[0] << 16), __uint_as_float(uw[0] & 0xffff0000u), __uint_as_float(uw[1] << 16), __uint_as_float(uw[1] & 0xffff0000u)};
        const f32x4 d = *(const f32x4*)(dp + (size_t)c * GH * GDK);
        { u32x2 w = {cvtpk(s0[0], s0[1]), cvtpk(s0[2], s0[3])}; *(u32x2*)(up + (size_t)c * cstride) = w; } const f32x4 sn = d * s0 + u;
        __syncthreads();
        T[(kg * 4 + 0) * 33 + vi] = sn[0]; T[(kg * 4 + 1) * 33 + vi] = sn[1]; T[(kg * 4 + 2) * 33 + vi] = sn[2]; T[(kg * 4 + 3) * 33 + vi] = sn[3];
        __syncthreads();
        { f32x4 o = {T[kr * 33 + v4], T[kr * 33 + v4 + 1], T[kr * 33 + v4 + 2], T[kr * 33 + v4 + 3]}; *(f32x4*)(outs + sb + (size_t)(kt * 64 + kr) * GDV + vt * 32 + v4) = o; }
        __syncthreads();
    }
}

__device__ __forceinline__ void state_transpose(const float* s0, bf16_t* out, char* lds, int tid) {
    float* T = (float*)lds; const int r = tid >> 3, c8 = (tid & 7) * 8;
    for (int t = 0; t < (GDK / 64) * (GDV / 64); ++t) { const int k0 = (t / (GDV / 64)) * 64, v0 = (t % (GDV / 64)) * 64;
        const f32x4 a = *(const f32x4*)(s0 + (size_t)(k0 + r) * GDV + v0 + c8), b = *(const f32x4*)(s0 + (size_t)(k0 + r) * GDV + v0 + c8 + 4);
        __syncthreads();
#pragma unroll
        for (int i = 0; i < 4; ++i) { T[r * 65 + c8 + i] = a[i]; T[r * 65 + c8 + 4 + i] = b[i]; }
        __syncthreads();
        float x[8];
#pragma unroll
        for (int i = 0; i < 8; ++i) x[i] = T[(c8 + i) * 65 + r];
        u32x4 w = {cvtpk(x[0], x[1]), cvtpk(x[2], x[3]), cvtpk(x[4], x[5]), cvtpk(x[6], x[7])};
        *(u32x4*)(out + (size_t)(v0 + r) * GDK + k0 + c8) = w; }
    asm volatile("s_waitcnt vmcnt(0)" ::: "memory"); __syncthreads();
}

__device__ __forceinline__ void g3_unit(int c, int h, const bf16_t* z, const float* wg2, const float* bg, const bf16_t* UT, const float* ng, const float* br, bf16_t* oc, char* lds, int g_wave) {
    const int tid = opaque_tid(); const int row0 = chunk_row0(c);
    u32x4 qpre[3], kpre[3];
#pragma unroll
    for (int j = 0; j < 3; ++j) { const int it = tid + 512 * j, s = it / 24, kb = (it % 24) * 8; qpre[j] = *(const u32x4*)(z + (size_t)(row0 + s) * ZLD + ZQ + h * GDK + kb); kpre[j] = *(const u32x4*)(z + (size_t)(row0 + s) * ZLD + ZK + h * GDK + kb); }
    decay_scan(z, wg2, bg, row0, h, lds, tid);
    const float* G = (const float*)(lds + L_G); const float* tot = (const float*)(lds + L_TOT);
    bf16_t* Qp = (bf16_t*)(lds + L_QP); bf16_t* Kp = (bf16_t*)(lds + L_KPB); bf16_t* Ab = (bf16_t*)(lds + L_AB); bf16_t* VT = (bf16_t*)(lds + L_VT); bf16_t* ST = (bf16_t*)(lds + L_ST);
    float* RS = (float*)(lds + L_RS);
    const float qs = 0.07216878364870322f;
#pragma unroll
    for (int j = 0; j < 3; ++j) {
        const int it = tid + 512 * j, s = it / 24, kb = (it % 24) * 8; float g[8];
#pragma unroll
        for (int i = 0; i < 8; ++i) g[i] = G[s * GDK + kb + i] + (s >= 32 ? tot[kb + i] : 0.f);
        const u32x4 qw = qpre[j], kw = kpre[j];
        u32x4 qo, ko;
#pragma unroll
        for (int i = 0; i < 4; ++i) { const float e0 = __expf(g[2 * i]), e1 = __expf(g[2 * i + 1]);
            qo[i] = cvtpk(__uint_as_float(qw[i] << 16) * qs * e0, __uint_as_float(qw[i] & 0xffff0000u) * qs * e1);
            ko[i] = cvtpk(__uint_as_float(kw[i] << 16) * __builtin_amdgcn_rcpf(e0), __uint_as_float(kw[i] & 0xffff0000u) * __builtin_amdgcn_rcpf(e1)); }
        *(u32x4*)(Qp + s * QP + kb) = qo; *(u32x4*)(Kp + s * QP + kb) = ko;
    }
    __syncthreads();
    const int wid = tid >> 6, lane = tid & 63, l32 = lane & 31, hi = lane >> 5;
    const int mt = wid & 1, nt = wid >> 1;
    f32x16 oacc[3];
    const bf16_t* Sb = UT + (size_t)(c * GH + h) * GDV * GDK;
    u32x4 stp[6], vtp[2];
#define G3_LOAD(vs_) do { _Pragma("unroll") for (int j = 0; j < 6; ++j) { const int it = tid + 512 * j, v = it / 24, kb = (it % 24) * 8; stp[j] = *(const u32x4*)(Sb + (size_t)((vs_) * 128 + v) * GDK + kb); } \
        _Pragma("unroll") for (int j = 0; j < 2; ++j) { const int it = tid + 512 * j, s = it & 63, vb = it >> 6; vtp[j] = *(const u32x4*)(z + (size_t)(row0 + s) * ZLD + ZV + h * GDV + (vs_) * 128 + vb * 8); } } while (0)
    G3_LOAD(0);
    if (wid < 4) {
        const int mt = wid & 1, nt = wid >> 1; f32x16 a = f32x16{};
        if (nt <= mt) {
#pragma unroll
            for (int ks = 0; ks < 12; ++ks) { const bf16x8 x = *(const bf16x8*)(Qp + (mt * 32 + l32) * QP + ks * 16 + hi * 8), y = *(const bf16x8*)(Kp + (nt * 32 + l32) * QP + ks * 16 + hi * 8);
                a = __builtin_amdgcn_mfma_f32_32x32x16_bf16(x, y, a, 0, 0, 0); }
        }
#pragma unroll
        for (int r = 0; r < 16; ++r) { const int t = mt * 32 + att::crow(r, hi), s = nt * 32 + l32; const float v = (s <= t) ? a[r] : 0.f; Ab[t * KP + s] = (bf16_t)(cvtpk(v, 0.f) & 0xffffu); }
    }
    __syncthreads();
#pragma unroll
    for (int vs = 0; vs < 3; ++vs) {
#pragma unroll
        for (int j = 0; j < 6; ++j) { const int it = tid + 512 * j, v = it / 24, kb = (it % 24) * 8; *(u32x4*)(ST + v * QP + kb) = stp[j]; }
#pragma unroll
        for (int j = 0; j < 2; ++j) { const int it = tid + 512 * j, s = it & 63, vb = it >> 6; const u32x4 w = vtp[j];
#pragma unroll
            for (int i = 0; i < 4; ++i) { VT[(vb * 8 + 2 * i) * KP + s] = (bf16_t)(w[i] & 0xffffu); VT[(vb * 8 + 2 * i + 1) * KP + s] = (bf16_t)(w[i] >> 16); } }
        __syncthreads();
        if (vs < 2) G3_LOAD(vs + 1);
        f32x16 a = f32x16{};
#pragma unroll
        for (int ks = 0; ks < 12; ++ks) { const bf16x8 x = *(const bf16x8*)(Qp + (mt * 32 + l32) * QP + ks * 16 + hi * 8), y = *(const bf16x8*)(ST + (nt * 32 + l32) * QP + ks * 16 + hi * 8);
            a = __builtin_amdgcn_mfma_f32_32x32x16_bf16(x, y, a, 0, 0, 0); }
#pragma unroll
        for (int ks = 0; ks < 4; ++ks) { const bf16x8 x = *(const bf16x8*)(Ab + (mt * 32 + l32) * KP + ks * 16 + hi * 8), y = *(const bf16x8*)(VT + (nt * 32 + l32) * KP + ks * 16 + hi * 8);
            a = __builtin_amdgcn_mfma_f32_32x32x16_bf16(x, y, a, 0, 0, 0); }
        oacc[vs] = a;
        __syncthreads();
    }
#undef G3_LOAD
#pragma unroll
    for (int r = 0; r < 16; ++r) { float q = oacc[0][r] * oacc[0][r] + oacc[1][r] * oacc[1][r] + oacc[2][r] * oacc[2][r];
        q += __shfl_xor(q, 1); q += __shfl_xor(q, 2); q += __shfl_xor(q, 4); q += __shfl_xor(q, 8); q += __shfl_xor(q, 16);
        if (l32 == 0) RS[(mt * 32 + att::crow(r, hi)) * 4 + nt] = q; }
    __syncthreads();
#pragma unroll
    for (int r = 0; r < 16; ++r) { const int t = mt * 32 + att::crow(r, hi); const f32x4 q4 = *(const f32x4*)(RS + t * 4);
        const float rstd = rsqrtf(((q4[0] + q4[1]) + (q4[2] + q4[3])) * (1.0f / GDV) + RMS_EPS);
#pragma unroll
        for (int vs = 0; vs < 3; ++vs) { const int cv = h * GDV + vs * 128 + nt * 32 + l32;
            const float gate = bf2f(z[(size_t)(row0 + t) * ZLD + ZR + cv]) + br[cv]; const float sg = gate / (1.f + __expf(-gate));
            const float val = oacc[vs][r] * rstd * ng[cv] * sg; const float vn = __shfl_xor(val, 1);
            if ((l32 & 1) == 0) *(unsigned*)(oc + (size_t)(row0 + t) * DM + cv) = cvtpk(val, vn); } }
    __syncthreads();
}
}

__device__ __forceinline__ int in_rowmap(int kind, int c) {
    if (kind == 0) return c < 4608 ? c : (c < 4620 ? 5120 + (c - 4608) : 4608 + (c - 4620));
    if (kind == 2) return c < 4608 ? c : (c < 4624 ? 5120 + (c - 4608) : 4608 + (c - 4624));
    return c;
}
constexpr int TR_SCR = 64 * 65 * 4;
struct TrItem { const float* W; bf16_t* WT; const float* gain; int K, N, kind, item; };
__device__ __forceinline__ bool tr_geom(const TrItem& t, int& k0, int& n0) {
    const int nblk = (t.N + 63) >> 6, kq = t.K >> 8, sb = t.item >> 4, e = t.item & 15, kb = (sb % kq) * 4 + (e & 3), nb = (sb / kq) * 4 + (e >> 2); k0 = 64 * kb; n0 = 64 * nb; return nb < nblk;
}
__device__ __forceinline__ void tr_load(const TrItem& t, float (&v)[64], int lane) {
    int k0, n0; if (!tr_geom(t, k0, n0)) return;
    const int nn = n0 + lane; const float* src = t.W + (size_t)k0 * t.N + (nn < t.N ? nn : 0);
#pragma unroll
    for (int i = 0; i < 64; ++i) v[i] = __builtin_nontemporal_load(src + (size_t)i * t.N);
}
__device__ __forceinline__ void tr_store(const TrItem& t, float (&v)[64], float* scr, int lane) {
    int k0, n0; if (!tr_geom(t, k0, n0)) return;
    const bool ok = n0 + lane < t.N;
    if (t.gain) {
#pragma unroll
        for (int i = 0; i < 64; ++i) v[i] *= t.gain[k0 + i];
    }
#pragma unroll
    for (int i = 0; i < 64; ++i) scr[i * 65 + lane] = ok ? v[i] : 0.f;
    LDS_WAIT(); asm volatile("" ::: "memory");
    const int c = lane & 7;
#pragma unroll
    for (int j = 0; j < 8; ++j) { const int n = (lane >> 3) + 8 * j; const float* s = scr + (8 * c) * 65 + n;
        if (n0 + n < t.N) { u32x4 o; o[0] = cvtpk(s[0 * 65], s[1 * 65]); o[1] = cvtpk(s[2 * 65], s[3 * 65]); o[2] = cvtpk(s[4 * 65], s[5 * 65]); o[3] = cvtpk(s[6 * 65], s[7 * 65]);
            *(u32x4*)(t.WT + (size_t)in_rowmap(t.kind, n0 + n) * t.K + k0 + 8 * c) = o; } }
    LDS_WAIT(); asm volatile("" ::: "memory");
}
template <int NF4>
__device__ __forceinline__ void cvt_row2(const float* s0, bf16_t* d0, const float* s1, bf16_t* d1, int lane) {
    f32x4 a[NF4], b[NF4];
#pragma unroll
    for (int q = 0; q < NF4; ++q) { a[q] = __builtin_nontemporal_load((const f32x4*)(s0 + q * 256 + lane * 4)); b[q] = __builtin_nontemporal_load((const f32x4*)(s1 + q * 256 + lane * 4)); }
#pragma unroll
    for (int q = 0; q < NF4; ++q) { u32x2 w = {cvtpk(a[q][0], a[q][1]), cvtpk(a[q][2], a[q][3])}; *(u32x2*)(d0 + q * 256 + lane * 4) = w;
        u32x2 x = {cvtpk(b[q][0], b[q][1]), cvtpk(b[q][2], b[q][3])}; *(u32x2*)(d1 + q * 256 + lane * 4) = x; }
}

#ifndef EN_MASK
#define EN_MASK 0xFFFF
#endif
#define EN(k) ((EN_MASK >> (k)) & 1)
template <int V> struct IC { static constexpr int value = V; };
struct Args { const float* in[29]; float* out; unsigned char* ws; int ph_lo, ph_hi; };
constexpr int PPL = 9;
constexpr int PH_FINAL = 1 + PPL * NLAYER, PH_END = PH_FINAL + 1;
constexpr int PT_OFF = MISC_OFF + 256;
__device__ __forceinline__ unsigned long long ptab_raw(const char* lds, int k) {
    const unsigned long long v = ((const unsigned long long*)(lds + PT_OFF))[k];
    const unsigned l = __builtin_amdgcn_readfirstlane((unsigned)v), h = __builtin_amdgcn_readfirstlane((unsigned)(v >> 32));
    return ((unsigned long long)h << 32) | l;
}
#define PIN(k) ((const float*)(const GAS float*)ptab_raw(lds, (k)))
#define POUT() ((float*)(GAS float*)ptab_raw(lds, 29))
#define PWS() ((unsigned char*)(GAS unsigned char*)ptab_raw(lds, 30))
#define WSP(T, off) ((T*)(ws + (off)))

__device__ __forceinline__ int queue_fetch(unsigned* qhead, volatile LAS unsigned* MISC, int g_wave) {
    if (opaque_tid() == 0) MISC[16] = __hip_atomic_fetch_add(qhead, 1u, __ATOMIC_RELAXED, __HIP_MEMORY_SCOPE_AGENT);
    __syncthreads(); const int v = (int)MISC[16]; __syncthreads(); return __builtin_amdgcn_readfirstlane(v);
}
__device__ __forceinline__ void convert_weights(int Ld, int Ln, int cs, char* lds, unsigned char* ws, unsigned* qh, volatile LAS unsigned* MISC, int g_wave) {
    const int Lq = Ln < 0 ? 0 : Ln, Lp = Ld < 0 ? 0 : Ld, kind = Lq % 3, j = Lq / 3, tid = opaque_tid(), lane = tid & 63, wave = tid >> 6;
    const int nin = kind == 0 ? 5132 : (kind == 1 ? 5120 : 5136);
    const int hn = Ln >= 0 ? 1 : 0, n0 = 128 * ((((nin + 63) / 64) + 3) / 4);
    const int m0 = Ld >= 0 ? 128 * 32 : 0, m1 = m0 + hn * 32 * 32, m2 = m1 + hn * 32 * 128, m3 = m2 + hn * 32 * 16, total = m3 + hn * n0, nchunks = (total + cs - 1) / cs, ipw = cs >> 3;
    float* scr = (float*)(lds + wave * TR_SCR);
    auto mk = [&](int it, TrItem& t) -> bool {
        if (it >= total) return false;
        if (it < m0) { t.W = PIN(28) + (size_t)Lp * DFF * DM; t.K = DFF; t.N = DM; t.WT = WSP(bf16_t, WS_WDN) + (size_t)Lp * DM * DFF; t.kind = 1; t.gain = nullptr; t.item = it; }
        else if (it < m1) { t.W = kind == 0 ? PIN(18) + (size_t)j * DM * DM : (kind == 1 ? PIN(20) : PIN(26)); t.K = DM; t.N = DM; t.WT = WSP(bf16_t, WS_WOUT) + (size_t)Lq * DM * DM; t.kind = 1; t.gain = nullptr; t.item = it - m0; }
        else if (it < m2) { t.W = PIN(27) + (size_t)Lq * DM * DFF; t.K = DM; t.N = DFF; t.WT = WSP(bf16_t, WS_WUP) + (size_t)Lq * DFF * DM; t.kind = 1; t.gain = PIN(12) + Lq * DM; t.item = it - m1; }
        else if (it < m3) { t.W = PIN(15) + (size_t)Lq * DM * 1024; t.K = DM; t.N = 1024; t.WT = WSP(bf16_t, WS_WMKV) + (size_t)Lq * 1024 * DM; t.kind = 1; t.gain = nullptr; t.item = it - m2; }
        else { t.W = kind == 0 ? PIN(16) + (size_t)j * DM * 5132 : (kind == 1 ? PIN(19) : PIN(21)); t.K = DM; t.N = nin; t.WT = WSP(bf16_t, WS_WIN) + (size_t)Lq * ZLD * DM; t.kind = kind; t.gain = PIN(11) + Lq * DM; t.item = it - m3; }
        return true;
    };
    for (;;) {
        const int chunk = queue_fetch(qh, MISC, g_wave); if (chunk >= nchunks) break;
        const int it0 = chunk * cs + wave * ipw; float va[64], vb[64]; TrItem ta, tb; bool oa = mk(it0, ta), ob;
        if (oa) tr_load(ta, va, lane);
#pragma unroll 1
        for (int i = 0; i < ipw; i += 2) {
            ob = mk(it0 + i + 1, tb); if (ob) tr_load(tb, vb, lane);
            if (oa) tr_store(ta, va, scr, lane);
            oa = i + 2 < ipw && mk(it0 + i + 2, ta); if (oa) tr_load(ta, va, lane);
            if (ob) tr_store(tb, vb, scr, lane);
        }
    }
}
__device__ __forceinline__ void convert_kv_cache(const float* ck, const float* cv, bf16_t* dk, bf16_t* dv, unsigned* qh, volatile LAS unsigned* MISC, int g_wave) {
    const int tid = opaque_tid(), lane = tid & 63, wave = tid >> 6;
    for (;;) {
        const int chunk = queue_fetch(qh, MISC, g_wave); if (chunk >= NB * PAST / 64) break;
#pragma unroll 2
        for (int i = 0; i < 8; ++i) { const int r = chunk * 64 + wave * 8 + i; const size_t so = (size_t)r * AW, dof = ((size_t)(r / PAST) * SKS + (r % PAST)) * AW;
            cvt_row2<6>(ck + so, dk + dof, cv + so, dv + dof, lane); }
    }
}

__global__ void __launch_bounds__(512, 2) trunk_fwd(Args args) {
    extern __shared__ __attribute__((aligned(16))) unsigned char lds_raw[];
    char* lds = (char*)lds_raw;
    volatile LAS unsigned* MISC = (volatile LAS unsigned*)((LAS unsigned char*)lds_raw + MISC_OFF);
    for (int u = threadIdx.x; u < 64; u += 512) MISC[u] = 0u;
    if (threadIdx.x < 29) ((unsigned long long*)(lds + PT_OFF))[threadIdx.x] = (unsigned long long)args.in[threadIdx.x];
    if (threadIdx.x == 29) ((unsigned long long*)(lds + PT_OFF))[29] = (unsigned long long)args.out;
    if (threadIdx.x == 30) ((unsigned long long*)(lds + PT_OFF))[30] = (unsigned long long)args.ws;
    const int g_wave = __builtin_amdgcn_readfirstlane(threadIdx.x >> 6);
    __syncthreads();
    const int G = gridDim.x, bx = blockIdx.x, vcu = (G % 8 == 0) ? (bx % 8) * (G / 8) + bx / 8 : bx;
#if !MK_PER_PHASE
    XcdBarrier bar = xcd_barrier_post((unsigned*)(args.ws + WS_CTL) + CW_BAR, MISC + 8); bar.wave = g_wave;
#define GRID_BAR() xcd_barrier(bar)
#else
#define GRID_BAR() do { } while (0)
#endif
    const int lo = args.ph_lo, hi = args.ph_hi;
#define IN(k) (lo <= (k) && (k) < hi)
#ifdef PROBE_TS_A
#define STAMP(k) do { if (bx == 0 && opaque_tid() == 0) ((unsigned long long*)((unsigned*)(PWS() + WS_CTL) + CW_TS))[(k) + 1] = __builtin_amdgcn_s_memrealtime(); } while (0)
#else
#define STAMP(k) do { } while (0)
#endif
#define SEAM(k) do { if ((k) + 1 < hi) GRID_BAR(); STAMP(k); } while (0)

    STAMP(-1);
    if (EN(0) && IN(0)) {
        unsigned char* ws = PWS();
        const int tid = opaque_tid(), lane = tid & 63, wave = tid >> 6, gw = vcu * 8 + wave, NGW = G * 8;
        float* scr = (float*)(lds + wave * 16384);
        convert_weights(-1, 0, 32, lds, ws, WSP(unsigned, WS_CTL) + CW_CONV, MISC, g_wave);
        { const float* xp = PIN(0); const float* xs = PIN(1); float* X = WSP(float, WS_X); bf16_t* XB = WSP(bf16_t, WS_XB); float* RSA = WSP(float, WS_RSS);
        for (int m = gw; m < MT; m += NGW) {
            const float* src = m < TP ? xp + (size_t)m * DM : xs + (size_t)(m - TP) * DM; float ss = 0.f;
#pragma unroll
            for (int q = 0; q < 8; ++q) { const int o = q * 256 + lane * 4; const f32x4 v = *(const f32x4*)(src + o);
                u32x2 w = {cvtpk(v[0], v[1]), cvtpk(v[2], v[3])}; *(u32x2*)(XB + (size_t)m * DM + o) = w; ss += (v[0] * v[0] + v[1] * v[1]) + (v[2] * v[2] + v[3] * v[3]); }
            ss = wave_sum(ss);
            if (lane < 32) RSA[(size_t)m * 32 + lane] = lane == 0 ? ss : 0.f;
        } }
        { const float* mp = PIN(10); const float* gm = PIN(13); bf16_t* MEMH = WSP(bf16_t, WS_MEMH);
        for (int it = gw; it < NLAYER * NMEM; it += NGW) { const int i = it / NMEM, r = it % NMEM; const float* src = mp + (size_t)r * DM; const float* g = gm + (size_t)i * DM;
            f32x4 v[8]; float ss = 0.f;
#pragma unroll
            for (int q = 0; q < 8; ++q) { v[q] = *(const f32x4*)(src + q * 256 + lane * 4); ss += (v[q][0] * v[q][0] + v[q][1] * v[q][1]) + (v[q][2] * v[q][2] + v[q][3] * v[q][3]); }
            const float rstd = rsqrtf(wave_sum(ss) * (1.0f / DM) + RMS_EPS);
#pragma unroll
            for (int q = 0; q < 8; ++q) { const f32x4 gg = *(const f32x4*)(g + q * 256 + lane * 4); u32x2 w = {cvtpk(v[q][0] * rstd * gg[0], v[q][1] * rstd * gg[1]), cvtpk(v[q][2] * rstd * gg[2], v[q][3] * rstd * gg[3])};
                *(u32x2*)(MEMH + ((size_t)i * NMEM + r) * DM + q * 256 + lane * 4) = w; } } }
        SEAM(0);
    }

    auto finalize = [&](int L, bool dn, bool fin, unsigned* ctr) {
        unsigned char* ws = PWS();
        const int tid = opaque_tid(), lane = tid & 63, wave = tid >> 6; const int SP = dn ? 16 : 8;
        float* rssw = WSP(float, WS_RSS) + (dn ? 0 : (size_t)MT * 32);
        bf16_t* XB = WSP(bf16_t, WS_XB); const float* part = WSP(float, WS_GU);
        const float* xin = (L == 0 && !dn) ? PIN(1) : nullptr;
        int r0 = vcu; asm volatile("" : "+s"(r0));
        for (int r = r0; r < TS; r += G) { const size_t o = (size_t)(TP + r) * DM + tid * 4; const float* pp = part + (size_t)r * DM + tid * 4;
            f32x4 a; if (xin) a = *(const f32x4*)(xin + (size_t)r * DM + tid * 4); else { const u32x2 w = *(const u32x2*)(XB + o); a = (f32x4){__uint_as_float(w[0] << 16), __uint_as_float(w[0] & 0xffff0000u), __uint_as_float(w[1] << 16), __uint_as_float(w[1] & 0xffff0000u)}; }
            f32x4 p[16];
#pragma unroll
            for (int s = 0; s < 16; ++s) p[s] = s < SP ? *(const f32x4*)(pp + (size_t)s * TS * DM) : (f32x4){0.f, 0.f, 0.f, 0.f};
#pragma unroll
            for (int s = 0; s < 16; ++s) a += p[s];
            const float ss = wave_sum((a[0] * a[0] + a[1] * a[1]) + (a[2] * a[2] + a[3] * a[3]));
            if (!fin) { u32x2 w = {cvtpk(a[0], a[1]), cvtpk(a[2], a[3])}; *(u32x2*)(XB + o) = w;
                if (lane < 4) rssw[(size_t)(TP + r) * 32 + wave + 8 * lane] = lane == 0 ? ss : 0.f; }
            else { if (lane == 0) MISC[32 + wave] = __float_as_uint(ss);
                __syncthreads();
                float tot = 0.f;
#pragma unroll
                for (int w8 = 0; w8 < 8; ++w8) tot += __uint_as_float(MISC[32 + w8]);
                __syncthreads();
                const float rstd = rsqrtf(tot * (1.0f / DM) + RMS_EPS); const f32x4 gg = *(const f32x4*)(PIN(14) + tid * 4);
                __builtin_nontemporal_store(a * rstd * gg, (f32x4*)(POUT() + O_YS + (size_t)r * DM + tid * 4)); }
        }
        if (ctr) { asm volatile("s_waitcnt vmcnt(0)" ::: "memory"); __syncthreads();
            if (tid == 0) (void)__hip_atomic_fetch_add(ctr, 1u, __ATOMIC_RELEASE, __HIP_MEMORY_SCOPE_AGENT); }
    };
    auto layer = [&](auto Lc) {
        constexpr int L = decltype(Lc)::value;
        const int kind = L % 3, j = L / 3, base = 1 + PPL * L;
        const bool att_in_g2 = kind == 2 && G >= 144 + NB * GH + 64;
        auto att_section = [&](int vc, int Gc) {
            unsigned char* ws = PWS();
            float* outp = POUT(); const float* lfc = PIN(4); const float* FL = WSP(float, WS_FL);
            const int nfox = kind == 0 ? 480 : 0, total = nfox + 160;
            unsigned long long hperm = 0;
            if (kind == 0) { const float* hsum = (const float*)(WSP(unsigned, WS_CTL) + CW_HS + j * 64); float hv[NH];
#pragma unroll
                for (int h = 0; h < NH; ++h) hv[h] = __builtin_amdgcn_readfirstlane(hsum[h]);
#pragma unroll
                for (int h = 0; h < NH; ++h) { int rank = 0;
#pragma unroll
                    for (int g = 0; g < NH; ++g) rank += (hv[g] > hv[h] || (hv[g] == hv[h] && g < h)) ? 1 : 0;
                    hperm |= (unsigned long long)h << (4 * rank); } }
            auto get = [&](int n, att::Blk& b) {
                int type, a0, a1;
                if (n < nfox) { if (n < 384) { type = 0; a0 = (int)((hperm >> (4 * (n >> 5))) & 15); a1 = 31 - (n & 31); } else { type = 1; a0 = (n - 384) / NH; a1 = (n - 384) % NH; } }
                else { const int m = n - nfox; if (m < 128) { type = 2; a0 = m / 32; a1 = m % 32; } else { type = 3; a0 = (m - 128) / MH; a1 = (m - 128) % MH; } }
                bf16_t* Z = WSP(bf16_t, WS_Z); bf16_t* OC = WSP(bf16_t, WS_OC);
                b.ldq = ZLD; b.ldo = DM; b.lf0 = b.lf1 = nullptr; b.n0 = 0; b.bmode = 0; b.qq = b.kq = nullptr; b.jlo = 0; b.bsel = 0; b.pre0 = 0; b.ls0 = 1; b.Kf = b.Vf = nullptr; b.nf = 0; b.ldf = AW;
                if (type == 0) { const int h = a0, qb = a1; b.Q = Z + (size_t)qb * 256 * ZLD + h * HD; b.K = Z + AW + h * HD; b.V = Z + 2 * AW + h * HD; b.ldkv = ZLD; b.O = OC + (size_t)qb * 256 * DM + h * HD;
                    b.P0 = qb * 256; b.skv = TP; b.nrows = 256; b.bmode = 1; b.lf0 = FL + (size_t)h * MT; b.ls0 = 1; b.n0 = 1 << 30; b.pre0 = 1;
                    b.qq = WSP(unsigned, WS_CTL) + CW_QQ + ((j * 32 + qb) * NH + h) * 4; b.kq = WSP(unsigned, WS_CTL) + CW_KQ + j * 64 + h * 4; }
                else if (type == 1) { const int bb = a0, h = a1; const bf16_t* fk = WSP(bf16_t, WS_KVF) + (size_t)(2 * j) * (KVS_ONE / 2);
                    b.Q = Z + (size_t)(TP + bb * 64) * ZLD + h * HD; b.K = fk + (size_t)bb * SKS * AW + h * HD; b.V = fk + KVS_ONE / 2 + (size_t)bb * SKS * AW + h * HD; b.ldkv = AW;
                    b.O = OC + (size_t)(TP + bb * 64) * DM + h * HD; b.P0 = PAST; b.skv = SKS; b.nrows = 64; b.bmode = 1; b.lf0 = lfc + ((size_t)j * NB + bb) * PAST * NH + h; b.ls0 = NH; b.n0 = PAST; b.lf1 = FL + (size_t)h * MT + TP + bb * 64;
                    b.nf = PAST; b.ldf = AW; b.Kf = PIN(2) + ((size_t)j * NB + bb) * PAST * AW + h * HD; b.Vf = PIN(3) + ((size_t)j * NB + bb) * PAST * AW + h * HD; }
                else if (type == 2) { const int h4 = a0, qb = a1; const bf16_t* mkb = WSP(bf16_t, WS_MKVB) + (size_t)L * NMEM * 1024;
                    b.Q = Z + (size_t)qb * 256 * ZLD + 4608 + h4 * HD; b.K = mkb + h4 * HD; b.V = mkb + MEMW + h4 * HD; b.ldkv = 1024; b.O = OC + (size_t)qb * 256 * DM + AW + h4 * HD;
                    b.P0 = 1 << 20; b.skv = NMEM; b.nrows = 256; }
                else { const int bb = a0, h4 = a1; const bf16_t* mck = WSP(bf16_t, WS_MEMC) + (size_t)(2 * L) * (MEMC_ONE / 2);
                    b.Q = Z + (size_t)(TP + bb * 64) * ZLD + 4608 + h4 * HD; b.K = mck + (size_t)bb * NMEM * MEMW + h4 * HD; b.V = mck + MEMC_ONE / 2 + (size_t)bb * NMEM * MEMW + h4 * HD; b.ldkv = MEMW;
                    b.O = OC + (size_t)(TP + bb * 64) * DM + AW + h4 * HD; b.P0 = 1 << 20; b.skv = NMEM; b.nrows = 64;
                    b.nf = NMEM; b.ldf = MEMW; b.Kf = PIN(8) + ((size_t)L * NB + bb) * NMEM * MEMW + h4 * HD; b.Vf = PIN(9) + ((size_t)L * NB + bb) * NMEM * MEMW + h4 * HD; }
            };
            unsigned* qhead = WSP(unsigned, WS_CTL) + CW_QUEUE + 64 * L;
            const int nfp = kind == 0 ? 384 : 0, nfs = kind == 0 ? 96 : 0, nmain = nfp + 128, nsmall = nfs + 32;
            if (EN(6)) for (int si = vc; si < nsmall; si += Gc) { att::Blk sbk; get(si < nfs ? nfp + si : nfp + nfs + 128 + (si - nfs), sbk); att::small_block(sbk, lds, g_wave); }
            { const bool t0 = opaque_tid() == 0; unsigned pend = 0; const bool dyn = kind == 1 || vc < nsmall; const int qb0 = kind == 1 ? 0 : (Gc > nsmall ? Gc - nsmall : 0);
                auto issue = [&]() { if (t0) pend = __hip_atomic_fetch_add(qhead, 1u, __ATOMIC_RELAXED, __HIP_MEMORY_SCOPE_AGENT); };
                auto take = [&]() -> int { if (t0) MISC[16] = pend; __syncthreads(); const int v = (int)MISC[16]; __syncthreads(); return qb0 + __builtin_amdgcn_readfirstlane(v); };
                auto main_n = [&](int m) -> int { return m < nfp ? m : m + nfs; };
                int first = vc - nsmall; if (dyn) { issue(); first = take(); }
                if (EN(6) && first < nmain) {
                att::Blk cur, nxt;
                issue();
                get(main_n(first), cur); cur.bsel = 0; att::prepare_bias(cur, lds, g_wave);
                att::Seam S; att::att_prime(cur, lds, S, g_wave);
                for (;;) { const int in_ = take(); const bool more = in_ < nmain;
                    if (more) { issue(); get(main_n(in_), nxt); nxt.bsel = cur.bsel ^ 1; att::prepare_bias(nxt, lds, g_wave); } else nxt = cur;
                    att::att_block(cur, nxt, lds, S, g_wave);
                    if (!more) break; cur = nxt; }
                } }
        };
        if (EN(1) && IN(base + 0)) {
            unsigned char* ws = PWS();
            const int tid = opaque_tid();
            pg8::Sched S; S.nM = MT / 256; S.nN = kind == 1 ? 20 : 21; S.nwg = S.nM * S.nN; S.G = G; S.c = bx; S.nextra = 4; S.nt = DM / 64; S.rdy = L > 0 ? WSP(unsigned, WS_CTL) + CW_FIN + 64 * (2 * L) : nullptr; S.need = (unsigned)G;
            S.A = (const char*)WSP(bf16_t, WS_XB); S.B = (const char*)(WSP(bf16_t, WS_WIN) + (size_t)L * ZLD * DM); S.tA = (size_t)256 * DM * 2; S.tB = (size_t)256 * DM * 2;
            S.Ae = (const char*)(WSP(bf16_t, WS_MEMH) + (size_t)L * NMEM * DM); S.Be = (const char*)(WSP(bf16_t, WS_WMKV) + (size_t)L * 1024 * DM); S.tAe = 0; S.tBe = (size_t)256 * DM * 2;
            pg8::EpiIn E; E.z = WSP(bf16_t, WS_Z); E.rss = WSP(float, WS_RSS); E.out = POUT(); E.mkvb = WSP(bf16_t, WS_MKVB); E.kind = kind; E.j = j; E.ml = L; E.ctl = (unsigned*)WSP(unsigned, WS_CTL); E.fl = WSP(float, WS_FL); E.dup = WSP(float, WS_GU);
            E.kvb = kind == 0 ? WSP(bf16_t, WS_KVF) + (size_t)(2 * j) * (KVS_ONE / 2) : WSP(bf16_t, WS_KVS); E.bfg = PIN(17) + j * NH;
            pg8::gemm_phase<pg8::EpiIn, pg8::Sched>((LAS unsigned char*)lds_raw, DM, DM, DM, S, E, tid);
            SEAM(base + 0);
        }
        if (IN(base + 1) && kind != 0) {
            unsigned char* ws = PWS();
            if (EN(2) && kind == 1) {
                bf16_t* Z = WSP(bf16_t, WS_Z); bf16_t* OC = WSP(bf16_t, WS_OC); bf16_t* KVS = WSP(bf16_t, WS_KVS);
                for (int n = vcu; n < 480; n += G) { att::Blk b; b.ldq = ZLD; b.ldo = DM; b.bmode = 0; b.lf0 = b.lf1 = nullptr; b.n0 = 0; b.qq = b.kq = nullptr; b.jlo = 0; b.bsel = 0; b.pre0 = 0; b.ls0 = 1; b.nf = 0; b.Kf = b.Vf = nullptr; b.ldf = AW;
                    if (n < 384) { const int h = n / 32, qb = n % 32; b.Q = Z + (size_t)qb * 256 * ZLD + h * HD; b.K = Z + AW + h * HD; b.V = Z + 2 * AW + h * HD; b.ldkv = ZLD;
                        b.O = OC + (size_t)qb * 256 * DM + h * HD; b.P0 = qb * 256; b.skv = TP; b.nrows = 256; }
                    else { const int m = n - 384, bb = m / NH, h = m % NH; b.Q = Z + (size_t)(TP + bb * 64) * ZLD + h * HD; b.K = KVS + (size_t)bb * SKS * AW + h * HD; b.V = KVS + KVS_ONE / 2 + (size_t)bb * SKS * AW + h * HD; b.ldkv = AW;
                        b.O = OC + (size_t)(TP + bb * 64) * DM + h * HD; b.P0 = PAST; b.skv = SKS; b.nrows = 64;
                        b.nf = PAST; b.Kf = PIN(5) + (size_t)bb * PAST * AW + h * HD; b.Vf = PIN(6) + (size_t)bb * PAST * AW + h * HD; }
                    att::sb_block(b, lds, g_wave); }
            } else if (EN(3) && kind == 2) {
                for (int u = vcu; u < NCHUNK * GH; u += G) gla::g1_unit(u / GH, u % GH, WSP(bf16_t, WS_Z), PIN(22), PIN(23), WSP(bf16_t, WS_GU), WSP(float, WS_GDEC), lds, g_wave);
            }
            if (kind != 1) SEAM(base + 1);
        }
        if (EN(4) && IN(base + 2) && kind == 2) {
            unsigned char* ws = PWS();
            const int tid = opaque_tid();
            if (vcu < 144) gla::g2_tile(vcu, WSP(bf16_t, WS_GU), WSP(float, WS_GDEC), PIN(7), POUT() + O_GSP, POUT() + O_GSS, lds, tid);
            __syncthreads();
            if (att_in_g2 && vcu >= 144 && vcu - 144 < NB * GH) {
                const int sb_ = (vcu - 144) / GH, sh_ = (vcu - 144) % GH;
                bf16_t* UTS = WSP(bf16_t, WS_MEMC);
                gla::state_transpose(PIN(7) + ((size_t)sb_ * GH + sh_) * GDK * GDV, UTS + ((size_t)sb_ * GH + sh_) * GDV * GDK, lds, opaque_tid());
                gla::g3_unit(TP / 64 + sb_, sh_, WSP(bf16_t, WS_Z), PIN(22), PIN(23), UTS - (size_t)(TP / 64) * GH * GDV * GDK, PIN(25), PIN(24), WSP(bf16_t, WS_OC), lds, g_wave); }
            if (att_in_g2 && vcu >= 144 + NB * GH) att_section(vcu - (144 + NB * GH), G - (144 + NB * GH));
            SEAM(base + 2);
        }
        if (IN(base + 3)) {
            unsigned char* ws = PWS();
            if (EN(5) && kind == 2) for (int u = vcu; u < (att_in_g2 ? (TP / 64) * GH : NCHUNK * GH); u += G) gla::g3_unit(u / GH, u % GH, WSP(bf16_t, WS_Z), PIN(22), PIN(23), WSP(bf16_t, WS_GU), PIN(25), PIN(24), WSP(bf16_t, WS_OC), lds, g_wave);
            float* outp = POUT(); const float* FL = WSP(float, WS_FL);
            if (!att_in_g2) att_section(vcu, G);
            if (kind == 0) {
                const int tid = opaque_tid();
                for (int e = vcu * 512 + tid; e < MT * NH; e += G * 512) { const int h = e / MT, row = e - h * MT; const float v = log_sigmoidf(FL[e]);
                    if (row < TP) outp[O_FLP + (size_t)j * TP * NH + (size_t)row * NH + h] = v; else outp[O_FLS + (size_t)j * TS * NH + (size_t)(row - TP) * NH + h] = v; }
            }
            SEAM(base + 3);
        }
        for (int q = 4; q <= 8; ++q) {
            if (q == 5 || !IN(base + q)) continue;
            if (q == 8) { if (EN(8)) finalize(L, true, L == NLAYER - 1, L + 1 < NLAYER ? (unsigned*)PWS() + CW_FIN + 64 * (2 * L + 2) : nullptr); continue; }
            unsigned char* ws = PWS();
            const bool dn = q == 7;
            float* rssw = WSP(float, WS_RSS) + (dn ? 0 : (size_t)MT * 32);
            const int SP = dn ? 16 : 8;
            if (q == 4 || q == 7) {
                if (EN(7)) {
                const int tid = opaque_tid();
                const int K = dn ? DFF : DM; const char* Ab = dn ? (const char*)WSP(bf16_t, WS_U) : (const char*)WSP(bf16_t, WS_OC);
                const char* Bb = dn ? (const char*)(WSP(bf16_t, WS_WDN) + (size_t)L * DM * DFF) : (const char*)(WSP(bf16_t, WS_WOUT) + (size_t)L * DM * DM);
                pg8::SchedRes S; S.S = SP; S.nu = 16 * SP; S.G = G; S.c = bx; S.ntm = K / 64; S.nts = K / SP / 64; S.A = Ab; S.B = Bb; S.tA = (size_t)256 * K * 2; S.tB = (size_t)256 * K * 2; S.kbytes = (size_t)(K / SP) * 2;
                pg8::EpiResPart E{pg8::EpiRes{(L == 0 && !dn) ? PIN(0) : nullptr, WSP(bf16_t, WS_XB), rssw}, pg8::EpiPart{WSP(float, WS_GU)}};
                pg8::gemm_phase<pg8::EpiResPart, pg8::SchedRes>((LAS unsigned char*)lds_raw, K, K, K, S, E, tid);
                }
            } else {
                if (EN(9)) {
                unsigned* fctr = WSP(unsigned, WS_CTL) + CW_FIN + 64 * (2 * L + 1);
                finalize(L, false, false, fctr);
                const int tid = opaque_tid();
                pg8::Sched S; S.nM = MT / 256; S.nN = DFF / 256; S.nwg = S.nM * S.nN; S.G = G; S.c = bx; S.nextra = 0; S.nt = DM / 64; S.rdy = fctr; S.need = (unsigned)G;
                S.A = (const char*)WSP(bf16_t, WS_XB); S.B = (const char*)(WSP(bf16_t, WS_WUP) + (size_t)L * DFF * DM); S.tA = (size_t)256 * DM * 2; S.tB = (size_t)256 * DM * 2; S.Ae = S.Be = nullptr; S.tAe = S.tBe = 0;
                pg8::EpiUp E{WSP(bf16_t, WS_U), WSP(float, WS_RSS) + (size_t)MT * 32};
                pg8::gemm_phase<pg8::EpiUp, pg8::Sched>((LAS unsigned char*)lds_raw, DM, DM, DM, S, E, tid);
                convert_weights(L, L + 1 < NLAYER ? L + 1 : -1, L + 1 < NLAYER ? 64 : 16, lds, ws, WSP(unsigned, WS_CTL) + CW_CONV + 64 * (L + 1 < NLAYER ? L + 1 : 6), MISC, g_wave);
                }
            }
            SEAM(base + q);
        }
    };
    layer(IC<0>{}); layer(IC<1>{}); layer(IC<2>{}); layer(IC<3>{});
    if (EN(10) && IN(PH_FINAL)) {
        unsigned char* ws = PWS(); float* out = POUT();
        const int tid = opaque_tid(), lane = tid & 63, wave = tid >> 6, gw = vcu * 8 + wave, NGW = G * 8;
        const float* g = PIN(14); const bf16_t* XB = WSP(bf16_t, WS_XB); const float* RSA = WSP(float, WS_RSS);
        for (int m = gw; m < TP; m += NGW) {
            const float rstd = rsqrtf(wave_sum(lane < 32 ? RSA[(size_t)m * 32 + lane] : 0.f) * (1.0f / DM) + RMS_EPS); float* dst = out + O_YP + (size_t)m * DM;
#pragma unroll
            for (int q = 0; q < 8; ++q) { const int o = q * 256 + lane * 4; const u32x2 w = *(const u32x2*)(XB + (size_t)m * DM + o); const f32x4 v = {__uint_as_float(w[0] << 16), __uint_as_float(w[0] & 0xffff0000u), __uint_as_float(w[1] << 16), __uint_as_float(w[1] & 0xffff0000u)}, gg = *(const f32x4*)(g + o);
                __builtin_nontemporal_store(v * rstd * gg, (f32x4*)(dst + o)); }
        }
    }
#ifdef PROBE_TS_A
    if (IN(PH_FINAL)) { GRID_BAR(); if (bx == 0 && opaque_tid() == 0) { const unsigned long long* ts = (const unsigned long long*)((unsigned*)(PWS() + WS_CTL) + CW_TS);
        POUT()[O_YP] = (float)(((ts[PROBE_TS_B + 1] - ts[PROBE_TS_A + 1]) / 2000) * 20 + 10) * 1000.0f; } }
#endif
#undef IN
#undef SEAM
#undef GRID_BAR
}

extern "C" void kernel_launch(void* const* d_in, const int* in_sizes, int n_in, void* d_out, int out_size, void* d_ws, size_t ws_size, hipStream_t stream) {
    static int grid = 0;
    if (grid == 0) {
        if (n_in != 29 || (size_t)out_size != O_END || ws_size < WS_END) { fprintf(stderr, "kernel_launch: unexpected shapes (n_in %d, out %d vs %zu, ws %zu vs %zu); nothing launched\n", n_in, out_size, (size_t)O_END, ws_size, (size_t)WS_END); grid = -1; return; }
        int dev = 0, cus = 0, per_cu = 0;
        if (hipGetDevice(&dev) != hipSuccess || hipDeviceGetAttribute(&cus, hipDeviceAttributeMultiprocessorCount, dev) != hipSuccess) { grid = -1; return; }
        if (hipFuncSetAttribute((const void*)trunk_fwd, hipFuncAttributeMaxDynamicSharedMemorySize, LDS_BYTES) != hipSuccess) { fprintf(stderr, "kernel_launch: hipFuncSetAttribute failed\n"); grid = -1; return; }
        if (hipOccupancyMaxActiveBlocksPerMultiprocessor(&per_cu, (const void*)trunk_fwd, 512, LDS_BYTES) != hipSuccess || per_cu < 1) fprintf(stderr, "kernel_launch: occupancy query reports %d workgroups per CU\n", per_cu);
        (void)hipGetLastError();
        grid = cus;
    }
    if (grid < 0) return;
    if (hipMemsetAsync((char*)d_ws + WS_CTL, 0, CTL_BYTES, stream) != hipSuccess) return;
    Args a{};
    for (int i = 0; i < 29; ++i) a.in[i] = (const float*)d_in[i];
    a.out = (float*)d_out; a.ws = (unsigned char*)d_ws;
#if MK_PER_PHASE
    for (int p = 0; p < PH_END; ++p) {
        if (p >= 1 && p < PH_FINAL) { const int L = (p - 1) / PPL, q = (p - 1) % PPL, kind = L % 3; if ((q == 1 && kind == 0) || (q == 2 && kind != 2) || q == 5) continue; }
        a.ph_lo = p; a.ph_hi = p + 1;
        hipLaunchKernelGGL(trunk_fwd, dim3(grid), dim3(512), LDS_BYTES, stream, a);
#ifdef PROBE_LO
        if (p == PROBE_HI - 1) { (void)hipMemsetAsync((char*)d_ws + WS_CTL + CW_QUEUE * 4, 0, 4 * 64 * 4, stream); }
        if (p == PROBE_HI - 1) for (int pp = PROBE_LO; pp < PROBE_HI; ++pp) { a.ph_lo = pp; a.ph_hi = pp + 1; hipLaunchKernelGGL(trunk_fwd, dim3(grid), dim3(512), LDS_BYTES, stream, a); }
#endif
    }
#else
    a.ph_lo = 0; a.ph_hi = PH_END;
    hipLaunchKernelGGL(trunk_fwd, dim3(grid), dim3(512), LDS_BYTES, stream, a);
#endif
}
```

```cpp
#include <hip/hip_runtime.h>
#include <hip/hip_bf16.h>
#include <cstdio>
#include <cstdint>

#define MK_PER_PHASE 0
#ifndef MK_PER_PHASE
#define MK_PER_PHASE 0
#endif

constexpr int DM = 2048, TP = 8192, TS = 512, MT = TP + TS, NB = 8, CSEQ = 64, PAST = 1024, SKS = PAST + CSEQ;
constexpr int HD = 128, NH = 12, AW = NH * HD, MEMW = 512, NMEM = 256, MH = 4;
constexpr int GH = 4, GDK = 192, GDV = 384, GKW = GH * GDK, GVW = GH * GDV, GRANK = 16;
constexpr int DFF = 8192, ZLD = 5376, NLAYER = 4;
constexpr int NCHUNK = TP / 64 + NB;
constexpr float RMS_EPS = 1e-6f;

constexpr size_t O_YP = 0;
constexpr size_t O_YS = O_YP + (size_t)TP * DM;
constexpr size_t O_FKP = O_YS + (size_t)TS * DM;
constexpr size_t O_FVP = O_FKP + (size_t)2 * TP * AW;
constexpr size_t O_FLP = O_FVP + (size_t)2 * TP * AW;
constexpr size_t O_SKP = O_FLP + (size_t)2 * TP * NH;
constexpr size_t O_SVP = O_SKP + (size_t)TP * AW;
constexpr size_t O_GSP = O_SVP + (size_t)TP * AW;
constexpr size_t O_MKP = O_GSP + (size_t)GH * GDK * GDV;
constexpr size_t O_MVP = O_MKP + (size_t)NLAYER * NMEM * MEMW;
constexpr size_t O_FKS = O_MVP + (size_t)NLAYER * NMEM * MEMW;
constexpr size_t O_FVS = O_FKS + (size_t)2 * TS * AW;
constexpr size_t O_FLS = O_FVS + (size_t)2 * TS * AW;
constexpr size_t O_SKS = O_FLS + (size_t)2 * TS * NH;
constexpr size_t O_SVS = O_SKS + (size_t)TS * AW;
constexpr size_t O_GSS = O_SVS + (size_t)TS * AW;
constexpr size_t O_END = O_GSS + (size_t)NB * GH * GDK * GDV;

constexpr size_t al256(size_t x) { return (x + 255) & ~(size_t)255; }
constexpr size_t WS_CTL = 0, CTL_BYTES = 2u << 20;
constexpr size_t WS_WIN = CTL_BYTES;
constexpr size_t WS_WOUT = WS_WIN + (size_t)NLAYER * ZLD * DM * 2;
constexpr size_t WS_WUP = WS_WOUT + (size_t)NLAYER * DM * DM * 2;
constexpr size_t WS_WDN = WS_WUP + (size_t)NLAYER * DFF * DM * 2;
constexpr size_t WS_WMKV = WS_WDN + (size_t)NLAYER * DM * DFF * 2;
constexpr size_t WS_X = WS_WMKV + (size_t)NLAYER * 1024 * DM * 2;
constexpr size_t WS_XB = WS_X + (size_t)MT * DM * 4;
constexpr size_t WS_Z = WS_XB + (size_t)MT * DM * 2;
constexpr size_t WS_OC = WS_Z + (size_t)MT * ZLD * 2;
constexpr size_t WS_U = WS_OC + (size_t)MT * DM * 2;
constexpr size_t WS_GU = WS_U + (size_t)MT * DFF * 2;
constexpr size_t WS_GDEC = WS_GU + (size_t)NCHUNK * GH * GDV * GDK * 4;
constexpr size_t WS_KVF = al256(WS_GDEC + (size_t)NCHUNK * GH * GDK * 4);
constexpr size_t KVS_ONE = (size_t)NB * SKS * AW * 2;
constexpr size_t WS_KVS = WS_KVF + 4 * KVS_ONE;
constexpr size_t WS_MEMC = WS_KVS + 2 * KVS_ONE;
constexpr size_t MEMC_ONE = (size_t)NB * NMEM * MEMW * 2;
constexpr size_t WS_MEMH = WS_MEMC + 8 * MEMC_ONE;
constexpr size_t WS_MKVB = WS_MEMH + (size_t)NLAYER * NMEM * DM * 2;
constexpr size_t WS_RSS = WS_MKVB + (size_t)NLAYER * NMEM * 1024 * 2;
constexpr size_t WS_FL = WS_RSS + (size_t)2 * MT * 32 * 4;
constexpr size_t WS_END = WS_FL + (size_t)MT * NH * 4;

constexpr int CW_BAR = 4096;
constexpr int CW_QUEUE = 8192;
constexpr int CW_KQ = 12288;
constexpr int CW_CONV = 20480;
constexpr int CW_HS = 12800;
constexpr int CW_FIN = 22528;
constexpr int CW_TS = 24576;
constexpr int CW_QQ = 16384;

constexpr int LDS_WORK = 136 * 1024;
constexpr int MISC_OFF = LDS_WORK;
constexpr int LDS_BYTES = 147456;

#define GAS __attribute__((address_space(1)))
#define LAS __attribute__((address_space(3)))
typedef unsigned short bf16_t;
typedef unsigned u32x4 __attribute__((ext_vector_type(4)));
typedef unsigned u32x2 __attribute__((ext_vector_type(2)));
typedef float f32x4 __attribute__((ext_vector_type(4)));
typedef float f32x2 __attribute__((ext_vector_type(2)));
typedef float f32x16 __attribute__((ext_vector_type(16)));
typedef short bf16x8 __attribute__((ext_vector_type(8)));
typedef short s16x4 __attribute__((ext_vector_type(4)));
#define LDS_WAIT() asm volatile("s_waitcnt lgkmcnt(0)" ::: "memory")
#define VM_WAIT() asm volatile("s_waitcnt vmcnt(0)" ::: "memory")
#define SBAR() __builtin_amdgcn_sched_barrier(0)
__device__ __forceinline__ unsigned cvtpk(float lo, float hi) { unsigned r; asm volatile("v_cvt_pk_bf16_f32 %0, %1, %2" : "=v"(r) : "v"(lo), "v"(hi)); return r; }
__device__ __forceinline__ float bf2f(unsigned short b) { return __uint_as_float((unsigned)b << 16); }
__device__ __forceinline__ u32x4 pack8u(f32x4 a, f32x4 b) { u32x4 w = {cvtpk(a[0], a[1]), cvtpk(a[2], a[3]), cvtpk(b[0], b[1]), cvtpk(b[2], b[3])}; return w; }
__device__ __forceinline__ bf16x8 pack8(f32x4 a, f32x4 b) { u32x4 w = pack8u(a, b); return *reinterpret_cast<bf16x8*>(&w); }
#define WS_SWZ(v, m) __int_as_float(__builtin_amdgcn_ds_swizzle(__float_as_int(v), ((m) << 10) | 0x1f))
__device__ __forceinline__ float wave_sum(float v) {
    v += WS_SWZ(v, 1); v += WS_SWZ(v, 2); v += WS_SWZ(v, 4); v += WS_SWZ(v, 8); v += WS_SWZ(v, 16);
    { auto rr = __builtin_amdgcn_permlane32_swap(__float_as_uint(v), __float_as_uint(v), false, false); v = __uint_as_float(rr[0]) + __uint_as_float(rr[1]); }
    return v;
}
__device__ __forceinline__ float log_sigmoidf(float x) { return fminf(x, 0.f) - log1pf(expf(-fabsf(x))); }
__device__ __forceinline__ float log_sigmoid_fast(float x) { return fminf(x, 0.f) - __logf(1.f + __expf(-fabsf(x))); }
__device__ __forceinline__ int opaque_tid_w(int wave) { int l; asm volatile("v_mbcnt_lo_u32_b32 %0, -1, 0\n\tv_mbcnt_hi_u32_b32 %0, -1, %0" : "=v"(l)); return wave * 64 + l; }
#define opaque_tid() opaque_tid_w(g_wave)
template <class T> __device__ __forceinline__ T* launder_s(T* p) { asm volatile("" : "+s"(p)); return p; }
#define XB_TMO      128
#define XB_XCNT(j)  (256  + 64 * (j))
#define XB_XSUB(j)  (1280 + 64 * (j))
#define XB_XGEN(j)  (2304 + 64 * (j))
#define XB_TOP      3328
#define XB_TOPGEN   3392
#define XCD_BAR_WORDS 3456
#define XB_SPIN_CAP (1u << 18)
__device__ __forceinline__ unsigned xb_ld(unsigned* p)              { return __hip_atomic_load(p, __ATOMIC_RELAXED, __HIP_MEMORY_SCOPE_AGENT); }
__device__ __forceinline__ unsigned xb_add(unsigned* p, unsigned v) { return __hip_atomic_fetch_add(p, v, __ATOMIC_RELAXED, __HIP_MEMORY_SCOPE_AGENT); }
__device__ __forceinline__ unsigned xb_xcc_id() { return (unsigned)__builtin_amdgcn_s_getreg((3 << 11) | 20) & 0xFu; }
#define XB_SPIN(cond, bar) do { unsigned _sp = 0; while (cond) { __builtin_amdgcn_s_sleep(1); \
    if ((++_sp & 255u) == 0u) { if (xb_ld(&(bar)[XB_TMO])) break; if (_sp > XB_SPIN_CAP) { atomicAdd(&(bar)[XB_TMO], 1u); break; } } } } while (0)
struct XcdBarrier { unsigned* bar; unsigned x; volatile LAS unsigned* st; int wave; };
__device__ __forceinline__ XcdBarrier xcd_barrier_post(unsigned* bar, volatile LAS unsigned* st) {
    XcdBarrier b; b.bar = bar; b.x = xb_xcc_id(); b.st = st;
    if (threadIdx.x == 0) (void)xb_add(&bar[XB_XCNT(b.x)], 1u);
    return b;
}
__device__ __forceinline__ void xcd_barrier_complete(unsigned* bar, unsigned x, unsigned& nloc, unsigned& nx) {
    const unsigned G = gridDim.x * gridDim.y * gridDim.z;
    unsigned sum, cnt, mine, sp = 0u;
    for (;;) {
        sum = 0u; cnt = 0u; mine = 0u;
#pragma unroll
        for (unsigned j = 0; j < 16; ++j) { const unsigned c = xb_ld(&bar[XB_XCNT(j)]); sum += c; cnt += (c > 0u) ? 1u : 0u; mine = (j == x) ? c : mine; }
        if (sum == G) break;
        __builtin_amdgcn_s_sleep(1);
        if ((++sp & 255u) == 0u) { if (xb_ld(&bar[XB_TMO])) break; if (sp > XB_SPIN_CAP) { atomicAdd(&bar[XB_TMO], 1u); break; } }
    }
    nloc = mine > 0u ? mine : 1u; nx = cnt > 0u ? cnt : 1u;
}
__device__ __forceinline__ void xcd_barrier(const XcdBarrier& b) {
    asm volatile("s_waitcnt vmcnt(0)" ::: "memory");
    __syncthreads();
    if (opaque_tid_w(b.wave) == 0) {
        unsigned* bar = b.bar;
        __builtin_amdgcn_s_waitcnt(0);
        unsigned nloc = b.st[0], nx = b.st[1];
        if (nloc == 0u) { xcd_barrier_complete(bar, b.x, nloc, nx); b.st[0] = nloc; b.st[1] = nx; }
        const unsigned old = xb_add(&bar[XB_XSUB(b.x)], 1u);
        const unsigned gen = old / nloc;
        if (old + 1u == (gen + 1u) * nloc) {
            __builtin_amdgcn_fence(__ATOMIC_RELEASE, "agent");
            asm volatile("s_waitcnt vmcnt(0)" ::: "memory");
            const unsigned og = xb_add(&bar[XB_TOP], 1u);
            const unsigned tg = og / nx;
            if (og + 1u == (tg + 1u) * nx) xb_add(&bar[XB_TOPGEN], 1u);
            else XB_SPIN(xb_ld(&bar[XB_TOPGEN]) == tg, bar);
            __builtin_amdgcn_fence(__ATOMIC_ACQUIRE, "agent");
            xb_add(&bar[XB_XGEN(b.x)], 1u);
            asm volatile("s_waitcnt vmcnt(0)" ::: "memory");
        } else {
            XB_SPIN(xb_ld(&bar[XB_XGEN(b.x)]) == gen, bar);
            __builtin_amdgcn_fence(__ATOMIC_ACQUIRE, "agent");
            asm volatile("s_waitcnt vmcnt(0)" ::: "memory");
        }
    }
    __syncthreads();
}

namespace pg8 {
constexpr int BM = 256, BK = 64, HALF = 128, HTB = HALF * BK * 2, STAGE_BYTES = 8 * HTB, NXCD = 8, WGM = 8;
__host__ __device__ __forceinline__ int lds_byte(int r, int c) { const int st = (r >> 4) * 2 + (c >> 5), rr = r & 15, cc = c & 31, ob = rr * 64 + cc * 2; return st * 1024 + (ob ^ (((ob >> 9) & 1) << 5)); }
__host__ __device__ __forceinline__ void stage_rc(int b, int& R, int& C) { const int st = b / 1024, sb = b % 1024, swz = sb ^ (((sb >> 9) & 1) << 5); R = (st >> 1) * 16 + swz / 64; C = (st & 1) * 32 + (swz % 64) / 2; }
__host__ __device__ __forceinline__ int perm32(int rho) { const int n = rho >> 4, i = rho & 15; return 8 * (i >> 2) + 4 * n + (i & 3); }

struct Unit { int pm, pn, g, nt; const char* A; const char* B; };

struct Sched {
    int nM, nN, nwg, G, c, nextra, nt;
    const char* A; const char* B; size_t tA, tB;
    const char* Ae; const char* Be; size_t tAe, tBe;
    unsigned* rdy; unsigned need;
    __device__ __forceinline__ bool waits(const Unit& u) const { return rdy != nullptr && u.g == 0 && u.pm >= TP / BM; }
    __device__ __forceinline__ void poll() const {
        unsigned sp = 0; while (__hip_atomic_load(rdy, __ATOMIC_RELAXED, __HIP_MEMORY_SCOPE_AGENT) < need) { __builtin_amdgcn_s_sleep(1); if (++sp > (1u << 22)) break; }
        __builtin_amdgcn_fence(__ATOMIC_ACQUIRE, "agent"); asm volatile("s_waitcnt vmcnt(0)" ::: "memory"); }
    __device__ __forceinline__ bool next(int i, Unit& u) const {
        const long L = (long)i * G + c; if (L >= nwg + nextra) return false;
        u.nt = nt;
        if (L >= nwg) { const int e = (int)(L - nwg); u.g = 1 + (e >> 2); u.pm = 0; u.pn = e & 3; u.A = Ae + (size_t)(e >> 2) * tAe; u.B = Be + (size_t)e * tBe; return true; }
        int wgid = (int)L; { const int q = nwg / NXCD, r = nwg % NXCD, xcd = wgid % NXCD, off = wgid / NXCD; wgid = (xcd < r ? xcd * (q + 1) : r * (q + 1) + (xcd - r) * q) + off; }
        const int nig = WGM * nN, gid = wgid / nig, fm = gid * WGM, gsz = (nM - fm) < WGM ? (nM - fm) : WGM;
        u.pm = fm + ((wgid % nig) % gsz); u.pn = (wgid % nig) / gsz; u.g = 0; u.A = A + (size_t)u.pm * tA; u.B = B + (size_t)u.pn * tB; return true;
    }
};

__device__ __forceinline__ void row_rstd8(const float* rss, int row0, int fq, float (&rs)[2][4]) {
    f32x4 a[2][4], b[2][4];
#pragma unroll
    for (int ai = 0; ai < 2; ++ai)
#pragma unroll
        for (int m = 0; m < 4; ++m) { const f32x4* p = (const f32x4*)(rss + (size_t)(row0 + ai * HALF + m * 16) * 32 + fq * 8); a[ai][m] = p[0]; b[ai][m] = p[1]; }
#pragma unroll
    for (int ai = 0; ai < 2; ++ai)
#pragma unroll
        for (int m = 0; m < 4; ++m) { const f32x4 v = a[ai][m] + b[ai][m]; float s = (v[0] + v[1]) + (v[2] + v[3]); s += __shfl_xor(s, 16); s += __shfl_xor(s, 32); rs[ai][m] = rsqrtf(s * (1.0f / DM) + RMS_EPS); }
}
__device__ __forceinline__ void rs_table(const LAS float* rst, int wr, int fr, float (&rs)[2][4]) {
#pragma unroll
    for (int ai = 0; ai < 2; ++ai)
#pragma unroll
        for (int m = 0; m < 4; ++m) rs[ai][m] = rst[wr * 64 + fr + ai * HALF + m * 16];
}
struct EpiIn {
    static constexpr bool PERM = true, AFTER_DRAIN = false, RSTD = true;
    bf16_t* z; const float* rss; float* out; bf16_t* kvb; bf16_t* mkvb; const float* bfg; unsigned* ctl; float* fl; float* dup; int kind, j, ml;
    __device__ __forceinline__ void operator()(const f32x4 (&acc)[2][2][4][2], const Unit& u, int wr, int wc, int fr, int fq, const LAS float* rst) const {
        asm volatile("" : "+v"(fr), "+v"(fq));
        const int row0 = u.pm * BM + wr * 64 + fr, colt = u.pn * BM, col0 = colt + wc * 32 + 8 * fq;
        if (u.g != 0) {
            const int e = ml; const bool isv = colt >= MEMW; float* of = out + (isv ? O_MVP : O_MKP) + (size_t)e * NMEM * MEMW; bf16_t* ob = mkvb + (size_t)e * NMEM * 1024;
#pragma unroll
            for (int ai = 0; ai < 2; ++ai)
#pragma unroll
                for (int m = 0; m < 4; ++m) { const int row = row0 + ai * HALF + m * 16;
#pragma unroll
                    for (int bj = 0; bj < 2; ++bj) { const int c = col0 + bj * HALF; const f32x4 v0 = acc[ai][bj][m][0], v1 = acc[ai][bj][m][1];
                        *(u32x4*)(ob + (size_t)row * 1024 + c) = pack8u(v0, v1);
                        float* o = of + (size_t)row * MEMW + (c - (isv ? MEMW : 0)); *(f32x4*)o = v0; *(f32x4*)(o + 4) = v1; } }
            return;
        }
        float rs[2][4]; rs_table(rst, wr, fr, rs);
        const bool kt = kind != 2 && colt >= AW && colt < 2 * AW, vt = kind != 2 && colt >= 2 * AW && colt < 3 * AW, smp = u.pm >= TP / BM;
        const int cbase = kt ? AW : 2 * AW;
        const size_t ocache = kind == 0 ? (smp ? (kt ? O_FKS : O_FVS) + (size_t)j * TS * AW : (kt ? O_FKP : O_FVP) + (size_t)j * TP * AW) : (smp ? (kt ? O_SKS : O_SVS) : (kt ? O_SKP : O_SVP));
        float* oc = out + ocache; bf16_t* kvs = kvb + (kt ? 0 : KVS_ONE / 2);
        const bool lft = kind == 0 && colt == 5120 && wc == 0 && fq < 2;
        const bool nrm = kind == 0 && !smp && colt < 2 * AW;
        float nmx[2] = {0.f, 0.f};
#pragma unroll
        for (int ai = 0; ai < 2; ++ai)
#pragma unroll
            for (int m = 0; m < 4; ++m) { const int row = row0 + ai * HALF + m * 16, rr = smp ? row - TP : row; const float sc = rs[ai][m];
#pragma unroll
                for (int bj = 0; bj < 2; ++bj) { const int c = col0 + bj * HALF; const f32x4 v0 = acc[ai][bj][m][0] * sc, v1 = acc[ai][bj][m][1] * sc; const u32x4 w = pack8u(v0, v1);
                    *(u32x4*)(z + (size_t)row * ZLD + c) = w;
                    if (nrm) { float q = (v0[0] * v0[0] + v0[1] * v0[1]) + (v0[2] * v0[2] + v0[3] * v0[3]) + (v1[0] * v1[0] + v1[1] * v1[1]) + (v1[2] * v1[2] + v1[3] * v1[3]);
                        q += __shfl_xor(q, 16); q += __shfl_xor(q, 32); nmx[bj] = fmaxf(nmx[bj], q); }
                    if (kt || vt) { const int cc = c - cbase; float* o = oc + (size_t)rr * AW + cc; __builtin_nontemporal_store(v0, (f32x4*)o); __builtin_nontemporal_store(v1, (f32x4*)(o + 4));
#ifdef PROBE_DUPKV
                        { float* o2 = dup + (size_t)row * AW + cc + (kt ? 0 : (size_t)MT * AW); *(f32x4*)o2 = v0; *(f32x4*)(o2 + 4) = v1; }
#endif
                        if (smp) *(u32x4*)(kvs + ((size_t)(rr >> 6) * SKS + PAST + (rr & 63)) * AW + cc) = w; }
                } }
        if (lft) {
            float bb[8], hs[8];
#pragma unroll
            for (int e = 0; e < 8; ++e) { bb[e] = bfg[(8 * fq + e) % NH]; hs[e] = 0.f; }
#pragma unroll
            for (int ai = 0; ai < 2; ++ai)
#pragma unroll
                for (int m = 0; m < 4; ++m) { const int row = row0 + ai * HALF + m * 16; const float sc = rs[ai][m]; float* o = fl + (size_t)(8 * fq) * MT + row;
                    f32x4 v0 = acc[ai][0][m][0] * sc, v1 = acc[ai][0][m][1] * sc;
#pragma unroll
                    for (int e = 0; e < 4; ++e) { v0[e] += bb[e]; v1[e] += bb[4 + e]; }
#pragma unroll
                    for (int e = 0; e < 4; ++e) { o[(size_t)e * MT] = v0[e]; if (fq == 0) o[(size_t)(4 + e) * MT] = v1[e]; }
#pragma unroll
                    for (int e = 0; e < 4; ++e) { hs[e] += v0[e]; hs[4 + e] += v1[e]; } }
            if (!smp) {
#pragma unroll
                for (int e = 0; e < 8; ++e) { float s = hs[e]; s += __shfl_xor(s, 1); s += __shfl_xor(s, 2); s += __shfl_xor(s, 4); s += __shfl_xor(s, 8);
                    if (fr == 0 && 8 * fq + e < NH) atomicAdd((float*)(ctl + CW_HS + j * 64) + 8 * fq + e, s); }
            }
        }
        if (nrm) {
#pragma unroll
            for (int bj = 0; bj < 2; ++bj) { float q = nmx[bj]; q = fmaxf(q, __shfl_xor(q, 1)); q = fmaxf(q, __shfl_xor(q, 2)); q = fmaxf(q, __shfl_xor(q, 4)); q = fmaxf(q, __shfl_xor(q, 8));
                if (fr == 0 && fq == 0) { const bool isq = colt < AW; const int h = (colt - (isq ? 0 : AW)) / HD + bj;
                    unsigned* t = isq ? ctl + CW_QQ + ((j * 32 + u.pm) * NH + h) * 4 + wc : ctl + CW_KQ + j * 64 + h * 4 + wc;
                    __hip_atomic_fetch_max(t, __float_as_uint(q), __ATOMIC_RELAXED, __HIP_MEMORY_SCOPE_AGENT); } }
        }
    }
};
struct EpiRes {
    static constexpr bool PERM = true, AFTER_DRAIN = false, RSTD = false;
    const float* base32; bf16_t* xb; float* rss;
    __device__ __forceinline__ void operator()(const f32x4 (&acc)[2][2][4][2], const Unit& u, int wr, int wc, int fr, int fq, const LAS float* rst) const {
        const int row0 = u.pm * BM + wr * 64 + fr, col0 = u.pn * BM + wc * 32 + 8 * fq;
#pragma unroll
        for (int ai = 0; ai < 2; ++ai)
#pragma unroll
            for (int m = 0; m < 4; ++m) { const int row = row0 + ai * HALF + m * 16; float ss = 0.f;
#pragma unroll
                for (int bj = 0; bj < 2; ++bj) { bf16_t* p = xb + (size_t)row * DM + col0 + bj * HALF; f32x4 a, b;
                    if (base32) { const float* pb = base32 + (size_t)row * DM + col0 + bj * HALF; a = *(const f32x4*)pb; b = *(const f32x4*)(pb + 4); }
                    else { const u32x4 w = *(const u32x4*)p; a = (f32x4){__uint_as_float(w[0] << 16), __uint_as_float(w[0] & 0xffff0000u), __uint_as_float(w[1] << 16), __uint_as_float(w[1] & 0xffff0000u)};
                           b = (f32x4){__uint_as_float(w[2] << 16), __uint_as_float(w[2] & 0xffff0000u), __uint_as_float(w[3] << 16), __uint_as_float(w[3] & 0xffff0000u)}; }
                    a += acc[ai][bj][m][0]; b += acc[ai][bj][m][1];
                    *(u32x4*)p = pack8u(a, b);
                    ss += (a[0] * a[0] + a[1] * a[1]) + (a[2] * a[2] + a[3] * a[3]) + (b[0] * b[0] + b[1] * b[1]) + (b[2] * b[2] + b[3] * b[3]); }
                ss += __shfl_xor(ss, 16); ss += __shfl_xor(ss, 32);
                if (fq == 0) rss[(size_t)row * 32 + u.pn * 4 + wc] = ss;
                if (m & 1) asm volatile("" ::: "memory"); }
    }
};
struct EpiUp {
    static constexpr bool PERM = true, AFTER_DRAIN = false, RSTD = true;
    bf16_t* o; const float* rss;
    __device__ __forceinline__ void operator()(const f32x4 (&acc)[2][2][4][2], const Unit& u, int wr, int wc, int fr, int fq, const LAS float* rst) const {
        const int row0 = u.pm * BM + wr * 64 + fr, col0 = u.pn * BM + wc * 32 + 8 * fq;
        float rs[2][4]; rs_table(rst, wr, fr, rs);
#pragma unroll
        for (int ai = 0; ai < 2; ++ai)
#pragma unroll
            for (int m = 0; m < 4; ++m) { const int row = row0 + ai * HALF + m * 16; const float sc = rs[ai][m];
#pragma unroll
                for (int bj = 0; bj < 2; ++bj) { f32x4 v0 = acc[ai][bj][m][0] * sc, v1 = acc[ai][bj][m][1] * sc;
#pragma unroll
                    for (int e = 0; e < 4; ++e) { const float a = fmaxf(v0[e], 0.f), b = fmaxf(v1[e], 0.f); v0[e] = a * a; v1[e] = b * b; }
                    *(u32x4*)(o + (size_t)row * DFF + col0 + bj * HALF) = pack8u(v0, v1); } }
    }
};

struct SchedRes {
    int S, nu, G, c, ntm, nts; const char* A; const char* B; size_t tA, tB, kbytes;
    __device__ __forceinline__ bool waits(const Unit&) const { return false; }
    __device__ __forceinline__ void poll() const {}
    __device__ __forceinline__ bool next(int i, Unit& u) const {
        const int L = i * G + c; constexpr int NMAIN = (TP / BM) * (DM / BM);
        if (L < NMAIN) { int wgid = L; { const int q = NMAIN / NXCD, xcd = wgid % NXCD, off = wgid / NXCD; wgid = xcd * q + off; }
            const int nig = WGM * (DM / BM), gid = wgid / nig, fm = gid * WGM; u.pm = fm + ((wgid % nig) % WGM); u.pn = (wgid % nig) / WGM; u.g = -1; u.nt = ntm;
            u.A = A + (size_t)u.pm * tA; u.B = B + (size_t)u.pn * tB; return true; }
        const int e = L - NMAIN; if (e >= nu) return false;
        const int tile = e / S, sp = e - tile * S; u.pm = TP / BM + (tile >> 3); u.pn = tile & 7; u.g = sp; u.nt = nts;
        u.A = A + (size_t)u.pm * tA + (size_t)sp * kbytes; u.B = B + (size_t)u.pn * tB + (size_t)sp * kbytes; return true;
    }
};
struct EpiPart {
    static constexpr bool PERM = true, AFTER_DRAIN = false, RSTD = false;
    float* part;
    __device__ __forceinline__ void operator()(const f32x4 (&acc)[2][2][4][2], const Unit& u, int wr, int wc, int fr, int fq, const LAS float* rst) const {
        const int row0 = (u.pm - TP / BM) * BM + wr * 64 + fr, col0 = u.pn * BM + wc * 32 + 8 * fq; float* base = part + (size_t)u.g * TS * DM;
#pragma unroll
        for (int ai = 0; ai < 2; ++ai)
#pragma unroll
            for (int m = 0; m < 4; ++m) { const int row = row0 + ai * HALF + m * 16;
#pragma unroll
                for (int bj = 0; bj < 2; ++bj) { float* p = base + (size_t)row * DM + col0 + bj * HALF; *(f32x4*)p = acc[ai][bj][m][0]; *(f32x4*)(p + 4) = acc[ai][bj][m][1]; } }
    }
};

struct EpiResPart {
    static constexpr bool PERM = true, AFTER_DRAIN = false, RSTD = false;
    EpiRes res; EpiPart part;
    __device__ __forceinline__ void operator()(const f32x4 (&acc)[2][2][4][2], const Unit& u, int wr, int wc, int fr, int fq, const LAS float* rst) const { if (u.g < 0) res(acc, u, wr, wc, fr, fq, rst); else part(acc, u, wr, wc, fr, fq, rst); }
};

template <class Epi, class Sch>
__device__ __forceinline__ void gemm_phase(LAS unsigned char* lds, const int K, const int lda, const int ldb, const Sch& S, const Epi& E, const int tid) {
    const int wid = __builtin_amdgcn_readfirstlane(tid >> 6), lane = tid & 63, wr = wid >> 2, wc = wid & 3, fr = lane & 15, fq = lane >> 4;
    unsigned voffA[2], voffB[2];
#pragma unroll
    for (int i = 0; i < 2; ++i) { int R, C; stage_rc(tid * 16 + i * 8192, R, C); const int Rb = Epi::PERM ? ((R & ~31) + perm32(R & 31)) : R;
        voffA[i] = (unsigned)(R * lda + C) * 2u; voffB[i] = (unsigned)(Rb * ldb + C) * 2u; }
    const size_t kstep = (size_t)(BK * 2);
    const size_t hstepA = (size_t)HALF * lda * 2, hstepB = (size_t)HALF * ldb * 2;
    const unsigned ldsw = (unsigned)wid * 1024u;
    const int aoff = lds_byte(wr * 64 + fr, fq * 8), boff = lds_byte(wc * 32 + fr, fq * 8);
#define PG8_SA(b, h) (((b) * 2 + (h)) * HTB)
#define PG8_SB(b, h) ((4 + (b) * 2 + (h)) * HTB)
#define PG8_STAGE(bufoff, gbase, voff) do { _Pragma("unroll") for (int _i = 0; _i < 2; ++_i) \
        __builtin_amdgcn_global_load_lds((const unsigned*)((const char*)(gbase) + (voff)[_i]), (LAS unsigned*)(lds + (bufoff) + ldsw + _i * 8192), 16, 0, 0); } while (0)
#define PG8_LDA(dst, b, h) do { _Pragma("unroll") for (int m = 0; m < 4; ++m) _Pragma("unroll") for (int k = 0; k < 2; ++k) dst[m][k] = *(const LAS bf16x8*)(lds + PG8_SA(b, h) + aoff + m * 2048 + k * 1024); } while (0)
#define PG8_LDB(dst, b, h) do { _Pragma("unroll") for (int n = 0; n < 2; ++n) _Pragma("unroll") for (int k = 0; k < 2; ++k) dst[n][k] = *(const LAS bf16x8*)(lds + PG8_SB(b, h) + boff + n * 2048 + k * 1024); } while (0)
#define PG8_MMA(ai, bj, At, Bt) do { __builtin_amdgcn_s_setprio(1); _Pragma("unroll") for (int m = 0; m < 4; ++m) _Pragma("unroll") for (int n = 0; n < 2; ++n) _Pragma("unroll") for (int k = 0; k < 2; ++k) \
        acc[ai][bj][m][n] = __builtin_amdgcn_mfma_f32_16x16x32_bf16(Bt[n][k], At[m][k], acc[ai][bj][m][n], 0, 0, 0); __builtin_amdgcn_s_setprio(0); } while (0)
#define PG8_WAIT_V(n) asm volatile("s_waitcnt vmcnt(" #n ")" ::: "memory")
#define PG8_WAIT_L(n) asm volatile("s_waitcnt lgkmcnt(" #n ")" ::: "memory")
#define PG8_BAR __builtin_amdgcn_s_barrier()
#define PG8_SCHED __builtin_amdgcn_sched_barrier(0)
    Unit cur, nxt; int ui = 0;
    if (!S.next(0, cur)) return;
    bool seen = false;
#define PG8_AREADY(u) do { if (!seen && S.waits(u)) { seen = true; if (wid == 0) S.poll(); __builtin_amdgcn_s_barrier(); } } while (0)
    PG8_AREADY(cur);
    LAS float* const rstab = (LAS float*)(lds + STAGE_BYTES);
#define PG8_RS_ISSUE(pm_) do { const float* p_ = E.rss + ((size_t)(pm_) * BM + (tid >> 1)) * 32 + (tid & 1) * 16; _Pragma("unroll") for (int i_ = 0; i_ < 4; ++i_) rq[i_] = *(const f32x4*)(p_ + 4 * i_); } while (0)
#define PG8_RS_FINISH(buf) do { const f32x4 v_ = (rq[0] + rq[1]) + (rq[2] + rq[3]); float s_ = (v_[0] + v_[1]) + (v_[2] + v_[3]); s_ += __shfl_xor(s_, 1); \
        if (!(tid & 1)) rstab[(buf) * 256 + (tid >> 1)] = rsqrtf(s_ * (1.0f / DM) + RMS_EPS); } while (0)
    f32x4 rq0[4];
    if constexpr (Epi::RSTD) { f32x4 (&rq)[4] = rq0; PG8_RS_ISSUE(cur.pm); }
    f32x4 acc[2][2][4][2];
#pragma unroll
    for (int a = 0; a < 2; ++a)
#pragma unroll
        for (int b = 0; b < 2; ++b)
#pragma unroll
            for (int m = 0; m < 4; ++m)
#pragma unroll
                for (int n = 0; n < 2; ++n) acc[a][b][m][n] = (f32x4){0.f, 0.f, 0.f, 0.f};
    bf16x8 At[4][2], B0[2][2], B1[2][2];
    const char* cA = cur.A; const char* cB = cur.B;
    PG8_STAGE(PG8_SB(0, 0), cB, voffB); PG8_STAGE(PG8_SB(0, 1), cB + hstepB, voffB); PG8_STAGE(PG8_SA(0, 0), cA, voffA); PG8_STAGE(PG8_SA(0, 1), cA + hstepA, voffA);
    if (wr == 1) PG8_BAR;
    PG8_WAIT_V(2); PG8_BAR;
    PG8_STAGE(PG8_SB(1, 0), cB + kstep, voffB); PG8_STAGE(PG8_SA(1, 0), cA + kstep, voffA); PG8_STAGE(PG8_SB(1, 1), cB + hstepB + kstep, voffB);
    PG8_WAIT_V(6); PG8_BAR;
    if constexpr (Epi::RSTD) { f32x4 (&rq)[4] = rq0; PG8_RS_FINISH(0); }
    for (;;) {
        const bool has_next = S.next(ui + 1, nxt);
        const char* nA = has_next ? nxt.A : cA; const char* nB = has_next ? nxt.B : cB;
        const int nt = cur.nt;
        for (int t = 0; t < nt; t += 2) {
            const bool last = (t == nt - 2);
            if (last && has_next) PG8_AREADY(nxt);
            const char* a1 = cA + (size_t)(t + 1) * kstep;
            const char* a2 = last ? nA : cA + (size_t)(t + 2) * kstep; const char* b2 = last ? nB : cB + (size_t)(t + 2) * kstep;
            const char* a3 = a2 + kstep; const char* b3 = b2 + kstep;
            PG8_LDB(B0, 0, 0); PG8_LDB(B1, 0, 1); PG8_SCHED; PG8_LDA(At, 0, 0); PG8_STAGE(PG8_SA(1, 1), a1 + hstepA, voffA);
            PG8_WAIT_V(8); PG8_WAIT_L(0); PG8_BAR; PG8_MMA(0, 0, At, B0); PG8_MMA(0, 1, At, B1); PG8_BAR; PG8_SCHED;
            PG8_LDA(At, 0, 1); PG8_STAGE(PG8_SB(0, 0), b2, voffB); PG8_STAGE(PG8_SB(0, 1), b2 + hstepB, voffB); PG8_STAGE(PG8_SA(0, 0), a2, voffA);
            PG8_WAIT_V(8); PG8_WAIT_L(0); PG8_BAR; PG8_MMA(1, 0, At, B0); PG8_MMA(1, 1, At, B1); PG8_BAR; PG8_SCHED;
            PG8_LDB(B0, 1, 0); PG8_LDB(B1, 1, 1); PG8_SCHED; PG8_LDA(At, 1, 0); PG8_STAGE(PG8_SA(0, 1), a2 + hstepA, voffA);
            PG8_WAIT_V(8); PG8_WAIT_L(0); PG8_BAR; PG8_MMA(0, 0, At, B0); PG8_MMA(0, 1, At, B1); PG8_BAR; PG8_SCHED;
            PG8_LDA(At, 1, 1); PG8_STAGE(PG8_SB(1, 0), b3, voffB); PG8_STAGE(PG8_SB(1, 1), b3 + hstepB, voffB); PG8_STAGE(PG8_SA(1, 0), a3, voffA);
            PG8_WAIT_V(8); PG8_WAIT_L(0); PG8_BAR; PG8_MMA(1, 0, At, B0); PG8_MMA(1, 1, At, B1); PG8_BAR; PG8_SCHED;
        }
        if (wr == 0) PG8_BAR;
        if constexpr (Epi::RSTD) { f32x4 rq[4]; PG8_RS_ISSUE(has_next ? nxt.pm : cur.pm); E(acc, cur, wr, wc, fr, fq, rstab + (ui & 1) * 256); PG8_RS_FINISH((ui + 1) & 1); }
        else E(acc, cur, wr, wc, fr, fq, rstab);
        if (!has_next) break;
#pragma unroll
        for (int a = 0; a < 2; ++a)
#pragma unroll
            for (int b = 0; b < 2; ++b)
#pragma unroll
                for (int m = 0; m < 4; ++m)
#pragma unroll
                    for (int n = 0; n < 2; ++n) acc[a][b][m][n] = (f32x4){0.f, 0.f, 0.f, 0.f};
        cur = nxt; cA = nA; cB = nB; ++ui;
        if (wr == 1) PG8_BAR;
    }
    PG8_WAIT_V(0);
    PG8_BAR;
#undef PG8_AREADY
#undef PG8_RS_ISSUE
#undef PG8_RS_FINISH
#undef PG8_SA
#undef PG8_SB
#undef PG8_STAGE
#undef PG8_LDA
#undef PG8_LDB
#undef PG8_MMA
#undef PG8_WAIT_V
#undef PG8_WAIT_L
#undef PG8_BAR
#undef PG8_SCHED
}
}

#ifndef PRUNE_T
#define PRUNE_T 25.f
#endif
namespace att {
constexpr float SCALE = 0.08838834764831845f;
constexpr float THR = 8.f;
constexpr int NW = 8, QBLK = 32, KVBLK = 64, QB = NW * QBLK, D = 128;
constexpr int SHM_V = KVBLK * D * 2, SHM_K = KVBLK * D * 2;
constexpr int ATT_LDS = 2 * SHM_V + 2 * SHM_K + NW * 64 * 4;
constexpr int BOS_OFF = ATT_LDS;
constexpr int BOS_BYTES = 8192 * 4;
constexpr int SCR_OFF = BOS_OFF + 2 * BOS_BYTES;
constexpr int WINF = 1 << 30;
static_assert(SCR_OFF + 256 <= LDS_WORK, "attention LDS map");

#define KSWZ(row, colB) ((row) * 256 + ((colB) ^ (((row) & 7) << 4)))
__device__ __forceinline__ int v_st(int k, int c) { const int kk = (k & ~0xC) | ((k & 4) << 1) | ((k & 8) >> 1); return ((kk >> 3) * 4 + (c >> 5)) * 512 + ((kk & 7) * 32 + (c & 31)) * 2; }
__device__ __forceinline__ int v_rd_base(int lane) { return ((lane & 3) << 3) | (((lane >> 2) & 3) << 6) | (((lane >> 4) & 1) << 5) | (((lane >> 5) & 1) << 8); }
constexpr int v_rd_off(int d0, int ks, int half) { return d0 * 512 + ks * 4096 + half * 2048; }
__device__ __forceinline__ int crow(int r, int hi) { return (r & 3) + 8 * (r >> 2) + 4 * hi; }
__device__ __forceinline__ bf16x8 load8(const bf16_t* p) { return *reinterpret_cast<const bf16x8*>(p); }

__device__ __forceinline__ void mask_tile(f32x16& p0, f32x16& p1, int dq, unsigned W) {
    const float NEG = -__builtin_inff();
#pragma unroll
    for (int r = 0; r < 16; ++r) {
        const int c = (r & 3) + 8 * (r >> 2);
        if ((unsigned)(dq - c) >= W) p0[r] = NEG;
        if ((unsigned)(dq - c - 32) >= W) p1[r] = NEG;
    }
}
__device__ __forceinline__ void partialSM(f32x16& p0, f32x16& p1, float& m_reg, float& mn, float& alpha) {
    float pmax = p0[0]; for (int r = 1; r < 16; ++r) pmax = fmaxf(pmax, p0[r]); for (int r = 0; r < 16; ++r) pmax = fmaxf(pmax, p1[r]);
    { auto rr = __builtin_amdgcn_permlane32_swap(__float_as_uint(pmax), __float_as_uint(pmax), false, false);
      pmax = fmaxf(__uint_as_float(rr[0]), __uint_as_float(rr[1])); }
    constexpr float C2 = 1.4426950408889634f * SCALE;
    if (__builtin_expect(__all((pmax - m_reg) * SCALE <= THR), 1)) { mn = m_reg; alpha = 1.f; }
    else { mn = fmaxf(m_reg, pmax); alpha = __builtin_amdgcn_exp2f((m_reg - mn) * C2); m_reg = mn; }
    const float mnL = -mn * C2;
    for (int r = 0; r < 16; ++r) p0[r] = fmaf(p0[r], C2, mnL); for (int r = 0; r < 16; ++r) p1[r] = fmaf(p1[r], C2, mnL);
    for (int r = 0; r < 16; ++r) p0[r] = __builtin_amdgcn_exp2f(p0[r]);
}
#define PK4(P, B_, OUT) do { unsigned a0 = cvtpk(P[B_+0], P[B_+1]), a1 = cvtpk(P[B_+2], P[B_+3]);                          \
        unsigned b0 = cvtpk(P[B_+4], P[B_+5]), b1 = cvtpk(P[B_+6], P[B_+7]);                                             \
        auto r0 = __builtin_amdgcn_permlane32_swap(a0, b0, false, false); auto r1 = __builtin_amdgcn_permlane32_swap(a1, b1, false, false); \
        u32x4 w = {r0[0], r1[0], r0[1], r1[1]}; OUT = *reinterpret_cast<bf16x8*>(&w); } while (0)
__device__ __forceinline__ void finishSM(f32x16& p0, f32x16& p1, float alpha, float& l_reg, bf16x8& pa0, bf16x8& pa1, bf16x8& pa2, bf16x8& pa3) {
    for (int r = 0; r < 16; ++r) p1[r] = __builtin_amdgcn_exp2f(p1[r]);
    float ps = 0; for (int r = 0; r < 16; ++r) ps += p0[r]; for (int r = 0; r < 16; ++r) ps += p1[r];
    { auto rr = __builtin_amdgcn_permlane32_swap(__float_as_uint(ps), __float_as_uint(ps), false, false);
      ps = __uint_as_float(rr[0]) + __uint_as_float(rr[1]); }
    l_reg = l_reg * alpha + ps;
    PK4(p0, 0, pa0); PK4(p0, 8, pa1); PK4(p1, 0, pa2); PK4(p1, 8, pa3);
}
template <int KB, bool BIAS>
__device__ __forceinline__ void qkt(f32x16& p0, f32x16& p1, const char* K_lds, int r32, int hi, const bf16x8* qr, const float* bk, bool act = true) {
    if (!act) { const float NEG = -__builtin_inff();
#pragma unroll
        for (int r = 0; r < 16; ++r) { p0[r] = NEG; p1[r] = NEG; } return; }
    if constexpr (BIAS) {
#pragma unroll
        for (int i = 0; i < 4; ++i) { const f32x4 a = *(const f32x4*)(bk + 8 * i), b = *(const f32x4*)(bk + 32 + 8 * i);
            p0[4 * i] = a[0]; p0[4 * i + 1] = a[1]; p0[4 * i + 2] = a[2]; p0[4 * i + 3] = a[3];
            p1[4 * i] = b[0]; p1[4 * i + 1] = b[1]; p1[4 * i + 2] = b[2]; p1[4 * i + 3] = b[3]; }
    } else { p0 = f32x16{}; p1 = f32x16{}; }
    const char* kb[4];
#pragma unroll
    for (int dd = 0; dd < 4; ++dd) kb[dd] = K_lds + KB * SHM_K + KSWZ(r32, (dd * 16 + hi * 8) * 2);
#pragma unroll
    for (int d0 = 0; d0 < 8; ++d0) { const char* a = kb[d0 & 3] + (d0 >> 2) * 128;
        bf16x8 b0 = *reinterpret_cast<const bf16x8*>(a);
        bf16x8 b1 = *reinterpret_cast<const bf16x8*>(a + 32 * 256);
        p0 = __builtin_amdgcn_mfma_f32_32x32x16_bf16(b0, qr[d0], p0, 0, 0, 0);
        p1 = __builtin_amdgcn_mfma_f32_32x32x16_bf16(b1, qr[d0], p1, 0, 0, 0); }
}
template <int VB>
__device__ __forceinline__ void pv_tile(f32x16* o, int vb0, bf16x8 pa0, bf16x8 pa1, bf16x8 pa2, bf16x8 pa3, bool act = true) {
    if (!act) return;
#define TRRD(dst, off) asm volatile("ds_read_b64_tr_b16 %0, %1 offset:%2" : "=&v"(dst) : "v"(vb0), "i"(off) : "memory")
#define PV_D0(d0) do { s16x4 l0, l1, l2, l3, h0, h1, h2, h3; constexpr int b_ = VB * SHM_V + v_rd_off(d0, 0, 0); \
        TRRD(l0, b_); TRRD(h0, b_ + 2048); TRRD(l1, b_ + 4096); TRRD(h1, b_ + 6144); TRRD(l2, b_ + 8192); TRRD(h2, b_ + 10240); TRRD(l3, b_ + 12288); TRRD(h3, b_ + 14336); \
        asm volatile("s_waitcnt lgkmcnt(0)" ::: "memory"); SBAR();   \
        o[d0] = __builtin_amdgcn_mfma_f32_32x32x16_bf16(pa0, (bf16x8){l0[0], l0[1], l0[2], l0[3], h0[0], h0[1], h0[2], h0[3]}, o[d0], 0, 0, 0);   \
        o[d0] = __builtin_amdgcn_mfma_f32_32x32x16_bf16(pa1, (bf16x8){l1[0], l1[1], l1[2], l1[3], h1[0], h1[1], h1[2], h1[3]}, o[d0], 0, 0, 0);   \
        o[d0] = __builtin_amdgcn_mfma_f32_32x32x16_bf16(pa2, (bf16x8){l2[0], l2[1], l2[2], l2[3], h2[0], h2[1], h2[2], h2[3]}, o[d0], 0, 0, 0);   \
        o[d0] = __builtin_amdgcn_mfma_f32_32x32x16_bf16(pa3, (bf16x8){l3[0], l3[1], l3[2], l3[3], h3[0], h3[1], h3[2], h3[3]}, o[d0], 0, 0, 0); } while (0)
    PV_D0(0); PV_D0(1); PV_D0(2); PV_D0(3);
#undef PV_D0
#undef TRRD
}

struct Blk { const bf16_t* Q; const bf16_t* K; const bf16_t* V; bf16_t* O; int ldq, ldkv, ldo; int P0, skv, nrows; int bmode; const float* lf0; int n0; const float* lf1;
             const unsigned* qq; const unsigned* kq; int jlo, bsel, pre0, ls0; const float* Kf; const float* Vf; int nf, ldf; };
struct Seam { bf16x8 qr[8]; bf16x8 st_v0, st_v1, st_k0, st_k1; };
__device__ __forceinline__ int blk_jhi(const Blk& b) { int j = (b.P0 + QB - 1) / KVBLK + 1; const int m = b.skv / KVBLK; return j > m ? m : j; }

__device__ __forceinline__ void prepare_bias(Blk& b, char* lds, int g_wave) {
    const int tid = opaque_tid();
    float* bos = (float*)(lds + BOS_OFF + b.bsel * BOS_BYTES); float* scr = (float*)(lds + SCR_OFF);
    const int nk = blk_jhi(b) * KVBLK, lane = tid & 63, wid = tid >> 6;
    b.jlo = 0;
    if (b.bmode == 0) { for (int k = tid; k < nk; k += 512) bos[k] = 0.f; __syncthreads(); return; }
    float v[16]; float tot = 0.f; const int k0 = tid * 16; const bool in = k0 < nk;
#pragma unroll
    for (int i = 0; i < 16; ++i) { const int k = k0 + i; float x = 0.f; if (in) { if (k < b.n0) { x = b.lf0[(size_t)k * b.ls0]; if (b.pre0) x = log_sigmoid_fast(x); } else x = log_sigmoid_fast(b.lf1[k - b.n0]); } v[i] = x; tot += x; }
    float inc = tot;
#pragma unroll
    for (int o = 1; o < 64; o <<= 1) { const float y = __int_as_float(__builtin_amdgcn_ds_bpermute(((lane + o) & 63) << 2, __float_as_int(inc))); if (lane + o < 64) inc += y; }
    if (lane == 0) scr[wid] = inc;
    if (tid == 0) ((int*)scr)[9] = 0;
    __syncthreads();
    float hiw = 0.f;
#pragma unroll
    for (int w = 0; w < 8; ++w) if (w > wid) hiw += scr[w];
    float run = (inc - tot) + hiw;
#pragma unroll
    for (int i = 15; i >= 0; --i) { const float lf = v[i]; v[i] = run; run += lf; }
    if (in) {
#pragma unroll
        for (int i = 0; i < 16; ++i) bos[k0 + i] = v[i] * (1.0f / SCALE);
    }
    if (b.qq != nullptr) {
        if (in && k0 == b.P0) scr[8] = v[0];
        { const int row = tid >> 1, half = tid & 1; const bf16_t* qp = b.Q + (size_t)row * b.ldq + half * 64; const bf16_t* kp = b.K + (size_t)(b.P0 + row) * b.ldkv + half * 64; float d = 0.f;
#pragma unroll
          for (int c8 = 0; c8 < 8; ++c8) { const u32x4 qa = *(const u32x4*)(qp + c8 * 8), ka = *(const u32x4*)(kp + c8 * 8);
#pragma unroll
              for (int e = 0; e < 4; ++e) d += __uint_as_float(qa[e] << 16) * __uint_as_float(ka[e] << 16) + __uint_as_float(qa[e] & 0xffff0000u) * __uint_as_float(ka[e] & 0xffff0000u); }
          d += __shfl_xor(d, 1);
#pragma unroll
          for (int o = 2; o < 64; o <<= 1) d = fminf(d, __shfl_xor(d, o));
          if (lane == 0) scr[10 + wid] = d * SCALE; }
        __syncthreads();
        float mmin = scr[10];
#pragma unroll
        for (int w = 1; w < 8; ++w) mmin = fminf(mmin, scr[10 + w]);
        const float q2 = (__uint_as_float(b.qq[0]) + __uint_as_float(b.qq[1])) + (__uint_as_float(b.qq[2]) + __uint_as_float(b.qq[3]));
        const float k2 = (__uint_as_float(b.kq[0]) + __uint_as_float(b.kq[1])) + (__uint_as_float(b.kq[2]) + __uint_as_float(b.kq[3]));
        const float B = sqrtf(q2 * k2) * SCALE * 1.02f, cut = scr[8] - (B - mmin + PRUNE_T);
        int cnt = 0;
#pragma unroll
        for (int i = 0; i < 16; ++i) cnt += (in && k0 + i < b.P0 && v[i] < cut) ? 1 : 0;
#pragma unroll
        for (int o = 1; o < 64; o <<= 1) cnt += __shfl_xor(cnt, o);
        if (lane == 0 && cnt) atomicAdd((int*)scr + 9, cnt);
        __syncthreads();
        b.jlo = ((int*)scr)[9] / KVBLK;
    }
    __syncthreads();
}

#define ROWK(p, ld, k0, rr) ((p) + (size_t)((k0) + (rr)) * (ld) + sc)
#define VMW() asm volatile("s_waitcnt vmcnt(0)" ::: "memory")
#define VMWN(n) asm volatile("s_waitcnt vmcnt(%0)" :: "i"(n) : "memory")
#define SLOAD_H(Kp, Vp, ld, k0) do { S.st_v0 = load8(ROWK(Vp, ld, k0, sr)); S.st_v1 = load8(ROWK(Vp, ld, k0, 32 + sr));              \
                         S.st_k0 = load8(ROWK(Kp, ld, k0, sr)); S.st_k1 = load8(ROWK(Kp, ld, k0, 32 + sr)); } while (0)
#define SWRITE_HK(bf) do { *(bf16x8*)(K_lds + (bf) * SHM_K + kws) = S.st_k0; *(bf16x8*)(K_lds + (bf) * SHM_K + kws + 32 * 256) = S.st_k1; } while (0)
#define SWRITE_HV(bf) do { *(bf16x8*)(V_lds + (bf) * SHM_V + vst0) = S.st_v0; *(bf16x8*)(V_lds + (bf) * SHM_V + vst1) = S.st_v1; } while (0)
#define SWRITE_H(bf) do { SWRITE_HV(bf); SWRITE_HK(bf); } while (0)
#define QROWP(b_) ((b_).Q + (size_t)((wid * QBLK + r32) & ((b_).nrows - 1)) * (b_).ldq + hi * 8)
__device__ __forceinline__ void att_prime(const Blk& cur, char* lds, Seam& S, int g_wave) {
    const int tid = opaque_tid();
    const int wid = __builtin_amdgcn_readfirstlane(tid >> 6), lane = tid & 63, r32 = lane & 31, hi = lane >> 5;
    const int sr = tid >> 4, sc = (tid & 15) * 8, kws = KSWZ(sr, sc * 2); char* K_lds = lds + 2 * SHM_V;
    const bf16_t* qp = QROWP(cur);
#pragma unroll
    for (int d0 = 0; d0 < 8; ++d0) S.qr[d0] = load8(qp + d0 * 16);
    SLOAD_H(cur.K, cur.V, cur.ldkv, cur.jlo * KVBLK); VMW(); SWRITE_HK(0);
    __syncthreads();
}
__device__ __forceinline__ void att_block(const Blk& cur, const Blk& nxt, char* lds, Seam& S, int g_wave) {
    const int tid = opaque_tid();
    const int wid = __builtin_amdgcn_readfirstlane(tid >> 6), lane = tid & 63, r32 = lane & 31, hi = lane >> 5;
    constexpr int W = WINF;
    const int j_lo = cur.jlo, NT = blk_jhi(cur) - j_lo;
    const int qlo = cur.P0 + wid * QBLK, qm = qlo + r32 - 4 * hi; const bool wact = wid * QBLK < cur.nrows;
    char* V_lds = lds; char* K_lds = lds + 2 * SHM_V;
    float* ws = (float*)(lds + 2 * SHM_V + 2 * SHM_K) + wid * 64; float* li_l = ws, * al_l = ws + 32;
    const float* bos = (const float*)(lds + BOS_OFF + cur.bsel * BOS_BYTES) + 4 * hi;
    float m_reg = -1e30f, l_reg = 0; f32x16 o[4] = {};
    const int sr = tid >> 4, sc = (tid & 15) * 8, vst0 = v_st(sr, sc), vst1 = v_st(32 + sr, sc), kws = KSWZ(sr, sc * 2);
    const int vb0 = (int)(uintptr_t)V_lds + v_rd_base(lane);
    const bf16_t* Kh = cur.K; const bf16_t* Vh = cur.V; const int ldkv = cur.ldkv;
#define RESC(a) do { if (__any((a) < 1.f)) { if (hi == 0) al_l[r32] = (a); asm volatile("s_waitcnt lgkmcnt(0)" ::: "memory");              \
                     for (int d_ = 0; d_ < 4; ++d_) for (int r = 0; r < 16; ++r) o[d_][r] *= al_l[crow(r, hi)]; } } while (0)
#define KBASE(t) ((j_lo + (t)) * KVBLK)
#define MASKT(P0_, P1_, t) do { const int kb_ = KBASE(t); if (kb_ + KVBLK - 1 > qlo) mask_tile(P0_, P1_, qm - kb_, (unsigned)W); } while (0)
    constexpr int NQL = 8;
#define SEAM_K0() do { VMWN(NQL); SWRITE_HK(0); SBAR(); } while (0)
    f32x16 pA0, pA1, pB0, pB1; float mnA, mnB, alA, alB; bf16x8 pa0, pa1, pa2, pa3;
    SWRITE_HV(0); SBAR();
    if (NT > 1) SLOAD_H(Kh, Vh, ldkv, KBASE(1));
    SBAR(); qkt<0, true>(pA0, pA1, K_lds, r32, hi, S.qr, bos + KBASE(0), wact);
    MASKT(pA0, pA1, 0); partialSM(pA0, pA1, m_reg, mnA, alA);
    if (NT > 1) { VMW(); SWRITE_H(1); }
    __syncthreads();
#define HALF_STEP(PX0, PX1, mnX, alX, PY0, PY1, alY, t, KB, VB, SB) do {                                                      \
        SBAR(); qkt<KB, true>(PX0, PX1, K_lds, r32, hi, S.qr, bos + KBASE(t), wact);                                                \
        finishSM(PY0, PY1, alY, l_reg, pa0, pa1, pa2, pa3); SBAR();                                                           \
        if ((t) + 1 < NT) { SLOAD_H(Kh, Vh, ldkv, KBASE((t) + 1)); SBAR(); }                                                  \
        pv_tile<VB>(o, vb0, pa0, pa1, pa2, pa3, wact); MASKT(PX0, PX1, (t)); partialSM(PX0, PX1, m_reg, mnX, alX);                  \
        __syncthreads();                                                                                                      \
        if ((t) + 1 < NT) { VMW(); SWRITE_H(SB); }                                                                            \
        RESC(alX); __syncthreads(); } while (0)
    for (int t = 1; t + 1 < NT; t += 2) {
        HALF_STEP(pB0, pB1, mnB, alB, pA0, pA1, alA, t, 1, 0, 0);
        HALF_STEP(pA0, pA1, mnA, alA, pB0, pB1, alB, t + 1, 0, 1, 1);
    }
    const bool even = (NT & 1) == 0;
    if (even) { SBAR(); qkt<1, true>(pB0, pB1, K_lds, r32, hi, S.qr, bos + KBASE(NT - 1), wact); SBAR(); }
    SLOAD_H(nxt.K, nxt.V, nxt.ldkv, nxt.jlo * KVBLK); SBAR();
    { const bf16_t* qp = QROWP(nxt);
#pragma unroll
      for (int d0 = 0; d0 < 8; ++d0) S.qr[d0] = load8(qp + d0 * 16); }
    SBAR();
    finishSM(pA0, pA1, alA, l_reg, pa0, pa1, pa2, pa3); SBAR();
    pv_tile<0>(o, vb0, pa0, pa1, pa2, pa3, wact);
    if (even) { MASKT(pB0, pB1, NT - 1); partialSM(pB0, pB1, m_reg, mnB, alB); __syncthreads(); RESC(alB);
        finishSM(pB0, pB1, alB, l_reg, pa0, pa1, pa2, pa3); SBAR(); pv_tile<1>(o, vb0, pa0, pa1, pa2, pa3, wact); }
    SBAR(); SEAM_K0();
    if (hi == 0) li_l[r32] = l_reg; asm volatile("s_waitcnt lgkmcnt(0)" ::: "memory");
    float rli[16];
#pragma unroll
    for (int r = 0; r < 16; ++r) rli[r] = __builtin_amdgcn_rcpf(li_l[crow(r, hi)]);
    if (wid * QBLK < cur.nrows) {
        bf16_t* Ow = cur.O + (size_t)(wid * QBLK) * cur.ldo;
#pragma unroll
        for (int r = 0; r < 16; ++r) { const int orow = crow(r, hi);
#pragma unroll
            for (int d0 = 0; d0 < 4; ++d0) { const float v = o[d0][r] * rli[r]; const float vn = __shfl_xor(v, 1);
                if ((r32 & 1) == 0) *(unsigned*)(Ow + (size_t)orow * cur.ldo + d0 * 32 + r32) = cvtpk(v, vn); } }
    }
    __syncthreads();
#undef RESC
#undef MASKT
#undef SEAM_K0
#undef HALF_STEP
}

__device__ __forceinline__ void sb_block(const Blk& b, char* lds, int g_wave) {
    const int tid = opaque_tid();
    const int wid = __builtin_amdgcn_readfirstlane(tid >> 6), lane = tid & 63, r32 = lane & 31, hi = lane >> 5;
    char* V_lds = lds; char* K_lds = lds + 2 * SHM_V; int* flags = (int*)(lds + 2 * SHM_V + 2 * SHM_K);
    const int sr = tid >> 4, sc = (tid & 15) * 8, vst0 = v_st(sr, sc), vst1 = v_st(32 + sr, sc), kws = KSWZ(sr, sc * 2);
    const int vb0 = (int)(uintptr_t)V_lds + v_rd_base(lane);
    bf16x8 qr[8];
    { const bf16_t* qp = QROWP(b);
#pragma unroll
      for (int d0 = 0; d0 < 8; ++d0) qr[d0] = load8(qp + d0 * 16); }
    const int NT = blk_jhi(b), qlo = b.P0 + wid * QBLK, pos = qlo + r32;
    bool wdead = wid * QBLK >= b.nrows;
    float prun = 1.f; f32x16 o[4] = {};
    constexpr float C2 = 1.4426950408889634f * SCALE;
    const int nf = b.nf; bf16x8 k0, k1, v0, v1; f32x4 fk[4], fv[4];
#define SB_LOAD(kn) do { if ((kn) < nf) { const float* pk_ = b.Kf + (size_t)((kn) + sr) * AW + sc; const float* pv_ = b.Vf + (size_t)((kn) + sr) * AW + sc; \
            fk[0] = *(const f32x4*)pk_; fk[1] = *(const f32x4*)(pk_ + 4); fk[2] = *(const f32x4*)(pk_ + 32 * AW); fk[3] = *(const f32x4*)(pk_ + 32 * AW + 4); \
            fv[0] = *(const f32x4*)pv_; fv[1] = *(const f32x4*)(pv_ + 4); fv[2] = *(const f32x4*)(pv_ + 32 * AW); fv[3] = *(const f32x4*)(pv_ + 32 * AW + 4); } \
        else { k0 = load8(ROWK(b.K, b.ldkv, (kn), sr)); k1 = load8(ROWK(b.K, b.ldkv, (kn), 32 + sr)); v0 = load8(ROWK(b.V, b.ldkv, (kn), sr)); v1 = load8(ROWK(b.V, b.ldkv, (kn), 32 + sr)); } } while (0)
    SB_LOAD((NT - 1) * KVBLK);
    for (int t = NT - 1; t >= 0; --t) {
        const int kb = t * KVBLK;
        __syncthreads();
        if (kb < nf) { k0 = pack8(fk[0], fk[1]); k1 = pack8(fk[2], fk[3]); v0 = pack8(fv[0], fv[1]); v1 = pack8(fv[2], fv[3]); }
        *(bf16x8*)(K_lds + kws) = k0; *(bf16x8*)(K_lds + kws + 32 * 256) = k1; *(bf16x8*)(V_lds + vst0) = v0; *(bf16x8*)(V_lds + vst1) = v1;
        __syncthreads();
        if (t > 0) { const int kn = kb - KVBLK;
            SB_LOAD(kn); }
        if (!wdead && kb < qlo + QBLK - 1) {
            f32x16 p0, p1; qkt<0, false>(p0, p1, K_lds, r32, hi, qr, nullptr);
            if (kb + KVBLK - 1 >= qlo) {
                const float NEG = -__builtin_inff();
#pragma unroll
                for (int r = 0; r < 16; ++r) { const int key = kb + crow(r, hi); if (key >= pos) p0[r] = NEG; if (key + 32 >= pos) p1[r] = NEG; }
            }
#pragma unroll
            for (int r = 0; r < 16; ++r) {
                p0[r] = __builtin_amdgcn_rcpf(1.f + __builtin_amdgcn_exp2f(fminf(p0[r] * C2, 60.f))); p1[r] = __builtin_amdgcn_rcpf(1.f + __builtin_amdgcn_exp2f(fminf(p1[r] * C2, 60.f))); }
            float gl[8], gu[8];
#pragma unroll
            for (int g = 0; g < 8; ++g) { const float gp = g < 4 ? (p0[4 * g] * p0[4 * g + 1]) * (p0[4 * g + 2] * p0[4 * g + 3]) : (p1[4 * g - 16] * p1[4 * g - 15]) * (p1[4 * g - 14] * p1[4 * g - 13]);
                auto x = __builtin_amdgcn_permlane32_swap(__float_as_uint(gp), __float_as_uint(gp), false, false); gl[g] = __uint_as_float(x[0]); gu[g] = __uint_as_float(x[1]); }
            float s = 1.f, sown[8];
#pragma unroll
            for (int g = 7; g >= 0; --g) { const float su = s; s *= gu[g]; const float sl = s; s *= gl[g]; sown[g] = hi ? su : sl; }
#define SB_EL(P, q) do { const float rr_ = P[q]; P[q] = (1.f - rr_) * tt; tt *= rr_; } while (0)
#pragma unroll
            for (int g = 0; g < 8; ++g) { float tt = sown[g] * prun;
                if (g < 4) { const int q = 4 * g; SB_EL(p0, q + 3); SB_EL(p0, q + 2); SB_EL(p0, q + 1); SB_EL(p0, q); }
                else { const int q = 4 * g - 16; SB_EL(p1, q + 3); SB_EL(p1, q + 2); SB_EL(p1, q + 1); SB_EL(p1, q); } }
#undef SB_EL
            prun *= s;
            bf16x8 pa0, pa1, pa2, pa3;
            PK4(p0, 0, pa0); PK4(p0, 8, pa1); PK4(p1, 0, pa2); PK4(p1, 8, pa3);
            pv_tile<0>(o, vb0, pa0, pa1, pa2, pa3);
            wdead = __all(prun < 9.1e-13f);
        }
        if (lane == 0) flags[wid] = wdead ? 1 : 0;
        __syncthreads();
        const int alld = flags[0] & flags[1] & flags[2] & flags[3] & flags[4] & flags[5] & flags[6] & flags[7];
        if (alld) break;
    }
    if (wid * QBLK < b.nrows) {
        bf16_t* Ow = b.O + (size_t)(wid * QBLK) * b.ldo;
#pragma unroll
        for (int r = 0; r < 16; ++r) { const int orow = crow(r, hi);
#pragma unroll
            for (int d0 = 0; d0 < 4; ++d0) { const float v = o[d0][r]; const float vn = __shfl_xor(v, 1);
                if ((r32 & 1) == 0) *(unsigned*)(Ow + (size_t)orow * b.ldo + d0 * 32 + r32) = cvtpk(v, vn); } }
    }
    __syncthreads();
}

__device__ __forceinline__ void small_block(const Blk& bin, char* lds, int g_wave) {
    Blk b = bin; b.bsel = 0; prepare_bias(b, lds, g_wave);
    const int tid = opaque_tid();
    const int wid = __builtin_amdgcn_readfirstlane(tid >> 6), lane = tid & 63, r32 = lane & 31, hi = lane >> 5;
    char* V_lds = lds; char* K_lds = lds + 2 * SHM_V;
    float* ws = (float*)(lds + 2 * SHM_V + 2 * SHM_K) + wid * 64; float* li_l = ws, * al_l = ws + 32;
    const float* bos = (const float*)(lds + BOS_OFF) + 4 * hi;
    const int sr = tid >> 4, sc = (tid & 15) * 8, vst0 = v_st(sr, sc), vst1 = v_st(32 + sr, sc), kws = KSWZ(sr, sc * 2);
    const int vb0 = (int)(uintptr_t)V_lds + v_rd_base(lane);
    const int NT = blk_jhi(b), qlo = b.P0 + wid * QBLK, qm = qlo + r32 - 4 * hi; const bool wact = wid * QBLK < b.nrows;
    bf16x8 qr[8];
    { const bf16_t* qp = QROWP(b);
#pragma unroll
      for (int d0 = 0; d0 < 8; ++d0) qr[d0] = load8(qp + d0 * 16); }
    const int nf = b.nf, ldf = b.ldf; bf16x8 k0, k1, v0, v1; f32x4 fk[4], fv[4];
#define SM_LOAD(kn) do { if ((kn) < nf) { const float* pk_ = b.Kf + (size_t)((kn) + sr) * ldf + sc; const float* pv_ = b.Vf + (size_t)((kn) + sr) * ldf + sc; \
            fk[0] = *(const f32x4*)pk_; fk[1] = *(const f32x4*)(pk_ + 4); fk[2] = *(const f32x4*)(pk_ + (size_t)32 * ldf); fk[3] = *(const f32x4*)(pk_ + (size_t)32 * ldf + 4); \
            fv[0] = *(const f32x4*)pv_; fv[1] = *(const f32x4*)(pv_ + 4); fv[2] = *(const f32x4*)(pv_ + (size_t)32 * ldf); fv[3] = *(const f32x4*)(pv_ + (size_t)32 * ldf + 4); } \
        else { k0 = load8(ROWK(b.K, b.ldkv, (kn), sr)); k1 = load8(ROWK(b.K, b.ldkv, (kn), 32 + sr)); v0 = load8(ROWK(b.V, b.ldkv, (kn), sr)); v1 = load8(ROWK(b.V, b.ldkv, (kn), 32 + sr)); } } while (0)
    SM_LOAD(0);
    float m_reg = -1e30f, l_reg = 0.f; f32x16 o[4] = {};
    for (int t = 0; t < NT; ++t) {
        const int kb = t * KVBLK;
        __syncthreads();
        if (kb < nf) { k0 = pack8(fk[0], fk[1]); k1 = pack8(fk[2], fk[3]); v0 = pack8(fv[0], fv[1]); v1 = pack8(fv[2], fv[3]); }
        *(bf16x8*)(K_lds + kws) = k0; *(bf16x8*)(K_lds + kws + 32 * 256) = k1; *(bf16x8*)(V_lds + vst0) = v0; *(bf16x8*)(V_lds + vst1) = v1;
        __syncthreads();
        if (t + 1 < NT) SM_LOAD(kb + KVBLK);
        if (wact) {
            f32x16 p0, p1; qkt<0, true>(p0, p1, K_lds, r32, hi, qr, bos + kb);
            if (kb + KVBLK - 1 > qlo) mask_tile(p0, p1, qm - kb, (unsigned)WINF);
            float mn, al; partialSM(p0, p1, m_reg, mn, al);
            if (__any(al < 1.f)) { if (hi == 0) al_l[r32] = al; asm volatile("s_waitcnt lgkmcnt(0)" ::: "memory");
#pragma unroll
                for (int d_ = 0; d_ < 4; ++d_)
#pragma unroll
                    for (int r = 0; r < 16; ++r) o[d_][r] *= al_l[crow(r, hi)]; }
            bf16x8 pa0, pa1, pa2, pa3; finishSM(p0, p1, al, l_reg, pa0, pa1, pa2, pa3);
            pv_tile<0>(o, vb0, pa0, pa1, pa2, pa3);
        }
    }
    if (wact) {
        if (hi == 0) li_l[r32] = l_reg; asm volatile("s_waitcnt lgkmcnt(0)" ::: "memory");
        bf16_t* Ow = b.O + (size_t)(wid * QBLK) * b.ldo;
#pragma unroll
        for (int r = 0; r < 16; ++r) { const int orow = crow(r, hi); const float rl = __builtin_amdgcn_rcpf(li_l[orow]);
#pragma unroll
            for (int d0 = 0; d0 < 4; ++d0) { const float v = o[d0][r] * rl; const float vn = __shfl_xor(v, 1);
                if ((r32 & 1) == 0) *(unsigned*)(Ow + (size_t)orow * b.ldo + d0 * 32 + r32) = cvtpk(v, vn); } }
    }
    __syncthreads();
#undef SM_LOAD
}
#undef SB_LOAD
#undef ROWK
#undef VMW
#undef VMWN
#undef SLOAD_H
#undef SWRITE_HK
#undef SWRITE_HV
#undef SWRITE_H
#undef QROWP
#undef PK4
#undef KSWZ
#undef KBASE
}

namespace gla {
constexpr int ZQ = 0, ZK = GKW, ZV = 2 * GKW, ZR = 2 * GKW + GVW, ZG = 5120;
constexpr int KP = 72, QP = 200;
constexpr int L_G = 0;
constexpr int L_GLOW = 49152;
constexpr int L_TOT = 53248;
constexpr int L_QP = 54272;
constexpr int L_KPB = L_QP + 64 * QP * 2;
constexpr int L_AB = L_KPB + 64 * QP * 2;
constexpr int L_VT = L_AB + 64 * KP * 2;
constexpr int L_RS = L_VT + 128 * KP * 2;
constexpr int L_ST = 0;
constexpr int L1_KD = 54272;
constexpr int L1_VT = L1_KD + 192 * KP * 2;
static_assert(L_RS + 1024 <= LDS_WORK && L1_VT + 384 * KP * 2 <= LDS_WORK, "GLA LDS map");

__device__ __forceinline__ int chunk_row0(int c) { return c < TP / 64 ? c * 64 : TP + (c - TP / 64) * 64; }

__device__ __forceinline__ void decay_scan(const bf16_t* z, const float* wg2, const float* bg, int row0, int h, char* lds, int tid) {
    float* G = (float*)(lds + L_G); float* glow = (float*)(lds + L_GLOW); float* tot = (float*)(lds + L_TOT);
    const int k = tid % 192, half = tid / 192; float w[16];
#pragma unroll
    for (int j = 0; j < 16; ++j) w[j] = wg2[(size_t)j * GKW + h * GDK + k];
    const float b = bg[h * GDK + k];
    for (int i = tid; i < 64 * 16; i += 512) glow[i] = bf2f(z[(size_t)(row0 + (i >> 4)) * ZLD + ZG + (i & 15)]);
    __syncthreads();
    if (tid < 384) {
        float g = 0.f;
        for (int s = half * 32; s < half * 32 + 32; ++s) { float a = b;
#pragma unroll
            for (int j = 0; j < 16; ++j) a += glow[s * 16 + j] * w[j];
            g += (fminf(a, 0.f) - __logf(1.f + __expf(-fabsf(a)))) * (1.0f / 16.0f); G[s * GDK + k] = g; }
        if (half == 0) tot[k] = g;
    }
    __syncthreads();
}

__device__ __forceinline__ void g1_unit(int c, int h, const bf16_t* z, const float* wg2, const float* bg, bf16_t* UT, float* DEC, char* lds, int g_wave) {
    const int tid = opaque_tid(); const int row0 = chunk_row0(c);
    bf16_t kpre[3][8]; u32x4 vpre[6];
#pragma unroll
    for (int j = 0; j < 3; ++j) { const int it = tid + 512 * j, k = it % 192, sb = it / 192;
#pragma unroll
        for (int i = 0; i < 8; ++i) kpre[j][i] = z[(size_t)(row0 + sb * 8 + i) * ZLD + ZK + h * GDK + k]; }
#pragma unroll
    for (int j = 0; j < 6; ++j) { const int it = tid + 512 * j, s = it & 63, vb = it >> 6; vpre[j] = *(const u32x4*)(z + (size_t)(row0 + s) * ZLD + ZV + h * GDV + vb * 8); }
    decay_scan(z, wg2, bg, row0, h, lds, tid);
    const float* G = (const float*)(lds + L_G); const float* tot = (const float*)(lds + L_TOT);
    bf16_t* KD = (bf16_t*)(lds + L1_KD); bf16_t* VT = (bf16_t*)(lds + L1_VT);
#pragma unroll
    for (int j = 0; j < 3; ++j) {
        const int it = tid + 512 * j, k = it % 192, sb = it / 192; const float t0 = tot[k], glast = G[63 * GDK + k] + t0; float v[8];
#pragma unroll
        for (int i = 0; i < 8; ++i) { const int s = sb * 8 + i; const float g = G[s * GDK + k] + (s >= 32 ? t0 : 0.f);
            v[i] = bf2f(kpre[j][i]) * __expf(glast - g); }
        u32x4 w = {cvtpk(v[0], v[1]), cvtpk(v[2], v[3]), cvtpk(v[4], v[5]), cvtpk(v[6], v[7])};
        *(u32x4*)(KD + k * KP + sb * 8) = w;
        if (sb == 0) DEC[(size_t)(c * GH + h) * GDK + k] = __expf(glast);
    }
#pragma unroll
    for (int j = 0; j < 6; ++j) {
        const int it = tid + 512 * j, s = it & 63, vb = it >> 6; const u32x4 w = vpre[j];
#pragma unroll
        for (int i = 0; i < 4; ++i) { VT[(vb * 8 + 2 * i) * KP + s] = (bf16_t)(w[i] & 0xffffu); VT[(vb * 8 + 2 * i + 1) * KP + s] = (bf16_t)(w[i] >> 16); }
    }
    __syncthreads();
    const int wid = tid >> 6, lane = tid & 63, l32 = lane & 31, hi = lane >> 5, mq = wid & 3, nh = wid >> 2;
    f32x16 acc[3][3];
#pragma unroll
    for (int i = 0; i < 3; ++i)
#pragma unroll
        for (int j = 0; j < 3; ++j) acc[i][j] = f32x16{};
#pragma unroll
    for (int ks = 0; ks < 4; ++ks) { bf16x8 a[3], bb[3];
#pragma unroll
        for (int i = 0; i < 3; ++i) { a[i] = *(const bf16x8*)(VT + ((mq * 3 + i) * 32 + l32) * KP + ks * 16 + hi * 8); bb[i] = *(const bf16x8*)(KD + ((nh * 3 + i) * 32 + l32) * KP + ks * 16 + hi * 8); }
#pragma unroll
        for (int i = 0; i < 3; ++i)
#pragma unroll
            for (int j = 0; j < 3; ++j) acc[i][j] = __builtin_amdgcn_mfma_f32_32x32x16_bf16(a[i], bb[j], acc[i][j], 0, 0, 0); }
    bf16_t* out = UT + (size_t)(c * GH + h) * GDV * GDK;
#pragma unroll
    for (int i = 0; i < 3; ++i)
#pragma unroll
        for (int j = 0; j < 3; ++j)
#pragma unroll
            for (int r = 0; r < 16; ++r) { const float v = acc[i][j][r], vn = __shfl_xor(v, 1);
                if ((l32 & 1) == 0) *(unsigned*)(out + (size_t)((mq * 3 + i) * 32 + att::crow(r, hi)) * GDK + (nh * 3 + j) * 32 + l32) = cvtpk(v, vn); }
    __syncthreads();
}

__device__ __forceinline__ void g2_tile(int tile, bf16_t* UT, const float* DEC, const float* s0in, float* outp, float* outs, char* lds, int tid, unsigned* sctr, unsigned sneed) {
    const int h = tile / 36, vt = (tile % 36) / 3, kt = tile % 3, vi = tid >> 4, kg = tid & 15, v = vt * 32 + vi, k = kt * 64 + kg * 4;
    float* T = (float*)lds;
    const size_t cstride = (size_t)GH * GDV * GDK; bf16_t* up = UT + ((size_t)h * GDV + v) * GDK + k; const float* dp = DEC + h * GDK + k;
    float zz = 0.f; asm volatile("" : "+v"(zz)); f32x4 S = {zz, zz, zz, zz};
#define G2_LOAD(U, D, c0_) do { _Pragma("unroll") for (int i = 0; i < 8; ++i) { U[i] = *(const u32x2*)(up + (size_t)((c0_) + i) * cstride); D[i] = *(const f32x4*)(dp + (size_t)((c0_) + i) * GH * GDK); } } while (0)
#define G2_STEP(U, D, c0_) do { _Pragma("unroll") for (int i = 0; i < 8; ++i) { u32x2 w = {cvtpk(S[0], S[1]), cvtpk(S[2], S[3])}; *(u32x2*)(up + (size_t)((c0_) + i) * cstride) = w; \
        const f32x4 u_ = {__uint_as_float(U[i][0] << 16), __uint_as_float(U[i][0] & 0xffff0000u), __uint_as_float(U[i][1] << 16), __uint_as_float(U[i][1] & 0xffff0000u)}; S = D[i] * S + u_; } } while (0)
    { u32x2 ua[8], ub[8], uc[8]; f32x4 da[8], db[8], dc[8];
      constexpr int NCH = TP / 64;
      static_assert(NCH % 24 == 8, "scan loop: 5 x 3 batches + 1");
      G2_LOAD(ua, da, 0); G2_LOAD(ub, db, 8);
      for (int c0 = 0; c0 + 24 <= NCH; c0 += 24) { G2_LOAD(uc, dc, c0 + 16); G2_STEP(ua, da, c0); G2_LOAD(ua, da, c0 + 24); G2_STEP(ub, db, c0 + 8); if (c0 + 32 < NCH) G2_LOAD(ub, db, c0 + 32); G2_STEP(uc, dc, c0 + 16); }
      G2_STEP(ua, da, NCH - 8); }
#undef G2_LOAD
#undef G2_STEP
    const int kr = tid >> 3, v4 = (tid & 7) * 4;
    T[(kg * 4 + 0) * 33 + vi] = S[0]; T[(kg * 4 + 1) * 33 + vi] = S[1]; T[(kg * 4 + 2) * 33 + vi] = S[2]; T[(kg * 4 + 3) * 33 + vi] = S[3];
    __syncthreads();
    { f32x4 o = {T[kr * 33 + v4], T[kr * 33 + v4 + 1], T[kr * 33 + v4 + 2], T[kr * 33 + v4 + 3]}; *(f32x4*)(outp + ((size_t)h * GDK + kt * 64 + kr) * GDV + vt * 32 + v4) = o; }
    __syncthreads();
    if (sctr != nullptr) {
        if (tid == 0) { unsigned sp = 0; while (__hip_atomic_load(sctr, __ATOMIC_RELAXED, __HIP_MEMORY_SCOPE_AGENT) < sneed) { __builtin_amdgcn_s_sleep(1); if (++sp > (1u << 22)) break; }
            __builtin_amdgcn_fence(__ATOMIC_ACQUIRE, "agent"); asm volatile("s_waitcnt vmcnt(0)" ::: "memory"); }
        __syncthreads(); }
    for (int b = 0; b < NB; ++b) {
        const int c = TP / 64 + b; const size_t sb = ((size_t)b * GH + h) * GDK * GDV;
        { const f32x4 i4 = *(const f32x4*)(s0in + sb + (size_t)(kt * 64 + kr) * GDV + vt * 32 + v4); T[kr * 33 + v4] = i4[0]; T[kr * 33 + v4 + 1] = i4[1]; T[kr * 33 + v4 + 2] = i4[2]; T[kr * 33 + v4 + 3] = i4[3]; }
        __syncthreads();
        f32x4 s0 = {T[(kg * 4 + 0) * 33 + vi], T[(kg * 4 + 1) * 33 + vi], T[(kg * 4 + 2) * 33 + vi], T[(kg * 4 + 3) * 33 + vi]};
        const u32x2 uw = *(const u32x2*)(up + (size_t)c * cstride); const f32x4 u = {__uint_as_float(uw[0] << 16), __uint_as_float(uw[0] & 0xffff0000u), __uint_as_float(uw[1] << 16), __uint_as_float(uw[1] & 0xffff0000u)};
        const f32x4 d = *(const f32x4*)(dp + (size_t)c * GH * GDK);
        { u32x2 w = {cvtpk(s0[0], s0[1]), cvtpk(s0[2], s0[3])}; *(u32x2*)(up + (size_t)c * cstride) = w; } const f32x4 sn = d * s0 + u;
        __syncthreads();
        T[(kg * 4 + 0) * 33 + vi] = sn[0]; T[(kg * 4 + 1) * 33 + vi] = sn[1]; T[(kg * 4 + 2) * 33 + vi] = sn[2]; T[(kg * 4 + 3) * 33 + vi] = sn[3];
        __syncthreads();
        { f32x4 o = {T[kr * 33 + v4], T[kr * 33 + v4 + 1], T[kr * 33 + v4 + 2], T[kr * 33 + v4 + 3]}; *(f32x4*)(outs + sb + (size_t)(kt * 64 + kr) * GDV + vt * 32 + v4) = o; }
        __syncthreads();
    }
}

__device__ __forceinline__ void state_transpose(const float* s0, bf16_t* out, char* lds, int tid) {
    float* T = (float*)lds; const int r = tid >> 3, c8 = (tid & 7) * 8;
    for (int t = 0; t < (GDK / 64) * (GDV / 64); ++t) { const int k0 = (t / (GDV / 64)) * 64, v0 = (t % (GDV / 64)) * 64;
        const f32x4 a = *(const f32x4*)(s0 + (size_t)(k0 + r) * GDV + v0 + c8), b = *(const f32x4*)(s0 + (size_t)(k0 + r) * GDV + v0 + c8 + 4);
        __syncthreads();
#pragma unroll
        for (int i = 0; i < 4; ++i) { T[r * 65 + c8 + i] = a[i]; T[r * 65 + c8 + 4 + i] = b[i]; }
        __syncthreads();
        float x[8];
#pragma unroll
        for (int i = 0; i < 8; ++i) x[i] = T[(c8 + i) * 65 + r];
        u32x4 w = {cvtpk(x[0], x[1]), cvtpk(x[2], x[3]), cvtpk(x[4], x[5]), cvtpk(x[6], x[7])};
        *(u32x4*)(out + (size_t)(v0 + r) * GDK + k0 + c8) = w; }
    asm volatile("s_waitcnt vmcnt(0)" ::: "memory"); __syncthreads();
}

__device__ __forceinline__ void g3_unit(int c, int h, const bf16_t* z, const float* wg2, const float* bg, const bf16_t* UT, const float* ng, const float* br, bf16_t* oc, char* lds, int g_wave) {
    const int tid = opaque_tid(); const int row0 = chunk_row0(c);
    u32x4 qpre[3], kpre[3];
#pragma unroll
    for (int j = 0; j < 3; ++j) { const int it = tid + 512 * j, s = it / 24, kb = (it % 24) * 8; qpre[j] = *(const u32x4*)(z + (size_t)(row0 + s) * ZLD + ZQ + h * GDK + kb); kpre[j] = *(const u32x4*)(z + (size_t)(row0 + s) * ZLD + ZK + h * GDK + kb); }
    decay_scan(z, wg2, bg, row0, h, lds, tid);
    const float* G = (const float*)(lds + L_G); const float* tot = (const float*)(lds + L_TOT);
    bf16_t* Qp = (bf16_t*)(lds + L_QP); bf16_t* Kp = (bf16_t*)(lds + L_KPB); bf16_t* Ab = (bf16_t*)(lds + L_AB); bf16_t* VT = (bf16_t*)(lds + L_VT); bf16_t* ST = (bf16_t*)(lds + L_ST);
    float* RS = (float*)(lds + L_RS);
    const float qs = 0.07216878364870322f;
#pragma unroll
    for (int j = 0; j < 3; ++j) {
        const int it = tid + 512 * j, s = it / 24, kb = (it % 24) * 8; float g[8];
#pragma unroll
        for (int i = 0; i < 8; ++i) g[i] = G[s * GDK + kb + i] + (s >= 32 ? tot[kb + i] : 0.f);
        const u32x4 qw = qpre[j], kw = kpre[j];
        u32x4 qo, ko;
#pragma unroll
        for (int i = 0; i < 4; ++i) { const float e0 = __expf(g[2 * i]), e1 = __expf(g[2 * i + 1]);
            qo[i] = cvtpk(__uint_as_float(qw[i] << 16) * qs * e0, __uint_as_float(qw[i] & 0xffff0000u) * qs * e1);
            ko[i] = cvtpk(__uint_as_float(kw[i] << 16) * __builtin_amdgcn_rcpf(e0), __uint_as_float(kw[i] & 0xffff0000u) * __builtin_amdgcn_rcpf(e1)); }
        *(u32x4*)(Qp + s * QP + kb) = qo; *(u32x4*)(Kp + s * QP + kb) = ko;
    }
    __syncthreads();
    const int wid = tid >> 6, lane = tid & 63, l32 = lane & 31, hi = lane >> 5;
    const int mt = wid & 1, nt = wid >> 1;
    f32x16 oacc[3];
    const bf16_t* Sb = UT + (size_t)(c * GH + h) * GDV * GDK;
    u32x4 stp[6], vtp[2];
#define G3_LOAD(vs_) do { _Pragma("unroll") for (int j = 0; j < 6; ++j) { const int it = tid + 512 * j, v = it / 24, kb = (it % 24) * 8; stp[j] = *(const u32x4*)(Sb + (size_t)((vs_) * 128 + v) * GDK + kb); } \
        _Pragma("unroll") for (int j = 0; j < 2; ++j) { const int it = tid + 512 * j, s = it & 63, vb = it >> 6; vtp[j] = *(const u32x4*)(z + (size_t)(row0 + s) * ZLD + ZV + h * GDV + (vs_) * 128 + vb * 8); } } while (0)
    G3_LOAD(0);
    if (wid < 4) {
        const int mt = wid & 1, nt = wid >> 1; f32x16 a = f32x16{};
        if (nt <= mt) {
#pragma unroll
            for (int ks = 0; ks < 12; ++ks) { const bf16x8 x = *(const bf16x8*)(Qp + (mt * 32 + l32) * QP + ks * 16 + hi * 8), y = *(const bf16x8*)(Kp + (nt * 32 + l32) * QP + ks * 16 + hi * 8);
                a = __builtin_amdgcn_mfma_f32_32x32x16_bf16(x, y, a, 0, 0, 0); }
        }
#pragma unroll
        for (int r = 0; r < 16; ++r) { const int t = mt * 32 + att::crow(r, hi), s = nt * 32 + l32; const float v = (s <= t) ? a[r] : 0.f; Ab[t * KP + s] = (bf16_t)(cvtpk(v, 0.f) & 0xffffu); }
    }
    __syncthreads();
#pragma unroll
    for (int vs = 0; vs < 3; ++vs) {
#pragma unroll
        for (int j = 0; j < 6; ++j) { const int it = tid + 512 * j, v = it / 24, kb = (it % 24) * 8; *(u32x4*)(ST + v * QP + kb) = stp[j]; }
#pragma unroll
        for (int j = 0; j < 2; ++j) { const int it = tid + 512 * j, s = it & 63, vb = it >> 6; const u32x4 w = vtp[j];
#pragma unroll
            for (int i = 0; i < 4; ++i) { VT[(vb * 8 + 2 * i) * KP + s] = (bf16_t)(w[i] & 0xffffu); VT[(vb * 8 + 2 * i + 1) * KP + s] = (bf16_t)(w[i] >> 16); } }
        __syncthreads();
        if (vs < 2) G3_LOAD(vs + 1);
        f32x16 a = f32x16{};
#pragma unroll
        for (int ks = 0; ks < 12; ++ks) { const bf16x8 x = *(const bf16x8*)(Qp + (mt * 32 + l32) * QP + ks * 16 + hi * 8), y = *(const bf16x8*)(ST + (nt * 32 + l32) * QP + ks * 16 + hi * 8);
            a = __builtin_amdgcn_mfma_f32_32x32x16_bf16(x, y, a, 0, 0, 0); }
#pragma unroll
        for (int ks = 0; ks < 4; ++ks) { const bf16x8 x = *(const bf16x8*)(Ab + (mt * 32 + l32) * KP + ks * 16 + hi * 8), y = *(const bf16x8*)(VT + (nt * 32 + l32) * KP + ks * 16 + hi * 8);
            a = __builtin_amdgcn_mfma_f32_32x32x16_bf16(x, y, a, 0, 0, 0); }
        oacc[vs] = a;
        __syncthreads();
    }
#undef G3_LOAD
#pragma unroll
    for (int r = 0; r < 16; ++r) { float q = oacc[0][r] * oacc[0][r] + oacc[1][r] * oacc[1][r] + oacc[2][r] * oacc[2][r];
        q += __shfl_xor(q, 1); q += __shfl_xor(q, 2); q += __shfl_xor(q, 4); q += __shfl_xor(q, 8); q += __shfl_xor(q, 16);
        if (l32 == 0) RS[(mt * 32 + att::crow(r, hi)) * 4 + nt] = q; }
    __syncthreads();
#pragma unroll
    for (int r = 0; r < 16; ++r) { const int t = mt * 32 + att::crow(r, hi); const f32x4 q4 = *(const f32x4*)(RS + t * 4);
        const float rstd = rsqrtf(((q4[0] + q4[1]) + (q4[2] + q4[3])) * (1.0f / GDV) + RMS_EPS);
#pragma unroll
        for (int vs = 0; vs < 3; ++vs) { const int cv = h * GDV + vs * 128 + nt * 32 + l32;
            const float gate = bf2f(z[(size_t)(row0 + t) * ZLD + ZR + cv]) + br[cv]; const float sg = gate / (1.f + __expf(-gate));
            const float val = oacc[vs][r] * rstd * ng[cv] * sg; const float vn = __shfl_xor(val, 1);
            if ((l32 & 1) == 0) *(unsigned*)(oc + (size_t)(row0 + t) * DM + cv) = cvtpk(val, vn); } }
    __syncthreads();
}
}

__device__ __forceinline__ int in_rowmap(int kind, int c) {
    if (kind == 0) return c < 4608 ? c : (c < 4620 ? 5120 + (c - 4608) : 4608 + (c - 4620));
    if (kind == 2) return c < 4608 ? c : (c < 4624 ? 5120 + (c - 4608) : 4608 + (c - 4624));
    return c;
}
constexpr int TR_SCR = 64 * 65 * 4;
struct TrItem { const float* W; bf16_t* WT; const float* gain; int K, N, kind, item; };
__device__ __forceinline__ bool tr_geom(const TrItem& t, int& k0, int& n0) {
    const int nblk = (t.N + 63) >> 6, kq = t.K >> 8, sb = t.item >> 4, e = t.item & 15, kb = (sb % kq) * 4 + (e & 3), nb = (sb / kq) * 4 + (e >> 2); k0 = 64 * kb; n0 = 64 * nb; return nb < nblk;
}
__device__ __forceinline__ void tr_load(const TrItem& t, float (&v)[64], int lane) {
    int k0, n0; if (!tr_geom(t, k0, n0)) return;
    const int nn = n0 + lane; const float* src = t.W + (size_t)k0 * t.N + (nn < t.N ? nn : 0);
#pragma unroll
    for (int i = 0; i < 64; ++i) v[i] = __builtin_nontemporal_load(src + (size_t)i * t.N);
}
__device__ __forceinline__ void tr_store(const TrItem& t, float (&v)[64], float* scr, int lane) {
    int k0, n0; if (!tr_geom(t, k0, n0)) return;
    const bool ok = n0 + lane < t.N;
    if (t.gain) {
#pragma unroll
        for (int i = 0; i < 64; ++i) v[i] *= t.gain[k0 + i];
    }
#pragma unroll
    for (int i = 0; i < 64; ++i) scr[i * 65 + lane] = ok ? v[i] : 0.f;
    LDS_WAIT(); asm volatile("" ::: "memory");
    const int c = lane & 7;
#pragma unroll
    for (int j = 0; j < 8; ++j) { const int n = (lane >> 3) + 8 * j; const float* s = scr + (8 * c) * 65 + n;
        if (n0 + n < t.N) { u32x4 o; o[0] = cvtpk(s[0 * 65], s[1 * 65]); o[1] = cvtpk(s[2 * 65], s[3 * 65]); o[2] = cvtpk(s[4 * 65], s[5 * 65]); o[3] = cvtpk(s[6 * 65], s[7 * 65]);
            *(u32x4*)(t.WT + (size_t)in_rowmap(t.kind, n0 + n) * t.K + k0 + 8 * c) = o; } }
    LDS_WAIT(); asm volatile("" ::: "memory");
}
template <int NF4>
__device__ __forceinline__ void cvt_row2(const float* s0, bf16_t* d0, const float* s1, bf16_t* d1, int lane) {
    f32x4 a[NF4], b[NF4];
#pragma unroll
    for (int q = 0; q < NF4; ++q) { a[q] = __builtin_nontemporal_load((const f32x4*)(s0 + q * 256 + lane * 4)); b[q] = __builtin_nontemporal_load((const f32x4*)(s1 + q * 256 + lane * 4)); }
#pragma unroll
    for (int q = 0; q < NF4; ++q) { u32x2 w = {cvtpk(a[q][0], a[q][1]), cvtpk(a[q][2], a[q][3])}; *(u32x2*)(d0 + q * 256 + lane * 4) = w;
        u32x2 x = {cvtpk(b[q][0], b[q][1]), cvtpk(b[q][2], b[q][3])}; *(u32x2*)(d1 + q * 256 + lane * 4) = x; }
}

#ifndef EN_MASK
#define EN_MASK 0xFFFF
#endif
#define EN(k) ((EN_MASK >> (k)) & 1)
template <int V> struct IC { static constexpr int value = V; };
struct Args { const float* in[29]; float* out; unsigned char* ws; int ph_lo, ph_hi; };
constexpr int PPL = 9;
constexpr int PH_FINAL = 1 + PPL * NLAYER, PH_END = PH_FINAL + 1;
constexpr int PT_OFF = MISC_OFF + 256;
__device__ __forceinline__ unsigned long long ptab_raw(const char* lds, int k) {
    const unsigned long long v = ((const unsigned long long*)(lds + PT_OFF))[k];
    const unsigned l = __builtin_amdgcn_readfirstlane((unsigned)v), h = __builtin_amdgcn_readfirstlane((unsigned)(v >> 32));
    return ((unsigned long long)h << 32) | l;
}
#define PIN(k) ((const float*)(const GAS float*)ptab_raw(lds, (k)))
#define POUT() ((float*)(GAS float*)ptab_raw(lds, 29))
#define PWS() ((unsigned char*)(GAS unsigned char*)ptab_raw(lds, 30))
#define WSP(T, off) ((T*)(ws + (off)))

__device__ __forceinline__ int queue_fetch(unsigned* qhead, volatile LAS unsigned* MISC, int g_wave) {
    if (opaque_tid() == 0) MISC[16] = __hip_atomic_fetch_add(qhead, 1u, __ATOMIC_RELAXED, __HIP_MEMORY_SCOPE_AGENT);
    __syncthreads(); const int v = (int)MISC[16]; __syncthreads(); return __builtin_amdgcn_readfirstlane(v);
}
__device__ __forceinline__ void convert_weights(int Ld, int Ln, int cs, char* lds, unsigned char* ws, unsigned* qh, volatile LAS unsigned* MISC, int g_wave) {
    const int Lq = Ln < 0 ? 0 : Ln, Lp = Ld < 0 ? 0 : Ld, kind = Lq % 3, j = Lq / 3, tid = opaque_tid(), lane = tid & 63, wave = tid >> 6;
    const int nin = kind == 0 ? 5132 : (kind == 1 ? 5120 : 5136);
    const int hn = Ln >= 0 ? 1 : 0, n0 = 128 * ((((nin + 63) / 64) + 3) / 4);
    const int m0 = Ld >= 0 ? 128 * 32 : 0, m1 = m0 + hn * 32 * 32, m2 = m1 + hn * 32 * 128, m3 = m2 + hn * 32 * 16, total = m3 + hn * n0, nchunks = (total + cs - 1) / cs, ipw = cs >> 3;
    float* scr = (float*)(lds + wave * TR_SCR);
    auto mk = [&](int it, TrItem& t) -> bool {
        if (it >= total) return false;
        if (it < m0) { t.W = PIN(28) + (size_t)Lp * DFF * DM; t.K = DFF; t.N = DM; t.WT = WSP(bf16_t, WS_WDN) + (size_t)Lp * DM * DFF; t.kind = 1; t.gain = nullptr; t.item = it; }
        else if (it < m1) { t.W = kind == 0 ? PIN(18) + (size_t)j * DM * DM : (kind == 1 ? PIN(20) : PIN(26)); t.K = DM; t.N = DM; t.WT = WSP(bf16_t, WS_WOUT) + (size_t)Lq * DM * DM; t.kind = 1; t.gain = nullptr; t.item = it - m0; }
        else if (it < m2) { t.W = PIN(27) + (size_t)Lq * DM * DFF; t.K = DM; t.N = DFF; t.WT = WSP(bf16_t, WS_WUP) + (size_t)Lq * DFF * DM; t.kind = 1; t.gain = PIN(12) + Lq * DM; t.item = it - m1; }
        else if (it < m3) { t.W = PIN(15) + (size_t)Lq * DM * 1024; t.K = DM; t.N = 1024; t.WT = WSP(bf16_t, WS_WMKV) + (size_t)Lq * 1024 * DM; t.kind = 1; t.gain = nullptr; t.item = it - m2; }
        else { t.W = kind == 0 ? PIN(16) + (size_t)j * DM * 5132 : (kind == 1 ? PIN(19) : PIN(21)); t.K = DM; t.N = nin; t.WT = WSP(bf16_t, WS_WIN) + (size_t)Lq * ZLD * DM; t.kind = kind; t.gain = PIN(11) + Lq * DM; t.item = it - m3; }
        return true;
    };
    for (;;) {
        const int chunk = queue_fetch(qh, MISC, g_wave); if (chunk >= nchunks) break;
        const int it0 = chunk * cs + wave * ipw; float va[64], vb[64]; TrItem ta, tb; bool oa = mk(it0, ta), ob;
        if (oa) tr_load(ta, va, lane);
#pragma unroll 1
        for (int i = 0; i < ipw; i += 2) {
            ob = mk(it0 + i + 1, tb); if (ob) tr_load(tb, vb, lane);
            if (oa) tr_store(ta, va, scr, lane);
            oa = i + 2 < ipw && mk(it0 + i + 2, ta); if (oa) tr_load(ta, va, lane);
            if (ob) tr_store(tb, vb, scr, lane);
        }
    }
}
__device__ __forceinline__ void convert_kv_cache(const float* ck, const float* cv, bf16_t* dk, bf16_t* dv, unsigned* qh, volatile LAS unsigned* MISC, int g_wave) {
    const int tid = opaque_tid(), lane = tid & 63, wave = tid >> 6;
    for (;;) {
        const int chunk = queue_fetch(qh, MISC, g_wave); if (chunk >= NB * PAST / 64) break;
#pragma unroll 2
        for (int i = 0; i < 8; ++i) { const int r = chunk * 64 + wave * 8 + i; const size_t so = (size_t)r * AW, dof = ((size_t)(r / PAST) * SKS + (r % PAST)) * AW;
            cvt_row2<6>(ck + so, dk + dof, cv + so, dv + dof, lane); }
    }
}

__global__ void __launch_bounds__(512, 2) trunk_fwd(Args args) {
    extern __shared__ __attribute__((aligned(16))) unsigned char lds_raw[];
    char* lds = (char*)lds_raw;
    volatile LAS unsigned* MISC = (volatile LAS unsigned*)((LAS unsigned char*)lds_raw + MISC_OFF);
    for (int u = threadIdx.x; u < 64; u += 512) MISC[u] = 0u;
    if (threadIdx.x < 29) ((unsigned long long*)(lds + PT_OFF))[threadIdx.x] = (unsigned long long)args.in[threadIdx.x];
    if (threadIdx.x == 29) ((unsigned long long*)(lds + PT_OFF))[29] = (unsigned long long)args.out;
    if (threadIdx.x == 30) ((unsigned long long*)(lds + PT_OFF))[30] = (unsigned long long)args.ws;
    const int g_wave = __builtin_amdgcn_readfirstlane(threadIdx.x >> 6);
    __syncthreads();
    const int G = gridDim.x, bx = blockIdx.x, vcu = (G % 8 == 0) ? (bx % 8) * (G / 8) + bx / 8 : bx;
#if !MK_PER_PHASE
    XcdBarrier bar = xcd_barrier_post((unsigned*)(args.ws + WS_CTL) + CW_BAR, MISC + 8); bar.wave = g_wave;
#define GRID_BAR() xcd_barrier(bar)
#else
#define GRID_BAR() do { } while (0)
#endif
    const int lo = args.ph_lo, hi = args.ph_hi;
#define IN(k) (lo <= (k) && (k) < hi)
#ifdef PROBE_TS_A
#define STAMP(k) do { if (bx == 0 && opaque_tid() == 0) ((unsigned long long*)((unsigned*)(PWS() + WS_CTL) + CW_TS))[(k) + 1] = __builtin_amdgcn_s_memrealtime(); } while (0)
#else
#define STAMP(k) do { } while (0)
#endif
#define SEAM(k) do { if ((k) + 1 < hi) GRID_BAR(); STAMP(k); } while (0)

    STAMP(-1);
    if (EN(0) && IN(0)) {
        unsigned char* ws = PWS();
        const int tid = opaque_tid(), lane = tid & 63, wave = tid >> 6, gw = vcu * 8 + wave, NGW = G * 8;
        float* scr = (float*)(lds + wave * 16384);
        convert_weights(-1, 0, 32, lds, ws, WSP(unsigned, WS_CTL) + CW_CONV, MISC, g_wave);
        { const float* xp = PIN(0); const float* xs = PIN(1); float* X = WSP(float, WS_X); bf16_t* XB = WSP(bf16_t, WS_XB); float* RSA = WSP(float, WS_RSS);
        for (int m = gw; m < MT; m += NGW) {
            const float* src = m < TP ? xp + (size_t)m * DM : xs + (size_t)(m - TP) * DM; float ss = 0.f;
#pragma unroll
            for (int q = 0; q < 8; ++q) { const int o = q * 256 + lane * 4; const f32x4 v = *(const f32x4*)(src + o);
                u32x2 w = {cvtpk(v[0], v[1]), cvtpk(v[2], v[3])}; *(u32x2*)(XB + (size_t)m * DM + o) = w; ss += (v[0] * v[0] + v[1] * v[1]) + (v[2] * v[2] + v[3] * v[3]); }
            ss = wave_sum(ss);
            if (lane < 32) RSA[(size_t)m * 32 + lane] = lane == 0 ? ss : 0.f;
        } }
        { const float* mp = PIN(10); const float* gm = PIN(13); bf16_t* MEMH = WSP(bf16_t, WS_MEMH);
        for (int it = gw; it < NLAYER * NMEM; it += NGW) { const int i = it / NMEM, r = it % NMEM; const float* src = mp + (size_t)r * DM; const float* g = gm + (size_t)i * DM;
            f32x4 v[8]; float ss = 0.f;
#pragma unroll
            for (int q = 0; q < 8; ++q) { v[q] = *(const f32x4*)(src + q * 256 + lane * 4); ss += (v[q][0] * v[q][0] + v[q][1] * v[q][1]) + (v[q][2] * v[q][2] + v[q][3] * v[q][3]); }
            const float rstd = rsqrtf(wave_sum(ss) * (1.0f / DM) + RMS_EPS);
#pragma unroll
            for (int q = 0; q < 8; ++q) { const f32x4 gg = *(const f32x4*)(g + q * 256 + lane * 4); u32x2 w = {cvtpk(v[q][0] * rstd * gg[0], v[q][1] * rstd * gg[1]), cvtpk(v[q][2] * rstd * gg[2], v[q][3] * rstd * gg[3])};
                *(u32x2*)(MEMH + ((size_t)i * NMEM + r) * DM + q * 256 + lane * 4) = w; } } }
        SEAM(0);
    }

    auto finalize = [&](int L, bool dn, bool fin, unsigned* ctr) {
        unsigned char* ws = PWS();
        const int tid = opaque_tid(), lane = tid & 63, wave = tid >> 6; const int SP = dn ? 16 : 8;
        float* rssw = WSP(float, WS_RSS) + (dn ? 0 : (size_t)MT * 32);
        bf16_t* XB = WSP(bf16_t, WS_XB); const float* part = WSP(float, WS_GU);
        const float* xin = (L == 0 && !dn) ? PIN(1) : nullptr;
        int r0 = vcu; asm volatile("" : "+s"(r0));
        for (int r = r0; r < TS; r += G) { const size_t o = (size_t)(TP + r) * DM + tid * 4; const float* pp = part + (size_t)r * DM + tid * 4;
            f32x4 a; if (xin) a = *(const f32x4*)(xin + (size_t)r * DM + tid * 4); else { const u32x2 w = *(const u32x2*)(XB + o); a = (f32x4){__uint_as_float(w[0] << 16), __uint_as_float(w[0] & 0xffff0000u), __uint_as_float(w[1] << 16), __uint_as_float(w[1] & 0xffff0000u)}; }
            f32x4 p[16];
#pragma unroll
            for (int s = 0; s < 16; ++s) p[s] = s < SP ? *(const f32x4*)(pp + (size_t)s * TS * DM) : (f32x4){0.f, 0.f, 0.f, 0.f};
#pragma unroll
            for (int s = 0; s < 16; ++s) a += p[s];
            const float ss = wave_sum((a[0] * a[0] + a[1] * a[1]) + (a[2] * a[2] + a[3] * a[3]));
            if (!fin) { u32x2 w = {cvtpk(a[0], a[1]), cvtpk(a[2], a[3])}; *(u32x2*)(XB + o) = w;
                if (lane < 4) rssw[(size_t)(TP + r) * 32 + wave + 8 * lane] = lane == 0 ? ss : 0.f; }
            else { if (lane == 0) MISC[32 + wave] = __float_as_uint(ss);
                __syncthreads();
                float tot = 0.f;
#pragma unroll
                for (int w8 = 0; w8 < 8; ++w8) tot += __uint_as_float(MISC[32 + w8]);
                __syncthreads();
                const float rstd = rsqrtf(tot * (1.0f / DM) + RMS_EPS); const f32x4 gg = *(const f32x4*)(PIN(14) + tid * 4);
                __builtin_nontemporal_store(a * rstd * gg, (f32x4*)(POUT() + O_YS + (size_t)r * DM + tid * 4)); }
        }
        if (ctr) { asm volatile("s_waitcnt vmcnt(0)" ::: "memory"); __syncthreads();
            if (tid == 0) (void)__hip_atomic_fetch_add(ctr, 1u, __ATOMIC_RELEASE, __HIP_MEMORY_SCOPE_AGENT); }
    };
    auto layer = [&](auto Lc) {
        constexpr int L = decltype(Lc)::value;
        const int kind = L % 3, j = L / 3, base = 1 + PPL * L;
        const bool att_in_g2 = kind == 2 && G >= 144 + NB * GH + 64;
        auto att_section = [&](int vc, int Gc) {
            unsigned char* ws = PWS();
            float* outp = POUT(); const float* lfc = PIN(4); const float* FL = WSP(float, WS_FL);
            const int nfox = kind == 0 ? 480 : 0, total = nfox + 160;
            unsigned long long hperm = 0;
            if (kind == 0) { const float* hsum = (const float*)(WSP(unsigned, WS_CTL) + CW_HS + j * 64); float hv[NH];
#pragma unroll
                for (int h = 0; h < NH; ++h) hv[h] = __builtin_amdgcn_readfirstlane(hsum[h]);
#pragma unroll
                for (int h = 0; h < NH; ++h) { int rank = 0;
#pragma unroll
                    for (int g = 0; g < NH; ++g) rank += (hv[g] > hv[h] || (hv[g] == hv[h] && g < h)) ? 1 : 0;
                    hperm |= (unsigned long long)h << (4 * rank); } }
            auto get = [&](int n, att::Blk& b) {
                int type, a0, a1;
                if (n < nfox) { if (n < 384) { type = 0; a0 = (int)((hperm >> (4 * (n >> 5))) & 15); a1 = 31 - (n & 31); } else { type = 1; a0 = (n - 384) / NH; a1 = (n - 384) % NH; } }
                else { const int m = n - nfox; if (m < 128) { type = 2; a0 = m / 32; a1 = m % 32; } else { type = 3; a0 = (m - 128) / MH; a1 = (m - 128) % MH; } }
                bf16_t* Z = WSP(bf16_t, WS_Z); bf16_t* OC = WSP(bf16_t, WS_OC);
                b.ldq = ZLD; b.ldo = DM; b.lf0 = b.lf1 = nullptr; b.n0 = 0; b.bmode = 0; b.qq = b.kq = nullptr; b.jlo = 0; b.bsel = 0; b.pre0 = 0; b.ls0 = 1; b.Kf = b.Vf = nullptr; b.nf = 0; b.ldf = AW;
                if (type == 0) { const int h = a0, qb = a1; b.Q = Z + (size_t)qb * 256 * ZLD + h * HD; b.K = Z + AW + h * HD; b.V = Z + 2 * AW + h * HD; b.ldkv = ZLD; b.O = OC + (size_t)qb * 256 * DM + h * HD;
                    b.P0 = qb * 256; b.skv = TP; b.nrows = 256; b.bmode = 1; b.lf0 = FL + (size_t)h * MT; b.ls0 = 1; b.n0 = 1 << 30; b.pre0 = 1;
                    b.qq = WSP(unsigned, WS_CTL) + CW_QQ + ((j * 32 + qb) * NH + h) * 4; b.kq = WSP(unsigned, WS_CTL) + CW_KQ + j * 64 + h * 4; }
                else if (type == 1) { const int bb = a0, h = a1; const bf16_t* fk = WSP(bf16_t, WS_KVF) + (size_t)(2 * j) * (KVS_ONE / 2);
                    b.Q = Z + (size_t)(TP + bb * 64) * ZLD + h * HD; b.K = fk + (size_t)bb * SKS * AW + h * HD; b.V = fk + KVS_ONE / 2 + (size_t)bb * SKS * AW + h * HD; b.ldkv = AW;
                    b.O = OC + (size_t)(TP + bb * 64) * DM + h * HD; b.P0 = PAST; b.skv = SKS; b.nrows = 64; b.bmode = 1; b.lf0 = lfc + ((size_t)j * NB + bb) * PAST * NH + h; b.ls0 = NH; b.n0 = PAST; b.lf1 = FL + (size_t)h * MT + TP + bb * 64;
                    b.nf = PAST; b.ldf = AW; b.Kf = PIN(2) + ((size_t)j * NB + bb) * PAST * AW + h * HD; b.Vf = PIN(3) + ((size_t)j * NB + bb) * PAST * AW + h * HD; }
                else if (type == 2) { const int h4 = a0, qb = a1; const bf16_t* mkb = WSP(bf16_t, WS_MKVB) + (size_t)L * NMEM * 1024;
                    b.Q = Z + (size_t)qb * 256 * ZLD + 4608 + h4 * HD; b.K = mkb + h4 * HD; b.V = mkb + MEMW + h4 * HD; b.ldkv = 1024; b.O = OC + (size_t)qb * 256 * DM + AW + h4 * HD;
                    b.P0 = 1 << 20; b.skv = NMEM; b.nrows = 256; }
                else { const int bb = a0, h4 = a1; const bf16_t* mck = WSP(bf16_t, WS_MEMC) + (size_t)(2 * L) * (MEMC_ONE / 2);
                    b.Q = Z + (size_t)(TP + bb * 64) * ZLD + 4608 + h4 * HD; b.K = mck + (size_t)bb * NMEM * MEMW + h4 * HD; b.V = mck + MEMC_ONE / 2 + (size_t)bb * NMEM * MEMW + h4 * HD; b.ldkv = MEMW;
                    b.O = OC + (size_t)(TP + bb * 64) * DM + AW + h4 * HD; b.P0 = 1 << 20; b.skv = NMEM; b.nrows = 64;
                    b.nf = NMEM; b.ldf = MEMW; b.Kf = PIN(8) + ((size_t)L * NB + bb) * NMEM * MEMW + h4 * HD; b.Vf = PIN(9) + ((size_t)L * NB + bb) * NMEM * MEMW + h4 * HD; }
            };
            unsigned* qhead = WSP(unsigned, WS_CTL) + CW_QUEUE + 64 * L;
            const int nfp = kind == 0 ? 384 : 0, nfs = kind == 0 ? 96 : 0, nmain = nfp + 128, nsmall = nfs + 32;
            if (EN(6)) for (int si = vc; si < nsmall; si += Gc) { att::Blk sbk; get(si < nfs ? nfp + si : nfp + nfs + 128 + (si - nfs), sbk); att::small_block(sbk, lds, g_wave); }
            { const bool t0 = opaque_tid() == 0; unsigned pend = 0; const bool dyn = kind == 1 || vc < nsmall; const int qb0 = kind == 1 ? 0 : (Gc > nsmall ? Gc - nsmall : 0);
                auto issue = [&]() { if (t0) pend = __hip_atomic_fetch_add(qhead, 1u, __ATOMIC_RELAXED, __HIP_MEMORY_SCOPE_AGENT); };
                auto take = [&]() -> int { if (t0) MISC[16] = pend; __syncthreads(); const int v = (int)MISC[16]; __syncthreads(); return qb0 + __builtin_amdgcn_readfirstlane(v); };
                auto main_n = [&](int m) -> int { return m < nfp ? m : m + nfs; };
                int first = vc - nsmall; if (dyn) { issue(); first = take(); }
                if (EN(6) && first < nmain) {
                att::Blk cur, nxt;
                issue();
                get(main_n(first), cur); cur.bsel = 0; att::prepare_bias(cur, lds, g_wave);
                att::Seam S; att::att_prime(cur, lds, S, g_wave);
                for (;;) { const int in_ = take(); const bool more = in_ < nmain;
                    if (more) { issue(); get(main_n(in_), nxt); nxt.bsel = cur.bsel ^ 1; att::prepare_bias(nxt, lds, g_wave); } else nxt = cur;
                    att::att_block(cur, nxt, lds, S, g_wave);
                    if (!more) break; cur = nxt; }
                } }
        };
        if (EN(1) && IN(base + 0)) {
            unsigned char* ws = PWS();
            const int tid = opaque_tid();
            pg8::Sched S; S.nM = MT / 256; S.nN = kind == 1 ? 20 : 21; S.nwg = S.nM * S.nN; S.G = G; S.c = bx; S.nextra = 4; S.nt = DM / 64; S.rdy = L > 0 ? WSP(unsigned, WS_CTL) + CW_FIN + 64 * (2 * L) : nullptr; S.need = (unsigned)G;
            S.A = (const char*)WSP(bf16_t, WS_XB); S.B = (const char*)(WSP(bf16_t, WS_WIN) + (size_t)L * ZLD * DM); S.tA = (size_t)256 * DM * 2; S.tB = (size_t)256 * DM * 2;
            S.Ae = (const char*)(WSP(bf16_t, WS_MEMH) + (size_t)L * NMEM * DM); S.Be = (const char*)(WSP(bf16_t, WS_WMKV) + (size_t)L * 1024 * DM); S.tAe = 0; S.tBe = (size_t)256 * DM * 2;
            pg8::EpiIn E; E.z = WSP(bf16_t, WS_Z); E.rss = WSP(float, WS_RSS); E.out = POUT(); E.mkvb = WSP(bf16_t, WS_MKVB); E.kind = kind; E.j = j; E.ml = L; E.ctl = (unsigned*)WSP(unsigned, WS_CTL); E.fl = WSP(float, WS_FL); E.dup = WSP(float, WS_GU);
            E.kvb = kind == 0 ? WSP(bf16_t, WS_KVF) + (size_t)(2 * j) * (KVS_ONE / 2) : WSP(bf16_t, WS_KVS); E.bfg = PIN(17) + j * NH;
            pg8::gemm_phase<pg8::EpiIn, pg8::Sched>((LAS unsigned char*)lds_raw, DM, DM, DM, S, E, tid);
            SEAM(base + 0);
        }
        if (IN(base + 1) && kind != 0) {
            unsigned char* ws = PWS();
            if (EN(2) && kind == 1) {
                bf16_t* Z = WSP(bf16_t, WS_Z); bf16_t* OC = WSP(bf16_t, WS_OC); bf16_t* KVS = WSP(bf16_t, WS_KVS);
                for (int n = vcu; n < 480; n += G) { att::Blk b; b.ldq = ZLD; b.ldo = DM; b.bmode = 0; b.lf0 = b.lf1 = nullptr; b.n0 = 0; b.qq = b.kq = nullptr; b.jlo = 0; b.bsel = 0; b.pre0 = 0; b.ls0 = 1; b.nf = 0; b.Kf = b.Vf = nullptr; b.ldf = AW;
                    if (n < 384) { const int h = n / 32, qb = n % 32; b.Q = Z + (size_t)qb * 256 * ZLD + h * HD; b.K = Z + AW + h * HD; b.V = Z + 2 * AW + h * HD; b.ldkv = ZLD;
                        b.O = OC + (size_t)qb * 256 * DM + h * HD; b.P0 = qb * 256; b.skv = TP; b.nrows = 256; }
                    else { const int m = n - 384, bb = m / NH, h = m % NH; b.Q = Z + (size_t)(TP + bb * 64) * ZLD + h * HD; b.K = KVS + (size_t)bb * SKS * AW + h * HD; b.V = KVS + KVS_ONE / 2 + (size_t)bb * SKS * AW + h * HD; b.ldkv = AW;
                        b.O = OC + (size_t)(TP + bb * 64) * DM + h * HD; b.P0 = PAST; b.skv = SKS; b.nrows = 64;
                        b.nf = PAST; b.Kf = PIN(5) + (size_t)bb * PAST * AW + h * HD; b.Vf = PIN(6) + (size_t)bb * PAST * AW + h * HD; }
                    att::sb_block(b, lds, g_wave); }
            } else if (EN(3) && kind == 2) {
                for (int u = vcu; u < (att_in_g2 ? (TP / 64) * GH : NCHUNK * GH); u += G) gla::g1_unit(u / GH, u % GH, WSP(bf16_t, WS_Z), PIN(22), PIN(23), WSP(bf16_t, WS_GU), WSP(float, WS_GDEC), lds, g_wave);
            }
            if (kind != 1) SEAM(base + 1);
        }
        if (EN(4) && IN(base + 2) && kind == 2) {
            unsigned char* ws = PWS();
            const int tid = opaque_tid();
            unsigned* sctr = WSP(unsigned, WS_CTL) + CW_FIN + 64 * 9;
            if (vcu < 144) gla::g2_tile(vcu, WSP(bf16_t, WS_GU), WSP(float, WS_GDEC), PIN(7), POUT() + O_GSP, POUT() + O_GSS, lds, tid, att_in_g2 ? sctr : nullptr, (unsigned)(NB * GH));
            __syncthreads();
            if (att_in_g2 && vcu >= 144 && vcu - 144 < NB * GH) {
                const int sb_ = (vcu - 144) / GH, sh_ = (vcu - 144) % GH;
                bf16_t* UTS = WSP(bf16_t, WS_MEMC);
                gla::state_transpose(PIN(7) + ((size_t)sb_ * GH + sh_) * GDK * GDV, UTS + ((size_t)sb_ * GH + sh_) * GDV * GDK, lds, opaque_tid());
                gla::g3_unit(TP / 64 + sb_, sh_, WSP(bf16_t, WS_Z), PIN(22), PIN(23), UTS - (size_t)(TP / 64) * GH * GDV * GDK, PIN(25), PIN(24), WSP(bf16_t, WS_OC), lds, g_wave); }
            if (att_in_g2 && vcu >= 144 + NB * GH && vcu - (144 + NB * GH) < NB * GH) { const int su = (TP / 64) * GH + (vcu - (144 + NB * GH));
                gla::g1_unit(su / GH, su % GH, WSP(bf16_t, WS_Z), PIN(22), PIN(23), WSP(bf16_t, WS_GU), WSP(float, WS_GDEC), lds, g_wave);
                asm volatile("s_waitcnt vmcnt(0)" ::: "memory"); __syncthreads();
                if (opaque_tid() == 0) (void)__hip_atomic_fetch_add(sctr, 1u, __ATOMIC_RELEASE, __HIP_MEMORY_SCOPE_AGENT); }
            if (att_in_g2 && vcu >= 144 + NB * GH) att_section(vcu - (144 + NB * GH), G - (144 + NB * GH));
            SEAM(base + 2);
        }
        if (IN(base + 3)) {
            unsigned char* ws = PWS();
            if (EN(5) && kind == 2) for (int u = vcu; u < (att_in_g2 ? (TP / 64) * GH : NCHUNK * GH); u += G) gla::g3_unit(u / GH, u % GH, WSP(bf16_t, WS_Z), PIN(22), PIN(23), WSP(bf16_t, WS_GU), PIN(25), PIN(24), WSP(bf16_t, WS_OC), lds, g_wave);
            float* outp = POUT(); const float* FL = WSP(float, WS_FL);
            if (!att_in_g2) att_section(vcu, G);
            if (kind == 0) {
                const int tid = opaque_tid();
                for (int e = vcu * 512 + tid; e < MT * NH; e += G * 512) { const int h = e / MT, row = e - h * MT; const float v = log_sigmoidf(FL[e]);
                    if (row < TP) outp[O_FLP + (size_t)j * TP * NH + (size_t)row * NH + h] = v; else outp[O_FLS + (size_t)j * TS * NH + (size_t)(row - TP) * NH + h] = v; }
            }
            SEAM(base + 3);
        }
        for (int q = 4; q <= 8; ++q) {
            if (q == 5 || !IN(base + q)) continue;
            if (q == 8) { if (EN(8)) finalize(L, true, L == NLAYER - 1, L + 1 < NLAYER ? (unsigned*)PWS() + CW_FIN + 64 * (2 * L + 2) : nullptr); continue; }
            unsigned char* ws = PWS();
            const bool dn = q == 7;
            float* rssw = WSP(float, WS_RSS) + (dn ? 0 : (size_t)MT * 32);
            const int SP = dn ? 16 : 8;
            if (q == 4 || q == 7) {
                if (EN(7)) {
                const int tid = opaque_tid();
                const int K = dn ? DFF : DM; const char* Ab = dn ? (const char*)WSP(bf16_t, WS_U) : (const char*)WSP(bf16_t, WS_OC);
                const char* Bb = dn ? (const char*)(WSP(bf16_t, WS_WDN) + (size_t)L * DM * DFF) : (const char*)(WSP(bf16_t, WS_WOUT) + (size_t)L * DM * DM);
                pg8::SchedRes S; S.S = SP; S.nu = 16 * SP; S.G = G; S.c = bx; S.ntm = K / 64; S.nts = K / SP / 64; S.A = Ab; S.B = Bb; S.tA = (size_t)256 * K * 2; S.tB = (size_t)256 * K * 2; S.kbytes = (size_t)(K / SP) * 2;
                pg8::EpiResPart E{pg8::EpiRes{(L == 0 && !dn) ? PIN(0) : nullptr, WSP(bf16_t, WS_XB), rssw}, pg8::EpiPart{WSP(float, WS_GU)}};
                pg8::gemm_phase<pg8::EpiResPart, pg8::SchedRes>((LAS unsigned char*)lds_raw, K, K, K, S, E, tid);
                }
            } else {
                if (EN(9)) {
                unsigned* fctr = WSP(unsigned, WS_CTL) + CW_FIN + 64 * (2 * L + 1);
                finalize(L, false, false, fctr);
                const int tid = opaque_tid();
                pg8::Sched S; S.nM = MT / 256; S.nN = DFF / 256; S.nwg = S.nM * S.nN; S.G = G; S.c = bx; S.nextra = 0; S.nt = DM / 64; S.rdy = fctr; S.need = (unsigned)G;
                S.A = (const char*)WSP(bf16_t, WS_XB); S.B = (const char*)(WSP(bf16_t, WS_WUP) + (size_t)L * DFF * DM); S.tA = (size_t)256 * DM * 2; S.tB = (size_t)256 * DM * 2; S.Ae = S.Be = nullptr; S.tAe = S.tBe = 0;
                pg8::EpiUp E{WSP(bf16_t, WS_U), WSP(float, WS_RSS) + (size_t)MT * 32};
                pg8::gemm_phase<pg8::EpiUp, pg8::Sched>((LAS unsigned char*)lds_raw, DM, DM, DM, S, E, tid);
                convert_weights(L, L + 1 < NLAYER ? L + 1 : -1, L + 1 < NLAYER ? 64 : 16, lds, ws, WSP(unsigned, WS_CTL) + CW_CONV + 64 * (L + 1 < NLAYER ? L + 1 : 6), MISC, g_wave);
                }
            }
            SEAM(base + q);
        }
    };
    layer(IC<0>{}); layer(IC<1>{}); layer(IC<2>{}); layer(IC<3>{});
    if (EN(10) && IN(PH_FINAL)) {
        unsigned char* ws = PWS(); float* out = POUT();
        const int tid = opaque_tid(), lane = tid & 63, wave = tid >> 6, gw = vcu * 8 + wave, NGW = G * 8;
        const float* g = PIN(14); const bf16_t* XB = WSP(bf16_t, WS_XB); const float* RSA = WSP(float, WS_RSS);
        for (int m = gw; m < TP; m += NGW) {
            const float rstd = rsqrtf(wave_sum(lane < 32 ? RSA[(size_t)m * 32 + lane] : 0.f) * (1.0f / DM) + RMS_EPS); float* dst = out + O_YP + (size_t)m * DM;
#pragma unroll
            for (int q = 0; q < 8; ++q) { const int o = q * 256 + lane * 4; const u32x2 w = *(const u32x2*)(XB + (size_t)m * DM + o); const f32x4 v = {__uint_as_float(w[0] << 16), __uint_as_float(w[0] & 0xffff0000u), __uint_as_float(w[1] << 16), __uint_as_float(w[1] & 0xffff0000u)}, gg = *(const f32x4*)(g + o);
                __builtin_nontemporal_store(v * rstd * gg, (f32x4*)(dst + o)); }
        }
    }
#ifdef PROBE_TS_A
    if (IN(PH_FINAL)) { GRID_BAR(); if (bx == 0 && opaque_tid() == 0) { const unsigned long long* ts = (const unsigned long long*)((unsigned*)(PWS() + WS_CTL) + CW_TS);
        POUT()[O_YP] = (float)(((ts[PROBE_TS_B + 1] - ts[PROBE_TS_A + 1]) / 2000) * 20 + 10) * 1000.0f; } }
#endif
#undef IN
#undef SEAM
#undef GRID_BAR
}

extern "C" void kernel_launch(void* const* d_in, const int* in_sizes, int n_in, void* d_out, int out_size, void* d_ws, size_t ws_size, hipStream_t stream) {
    static int grid = 0;
    if (grid == 0) {
        if (n_in != 29 || (size_t)out_size != O_END || ws_size < WS_END) { fprintf(stderr, "kernel_launch: unexpected shapes (n_in %d, out %d vs %zu, ws %zu vs %zu); nothing launched\n", n_in, out_size, (size_t)O_END, ws_size, (size_t)WS_END); grid = -1; return; }
        int dev = 0, cus = 0, per_cu = 0;
        if (hipGetDevice(&dev) != hipSuccess || hipDeviceGetAttribute(&cus, hipDeviceAttributeMultiprocessorCount, dev) != hipSuccess) { grid = -1; return; }
        if (hipFuncSetAttribute((const void*)trunk_fwd, hipFuncAttributeMaxDynamicSharedMemorySize, LDS_BYTES) != hipSuccess) { fprintf(stderr, "kernel_launch: hipFuncSetAttribute failed\n"); grid = -1; return; }
        if (hipOccupancyMaxActiveBlocksPerMultiprocessor(&per_cu, (const void*)trunk_fwd, 512, LDS_BYTES) != hipSuccess || per_cu < 1) fprintf(stderr, "kernel_launch: occupancy query reports %d workgroups per CU\n", per_cu);
        (void)hipGetLastError();
        grid = cus;
    }
    if (grid < 0) return;
    if (hipMemsetAsync((char*)d_ws + WS_CTL, 0, CTL_BYTES, stream) != hipSuccess) return;
    Args a{};
    for (int i = 0; i < 29; ++i) a.in[i] = (const float*)d_in[i];
    a.out = (float*)d_out; a.ws = (unsigned char*)d_ws;
#if MK_PER_PHASE
    for (int p = 0; p < PH_END; ++p) {
        if (p >= 1 && p < PH_FINAL) { const int L = (p - 1) / PPL, q = (p - 1) % PPL, kind = L % 3; if ((q == 1 && kind == 0) || (q == 2 && kind != 2) || q == 5) continue; }
        a.ph_lo = p; a.ph_hi = p + 1;
        hipLaunchKernelGGL(trunk_fwd, dim3(grid), dim3(512), LDS_BYTES, stream, a);
#ifdef PROBE_LO
        if (p == PROBE_HI - 1) { (void)hipMemsetAsync((char*)d_ws + WS_CTL + CW_QUEUE * 4, 0, 4 * 64 * 4, stream); }
        if (p == PROBE_HI - 1) for (int pp = PROBE_LO; pp < PROBE_HI; ++pp) { a.ph_lo = pp; a.ph_hi = pp + 1; hipLaunchKernelGGL(trunk_fwd, dim3(grid), dim3(512), LDS_BYTES, stream, a); }
#endif
    }
#else
    a.ph_lo = 0; a.ph_hi = PH_END;
    hipLaunchKernelGGL(trunk_fwd, dim3(grid), dim3(512), LDS_BYTES, stream, a);
#endif
}
```
